# Optimizing an MI355X kernel written in HIP

```python
import math
import jax, jax.numpy as jnp
from jax import lax
import numpy as np

D_MODEL = 2048
BATCH = 2
SEQ = 8192
DEPTH = 4

N_EVEN = (DEPTH + 1) // 2
N_ODD = DEPTH // 2

S5_WIDTH = D_MODEL // 2
S5_GROUP = 16
S5_GROUPS = S5_WIDTH // S5_GROUP
S5_STATE = 64
DIFF_WIDTH = D_MODEL // 2
DIFF_HEAD_DIM = 128
DIFF_VDIM = 2 * DIFF_HEAD_DIM
DIFF_HEADS = DIFF_WIDTH // DIFF_VDIM

C_HEAD_DIM = 128
C_HEADS = D_MODEL // C_HEAD_DIM
DILATED_BRANCHES = ((128, 1), (512, 4), (2048, 16))

MEM_LEN = 256
XA_HEADS = 4
XA_HEAD_DIM = D_MODEL // XA_HEADS

FFN_HIDDEN = -(-8 * D_MODEL // (3 * 256)) * 256

ROPE_THETA = 500000.0
ROPE_DIM = 128 // 4
Q_BLOCK = 128
NORM_EPS = 1e-6
MASK_VALUE = -1e30

kernel_name = 'hybrid_s5_diffattn_dilated_encoder'

f32 = jnp.float32


def rmsnorm(x, g):
    xf = x.astype(f32)
    y = xf * lax.rsqrt(jnp.mean(xf * xf, axis=-1, keepdims=True) + NORM_EPS)
    return (y * g.astype(f32)).astype(x.dtype)


def rope_tables(seq):
    pos = jnp.arange(seq, dtype=f32)
    inv = ROPE_THETA ** (-jnp.arange(0, ROPE_DIM, 2, dtype=f32) / ROPE_DIM)
    ang = pos[:, None] * inv[None, :]
    return jnp.cos(ang), jnp.sin(ang)


def apply_partial_rope(t, cos, sin):
    seq = t.shape[1]
    bshape = (1, seq) + (1,) * (t.ndim - 3) + (ROPE_DIM // 2,)
    c = cos.reshape(bshape)
    s = sin.reshape(bshape)
    tf = t.astype(f32)
    x1 = tf[..., :ROPE_DIM // 2]
    x2 = tf[..., ROPE_DIM // 2:ROPE_DIM]
    out = jnp.concatenate([x1 * c - x2 * s, x2 * c + x1 * s, tf[..., ROPE_DIM:]], axis=-1)
    return out.astype(t.dtype)


def _ssm_combine(e1, e2):
    a1, b1 = e1
    a2, b2 = e2
    return a1 * a2, a2 * b1 + b2


def s5_mixer(u, lam_re, lam_im, log_step, b_re, b_im, c_re, c_im, d_skip, glu_w, glu_b):
    bsz, seq, _ = u.shape
    uf = u.astype(f32)
    ug = uf.reshape(bsz, seq, S5_GROUPS, S5_GROUP)
    lam = lax.complex(lam_re.astype(f32), lam_im.astype(f32))
    step = jnp.exp(log_step.astype(f32))[..., None]
    lam_bar = jnp.exp(lam * step)
    bmat = lax.complex(b_re.astype(f32), b_im.astype(f32))
    b_bar = ((lam_bar - 1.0) / lam)[..., None] * bmat
    cmat = lax.complex(c_re.astype(f32), c_im.astype(f32))
    y = ug * d_skip.astype(f32).reshape(S5_GROUPS, S5_GROUP)
    for direction in (0, 1):
        bu = jnp.einsum('bsgn,gpn->bsgp', ug, b_bar[direction])
        a = jnp.broadcast_to(lam_bar[direction], bu.shape)
        _, state = lax.associative_scan(_ssm_combine, (a, bu), reverse=(direction == 1), axis=1)
        y = y + jnp.einsum('bsgp,gnp->bsgn', state, cmat[direction]).real
    y = y.reshape(bsz, seq, S5_WIDTH)
    g = jax.nn.gelu(y)
    out = g * jax.nn.sigmoid(g @ glu_w.astype(f32) + glu_b.astype(f32))
    return out.astype(u.dtype)


def differential_attention(q, k, v, lam_vec, subln_g, lambda_init, cos, sin):
    bsz, seq, _ = q.shape
    H, dh = DIFF_HEADS, DIFF_HEAD_DIM
    q = apply_partial_rope(q.reshape(bsz, seq, H, 2, dh), cos, sin)
    k = apply_partial_rope(k.reshape(bsz, seq, H, 2, dh), cos, sin)
    v = v.reshape(bsz, seq, H, DIFF_VDIM)
    lv = lam_vec.astype(f32)
    lam = jnp.exp(jnp.dot(lv[0], lv[1])) - jnp.exp(jnp.dot(lv[2], lv[3])) + lambda_init
    scale = dh ** -0.5
    nb = seq // Q_BLOCK
    qb = jnp.moveaxis(q.reshape(bsz, nb, Q_BLOCK, H, 2, dh), 1, 0)

    def block(qblk):
        s = jnp.einsum('bqhcd,bkhcd->bhcqk', qblk, k, preferred_element_type=f32) * scale
        p = jax.nn.softmax(s, axis=-1)
        w = p[:, :, 0] - lam * p[:, :, 1]
        return jnp.einsum('bhqk,bkhe->bqhe', w.astype(v.dtype), v, preferred_element_type=f32)

    o = lax.map(block, qb)
    o = jnp.moveaxis(o, 0, 1).reshape(bsz, seq, H, DIFF_VDIM)
    o = rmsnorm(o, subln_g) * (1.0 - lambda_init)
    return o.reshape(bsz, seq, DIFF_WIDTH).astype(v.dtype)


def even_mixer(hn, w_in, w_out, lam_re, lam_im, log_step, b_re, b_im, c_re, c_im,
               d_skip, glu_w, glu_b, lam_vec, subln_g, lambda_init, cos, sin):
    proj = hn @ w_in
    u, q, k, v = jnp.split(proj, [S5_WIDTH, S5_WIDTH + DIFF_WIDTH, S5_WIDTH + 2 * DIFF_WIDTH], axis=-1)
    y_s5 = s5_mixer(u, lam_re, lam_im, log_step, b_re, b_im, c_re, c_im, d_skip, glu_w, glu_b)
    y_diff = differential_attention(q, k, v, lam_vec, subln_g, lambda_init, cos, sin)
    return jnp.concatenate([y_s5.astype(hn.dtype), y_diff.astype(hn.dtype)], axis=-1) @ w_out


def dilated_window_branch(q, k, v, dil, half):
    bsz, seq, H, dh = q.shape
    M = seq // dil
    nb = -(-M // Q_BLOCK)
    Mp = nb * Q_BLOCK
    qs = q.reshape(bsz, M, dil, H, dh)
    ks = k.reshape(bsz, M, dil, H, dh)
    vs = v.reshape(bsz, M, dil, H, dh)
    qp = jnp.pad(qs, ((0, 0), (0, Mp - M), (0, 0), (0, 0), (0, 0)))
    kpad = ((0, 0), (half, Mp - M + Q_BLOCK - half), (0, 0), (0, 0), (0, 0))
    kp = jnp.pad(ks, kpad).reshape(bsz, nb + 1, Q_BLOCK, dil, H, dh)
    vp = jnp.pad(vs, kpad).reshape(bsz, nb + 1, Q_BLOCK, dil, H, dh)
    kslab = jnp.concatenate([kp[:, :-1], kp[:, 1:]], axis=2)
    vslab = jnp.concatenate([vp[:, :-1], vp[:, 1:]], axis=2)
    qb = qp.reshape(bsz, nb, Q_BLOCK, dil, H, dh)
    s = jnp.einsum('bnqrhd,bnkrhd->bnrhqk', qb, kslab, preferred_element_type=f32) * (dh ** -0.5)
    i = jnp.arange(Q_BLOCK)[:, None]
    t = jnp.arange(2 * Q_BLOCK)[None, :]
    offset = t - half - i
    kpos = jnp.arange(nb)[:, None, None] * Q_BLOCK + t[None] - half
    valid = (jnp.abs(offset) <= half)[None] & (kpos >= 0) & (kpos < M)
    s = jnp.where(valid[None, :, None, None], s, MASK_VALUE)
    m = jnp.max(s, axis=-1, keepdims=True)
    e = jnp.exp(s - m)
    den = jnp.sum(e, axis=-1, keepdims=True)
    o = jnp.einsum('bnrhqk,bnkrhd->bnqrhd', (e / den).astype(v.dtype), vslab, preferred_element_type=f32)
    lse = (m + jnp.log(den))[..., 0]
    o = o.reshape(bsz, Mp, dil, H, dh)[:, :M].reshape(bsz, seq, H, dh)
    lse = jnp.moveaxis(lse, -1, 2).reshape(bsz, Mp, dil, H)[:, :M].reshape(bsz, seq, H)
    return o, lse


def odd_mixer(hn, w_qkv, w_out, cos, sin):
    bsz, seq, _ = hn.shape
    qkv = (hn @ w_qkv).reshape(bsz, seq, 3, C_HEADS, C_HEAD_DIM)
    q = apply_partial_rope(qkv[:, :, 0], cos, sin)
    k = apply_partial_rope(qkv[:, :, 1], cos, sin)
    v = qkv[:, :, 2]
    outs, lses = [], []
    for window, dil in DILATED_BRANCHES:
        o, lse = dilated_window_branch(q, k, v, dil, window // (2 * dil))
        outs.append(o)
        lses.append(lse)
    alpha = jax.nn.softmax(jnp.stack(lses, axis=0), axis=0)
    o = jnp.sum(alpha[..., None] * jnp.stack(outs, axis=0), axis=0)
    return o.reshape(bsz, seq, D_MODEL).astype(hn.dtype) @ w_out


def memory_cross_attention(hn, mem_n, wq, wkv, wo):
    bsz, seq, _ = hn.shape
    q = (hn @ wq).reshape(bsz, seq, XA_HEADS, XA_HEAD_DIM)
    kv = (mem_n @ wkv).reshape(bsz, mem_n.shape[1], 2, XA_HEADS, XA_HEAD_DIM)
    s = jnp.einsum('bqhd,bkhd->bhqk', q, kv[:, :, 0], preferred_element_type=f32) * (XA_HEAD_DIM ** -0.5)
    p = jax.nn.softmax(s, axis=-1)
    o = jnp.einsum('bhqk,bkhd->bqhd', p.astype(hn.dtype), kv[:, :, 1])
    return o.reshape(bsz, seq, D_MODEL) @ wo


def swiglu(hn, w13, w2):
    a, b = jnp.split(hn @ w13, 2, axis=-1)
    return (jax.nn.silu(a) * b) @ w2


def setup_inputs(seed: int = 0) -> dict:
    key = jax.random.key(seed)
    keys = iter(jax.random.split(key, 40))
    D, G, P, N = D_MODEL, S5_GROUPS, S5_STATE, S5_GROUP

    def nrm(shape, scale):
        return jax.random.normal(next(keys), shape, f32) * scale

    def gain(shape):
        return 1.0 + nrm(shape, 0.02)

    n_idx = jnp.arange(P, dtype=f32)
    inp = {}
    inp['x'] = nrm((BATCH, SEQ, D), 1.0)
    inp['mem'] = nrm((BATCH, MEM_LEN, D), 1.0)
    inp['norm_mix_g'] = gain((DEPTH, D))
    inp['norm_xa_g'] = gain((DEPTH, D))
    inp['norm_mem_g'] = gain((DEPTH, D))
    inp['xa_wq'] = nrm((DEPTH, D, D), D ** -0.5)
    inp['xa_wkv'] = nrm((DEPTH, D, 2 * D), D ** -0.5)
    inp['xa_wo'] = nrm((DEPTH, D, D), D ** -0.5)
    inp['norm_ffn_g'] = gain((DEPTH, D))
    inp['ffn_w13'] = nrm((DEPTH, D, 2 * FFN_HIDDEN), D ** -0.5)
    inp['ffn_w2'] = nrm((DEPTH, FFN_HIDDEN, D), FFN_HIDDEN ** -0.5)
    inp['ab_w_in'] = nrm((N_EVEN, D, S5_WIDTH + 3 * DIFF_WIDTH), D ** -0.5)
    inp['ab_w_out'] = nrm((N_EVEN, S5_WIDTH + DIFF_WIDTH, D), (S5_WIDTH + DIFF_WIDTH) ** -0.5)
    inp['s5_lambda_re'] = -0.5 + nrm((N_EVEN, 2, G, P), 0.01)
    inp['s5_lambda_im'] = math.pi * n_idx + nrm((N_EVEN, 2, G, P), 0.01)
    inp['s5_log_step'] = jax.random.uniform(next(keys), (N_EVEN, 2, G), f32, math.log(1e-3), math.log(1e-1))
    inp['s5_b_re'] = nrm((N_EVEN, 2, G, P, N), (2 * N) ** -0.5)
    inp['s5_b_im'] = nrm((N_EVEN, 2, G, P, N), (2 * N) ** -0.5)
    inp['s5_c_re'] = nrm((N_EVEN, 2, G, N, P), 2.0 * (2 * P) ** -0.5)
    inp['s5_c_im'] = nrm((N_EVEN, 2, G, N, P), 2.0 * (2 * P) ** -0.5)
    inp['s5_d'] = nrm((N_EVEN, S5_WIDTH), 1.0)
    inp['s5_glu_w'] = nrm((N_EVEN, S5_WIDTH, S5_WIDTH), S5_WIDTH ** -0.5)
    inp['s5_glu_b'] = nrm((N_EVEN, S5_WIDTH), 0.02)
    inp['diff_lambda'] = nrm((N_EVEN, 4, DIFF_HEAD_DIM), 0.1)
    inp['diff_subln_g'] = gain((N_EVEN, DIFF_VDIM))
    inp['c_w_qkv'] = nrm((N_ODD, D, 3 * D), D ** -0.5)
    inp['c_w_out'] = nrm((N_ODD, D, D), D ** -0.5)
    inp['final_norm_g'] = gain((D,))
    return inp


def reference(x, mem, norm_mix_g, norm_xa_g, norm_mem_g, xa_wq, xa_wkv, xa_wo, norm_ffn_g,
              ffn_w13, ffn_w2, ab_w_in, ab_w_out, s5_lambda_re, s5_lambda_im, s5_log_step,
              s5_b_re, s5_b_im, s5_c_re, s5_c_im, s5_d, s5_glu_w, s5_glu_b, diff_lambda,
              diff_subln_g, c_w_qkv, c_w_out, final_norm_g):
    cos, sin = rope_tables(x.shape[1])
    h = x
    for layer in range(DEPTH):
        i = layer // 2
        hn = rmsnorm(h, norm_mix_g[layer])
        if layer % 2 == 0:
            lambda_init = 0.8 - 0.6 * math.exp(-0.3 * layer)
            mix = even_mixer(hn, ab_w_in[i], ab_w_out[i], s5_lambda_re[i], s5_lambda_im[i],
                             s5_log_step[i], s5_b_re[i], s5_b_im[i], s5_c_re[i], s5_c_im[i],
                             s5_d[i], s5_glu_w[i], s5_glu_b[i], diff_lambda[i], diff_subln_g[i],
                             lambda_init, cos, sin)
        else:
            mix = odd_mixer(hn, c_w_qkv[i], c_w_out[i], cos, sin)
        h = h + mix
        h = h + memory_cross_attention(rmsnorm(h, norm_xa_g[layer]), rmsnorm(mem, norm_mem_g[layer]),
                                       xa_wq[layer], xa_wkv[layer], xa_wo[layer])
        h = h + swiglu(rmsnorm(h, norm_ffn_g[layer]), ffn_w13[layer], ffn_w2[layer])
    return rmsnorm(h, final_norm_g)
```

```cpp
#include <hip/hip_runtime.h>
#include <cstdio>
#include <cstdint>

#define LAS __attribute__((address_space(3)))
typedef unsigned short bf16_t;
typedef short bf16x8 __attribute__((ext_vector_type(8)));
typedef short s16x4 __attribute__((ext_vector_type(4)));
typedef float f32x2 __attribute__((ext_vector_type(2)));
typedef float f32x4 __attribute__((ext_vector_type(4)));
typedef float f32x8 __attribute__((ext_vector_type(8)));
typedef float f32x16 __attribute__((ext_vector_type(16)));
typedef unsigned u32x2 __attribute__((ext_vector_type(2)));
typedef unsigned u32x4 __attribute__((ext_vector_type(4)));

constexpr int BATCH = 2, SEQ = 8192, DM = 2048, MTOK = BATCH * SEQ, DEPTH = 4, FFN = 5632, MEML = 256;
constexpr float NORM_EPS = 1e-6f;
constexpr int S5L = 32, S5KT = 768, S5NCH = MTOK / S5L;

constexpr size_t MiB = 1u << 20;
constexpr size_t WS_CTL = 0, CTL_BYTES = 65536;
constexpr size_t WS_ROPE = 1 * MiB;
constexpr size_t WS_LP = 2 * MiB;
constexpr size_t WS_BBAR = 7 * MiB;
constexpr size_t WS_KTAB = 9 * MiB;
constexpr size_t WS_MEMN = 17 * MiB;
constexpr size_t WS_W_IN = 20 * MiB;
constexpr size_t WS_W_ABO = WS_W_IN + 32 * MiB;
constexpr size_t WS_W_GLU = WS_W_ABO + 16 * MiB;
constexpr size_t WS_W_QKV = WS_W_GLU + 4 * MiB;
constexpr size_t WS_W_CO = WS_W_QKV + 48 * MiB;
constexpr size_t WS_W13 = WS_W_CO + 16 * MiB;
constexpr size_t WS_W2 = WS_W13 + 176 * MiB;
constexpr size_t WS_WQK = WS_W2 + 88 * MiB;
constexpr size_t WS_VWO = WS_WQK + 32 * MiB;
constexpr size_t WS_BTT = WS_VWO + 32 * MiB;
constexpr size_t WS_BTE = WS_BTT + 96 * MiB;
constexpr size_t WS_HID = WS_BTE + 32 * MiB;
constexpr size_t WS_H = WS_HID;
constexpr size_t WS_HB = WS_HID + 176 * MiB;
constexpr size_t WS_CAT = WS_HB + 64 * MiB;
constexpr size_t WS_XP = WS_CAT + 64 * MiB;
constexpr size_t WS_R1 = WS_XP + 32 * MiB;
constexpr size_t WS_R2 = WS_R1 + 192 * MiB;
constexpr size_t WS_RSSP = WS_R2 + 196 * MiB;
constexpr size_t WS_END = WS_RSSP + 26 * MiB;
constexpr size_t WS_QKVO = WS_R1;
constexpr size_t WS_U2 = WS_R1;
constexpr size_t WS_QKVE = WS_R1 + 48 * MiB;
constexpr size_t WS_WKV_T = WS_R1;
constexpr size_t WS_WQ_B = WS_R1 + 64 * MiB;
constexpr size_t WS_WO_T = WS_R1 + 96 * MiB;
constexpr size_t WS_KVALL = WS_R1 + 128 * MiB;
constexpr size_t WS_OB = WS_R2;
constexpr size_t WS_LSE = WS_R2 + 192 * MiB;
constexpr size_t WS_O12 = WS_R2;
constexpr size_t WS_E = WS_R2 + 64 * MiB;
constexpr size_t WS_G = WS_R2 + 96 * MiB;

constexpr int LDS_STAGE = 131072;
constexpr int LDS_EPI = LDS_STAGE;
constexpr int LDS_MISC = LDS_STAGE + 8192;
constexpr int LDS_RSTD = LDS_MISC + 256;
constexpr int LDS_BYTES = 147456;

__device__ __forceinline__ unsigned f2bf(float f) { unsigned u = __builtin_bit_cast(unsigned, f); return (u + 0x7fffu + ((u >> 16) & 1u)) >> 16; }
__device__ __forceinline__ float bf2f(unsigned h) { return __builtin_bit_cast(float, h << 16); }
__device__ __forceinline__ unsigned cvt_pk_bf16(float lo, float hi) { unsigned r; asm volatile("v_cvt_pk_bf16_f32 %0, %1, %2" : "=v"(r) : "v"(lo), "v"(hi)); return r; }
__device__ __forceinline__ u32x2 pack4(f32x4 v) { u32x2 w; w.x = cvt_pk_bf16(v[0], v[1]); w.y = cvt_pk_bf16(v[2], v[3]); return w; }
template <int CTRL> __device__ __forceinline__ float dpp_f(float x) { return __builtin_bit_cast(float, __builtin_amdgcn_update_dpp(0, __builtin_bit_cast(int, x), CTRL, 0xf, 0xf, true)); }
__device__ __forceinline__ float wave_sum(float v) {
    v += dpp_f<0xB1>(v); v += dpp_f<0x4E>(v); v += dpp_f<0x141>(v); v += dpp_f<0x128>(v);
    auto s = __builtin_amdgcn_permlane16_swap(__float_as_uint(v), __float_as_uint(v), false, false); v = __uint_as_float(s[0]) + __uint_as_float(s[1]);
    auto u = __builtin_amdgcn_permlane32_swap(__float_as_uint(v), __float_as_uint(v), false, false); return __uint_as_float(u[0]) + __uint_as_float(u[1]);
}
__device__ __forceinline__ float x16_sum(float x) {
    auto s = __builtin_amdgcn_permlane16_swap(__float_as_uint(x), __float_as_uint(x), false, false); x = __uint_as_float(s[0]) + __uint_as_float(s[1]);
    auto u = __builtin_amdgcn_permlane32_swap(__float_as_uint(x), __float_as_uint(x), false, false); return __uint_as_float(u[0]) + __uint_as_float(u[1]);
}
__device__ __forceinline__ float x16_max(float x) {
    auto s = __builtin_amdgcn_permlane16_swap(__float_as_uint(x), __float_as_uint(x), false, false); x = fmaxf(__uint_as_float(s[0]), __uint_as_float(s[1]));
    auto u = __builtin_amdgcn_permlane32_swap(__float_as_uint(x), __float_as_uint(x), false, false); return fmaxf(__uint_as_float(u[0]), __uint_as_float(u[1]));
}
__device__ __forceinline__ float row_rstd(const float* rssp, int row, int fq) {
    const f32x4 a = *(const f32x4*)(rssp + (size_t)row * 32 + fq * 8), b = *(const f32x4*)(rssp + (size_t)row * 32 + fq * 8 + 4);
    float s = ((a[0] + a[1]) + (a[2] + a[3])) + ((b[0] + b[1]) + (b[2] + b[3]));
    s += __shfl_xor(s, 16); s += __shfl_xor(s, 32);
    return 1.0f / sqrtf(s * (1.0f / DM) + NORM_EPS);
}
__device__ __forceinline__ void fill_rstd_tab(const float* rssp, int pm, LAS float* tab) {
    int t = threadIdx.x; asm volatile("" : "+v"(t));
    if (t < 256) { const f32x4* p = (const f32x4*)(rssp + ((size_t)pm * 256 + t) * 32); float s = 0.f;
#pragma unroll
        for (int j = 0; j < 8; ++j) { const f32x4 a = p[j]; s += (a[0] + a[1]) + (a[2] + a[3]); }
        tab[t] = __builtin_amdgcn_rsqf(s * (1.0f / DM) + NORM_EPS); }
}
#define LDS_WAIT() asm volatile("s_waitcnt lgkmcnt(0)" ::: "memory")
#define VM_WAIT() asm volatile("s_waitcnt vmcnt(0)" ::: "memory")

#define XB_TMO      128
#define XB_XCNT(j)  (256  + 64 * (j))
#define XB_XSUB(j)  (1280 + 64 * (j))
#define XB_XGEN(j)  (2304 + 64 * (j))
#define XB_TOP      3328
#define XB_TOPGEN   3392
#define XCD_BAR_WORDS 3456
#define XB_SPIN_CAP (1u << 20)

__device__ __forceinline__ unsigned xb_ld(unsigned* p)              { return __hip_atomic_load(p, __ATOMIC_RELAXED, __HIP_MEMORY_SCOPE_AGENT); }
__device__ __forceinline__ unsigned xb_add(unsigned* p, unsigned v) { return __hip_atomic_fetch_add(p, v, __ATOMIC_RELAXED, __HIP_MEMORY_SCOPE_AGENT); }
__device__ __forceinline__ unsigned xb_xcc_id() { return (unsigned)__builtin_amdgcn_s_getreg((3 << 11) | 20) & 0xFu; }
#define XB_SPIN(cond, bar) do { unsigned _sp = 0; while (cond) { __builtin_amdgcn_s_sleep(1); \
    if ((++_sp & 255u) == 0u) { if (xb_ld(&(bar)[XB_TMO])) break; if (_sp > XB_SPIN_CAP) { atomicAdd(&(bar)[XB_TMO], 1u); break; } } } } while (0)

struct XcdBarrier { unsigned* bar; unsigned x; volatile LAS unsigned* st; };

__device__ __forceinline__ XcdBarrier xcd_barrier_post(unsigned* bar, volatile LAS unsigned* st) {
    XcdBarrier b; b.bar = bar; b.x = xb_xcc_id(); b.st = st;
    if (threadIdx.x == 0) (void)xb_add(&bar[XB_XCNT(b.x)], 1u);
    return b;
}
__device__ __forceinline__ void xcd_barrier_complete(unsigned* bar, unsigned x, unsigned& nloc, unsigned& nx) {
    const unsigned G = gridDim.x * gridDim.y * gridDim.z;
    unsigned sum, cnt, mine, sp = 0u;
    for (;;) {
        sum = 0u; cnt = 0u;
#pragma unroll
        for (unsigned j = 0; j < 16; ++j) { const unsigned c = xb_ld(&bar[XB_XCNT(j)]); sum += c; cnt += (c > 0u) ? 1u : 0u; }
        mine = xb_ld(&bar[XB_XCNT(x)]);
        if (sum == G) break;
        __builtin_amdgcn_s_sleep(1);
        if ((++sp & 255u) == 0u) { if (xb_ld(&bar[XB_TMO])) break; if (sp > XB_SPIN_CAP) { atomicAdd(&bar[XB_TMO], 1u); break; } }
    }
    nloc = mine > 0u ? mine : 1u; nx = cnt > 0u ? cnt : 1u;
}
__device__ __forceinline__ void xcd_barrier(const XcdBarrier& b) {
    asm volatile("s_waitcnt vmcnt(0)" ::: "memory");
    __syncthreads();
    if (threadIdx.x == 0) {
        unsigned* bar = b.bar; unsigned bx_ = b.x; asm volatile("" : "+s"(bx_));
        __builtin_amdgcn_s_waitcnt(0);
        unsigned nloc = b.st[0], nx = b.st[1];
        if (nloc == 0u) { xcd_barrier_complete(bar, bx_, nloc, nx); b.st[0] = nloc; b.st[1] = nx; }
        const unsigned old = xb_add(&bar[XB_XSUB(bx_)], 1u);
        const unsigned gen = old / nloc;
        if (old + 1u == (gen + 1u) * nloc) {
            __builtin_amdgcn_fence(__ATOMIC_RELEASE, "agent");
            asm volatile("s_waitcnt vmcnt(0)" ::: "memory");
            const unsigned og = xb_add(&bar[XB_TOP], 1u);
            const unsigned tg = og / nx;
            if (og + 1u == (tg + 1u) * nx) xb_add(&bar[XB_TOPGEN], 1u);
            else XB_SPIN(xb_ld(&bar[XB_TOPGEN]) == tg, bar);
            __builtin_amdgcn_fence(__ATOMIC_ACQUIRE, "agent");
            xb_add(&bar[XB_XGEN(bx_)], 1u);
            asm volatile("s_waitcnt vmcnt(0)" ::: "memory");
        } else {
            XB_SPIN(xb_ld(&bar[XB_XGEN(bx_)]) == gen, bar);
            __builtin_amdgcn_fence(__ATOMIC_ACQUIRE, "agent");
            asm volatile("s_waitcnt vmcnt(0)" ::: "memory");
        }
    }
    __syncthreads();
}

#define GS_XCC_WORD 8192
#define GS_CNT_WORD 9216
__device__ __forceinline__ void group_sync(unsigned* ctl, int gid, unsigned need) {
    asm volatile("s_waitcnt vmcnt(0)" ::: "memory");
    __syncthreads();
    if (threadIdx.x == 0) {
        unsigned* c = ctl + GS_CNT_WORD + 64 * gid;
        (void)xb_add(c, 1u);
        XB_SPIN(xb_ld(c) < need, ctl);
        __builtin_amdgcn_fence(__ATOMIC_ACQUIRE, "agent");
        asm volatile("s_waitcnt vmcnt(0)" ::: "memory");
    }
    __syncthreads();
}

namespace pg8 {
constexpr int BM = 256, BK = 64, HALF = 128, HTB = HALF * BK * 2, STAGE_BYTES = 8 * HTB, NXCD = 8, WGM = 8;
__device__ __forceinline__ int lds_byte(int r, int c) { const int st = (r >> 4) * 2 + (c >> 5), rr = r & 15, cc = c & 31, ob = rr * 64 + cc * 2; return st * 1024 + (ob ^ (((ob >> 9) & 1) << 5)); }
__device__ __forceinline__ void stage_rc(int b, int& R, int& C) { const int st = b / 1024, sb = b % 1024, swz = sb ^ (((sb >> 9) & 1) << 5); R = (st >> 1) * 16 + swz / 64; C = (st & 1) * 32 + (swz % 64) / 2; }

struct Unit { int pm, pn, g; const char* a; const char* b; };

struct DenseOrder {
    int nM, nN, nwg, G, c, pmdiv; const char* A; const char* B; size_t tA, tB, bgroup;
    __device__ __forceinline__ void init(const void* A_, int lda, const void* B_, int ldb, int M, int N, int G_, int c_, int pmdiv_ = 1 << 30, size_t bgroup_ = 0) {
        nM = M / BM; nN = N / BM; nwg = nM * nN; G = G_; c = c_; A = (const char*)A_; B = (const char*)B_; tA = (size_t)BM * lda * 2; tB = (size_t)BM * ldb * 2; pmdiv = pmdiv_; bgroup = bgroup_; }
    __device__ __forceinline__ bool next(int i, Unit& u) const {
        const long L = (long)i * G + c; if (L >= nwg) return false;
        int wgid = (int)L; { const int q = nwg / NXCD, r = nwg % NXCD, xcd = wgid % NXCD, off = wgid / NXCD; wgid = (xcd < r ? xcd * (q + 1) : r * (q + 1) + (xcd - r) * q) + off; }
        const int nig = WGM * nN, gid = wgid / nig, fm = gid * WGM, gsz = (nM - fm) < WGM ? (nM - fm) : WGM;
        u.pm = fm + ((wgid % nig) % gsz); u.pn = (wgid % nig) / gsz; u.g = u.pm / pmdiv;
        u.a = A + (size_t)u.pm * tA; u.b = B + (size_t)u.pn * tB + (size_t)u.g * bgroup; return true;
    }
};

template <class Epi, class Sched>
__device__ __forceinline__ void gemm_phase(LAS unsigned char* lds, const int K, const int lda, const int ldb, const Sched& S, const Epi& E) {
    int tid = threadIdx.x; asm volatile("" : "+v"(tid));
    const int wid = __builtin_amdgcn_readfirstlane(tid >> 6), lane = tid & 63, wr = wid >> 2, wc = wid & 3, fr = lane & 15, fq = lane >> 4;
    const int nt = K / BK;
    unsigned voffA[2], voffB[2];
#pragma unroll
    for (int i = 0; i < 2; ++i) { int R, C; stage_rc(tid * 16 + i * 8192, R, C);
        const int Rb = Epi::PERM ? ((R & ~31) + 8 * ((R & 15) >> 2) + 4 * ((R >> 4) & 1) + (R & 3)) : R;
        voffA[i] = (unsigned)(R * lda + C) * 2u; voffB[i] = (unsigned)(Rb * ldb + C) * 2u; }
    const size_t kstep = (size_t)(BK * 2);
    const size_t hstepA = (size_t)HALF * lda * 2, hstepB = (size_t)HALF * ldb * 2;
    const unsigned ldsw = (unsigned)wid * 1024u;
    const int aoff = lds_byte(wr * 64 + fr, fq * 8), boff = lds_byte(wc * 32 + fr, fq * 8);
#define PG8_SA(b, h) (((b) * 2 + (h)) * HTB)
#define PG8_SB(b, h) ((4 + (b) * 2 + (h)) * HTB)
#ifndef PG8_AUX_A
#define PG8_AUX_A 0
#endif
#ifndef PG8_AUX_B
#define PG8_AUX_B 0
#endif
#define PG8_STAGE_X(bufoff, gbase, voff, AUX) do { _Pragma("unroll") for (int _i = 0; _i < 2; ++_i) \
        __builtin_amdgcn_global_load_lds((const unsigned*)((const char*)(gbase) + (voff)[_i]), (LAS unsigned*)(lds + (bufoff) + ldsw + _i * 8192), 16, 0, AUX); } while (0)
#define PG8_STAGE_voffA(bufoff, gbase) PG8_STAGE_X(bufoff, gbase, voffA, PG8_AUX_A)
#define PG8_STAGE_voffB(bufoff, gbase) PG8_STAGE_X(bufoff, gbase, voffB, PG8_AUX_B)
#define PG8_STAGE(bufoff, gbase, voff) PG8_STAGE_##voff(bufoff, gbase)
#define PG8_LDA(dst, b, h) do { _Pragma("unroll") for (int m = 0; m < 4; ++m) _Pragma("unroll") for (int k = 0; k < 2; ++k) dst[m][k] = *(const LAS bf16x8*)(lds + PG8_SA(b, h) + aoff + m * 2048 + k * 1024); } while (0)
#define PG8_LDB(dst, b, h) do { _Pragma("unroll") for (int n = 0; n < 2; ++n) _Pragma("unroll") for (int k = 0; k < 2; ++k) dst[n][k] = *(const LAS bf16x8*)(lds + PG8_SB(b, h) + boff + n * 2048 + k * 1024); } while (0)
#define PG8_MMA(ai, bj, At, Bt) do { __builtin_amdgcn_s_setprio(1); _Pragma("unroll") for (int m = 0; m < 4; ++m) _Pragma("unroll") for (int n = 0; n < 2; ++n) _Pragma("unroll") for (int k = 0; k < 2; ++k) \
        acc[ai][bj][m][n] = __builtin_amdgcn_mfma_f32_16x16x32_bf16(Bt[n][k], At[m][k], acc[ai][bj][m][n], 0, 0, 0); __builtin_amdgcn_s_setprio(0); } while (0)
#define PG8_WAIT_V(n) asm volatile("s_waitcnt vmcnt(" #n ")" ::: "memory")
#define PG8_WAIT_L(n) asm volatile("s_waitcnt lgkmcnt(" #n ")" ::: "memory")
#define PG8_BAR __builtin_amdgcn_s_barrier()
#define PG8_SCHED __builtin_amdgcn_sched_barrier(0)
    Unit cur, nxt; int ui = 0;
    if (!S.next(0, cur)) return;
    f32x4 acc[2][2][4][2];
#pragma unroll
    for (int a = 0; a < 2; ++a)
#pragma unroll
        for (int b = 0; b < 2; ++b)
#pragma unroll
            for (int m = 0; m < 4; ++m)
#pragma unroll
                for (int n = 0; n < 2; ++n) acc[a][b][m][n] = (f32x4){0.f, 0.f, 0.f, 0.f};
    bf16x8 At[4][2], B0[2][2], B1[2][2];
    const char* cA = cur.a; const char* cB = cur.b;
    PG8_STAGE(PG8_SB(0, 0), cB, voffB); PG8_STAGE(PG8_SA(0, 0), cA, voffA); PG8_STAGE(PG8_SB(0, 1), cB + hstepB, voffB); PG8_STAGE(PG8_SA(0, 1), cA + hstepA, voffA);
    if (wr == 1) PG8_BAR;
    PG8_WAIT_V(4); PG8_BAR;
    PG8_STAGE(PG8_SB(1, 0), cB + kstep, voffB); PG8_STAGE(PG8_SA(1, 0), cA + kstep, voffA); PG8_STAGE(PG8_SB(1, 1), cB + hstepB + kstep, voffB);
    PG8_WAIT_V(6); PG8_BAR;
    for (;;) {
        const bool has_next = S.next(ui + 1, nxt);
        const char* nA = has_next ? nxt.a : cA; const char* nB = has_next ? nxt.b : cB;
#if defined(KREP_DIAG)
        const int nt_eff = Epi::REPEATABLE ? 2 * nt : nt;
#else
        const int nt_eff = nt;
#endif
        for (int tt = 0; tt < nt_eff; tt += 2) {
            const bool last = (tt == nt_eff - 2);
            const int t = tt >= nt ? tt - nt : tt, t2 = (tt + 2 >= nt && tt + 2 < nt_eff) ? tt + 2 - nt : tt + 2;
            const char* a1 = cA + (size_t)(t + 1) * kstep;
            const char* a2 = last ? nA : cA + (size_t)t2 * kstep; const char* b2 = last ? nB : cB + (size_t)t2 * kstep;
            const char* a3 = a2 + kstep; const char* b3 = b2 + kstep;
            PG8_LDB(B0, 0, 0); PG8_SCHED; PG8_LDA(At, 0, 0); PG8_STAGE(PG8_SA(1, 1), a1 + hstepA, voffA);
            PG8_WAIT_L(8); PG8_BAR; PG8_WAIT_L(0); PG8_MMA(0, 0, At, B0); PG8_BAR; PG8_SCHED;
            PG8_LDB(B1, 0, 1); PG8_STAGE(PG8_SB(0, 0), b2, voffB);
            PG8_BAR; PG8_WAIT_L(0); PG8_MMA(0, 1, At, B1); PG8_BAR;
            PG8_LDA(At, 0, 1); PG8_STAGE(PG8_SA(0, 0), a2, voffA);
            PG8_BAR; PG8_WAIT_L(0); PG8_MMA(1, 0, At, B0); PG8_BAR; PG8_SCHED;
            PG8_STAGE(PG8_SB(0, 1), b2 + hstepB, voffB);
            PG8_WAIT_V(6); PG8_BAR; PG8_MMA(1, 1, At, B1); PG8_BAR;
            PG8_LDB(B0, 1, 0); PG8_SCHED; PG8_LDA(At, 1, 0); PG8_STAGE(PG8_SA(0, 1), a2 + hstepA, voffA);
            PG8_WAIT_L(8); PG8_BAR; PG8_WAIT_L(0); PG8_MMA(0, 0, At, B0); PG8_BAR; PG8_SCHED;
            PG8_LDB(B1, 1, 1); PG8_STAGE(PG8_SB(1, 0), b3, voffB);
            PG8_BAR; PG8_WAIT_L(0); PG8_MMA(0, 1, At, B1); PG8_BAR;
            PG8_LDA(At, 1, 1); PG8_STAGE(PG8_SA(1, 0), a3, voffA);
            PG8_BAR; PG8_WAIT_L(0); PG8_MMA(1, 0, At, B0); PG8_BAR; PG8_SCHED;
            PG8_STAGE(PG8_SB(1, 1), b3 + hstepB, voffB);
            PG8_WAIT_V(6); PG8_BAR; PG8_MMA(1, 1, At, B1); PG8_BAR;
        }
        E(acc, cur, wr, wc, fr, fq);
#if defined(REP_EPI)
        if constexpr (Epi::REPEATABLE) { asm volatile("" ::: "memory"); Epi E2 = E; E2.dry = true; E2(acc, cur, wr, wc, fr, fq); }
#endif
        if (!has_next) break;
#pragma unroll
        for (int a = 0; a < 2; ++a)
#pragma unroll
            for (int b = 0; b < 2; ++b)
#pragma unroll
                for (int m = 0; m < 4; ++m)
#pragma unroll
                    for (int n = 0; n < 2; ++n) acc[a][b][m][n] = (f32x4){0.f, 0.f, 0.f, 0.f};
        cur = nxt; cA = nA; cB = nB; ++ui;
    }
    PG8_WAIT_V(0);
    if (wr == 0) PG8_BAR;
    PG8_BAR;
#undef PG8_SA
#undef PG8_SB
#undef PG8_STAGE
#undef PG8_STAGE_X
#undef PG8_STAGE_voffA
#undef PG8_STAGE_voffB
#undef PG8_LDA
#undef PG8_LDB
#undef PG8_MMA
#undef PG8_WAIT_V
#undef PG8_WAIT_L
#undef PG8_BAR
#undef PG8_SCHED
}
}

typedef f32x4 acc_t[2][2][4][2];
#define EPI_ROWS(ai, m) _Pragma("unroll") for (int ai = 0; ai < 2; ++ai) _Pragma("unroll") for (int m = 0; m < 4; ++m)
#define EPI_COLS(bj, n) _Pragma("unroll") for (int bj = 0; bj < 2; ++bj) _Pragma("unroll") for (int n = 0; n < 2; ++n)

struct EpiBf16Plain {
    static constexpr bool REPEATABLE = false; static constexpr bool PERM = false;
    bf16_t* O; int ldo; const float* colscale; float scale;
    __device__ __forceinline__ void operator()(acc_t& acc, const pg8::Unit& u, int wr, int wc, int fr, int fq) const {
        const int row0 = u.pm * 256 + wr * 64 + fr, col0 = u.pn * 256 + wc * 32 + 4 * fq;
        f32x4 cs[2][2];
        EPI_COLS(bj, n) { cs[bj][n] = colscale ? *(const f32x4*)(colscale + col0 + bj * 128 + n * 16) * scale : (f32x4){scale, scale, scale, scale}; }
        EPI_ROWS(ai, m) { bf16_t* rowp = O + (size_t)(row0 + ai * 128 + m * 16) * ldo + col0;
            EPI_COLS(bj, n) { *(u32x2*)(rowp + bj * 128 + n * 16) = pack4(acc[ai][bj][m][n] * cs[bj][n]); } }
    }
};
struct EpiWqK {
    static constexpr bool REPEATABLE = false; static constexpr bool PERM = false;
    bf16_t* O; const float* gain;
    __device__ __forceinline__ void operator()(acc_t& acc, const pg8::Unit& u, int wr, int wc, int fr, int fq) const {
        const int l = u.g >> 3, lb = u.g >> 2, h = u.g & 3;
        const int row0 = wr * 64 + fr, col0 = u.pn * 256 + wc * 32 + 4 * fq;
        bf16_t* base = O + ((size_t)lb * 1024 + h * 256) * 2048;
        const float* gl = gain + l * 2048;
        f32x4 cs[2][2];
        EPI_COLS(bj, n) { cs[bj][n] = *(const f32x4*)(gl + col0 + bj * 128 + n * 16) * 0.04419417382415922f; }
        EPI_ROWS(ai, m) { bf16_t* rowp = base + (size_t)(row0 + ai * 128 + m * 16) * 2048 + col0;
            EPI_COLS(bj, n) { *(u32x2*)(rowp + bj * 128 + n * 16) = pack4(acc[ai][bj][m][n] * cs[bj][n]); } }
    }
};
struct EpiVWo {
    static constexpr bool REPEATABLE = false; static constexpr bool PERM = false;
    bf16_t* O;
    __device__ __forceinline__ void operator()(acc_t& acc, const pg8::Unit& u, int wr, int wc, int fr, int fq) const {
        const int lb = u.g >> 2, h = u.g & 3;
        const int row0 = u.pm * 256 + wr * 64 + fr, col0 = h * 256 + wc * 32 + 4 * fq;
        bf16_t* base = O + (size_t)lb * 2048 * 1024;
        EPI_ROWS(ai, m) { bf16_t* rowp = base + (size_t)(row0 + ai * 128 + m * 16) * 1024 + col0;
            EPI_COLS(bj, n) { *(u32x2*)(rowp + bj * 128 + n * 16) = pack4(acc[ai][bj][m][n]); } }
    }
};
struct EpiF32 {
    static constexpr bool REPEATABLE = false; static constexpr bool PERM = false;
    float* C; int ldc;
    __device__ __forceinline__ void operator()(acc_t& acc, const pg8::Unit& u, int wr, int wc, int fr, int fq) const {
        const int row0 = u.pm * 256 + wr * 64 + fr, col0 = u.pn * 256 + wc * 32 + 4 * fq;
        EPI_ROWS(ai, m) { float* rowp = C + (size_t)(row0 + ai * 128 + m * 16) * ldc + col0;
            EPI_COLS(bj, n) { *(f32x4*)(rowp + bj * 128 + n * 16) = acc[ai][bj][m][n]; } }
    }
};
struct EpiProj {
    static constexpr bool REPEATABLE = false; static constexpr bool PERM = false;
    LAS const float* rstd_tab; const float* rc; const float* rs; bf16_t* O; int ldo; bf16_t* U2; int u_tiles, rope_lo, rope_hi;
    __device__ __forceinline__ void operator()(acc_t& acc, const pg8::Unit& u, int wr, int wc, int fr, int fq) const {
        const int row0 = u.pm * 256 + wr * 64 + fr;
        const bool is_u = u.pn < u_tiles, rope = (u.pn >= rope_lo) && (u.pn < rope_hi) && (wc == 0);
        EPI_ROWS(ai, m) {
            const int row = row0 + ai * 128 + m * 16;
            const float rstd = rstd_tab[ai * 128 + wr * 64 + m * 16 + fr];
            f32x4 v[2][2];
            EPI_COLS(bj, n) { v[bj][n] = acc[ai][bj][m][n] * rstd; }
            if (rope) {
                const int pos = row & (SEQ - 1);
#if defined(ROPE_TABLE)
                const f32x4 c = *(const f32x4*)(rc + pos * 16 + 4 * fq), s = *(const f32x4*)(rs + pos * 16 + 4 * fq);
#else
                f32x4 c, s;
#pragma unroll
                for (int e = 0; e < 4; ++e) { const float invrev = __builtin_amdgcn_exp2f(-1.1832230355827609f * (float)(4 * fq + e) - 2.6514961294723187f);
                    const float fr_ = __builtin_amdgcn_fractf((float)pos * invrev); c[e] = __builtin_amdgcn_cosf(fr_); s[e] = __builtin_amdgcn_sinf(fr_); }
#endif
#pragma unroll
                for (int bj = 0; bj < 2; ++bj) { const f32x4 x1 = v[bj][0], x2 = v[bj][1]; v[bj][0] = x1 * c - x2 * s; v[bj][1] = x2 * c + x1 * s; }
            }
            if (is_u) {
                const int cg = row >> 5, t = row & 31;
                EPI_COLS(bj, n) { const int g = (u.pn * 256 + bj * 128 + wc * 32 + n * 16) >> 4;
                    *(u32x2*)(U2 + ((size_t)g * S5NCH + cg) * S5KT + t * 16 + 4 * fq) = pack4(v[bj][n]); }
            } else if (ldo == 0) {
                const int t = u.pn - u_tiles, which = t >> 3, b = row >> 13, pos = row & (SEQ - 1);
#pragma unroll
                for (int bj = 0; bj < 2; ++bj) { const int h = 2 * (t & 7) + bj;
                    bf16_t* rowp = O + (size_t)which * MTOK * DM + ((size_t)(b * 16 + h) * SEQ + pos) * 128 + wc * 32 + 4 * fq;
#pragma unroll
                    for (int n = 0; n < 2; ++n) *(u32x2*)(rowp + n * 16) = pack4(v[bj][n]); }
            } else {
                bf16_t* rowp = O + (size_t)row * ldo + (u.pn - u_tiles) * 256 + wc * 32 + 4 * fq;
                EPI_COLS(bj, n) { *(u32x2*)(rowp + bj * 128 + n * 16) = pack4(v[bj][n]); }
            }
        }
    }
};
struct EpiRes {
    static constexpr bool REPEATABLE = false; static constexpr bool PERM = true;
    const float* base32; bf16_t* HB; float* rss_next; bool dry = false;
    __device__ __forceinline__ void operator()(acc_t& acc, const pg8::Unit& u, int wr, int wc, int fr, int fq) const {
        const int row0 = u.pm * 256 + wr * 64 + fr, col0 = u.pn * 256 + wc * 32 + 8 * fq;
        EPI_ROWS(ai, m) {
            const int row = row0 + ai * 128 + m * 16; const size_t off = (size_t)row * DM + col0; float ss = 0.f;
            if (base32) {
                EPI_COLS(bj, n) { acc[ai][bj][m][n] += *(const f32x4*)(base32 + off + bj * 128 + n * 4); }
            } else {
#pragma unroll
                for (int bj = 0; bj < 2; ++bj) { const u32x4 w = *(const u32x4*)(HB + off + bj * 128);
                    acc[ai][bj][m][0] += (f32x4){bf2f(w.x & 0xffffu), bf2f(w.x >> 16), bf2f(w.y & 0xffffu), bf2f(w.y >> 16)};
                    acc[ai][bj][m][1] += (f32x4){bf2f(w.z & 0xffffu), bf2f(w.z >> 16), bf2f(w.w & 0xffffu), bf2f(w.w >> 16)}; }
            }
#pragma unroll
            for (int bj = 0; bj < 2; ++bj) { const f32x4 o0 = acc[ai][bj][m][0], o1 = acc[ai][bj][m][1]; const u32x2 w0 = pack4(o0), w1 = pack4(o1); const u32x4 w = {w0.x, w0.y, w1.x, w1.y};
                if (dry) { asm volatile("" :: "v"(w.x), "v"(w.y), "v"(w.z), "v"(w.w)); } else { *(u32x4*)(HB + off + bj * 128) = w; }
                ss += ((o0[0] * o0[0] + o0[1] * o0[1]) + (o0[2] * o0[2] + o0[3] * o0[3])) + ((o1[0] * o1[0] + o1[1] * o1[1]) + (o1[2] * o1[2] + o1[3] * o1[3])); }
            ss = x16_sum(ss);
            if (fq == 0 && !dry) rss_next[(size_t)row * 32 + u.pn * 4 + wc] = ss;
        }
    }
};
struct EpiSoftmax {
    static constexpr bool REPEATABLE = false; static constexpr bool PERM = false;
    LAS const float* rstd_tab; bf16_t* P; LAS float* xch;
    __device__ __forceinline__ void operator()(acc_t& acc, const pg8::Unit& u, int wr, int wc, int fr, int fq) const {
        const int row0 = u.pm * 256 + wr * 64 + fr;
        LAS float* xmax = xch; LAS float* xsum = xch + 1024;
        EPI_ROWS(ai, m) {
            const int rl = ai * 128 + wr * 64 + m * 16 + fr, row = u.pm * 256 + rl;
            const float rstd = rstd_tab[rl] * 1.4426950408889634f;
            float mx = -3.0e38f;
            EPI_COLS(bj, n) { const f32x4 s = acc[ai][bj][m][n] * rstd; acc[ai][bj][m][n] = s; mx = fmaxf(mx, fmaxf(fmaxf(s[0], s[1]), fmaxf(s[2], s[3]))); }
            mx = x16_max(mx);
            if (fq == 0) xmax[rl * 4 + wc] = mx;
        }
        LDS_WAIT(); __builtin_amdgcn_s_barrier(); asm volatile("" ::: "memory");
        EPI_ROWS(ai, m) {
            const int rl = ai * 128 + wr * 64 + m * 16 + fr;
            const f32x4 m4 = *(const LAS f32x4*)(xmax + rl * 4); const float mx = fmaxf(fmaxf(m4[0], m4[1]), fmaxf(m4[2], m4[3]));
            float sm = 0.f;
            EPI_COLS(bj, n) { f32x4 s = acc[ai][bj][m][n];
#pragma unroll
                for (int j = 0; j < 4; ++j) s[j] = __builtin_amdgcn_exp2f(s[j] - mx);
                acc[ai][bj][m][n] = s; sm += (s[0] + s[1]) + (s[2] + s[3]); }
            sm = x16_sum(sm);
            if (fq == 0) xsum[rl * 4 + wc] = sm;
        }
        LDS_WAIT(); __builtin_amdgcn_s_barrier(); asm volatile("" ::: "memory");
        EPI_ROWS(ai, m) {
            const int rl = ai * 128 + wr * 64 + m * 16 + fr;
            const f32x4 s4 = *(const LAS f32x4*)(xsum + rl * 4); const float inv = __builtin_amdgcn_rcpf((s4[0] + s4[1]) + (s4[2] + s4[3]));
            bf16_t* rowp = P + (size_t)(row0 + ai * 128 + m * 16) * 1024 + u.pn * 256 + wc * 32 + 4 * fq;
            EPI_COLS(bj, n) { *(u32x2*)(rowp + bj * 128 + n * 16) = pack4(acc[ai][bj][m][n] * inv); }
        }
    }
};
struct EpiSwiglu {
    static constexpr bool REPEATABLE = true; static constexpr bool PERM = true;
    LAS const float* rstd_tab; bf16_t* O; bool dry = false;
    __device__ __forceinline__ void operator()(acc_t& acc, const pg8::Unit& u, int wr, int wc, int fr, int fq) const {
        const int row0 = u.pm * 256 + wr * 64 + fr;
        EPI_ROWS(ai, m) {
            const int row = row0 + ai * 128 + m * 16;
#if defined(KREP_DIAG)
            const float rstd = 0.5f * rstd_tab[ai * 128 + wr * 64 + m * 16 + fr];
#else
            const float rstd = rstd_tab[ai * 128 + wr * 64 + m * 16 + fr];
#endif
            bf16_t* rowp = O + (size_t)row * FFN + u.pn * 128 + wc * 32 + 8 * fq;
            u32x2 wn[2];
#pragma unroll
            for (int n = 0; n < 2; ++n) { const f32x4 a = acc[ai][0][m][n] * rstd, b = acc[ai][1][m][n] * rstd; f32x4 o;
#pragma unroll
                for (int j = 0; j < 4; ++j) o[j] = a[j] * b[j] * __builtin_amdgcn_rcpf(1.0f + __builtin_amdgcn_exp2f(-1.4426950408889634f * a[j]));
                wn[n] = pack4(o); }
            { const u32x4 w = {wn[0].x, wn[0].y, wn[1].x, wn[1].y}; if (dry) { asm volatile("" :: "v"(w.x), "v"(w.y), "v"(w.z), "v"(w.w)); } else { *(u32x4*)rowp = w; } }
        }
    }
};
__device__ __forceinline__ float gelu_tanh(float x) { const float z = 0.7978845608028654f * (x + 0.044715f * x * x * x); const float e = __builtin_amdgcn_exp2f(2.8853900817779268f * z); return x * (1.0f - __builtin_amdgcn_rcpf(1.0f + e)); }
struct EpiS5Y {
    static constexpr bool REPEATABLE = false; static constexpr bool PERM = false;
    bf16_t* G;
    __device__ __forceinline__ void operator()(acc_t& acc, const pg8::Unit& u, int wr, int wc, int fr, int fq) const {
        const int g = u.pm >> 1;
        EPI_ROWS(ai, m) {
            const int cg = (u.pm & 1) * 256 + ai * 128 + wr * 64 + m * 16 + fr;
            EPI_COLS(bj, n) { const int t = (u.pn * 256 + bj * 128 + wc * 32 + n * 16) >> 4; const f32x4 y = acc[ai][bj][m][n]; f32x4 o;
#pragma unroll
                for (int j = 0; j < 4; ++j) o[j] = gelu_tanh(y[j]);
                *(u32x2*)(G + (size_t)(cg * S5L + t) * 1024 + g * 16 + 4 * fq) = pack4(o); }
        }
    }
};
struct EpiGlu {
    static constexpr bool REPEATABLE = false; static constexpr bool PERM = false;
    const bf16_t* G; const float* bias; bf16_t* O;
    __device__ __forceinline__ void operator()(acc_t& acc, const pg8::Unit& u, int wr, int wc, int fr, int fq) const {
        const int row0 = u.pm * 256 + wr * 64 + fr, col0 = u.pn * 256 + wc * 32 + 4 * fq;
        f32x4 bv[2][2];
        EPI_COLS(bj, n) { bv[bj][n] = *(const f32x4*)(bias + col0 + bj * 128 + n * 16); }
        EPI_ROWS(ai, m) {
            const int row = row0 + ai * 128 + m * 16;
            EPI_COLS(bj, n) { const int c = col0 + bj * 128 + n * 16; const u32x2 gw = *(const u32x2*)(G + (size_t)row * 1024 + c);
                const f32x4 s = acc[ai][bj][m][n] + bv[bj][n]; f32x4 o;
                const float g0 = bf2f(gw.x & 0xffffu), g1 = bf2f(gw.x >> 16), g2 = bf2f(gw.y & 0xffffu), g3 = bf2f(gw.y >> 16);
                o[0] = g0 * __builtin_amdgcn_rcpf(1.0f + __builtin_amdgcn_exp2f(-1.4426950408889634f * s[0])); o[1] = g1 * __builtin_amdgcn_rcpf(1.0f + __builtin_amdgcn_exp2f(-1.4426950408889634f * s[1])); o[2] = g2 * __builtin_amdgcn_rcpf(1.0f + __builtin_amdgcn_exp2f(-1.4426950408889634f * s[2])); o[3] = g3 * __builtin_amdgcn_rcpf(1.0f + __builtin_amdgcn_exp2f(-1.4426950408889634f * s[3]));
                *(u32x2*)(O + (size_t)row * DM + c) = pack4(o); }
        }
    }
};

namespace att {
constexpr int D = 128, NW = 8, QBLK = 32, KVBLK = 64;
constexpr float SCALE = 0.088388347648318440f;
constexpr float THR = 8.f;
constexpr size_t SHM_V = KVBLK * D * 2, SHM_K = KVBLK * D * 2, SHM_ATTN = 2 * SHM_V + 2 * SHM_K + NW * 64 * 4;
#define KSWZ(row, colB) ((row) * 256 + ((colB) ^ (((row) & 15) << 4)))
#define SBAR() __builtin_amdgcn_sched_barrier(0)
__device__ __forceinline__ int crow(int r, int hi) { return (r & 3) + 8 * (r >> 2) + 4 * hi; }
__device__ __forceinline__ unsigned cvtpk(float lo, float hi) { unsigned r; asm volatile("v_cvt_pk_bf16_f32 %0, %1, %2" : "=v"(r) : "v"(lo), "v"(hi)); return r; }

__device__ __forceinline__ void partialSM(f32x16& p0, f32x16& p1, float& m_reg, float& mn, float& alpha) {
  constexpr float C = SCALE * 1.4426950408889634f;
  float pmax = p0[0];
#pragma unroll
  for (int r = 1; r < 16; ++r) pmax = fmaxf(pmax, p0[r]);
#pragma unroll
  for (int r = 0; r < 16; ++r) pmax = fmaxf(pmax, p1[r]);
  { auto rr = __builtin_amdgcn_permlane32_swap(__float_as_uint(pmax), __float_as_uint(pmax), false, false);
    pmax = fmaxf(__uint_as_float(rr[0]), __uint_as_float(rr[1])); }
  if (__builtin_expect(__all(pmax - m_reg <= THR / SCALE), 1)) { mn = m_reg; alpha = 1.f; }
  else { mn = fmaxf(m_reg, pmax); alpha = __builtin_amdgcn_exp2f((m_reg - mn) * C); m_reg = mn; }
  float mnC = -mn * C;
#pragma unroll
  for (int r = 0; r < 16; ++r) p0[r] = fmaf(p0[r], C, mnC);
#pragma unroll
  for (int r = 0; r < 16; ++r) p1[r] = fmaf(p1[r], C, mnC);
#pragma unroll
  for (int r = 0; r < 16; ++r) p0[r] = __builtin_amdgcn_exp2f(p0[r]);
}
__device__ __forceinline__ void finishSM(f32x16& p0, f32x16& p1, float alpha, float& l_reg, bf16x8& pa0, bf16x8& pa1, bf16x8& pa2, bf16x8& pa3) {
#pragma unroll
  for (int r = 0; r < 16; ++r) p1[r] = __builtin_amdgcn_exp2f(p1[r]);
  float ps = 0;
#pragma unroll
  for (int r = 0; r < 16; ++r) ps += p0[r];
#pragma unroll
  for (int r = 0; r < 16; ++r) ps += p1[r];
  { auto rr = __builtin_amdgcn_permlane32_swap(__float_as_uint(ps), __float_as_uint(ps), false, false);
    ps = __uint_as_float(rr[0]) + __uint_as_float(rr[1]); }
  l_reg = l_reg * alpha + ps;
#define PK4(P, BASE, OUT) do { unsigned a0 = cvtpk(P[BASE + 0], P[BASE + 1]), a1 = cvtpk(P[BASE + 2], P[BASE + 3]);   \
    unsigned b0 = cvtpk(P[BASE + 4], P[BASE + 5]), b1 = cvtpk(P[BASE + 6], P[BASE + 7]);                              \
    auto r0 = __builtin_amdgcn_permlane32_swap(a0, b0, false, false); auto r1 = __builtin_amdgcn_permlane32_swap(a1, b1, false, false); \
    u32x4 w = {r0[0], r1[0], r0[1], r1[1]}; OUT = *reinterpret_cast<bf16x8*>(&w); } while (0)
  PK4(p0, 0, pa0); PK4(p0, 8, pa1); PK4(p1, 0, pa2); PK4(p1, 8, pa3);
#undef PK4
}
__device__ __forceinline__ void qkt(f32x16& p0, f32x16& p1, const char* Ks, const bf16x8* qr, int r32, int hi) {
  p0 = f32x16{}; p1 = f32x16{};
#pragma unroll
  for (int d0 = 0; d0 < 8; ++d0) { int cb = (d0 * 16 + hi * 8) * 2;
    bf16x8 b0 = *reinterpret_cast<const bf16x8*>(Ks + KSWZ(r32, cb));
    bf16x8 b1 = *reinterpret_cast<const bf16x8*>(Ks + KSWZ(32 + r32, cb));
    p0 = __builtin_amdgcn_mfma_f32_32x32x16_bf16(b0, qr[d0], p0, 0, 0, 0);
    p1 = __builtin_amdgcn_mfma_f32_32x32x16_bf16(b1, qr[d0], p1, 0, 0, 0); }
}
__device__ __forceinline__ void mask_tile(f32x16& p0, f32x16& p1, int tb, int kq, int Mr, int hi) {
#pragma unroll
  for (int r = 0; r < 16; ++r) { const int tt = tb + crow(r, hi);
    const bool ok0 = ((unsigned)tt <= 128u) && ((unsigned)(kq + tt) < (unsigned)Mr);
    const bool ok1 = ((unsigned)(tt + 32) <= 128u) && ((unsigned)(kq + tt + 32) < (unsigned)Mr);
    p0[r] = ok0 ? p0[r] : -3.0e4f; p1[r] = ok1 ? p1[r] : -3.0e4f; }
}
__device__ __forceinline__ int v_st(int k, int c) { const int kk = (k & ~0xC) | ((k & 4) << 1) | ((k & 8) >> 1); return ((kk >> 3) * 4 + (c >> 5)) * 512 + ((kk & 7) * 32 + (c & 31)) * 2; }
__device__ __forceinline__ int v_rd_base(int lane) { return ((lane & 3) << 3) | (((lane >> 2) & 3) << 6) | (((lane >> 4) & 1) << 5) | (((lane >> 5) & 1) << 8); }
constexpr int v_rd_off(int d0, int ks, int half) { return d0 * 512 + ks * 4096 + half * 2048; }
template <int OFF> __device__ __forceinline__ s16x4 tr_read(int vb) {
  s16x4 r; asm volatile("ds_read_b64_tr_b16 %0, %1 offset:%2" : "=&v"(r) : "v"(vb), "i"(OFF) : "memory"); return r;
}
template <int D0> __device__ __forceinline__ void pv_one(f32x16& od, int vb, bf16x8 pa0, bf16x8 pa1, bf16x8 pa2, bf16x8 pa3) {
  const s16x4 l0 = tr_read<v_rd_off(D0, 0, 0)>(vb), h0 = tr_read<v_rd_off(D0, 0, 1)>(vb), l1 = tr_read<v_rd_off(D0, 1, 0)>(vb), h1 = tr_read<v_rd_off(D0, 1, 1)>(vb);
  const s16x4 l2 = tr_read<v_rd_off(D0, 2, 0)>(vb), h2 = tr_read<v_rd_off(D0, 2, 1)>(vb), l3 = tr_read<v_rd_off(D0, 3, 0)>(vb), h3 = tr_read<v_rd_off(D0, 3, 1)>(vb);
  asm volatile("s_waitcnt lgkmcnt(0)" ::: "memory"); SBAR();
#define PK(L, H) (bf16x8){L[0], L[1], L[2], L[3], H[0], H[1], H[2], H[3]}
  od = __builtin_amdgcn_mfma_f32_32x32x16_bf16(pa0, PK(l0, h0), od, 0, 0, 0);
  od = __builtin_amdgcn_mfma_f32_32x32x16_bf16(pa1, PK(l1, h1), od, 0, 0, 0);
  od = __builtin_amdgcn_mfma_f32_32x32x16_bf16(pa2, PK(l2, h2), od, 0, 0, 0);
  od = __builtin_amdgcn_mfma_f32_32x32x16_bf16(pa3, PK(l3, h3), od, 0, 0, 0);
#undef PK
}
__device__ __forceinline__ void pv_d0(f32x16* o, int vb, bf16x8 pa0, bf16x8 pa1, bf16x8 pa2, bf16x8 pa3) {
  pv_one<0>(o[0], vb, pa0, pa1, pa2, pa3); pv_one<1>(o[1], vb, pa0, pa1, pa2, pa3); pv_one<2>(o[2], vb, pa0, pa1, pa2, pa3); pv_one<3>(o[3], vb, pa0, pa1, pa2, pa3);
}

template <bool MASK>
__device__ __forceinline__ void attn_body(const bf16_t* __restrict__ Qb, const long ldq, const bf16_t* __restrict__ Kh, const bf16_t* __restrict__ Vh, const long ldk,
                                          const int kfirst, const int Mr, const int NT, bf16_t* __restrict__ Ob, const long ldo, float* __restrict__ lse, const long ldlse, char* lds) {
  int tid = threadIdx.x; asm volatile("" : "+v"(tid));
  const int wid = tid >> 6, lane = tid & 63, r32 = lane & 31, hi = lane >> 5;
  char* V_lds = lds; char* K_lds = lds + 2 * SHM_V;
  float* ws = (float*)(lds + 2 * SHM_V + 2 * SHM_K) + wid * 64; float* li_l = ws; float* al_l = ws + 32;
  float m_reg = -1e30f, l_reg = 0; f32x16 o[4] = {}; bf16x8 qr[8];
  const bf16_t* Qw = Qb + (long)(wid * QBLK + r32) * ldq + hi * 8;
#pragma unroll
  for (int d0 = 0; d0 < 8; ++d0) qr[d0] = *reinterpret_cast<const bf16x8*>(Qw + d0 * 16);
  const int sr = tid >> 4, sc = (tid & 15) * 8, vst0 = v_st(sr, sc), vst1 = v_st(32 + sr, sc);
  const int vb0 = (int)(uintptr_t)V_lds + v_rd_base(lane);
  const int qi = wid * QBLK + r32;
  struct { bf16x8 vs0, vs1, ks0, ks1; } sr_[2];
#define KROW(k0, rr) (MASK ? (long)min(max(kfirst + (k0) + (rr), 0), Mr - 1) : (long)((k0) + (rr)))
#define SLOAD(i, k0) do { const long _r0 = KROW(k0, sr) * ldk + sc, _r1 = KROW(k0, 32 + sr) * ldk + sc; \
    sr_[i].vs0 = *reinterpret_cast<const bf16x8*>(Vh + _r0); sr_[i].vs1 = *reinterpret_cast<const bf16x8*>(Vh + _r1); \
    sr_[i].ks0 = *reinterpret_cast<const bf16x8*>(Kh + _r0); sr_[i].ks1 = *reinterpret_cast<const bf16x8*>(Kh + _r1); } while (0)
#define SWRITE(b, i) do { *(bf16x8*)(V_lds + (b) * SHM_V + vst0) = sr_[i].vs0;          \
    *(bf16x8*)(V_lds + (b) * SHM_V + vst1) = sr_[i].vs1; int kc = sc * 2;               \
    *(bf16x8*)(K_lds + (b) * SHM_K + KSWZ(sr, kc)) = sr_[i].ks0;                       \
    *(bf16x8*)(K_lds + (b) * SHM_K + KSWZ(32 + sr, kc)) = sr_[i].ks1; } while (0)
#define SWAIT() asm volatile("s_waitcnt vmcnt(4)" ::: "memory")
#define RESC(a) do { if (__any((a) < 1.f)) { if (hi == 0) al_l[r32] = (a); asm volatile("s_waitcnt lgkmcnt(0)" ::: "memory"); \
    _Pragma("unroll") for (int d = 0; d < 4; ++d) _Pragma("unroll") for (int r = 0; r < 16; ++r) o[d][r] *= al_l[crow(r, hi)]; } } while (0)
#define MASKT(P0, P1, j) do { if (MASK) mask_tile(P0, P1, (j) * KVBLK - qi, kfirst + qi, Mr, hi); } while (0)
  f32x16 pA0, pA1, pB0, pB1; float mnA, mnB, alA, alB; bf16x8 pa0, pa1, pa2, pa3;
  constexpr int SE = 0, SO = 1;
  SLOAD(SE, 0); asm volatile("s_waitcnt vmcnt(0)" ::: "memory"); SWRITE(0, SE); __syncthreads();
  qkt(pA0, pA1, K_lds, qr, r32, hi); MASKT(pA0, pA1, 0); partialSM(pA0, pA1, m_reg, mnA, alA);
  SLOAD(SO, KVBLK); if (2 < NT) SLOAD(SE, 2 * KVBLK);
  SWAIT(); SWRITE(1, SO); __syncthreads();
  for (int j = 1; j + 1 < NT; j += 2) {
    SBAR(); qkt(pB0, pB1, K_lds + SHM_K, qr, r32, hi);
    finishSM(pA0, pA1, alA, l_reg, pa0, pa1, pa2, pa3); SBAR();
    SLOAD(SO, (j + 2) * KVBLK); SBAR();
    pv_d0(o, vb0, pa0, pa1, pa2, pa3); MASKT(pB0, pB1, j); partialSM(pB0, pB1, m_reg, mnB, alB);
    __syncthreads(); SWAIT(); SWRITE(0, SE);
    RESC(alB); __syncthreads();
    SBAR(); qkt(pA0, pA1, K_lds, qr, r32, hi);
    finishSM(pB0, pB1, alB, l_reg, pa0, pa1, pa2, pa3); SBAR();
    if (j + 3 < NT) SLOAD(SE, (j + 3) * KVBLK); SBAR();
    pv_d0(o, vb0 + (int)SHM_V, pa0, pa1, pa2, pa3); MASKT(pA0, pA1, j + 1); partialSM(pA0, pA1, m_reg, mnA, alA);
    __syncthreads(); SWAIT(); SWRITE(1, SO);
    RESC(alA); __syncthreads();
  }
  SBAR(); qkt(pB0, pB1, K_lds + SHM_K, qr, r32, hi);
  finishSM(pA0, pA1, alA, l_reg, pa0, pa1, pa2, pa3); SBAR();
  pv_d0(o, vb0, pa0, pa1, pa2, pa3); MASKT(pB0, pB1, NT - 1); partialSM(pB0, pB1, m_reg, mnB, alB);
  __syncthreads(); RESC(alB);
  finishSM(pB0, pB1, alB, l_reg, pa0, pa1, pa2, pa3); SBAR();
  pv_d0(o, vb0 + (int)SHM_V, pa0, pa1, pa2, pa3);
  if (hi == 0) li_l[r32] = l_reg; asm volatile("s_waitcnt lgkmcnt(0)" ::: "memory");
  float rli[16];
#pragma unroll
  for (int r = 0; r < 16; ++r) rli[r] = __builtin_amdgcn_rcpf(li_l[crow(r, hi)]);
  bf16_t* Ow = Ob + (long)(wid * QBLK) * ldo;
#pragma unroll
  for (int r = 0; r < 16; ++r) { const int orow = crow(r, hi);
#pragma unroll
    for (int d0 = 0; d0 < 4; ++d0) Ow[(long)orow * ldo + d0 * 32 + r32] = (bf16_t)f2bf(o[d0][r] * rli[r]); }
  if (lse != nullptr && hi == 0) lse[(long)(wid * QBLK + r32) * ldlse] = m_reg * SCALE + __logf(l_reg);
#undef KROW
#undef SLOAD
#undef SWRITE
#undef SWAIT
#undef RESC
#undef MASKT
}

struct VFB { s16x4 l0, h0, l1, h1, l2, h2, l3, h3; };
template <int D0> __device__ __forceinline__ void vfb_load(VFB& f, int vb) {
  f.l0 = tr_read<v_rd_off(D0, 0, 0)>(vb); f.h0 = tr_read<v_rd_off(D0, 0, 1)>(vb); f.l1 = tr_read<v_rd_off(D0, 1, 0)>(vb); f.h1 = tr_read<v_rd_off(D0, 1, 1)>(vb);
  f.l2 = tr_read<v_rd_off(D0, 2, 0)>(vb); f.h2 = tr_read<v_rd_off(D0, 2, 1)>(vb); f.l3 = tr_read<v_rd_off(D0, 3, 0)>(vb); f.h3 = tr_read<v_rd_off(D0, 3, 1)>(vb);
}
#define VFB_WAIT(N, f) asm volatile("s_waitcnt lgkmcnt(" #N ")" : "+v"(f.l0), "+v"(f.h0), "+v"(f.l1), "+v"(f.h1), "+v"(f.l2), "+v"(f.h2), "+v"(f.l3), "+v"(f.h3) :: "memory")
__device__ __forceinline__ void vfb_mma(f32x16& od, const VFB& f, bf16x8 pa0, bf16x8 pa1, bf16x8 pa2, bf16x8 pa3) {
#define PK(L, H) (bf16x8){L[0], L[1], L[2], L[3], H[0], H[1], H[2], H[3]}
  od = __builtin_amdgcn_mfma_f32_32x32x16_bf16(pa0, PK(f.l0, f.h0), od, 0, 0, 0);
  od = __builtin_amdgcn_mfma_f32_32x32x16_bf16(pa1, PK(f.l1, f.h1), od, 0, 0, 0);
  od = __builtin_amdgcn_mfma_f32_32x32x16_bf16(pa2, PK(f.l2, f.h2), od, 0, 0, 0);
  od = __builtin_amdgcn_mfma_f32_32x32x16_bf16(pa3, PK(f.l3, f.h3), od, 0, 0, 0);
#undef PK
}
template <int OFF> __device__ __forceinline__ bf16x8 dsb_rd128(int a) { bf16x8 r; asm volatile("ds_read_b128 %0, %1 offset:%2" : "=&v"(r) : "v"(a), "i"(OFF) : "memory"); return r; }
#define KB_RD(A, B, d0) do { const int _a = (kx ^ ((d0) * 32)) + krow; A = dsb_rd128<0>(_a); B = dsb_rd128<8192>(_a); } while (0)
#define KB_WAIT(N, A, B) asm volatile("s_waitcnt lgkmcnt(" #N ")" : "+v"(A), "+v"(B) :: "memory")
#define KB_MMA(A, B, d0) do { p0 = __builtin_amdgcn_mfma_f32_32x32x16_bf16(A, qr[d0], p0, 0, 0, 0); p1 = __builtin_amdgcn_mfma_f32_32x32x16_bf16(B, qr[d0], p1, 0, 0, 0); } while (0)
__device__ __forceinline__ void attn_band_body(const bf16_t* __restrict__ Qb, const long ldq, const bf16_t* __restrict__ Kh, const bf16_t* __restrict__ Vh, const long ldk,
                                               const int kfirst, const int Mr, bf16_t* __restrict__ Ob, const long ldo, float* __restrict__ lse, const long ldlse, char* lds) {
  int tid = threadIdx.x; asm volatile("" : "+v"(tid));
  const int wid = __builtin_amdgcn_readfirstlane(tid >> 6), lane = tid & 63, r32 = lane & 31, hi = lane >> 5;
  char* V_lds = lds; char* K_lds = lds + 2 * SHM_V;
  float* ws = (float*)(lds + 2 * SHM_V + 2 * SHM_K) + wid * 64; float* li_l = ws; float* al_l = ws + 32;
  float m_reg = -1e30f, l_reg = 0; f32x16 o[4] = {}; bf16x8 qr[8];
  const bf16_t* Qw = Qb + (long)(wid * QBLK + r32) * ldq + hi * 8;
#pragma unroll
  for (int d0 = 0; d0 < 8; ++d0) qr[d0] = *reinterpret_cast<const bf16x8*>(Qw + d0 * 16);
  const int sr = tid >> 4, sc = (tid & 15) * 8, vst0 = v_st(sr, sc), vst1 = v_st(32 + sr, sc);
  const int vb0 = (int)(uintptr_t)V_lds + v_rd_base(lane);
  const int qi = wid * QBLK + r32;
  const int jlo = wid >> 1, jhi = (32 * wid + 159) >> 6;
  const int kx = (hi * 16) ^ ((r32 & 15) << 4), krow0 = (int)(uintptr_t)K_lds + r32 * 256;
  const bool edge = (kfirst < 0) | (kfirst + 384 > Mr);
  bf16x8 vs0, vs1, ks0, ks1;
#define KROW(k0, rr) ((long)min(max(kfirst + (k0) + (rr), 0), Mr - 1))
#define SLOAD(k0) do { const long _r0 = KROW(k0, sr) * ldk + sc, _r1 = KROW(k0, 32 + sr) * ldk + sc; \
    vs0 = *reinterpret_cast<const bf16x8*>(Vh + _r0); vs1 = *reinterpret_cast<const bf16x8*>(Vh + _r1); \
    ks0 = *reinterpret_cast<const bf16x8*>(Kh + _r0); ks1 = *reinterpret_cast<const bf16x8*>(Kh + _r1); } while (0)
#define SWRITE(b) do { *(bf16x8*)(V_lds + (b) * SHM_V + vst0) = vs0; *(bf16x8*)(V_lds + (b) * SHM_V + vst1) = vs1; const int kc = sc * 2; \
    *(bf16x8*)(K_lds + (b) * SHM_K + KSWZ(sr, kc)) = ks0; *(bf16x8*)(K_lds + (b) * SHM_K + KSWZ(32 + sr, kc)) = ks1; } while (0)
  SLOAD(0); SWRITE(0); __syncthreads();
#pragma unroll
  for (int d0 = 0; d0 < 8; ++d0) asm volatile("" : "+v"(qr[d0]));
#pragma unroll 1
  for (int j = 0; j < 6; ++j) {
    const int b = j & 1;
    if (j + 1 < 6) SLOAD((j + 1) * KVBLK);
    if (j >= jlo && j <= jhi) {
      f32x16 p0 = {}, p1 = {}; float mn, alpha; bf16x8 pa0, pa1, pa2, pa3;
      { const int krow = krow0 + b * (int)SHM_K; bf16x8 ka0, kb0, ka1, kb1, ka2, kb2;
        KB_RD(ka0, kb0, 0); KB_RD(ka1, kb1, 1);
        KB_RD(ka2, kb2, 2); KB_WAIT(4, ka0, kb0); KB_MMA(ka0, kb0, 0);
        KB_RD(ka0, kb0, 3); KB_WAIT(4, ka1, kb1); KB_MMA(ka1, kb1, 1);
        KB_RD(ka1, kb1, 4); KB_WAIT(4, ka2, kb2); KB_MMA(ka2, kb2, 2);
        KB_RD(ka2, kb2, 5); KB_WAIT(4, ka0, kb0); KB_MMA(ka0, kb0, 3);
        KB_RD(ka0, kb0, 6); KB_WAIT(4, ka1, kb1); KB_MMA(ka1, kb1, 4);
        KB_RD(ka1, kb1, 7); KB_WAIT(4, ka2, kb2); KB_MMA(ka2, kb2, 5);
        KB_WAIT(2, ka0, kb0); KB_MMA(ka0, kb0, 6);
        KB_WAIT(0, ka1, kb1); KB_MMA(ka1, kb1, 7); }
      if (edge | (j != jlo + 1)) mask_tile(p0, p1, j * KVBLK - qi, kfirst + qi, Mr, hi);
      partialSM(p0, p1, m_reg, mn, alpha);
      if (__any(alpha < 1.f)) { if (hi == 0) al_l[r32] = alpha; asm volatile("s_waitcnt lgkmcnt(0)" ::: "memory");
#pragma unroll
        for (int d = 0; d < 4; ++d)
#pragma unroll
          for (int r = 0; r < 16; ++r) o[d][r] *= al_l[crow(r, hi)]; }
      finishSM(p0, p1, alpha, l_reg, pa0, pa1, pa2, pa3); SBAR();
      { const int vb = vb0 + b * (int)SHM_V; VFB fa, fb;
        vfb_load<0>(fa, vb);
        vfb_load<1>(fb, vb); VFB_WAIT(8, fa); vfb_mma(o[0], fa, pa0, pa1, pa2, pa3);
        vfb_load<2>(fa, vb); VFB_WAIT(8, fb); vfb_mma(o[1], fb, pa0, pa1, pa2, pa3);
        vfb_load<3>(fb, vb); VFB_WAIT(8, fa); vfb_mma(o[2], fa, pa0, pa1, pa2, pa3);
        VFB_WAIT(0, fb); vfb_mma(o[3], fb, pa0, pa1, pa2, pa3); }
    }
    if (j + 1 < 6) SWRITE(b ^ 1);
    __syncthreads();
  }
  if (hi == 0) li_l[r32] = l_reg; asm volatile("s_waitcnt lgkmcnt(0)" ::: "memory");
  float rli[16];
#pragma unroll
  for (int r = 0; r < 16; ++r) rli[r] = __builtin_amdgcn_rcpf(li_l[crow(r, hi)]);
  bf16_t* Ow = Ob + (long)(wid * QBLK) * ldo;
#pragma unroll
  for (int r = 0; r < 16; ++r) { const int orow = crow(r, hi);
#pragma unroll
    for (int d0 = 0; d0 < 4; ++d0) Ow[(long)orow * ldo + d0 * 32 + r32] = (bf16_t)f2bf(o[d0][r] * rli[r]); }
  if (hi == 0) lse[(long)(wid * QBLK + r32) * ldlse] = m_reg * SCALE + __logf(l_reg);
#undef KROW
#undef SLOAD
#undef SWRITE
}

struct BandUnit { const bf16_t* Q; const bf16_t* K; const bf16_t* V; bf16_t* O; float* L; int ld, ldo, ldl, kfirst, Mr, lsh; };
template <class UF>
__device__ __forceinline__ void attn_band_stream(const int U, UF unit_of, char* lds) {
  int tid = threadIdx.x; asm volatile("" : "+v"(tid));
  const int wid = __builtin_amdgcn_readfirstlane(tid >> 6), lane = tid & 63, r32 = lane & 31, hi = lane >> 5, w32 = lane & 31;
  constexpr int TILE = 32768, OFF_B = 3 * TILE, OFF_WS = 4 * TILE;
  float* ws = (float*)(lds + OFF_WS) + wid * 64; float* li_l = ws; float* al_l = ws + 32;
  const int jlo = wid >> 1, qi = wid * QBLK + r32;
  const int kx = (hi * 16) ^ ((r32 & 15) << 4);
  const int krow_l = (int)(uintptr_t)lds + 16384 + r32 * 256, vb_l = (int)(uintptr_t)lds + v_rd_base(lane);
  const int krow0 = 4 * wid + (lane >> 4), kch = ((lane & 15) ^ (krow0 & 15)) * 8;
  const int vkk = (wid >> 1) * 8 + (w32 >> 2), vkey0 = (vkk & ~0xC) | ((vkk & 4) << 1) | ((vkk & 8) >> 1), vcol = (2 * (wid & 1) + (lane >> 5)) * 32 + (w32 & 3) * 8;
#define BS_DMA(bu, j, boff) do { const int _kb = (bu).kfirst + 64 * (j); const unsigned _ld = (unsigned)(bu).ld; \
    _Pragma("unroll") for (int _i = 0; _i < 2; ++_i) { const unsigned _ro = (unsigned)min(max(_kb + krow0 + 32 * _i, 0), (bu).Mr - 1) * _ld + kch; \
      __builtin_amdgcn_global_load_lds((const unsigned*)((bu).K + _ro), (LAS unsigned*)(lds + (boff) + 16384 + (wid + 8 * _i) * 1024), 16, 0, 0); } \
    _Pragma("unroll") for (int _i = 0; _i < 2; ++_i) { const unsigned _ro = (unsigned)min(max(_kb + vkey0 + 32 * _i, 0), (bu).Mr - 1) * _ld + vcol; \
      __builtin_amdgcn_global_load_lds((const unsigned*)((bu).V + _ro), (LAS unsigned*)(lds + (boff) + (wid + 8 * _i) * 1024), 16, 0, 0); } } while (0)
#define BS_QLOAD(bu) do { const bf16_t* _q = (bu).Q + (long)qi * (bu).ld + hi * 8; \
    asm volatile("global_load_dwordx4 %0, %8, off\n\tglobal_load_dwordx4 %1, %8, off offset:32\n\tglobal_load_dwordx4 %2, %8, off offset:64\n\tglobal_load_dwordx4 %3, %8, off offset:96\n\t" \
                 "global_load_dwordx4 %4, %8, off offset:128\n\tglobal_load_dwordx4 %5, %8, off offset:160\n\tglobal_load_dwordx4 %6, %8, off offset:192\n\tglobal_load_dwordx4 %7, %8, off offset:224" \
                 : "=&v"(qr[0]), "=&v"(qr[1]), "=&v"(qr[2]), "=&v"(qr[3]), "=&v"(qr[4]), "=&v"(qr[5]), "=&v"(qr[6]), "=&v"(qr[7]) : "v"(_q) : "memory"); } while (0)
#define BS_POS_DMA(gq) do { const int _un = (gq) / 5, _jn = (gq) - 5 * _un; \
    if ((gq) <= 5 * U) { \
      if (_un < U) { const BandUnit _bn = unit_of(_un); BS_DMA(_bn, _jn, ((gq) % 3) * TILE); ndma += 4; } \
      if (_jn == 0 && _un >= 1) { const BandUnit _bp = unit_of(_un - 1); BS_DMA(_bp, 5, OFF_B); ndma += 4; } } } while (0)
  float m_reg = -1e30f, l_reg = 0; f32x16 o[4] = {}; bf16x8 qr[8];
  { int ndma = 0; if (U > 0) { const BandUnit b0 = unit_of(0); BS_QLOAD(b0); } else {
#pragma unroll
      for (int d0 = 0; d0 < 8; ++d0) qr[d0] = bf16x8{}; }
    BS_POS_DMA(0); BS_POS_DMA(1); }
  asm volatile("s_waitcnt vmcnt(0)" ::: "memory");
#pragma unroll
  for (int d0 = 0; d0 < 8; ++d0) asm volatile("" : "+v"(qr[d0]));
  __builtin_amdgcn_s_barrier(); asm volatile("" ::: "memory");
#pragma unroll 1
  for (int g = 0; g <= 5 * U + 2; ++g) {
    const int rel = g - jlo, uw = rel >= 0 ? rel / 5 : -1, jr = rel - 5 * uw;
    int ndma = 0;
    if (uw >= 0 && jr >= 3 && uw < U) {
      const BandUnit bu = unit_of(uw);
      if (hi == 0) li_l[r32] = l_reg; asm volatile("s_waitcnt lgkmcnt(0)" ::: "memory");
      bf16_t* Ow = bu.O + (long)(wid * QBLK) * bu.ldo;
      const int rb = (jr - 3) * 8;
#pragma unroll
      for (int rr = 0; rr < 8; ++rr) { const int orow = ((rb + rr) & 3) + 8 * ((rb + rr) >> 2) + 4 * hi; const float rl = __builtin_amdgcn_rcpf(li_l[orow]);
#pragma unroll
        for (int d0 = 0; d0 < 4; ++d0) { const float v = jr == 3 ? o[d0][rr] : o[d0][8 + rr]; Ow[(long)orow * bu.ldo + d0 * 32 + r32] = (bf16_t)f2bf(v * rl); } }
      if (jr == 3 && hi == 0) bu.L[(long)qi * bu.ldl] = m_reg * SCALE + __logf(l_reg);
      asm volatile("s_waitcnt vmcnt(0)" ::: "memory");
      if (jr == 3 && uw + 1 < U) { const BandUnit bn = unit_of(uw + 1); BS_QLOAD(bn); ndma += 8; }
      BS_POS_DMA(g + 2);
    } else {
    BS_POS_DMA(g + 2);
    if (uw >= 0 && jr <= 2 && uw < U) {
      const BandUnit bu = unit_of(uw);
      const int j = jlo + jr, boff = (j == 5) ? OFF_B : (g % 3) * TILE;
      if (jr == 0) { m_reg = -1e30f; l_reg = 0.f;
#pragma unroll
        for (int d = 0; d < 4; ++d) o[d] = f32x16{}; }
      const bool edge = (bu.kfirst < 0) | (bu.kfirst + 384 > bu.Mr);
      f32x16 p0 = {}, p1 = {}; float mn, alpha; bf16x8 pa0, pa1, pa2, pa3;
      { const int krow = krow_l + boff; bf16x8 ka0, kb0, ka1, kb1, ka2, kb2;
        KB_RD(ka0, kb0, 0); KB_RD(ka1, kb1, 1);
        KB_RD(ka2, kb2, 2); KB_WAIT(4, ka0, kb0); KB_MMA(ka0, kb0, 0);
        KB_RD(ka0, kb0, 3); KB_WAIT(4, ka1, kb1); KB_MMA(ka1, kb1, 1);
        KB_RD(ka1, kb1, 4); KB_WAIT(4, ka2, kb2); KB_MMA(ka2, kb2, 2);
        KB_RD(ka2, kb2, 5); KB_WAIT(4, ka0, kb0); KB_MMA(ka0, kb0, 3);
        KB_RD(ka0, kb0, 6); KB_WAIT(4, ka1, kb1); KB_MMA(ka1, kb1, 4);
        KB_RD(ka1, kb1, 7); KB_WAIT(4, ka2, kb2); KB_MMA(ka2, kb2, 5);
        KB_WAIT(2, ka0, kb0); KB_MMA(ka0, kb0, 6);
        KB_WAIT(0, ka1, kb1); KB_MMA(ka1, kb1, 7); }
      if (edge | (jr != 1)) mask_tile(p0, p1, j * KVBLK - qi, bu.kfirst + qi, bu.Mr, hi);
      partialSM(p0, p1, m_reg, mn, alpha);
      if (jr != 0 && __any(alpha < 1.f)) { if (hi == 0) al_l[r32] = alpha; asm volatile("s_waitcnt lgkmcnt(0)" ::: "memory");
#pragma unroll
        for (int d = 0; d < 4; ++d)
#pragma unroll
          for (int r = 0; r < 16; ++r) o[d][r] *= al_l[crow(r, hi)]; }
      if (jr == 0) alpha = 0.f;
      finishSM(p0, p1, alpha, l_reg, pa0, pa1, pa2, pa3); SBAR();
      { const int vb = vb_l + boff; VFB fa, fb;
        vfb_load<0>(fa, vb);
        vfb_load<1>(fb, vb); VFB_WAIT(8, fa); vfb_mma(o[0], fa, pa0, pa1, pa2, pa3);
        vfb_load<2>(fa, vb); VFB_WAIT(8, fb); vfb_mma(o[1], fb, pa0, pa1, pa2, pa3);
        vfb_load<3>(fb, vb); VFB_WAIT(8, fa); vfb_mma(o[2], fa, pa0, pa1, pa2, pa3);
        VFB_WAIT(0, fb); vfb_mma(o[3], fb, pa0, pa1, pa2, pa3); }
    } }
    asm volatile("s_waitcnt lgkmcnt(0)" ::: "memory");
#define BS_VMW(n) case n: asm volatile("s_waitcnt vmcnt(" #n ")" ::: "memory"); break;
    switch (ndma) { BS_VMW(4) BS_VMW(8) BS_VMW(12) BS_VMW(16) default: asm volatile("s_waitcnt vmcnt(0)" ::: "memory"); break; }
#undef BS_VMW
    __builtin_amdgcn_s_barrier(); asm volatile("" ::: "memory");
  }
#undef BS_DMA
#undef BS_QLOAD
#undef BS_POS_DMA
}

__device__ __forceinline__ void partialSM1(f32x16& p0, float& m_reg, float& mn, float& alpha) {
  constexpr float C = SCALE * 1.4426950408889634f;
  float pmax = p0[0];
#pragma unroll
  for (int r = 1; r < 16; ++r) pmax = fmaxf(pmax, p0[r]);
  { auto rr = __builtin_amdgcn_permlane32_swap(__float_as_uint(pmax), __float_as_uint(pmax), false, false);
    pmax = fmaxf(__uint_as_float(rr[0]), __uint_as_float(rr[1])); }
  if (__builtin_expect(__all(pmax - m_reg <= THR / SCALE), 1)) { mn = m_reg; alpha = 1.f; }
  else { mn = fmaxf(m_reg, pmax); alpha = __builtin_amdgcn_exp2f((m_reg - mn) * C); m_reg = mn; }
  const float mnC = -mn * C;
#pragma unroll
  for (int r = 0; r < 16; ++r) p0[r] = __builtin_amdgcn_exp2f(fmaf(p0[r], C, mnC));
}
__device__ __forceinline__ void finishSM1(f32x16& p0, float alpha, float& l_reg, bf16x8& pa0, bf16x8& pa1) {
  float ps = 0;
#pragma unroll
  for (int r = 0; r < 16; ++r) ps += p0[r];
  { auto rr = __builtin_amdgcn_permlane32_swap(__float_as_uint(ps), __float_as_uint(ps), false, false);
    ps = __uint_as_float(rr[0]) + __uint_as_float(rr[1]); }
  l_reg = l_reg * alpha + ps;
#define PK4(P, BASE, OUT) do { unsigned a0 = cvtpk(P[BASE + 0], P[BASE + 1]), a1 = cvtpk(P[BASE + 2], P[BASE + 3]);   \
    unsigned b0 = cvtpk(P[BASE + 4], P[BASE + 5]), b1 = cvtpk(P[BASE + 6], P[BASE + 7]);                              \
    auto r0 = __builtin_amdgcn_permlane32_swap(a0, b0, false, false); auto r1 = __builtin_amdgcn_permlane32_swap(a1, b1, false, false); \
    u32x4 w = {r0[0], r1[0], r0[1], r1[1]}; OUT = *reinterpret_cast<bf16x8*>(&w); } while (0)
  PK4(p0, 0, pa0); PK4(p0, 8, pa1);
#undef PK4
}
struct VF2 { s16x4 l0, h0, l1, h1; };
template <int D0> __device__ __forceinline__ void vf2_load(VF2& f, int vb) {
  f.l0 = tr_read<v_rd_off(D0, 0, 0)>(vb); f.h0 = tr_read<v_rd_off(D0, 0, 1)>(vb); f.l1 = tr_read<v_rd_off(D0, 1, 0)>(vb); f.h1 = tr_read<v_rd_off(D0, 1, 1)>(vb);
}
#define VF2_WAIT(N, f) asm volatile("s_waitcnt lgkmcnt(" #N ")" : "+v"(f.l0), "+v"(f.h0), "+v"(f.l1), "+v"(f.h1) :: "memory")
__device__ __forceinline__ void vf2_mma(f32x16& od, const VF2& f, bf16x8 pa0, bf16x8 pa1) {
#define PK(L, H) (bf16x8){L[0], L[1], L[2], L[3], H[0], H[1], H[2], H[3]}
  od = __builtin_amdgcn_mfma_f32_32x32x16_bf16(pa0, PK(f.l0, f.h0), od, 0, 0, 0);
  od = __builtin_amdgcn_mfma_f32_32x32x16_bf16(pa1, PK(f.l1, f.h1), od, 0, 0, 0);
#undef PK
}
__device__ __forceinline__ void attn_band_wave(const bf16_t* __restrict__ Qb, const long ldq, const bf16_t* __restrict__ Kh, const bf16_t* __restrict__ Vh, const long ldk,
                                               const int kfirst, const int Mr, bf16_t* __restrict__ Ob, const long ldo, float* __restrict__ lse, const long ldlse, char* lds) {
  int tid = threadIdx.x; asm volatile("" : "+v"(tid));
  const int wid = __builtin_amdgcn_readfirstlane(tid >> 6), lane = tid & 63, r32 = lane & 31, hi = lane >> 5, w32 = lane & 31;
  char* Vw = lds + wid * 16384;
  float* ws = (float*)(lds + 131072) + wid * 64; float* li_l = ws; float* al_l = ws + 32;
  const int kf = kfirst + 32 * wid;
  const bool edge = (kf < 0) | (kf + 160 > Mr);
  float m_reg = -1e30f, l_reg = 0; f32x16 o[4] = {}; bf16x8 qr[8], kr[8];
  const bf16_t* Qw = Qb + (long)(wid * QBLK + r32) * ldq + hi * 8;
#pragma unroll
  for (int d0 = 0; d0 < 8; ++d0) qr[d0] = *reinterpret_cast<const bf16x8*>(Qw + d0 * 16);
  const int vb0 = (int)(uintptr_t)Vw + v_rd_base(lane);
  const int vkey = ((w32 >> 2) & 3) + 8 * ((w32 >> 4) & 1), vcol = (lane >> 5) * 32 + (w32 & 3) * 8;
  const unsigned ldku = (unsigned)ldk;
#define BW_KLOAD(s) do { const unsigned _ro = (unsigned)min(max(kf + 32 * (s) + r32, 0), Mr - 1) * ldku + hi * 8; const bf16_t* _kp = Kh + _ro; \
    asm volatile("global_load_dwordx4 %0, %8, off\n\tglobal_load_dwordx4 %1, %8, off offset:32\n\tglobal_load_dwordx4 %2, %8, off offset:64\n\tglobal_load_dwordx4 %3, %8, off offset:96\n\t" \
                 "global_load_dwordx4 %4, %8, off offset:128\n\tglobal_load_dwordx4 %5, %8, off offset:160\n\tglobal_load_dwordx4 %6, %8, off offset:192\n\tglobal_load_dwordx4 %7, %8, off offset:224" \
                 : "=&v"(kr[0]), "=&v"(kr[1]), "=&v"(kr[2]), "=&v"(kr[3]), "=&v"(kr[4]), "=&v"(kr[5]), "=&v"(kr[6]), "=&v"(kr[7]) : "v"(_kp) : "memory"); } while (0)
#define BW_KWAIT(N) asm volatile("s_waitcnt vmcnt(" #N ")" : "+v"(kr[0]), "+v"(kr[1]), "+v"(kr[2]), "+v"(kr[3]), "+v"(kr[4]), "+v"(kr[5]), "+v"(kr[6]), "+v"(kr[7]) :: "memory")
#define BW_VDMA(s, b) do { _Pragma("unroll") for (int kg = 0; kg < 4; ++kg) { \
      const unsigned _ro = (unsigned)min(max(kf + 32 * (s) + vkey + 4 * (kg & 1) + 16 * (kg >> 1), 0), Mr - 1) * ldku + vcol; \
      __builtin_amdgcn_global_load_lds((const unsigned*)(Vh + _ro), (LAS unsigned*)(Vw + (b) * 8192 + (2 * kg) * 1024), 16, 0, 0); \
      __builtin_amdgcn_global_load_lds((const unsigned*)(Vh + _ro + 64), (LAS unsigned*)(Vw + (b) * 8192 + (2 * kg + 1) * 1024), 16, 0, 0); } } while (0)
  BW_VDMA(0, 0); BW_KLOAD(0);
#pragma unroll
  for (int d0 = 0; d0 < 8; ++d0) asm volatile("" : "+v"(qr[d0]));
#define BW_STEP(s, LAST) do { const int b = (s) & 1; \
    if (!(LAST)) BW_VDMA((s) + 1, b ^ 1); \
    f32x16 p0 = {}; float mn, alpha; bf16x8 pa0, pa1; \
    if (!(LAST)) BW_KWAIT(8); else BW_KWAIT(0); \
    _Pragma("unroll") for (int d0 = 0; d0 < 8; ++d0) p0 = __builtin_amdgcn_mfma_f32_32x32x16_bf16(kr[d0], qr[d0], p0, 0, 0, 0); \
    SBAR(); \
    if (!(LAST)) BW_KLOAD((s) + 1); \
    if (edge | ((s) == 0) | ((s) == 4)) { \
      _Pragma("unroll") for (int r = 0; r < 16; ++r) { const int key = 32 * (s) + crow(r, hi); \
        const bool ok = ((unsigned)(key - r32) <= 128u) && ((unsigned)(kf + key) < (unsigned)Mr); \
        p0[r] = ok ? p0[r] : -3.0e4f; } } \
    partialSM1(p0, m_reg, mn, alpha); \
    if (__any(alpha < 1.f)) { if (hi == 0) al_l[r32] = alpha; asm volatile("s_waitcnt lgkmcnt(0)" ::: "memory"); \
      _Pragma("unroll") for (int d = 0; d < 4; ++d) \
        _Pragma("unroll") for (int r = 0; r < 16; ++r) o[d][r] *= al_l[crow(r, hi)]; } \
    finishSM1(p0, alpha, l_reg, pa0, pa1); \
    if (!(LAST)) asm volatile("s_waitcnt vmcnt(16)" ::: "memory"); else asm volatile("s_waitcnt vmcnt(0)" ::: "memory");     \
    SBAR(); \
    const int vb = vb0 + b * 8192; VF2 fa, fb; \
    vf2_load<0>(fa, vb); vf2_load<1>(fb, vb); VF2_WAIT(4, fa); vf2_mma(o[0], fa, pa0, pa1); \
    vf2_load<2>(fa, vb); VF2_WAIT(4, fb); vf2_mma(o[1], fb, pa0, pa1); \
    vf2_load<3>(fb, vb); VF2_WAIT(4, fa); vf2_mma(o[2], fa, pa0, pa1); \
    VF2_WAIT(0, fb); vf2_mma(o[3], fb, pa0, pa1); } while (0)
#pragma unroll 1
  for (int s = 0; s < 4; ++s) BW_STEP(s, false);
  BW_STEP(4, true);
#undef BW_STEP
  if (hi == 0) li_l[r32] = l_reg; asm volatile("s_waitcnt lgkmcnt(0)" ::: "memory");
  float rli[16];
#pragma unroll
  for (int r = 0; r < 16; ++r) rli[r] = __builtin_amdgcn_rcpf(li_l[crow(r, hi)]);
  bf16_t* Ow = Ob + (long)(wid * QBLK) * ldo;
#pragma unroll
  for (int r = 0; r < 16; ++r) { const int orow = crow(r, hi);
#pragma unroll
    for (int d0 = 0; d0 < 4; ++d0) Ow[(long)orow * ldo + d0 * 32 + r32] = (bf16_t)f2bf(o[d0][r] * rli[r]); }
  if (hi == 0) lse[(long)(wid * QBLK + r32) * ldlse] = m_reg * SCALE + __logf(l_reg);
#undef BW_KLOAD
#undef BW_KWAIT
#undef BW_VDMA
}

constexpr int W_SHM_V = KVBLK * 256 * 2, W_SHM_K = KVBLK * D * 2, W_OFF_K = 3 * W_SHM_V, W_OFF_WS = W_OFF_K + 2 * W_SHM_K, W_SHM_TOTAL = W_OFF_WS + NW * 64 * 4;
constexpr int w_rd_off(int d0, int ks, int half) { return d0 * 512 + ks * 8192 + half * 4096; }
template <int D0> __device__ __forceinline__ void pvw_one(f32x16& od, int vb, bf16x8 pa0, bf16x8 pa1, bf16x8 pa2, bf16x8 pa3) {
  const s16x4 l0 = tr_read<w_rd_off(D0, 0, 0)>(vb), h0 = tr_read<w_rd_off(D0, 0, 1)>(vb), l1 = tr_read<w_rd_off(D0, 1, 0)>(vb), h1 = tr_read<w_rd_off(D0, 1, 1)>(vb);
  const s16x4 l2 = tr_read<w_rd_off(D0, 2, 0)>(vb), h2 = tr_read<w_rd_off(D0, 2, 1)>(vb), l3 = tr_read<w_rd_off(D0, 3, 0)>(vb), h3 = tr_read<w_rd_off(D0, 3, 1)>(vb);
  asm volatile("s_waitcnt lgkmcnt(0)" ::: "memory"); SBAR();
#define PK(L, H) (bf16x8){L[0], L[1], L[2], L[3], H[0], H[1], H[2], H[3]}
  od = __builtin_amdgcn_mfma_f32_32x32x16_bf16(pa0, PK(l0, h0), od, 0, 0, 0);
  od = __builtin_amdgcn_mfma_f32_32x32x16_bf16(pa1, PK(l1, h1), od, 0, 0, 0);
  od = __builtin_amdgcn_mfma_f32_32x32x16_bf16(pa2, PK(l2, h2), od, 0, 0, 0);
  od = __builtin_amdgcn_mfma_f32_32x32x16_bf16(pa3, PK(l3, h3), od, 0, 0, 0);
#undef PK
}
struct VF { s16x4 l0, h0, l1, h1, l2, h2, l3, h3; };
template <int D0> __device__ __forceinline__ void vf_load(VF& f, int vb) {
  f.l0 = tr_read<w_rd_off(D0, 0, 0)>(vb); f.h0 = tr_read<w_rd_off(D0, 0, 1)>(vb); f.l1 = tr_read<w_rd_off(D0, 1, 0)>(vb); f.h1 = tr_read<w_rd_off(D0, 1, 1)>(vb);
  f.l2 = tr_read<w_rd_off(D0, 2, 0)>(vb); f.h2 = tr_read<w_rd_off(D0, 2, 1)>(vb); f.l3 = tr_read<w_rd_off(D0, 3, 0)>(vb); f.h3 = tr_read<w_rd_off(D0, 3, 1)>(vb);
}
#define VF_WAIT(N, f) asm volatile("s_waitcnt lgkmcnt(" #N ")" : "+v"(f.l0), "+v"(f.h0), "+v"(f.l1), "+v"(f.h1), "+v"(f.l2), "+v"(f.h2), "+v"(f.l3), "+v"(f.h3) :: "memory")
__device__ __forceinline__ void vf_mma(f32x16& od, const VF& f, bf16x8 pa0, bf16x8 pa1, bf16x8 pa2, bf16x8 pa3) {
#define PK(L, H) (bf16x8){L[0], L[1], L[2], L[3], H[0], H[1], H[2], H[3]}
  od = __builtin_amdgcn_mfma_f32_32x32x16_bf16(pa0, PK(f.l0, f.h0), od, 0, 0, 0);
  od = __builtin_amdgcn_mfma_f32_32x32x16_bf16(pa1, PK(f.l1, f.h1), od, 0, 0, 0);
  od = __builtin_amdgcn_mfma_f32_32x32x16_bf16(pa2, PK(f.l2, f.h2), od, 0, 0, 0);
  od = __builtin_amdgcn_mfma_f32_32x32x16_bf16(pa3, PK(f.l3, f.h3), od, 0, 0, 0);
#undef PK
}
template <int OFF> __device__ __forceinline__ bf16x8 ds_rd128(int a) { bf16x8 r; asm volatile("ds_read_b128 %0, %1 offset:%2" : "=&v"(r) : "v"(a), "i"(OFF) : "memory"); return r; }
#define KF_RD(A, B, d0) do { const int _a = (kx ^ ((d0) * 32)) + krow; A = ds_rd128<0>(_a); B = ds_rd128<8192>(_a); } while (0)
#define KF_WAIT(N, A, B) asm volatile("s_waitcnt lgkmcnt(" #N ")" : "+v"(A), "+v"(B) :: "memory")
#define KF_MMA(A, B, d0) do { p0 = __builtin_amdgcn_mfma_f32_32x32x16_bf16(A, qr[d0], p0, 0, 0, 0); p1 = __builtin_amdgcn_mfma_f32_32x32x16_bf16(B, qr[d0], p1, 0, 0, 0); } while (0)
__device__ __forceinline__ void attn_wide_body(const bf16_t* __restrict__ Qb, const bf16_t* __restrict__ Kh, const bf16_t* __restrict__ Vh, const int ld, const int NT,
                                               bf16_t* __restrict__ Ob, const int ldo, char* lds,
                                               const bool comb, const float lam, const float gscale, const float* __restrict__ subln, bf16_t* __restrict__ Cb, const int ldc) {
  int tid = threadIdx.x; asm volatile("" : "+v"(tid));
  const int wid = __builtin_amdgcn_readfirstlane(tid >> 6), lane = tid & 63, r32 = lane & 31, hi = lane >> 5;
  float* ws = (float*)(lds + W_OFF_WS) + wid * 64; float* li_l = ws; float* al_l = ws + 32;
  float m_reg = -1e30f, l_reg = 0; f32x16 o[8] = {}; bf16x8 qr[8];
  const bf16_t* Qw = Qb + (long)(wid * QBLK + r32) * ld + hi * 8;
#pragma unroll
  for (int d0 = 0; d0 < 8; ++d0) qr[d0] = *reinterpret_cast<const bf16x8*>(Qw + d0 * 16);
  unsigned kof[2], vof[4];
#pragma unroll
  for (int i = 0; i < 2; ++i) { const int g = wid + 8 * i, row = 4 * g + (lane >> 4), chunk = (lane & 15) ^ (row & 15); kof[i] = (unsigned)(row * ld + chunk * 8); }
#pragma unroll
  for (int i = 0; i < 4; ++i) { const int p = wid + 8 * i, sub = lane >> 5, w32 = lane & 31, kk = (p >> 2) * 8 + (w32 >> 2), k = (kk & ~0xC) | ((kk & 4) << 1) | ((kk & 8) >> 1);
    vof[i] = (unsigned)(k * ld + (2 * (p & 3) + sub) * 32 + (w32 & 3) * 8); }
  const int vb0 = (int)(uintptr_t)lds + v_rd_base(lane);
  const int kx = (hi * 16) ^ ((r32 & 15) << 4), krow0 = (int)(uintptr_t)lds + W_OFF_K + r32 * 256;
#define W_DMA(k0, b, bv) do { const bf16_t* _kp = Kh + (long)(k0) * ld; const bf16_t* _vp = Vh + (long)(k0) * ld; \
    _Pragma("unroll") for (int _i = 0; _i < 2; ++_i) __builtin_amdgcn_global_load_lds((const unsigned*)(_kp + kof[_i]), (LAS unsigned*)(lds + W_OFF_K + (b) * W_SHM_K + (wid + 8 * _i) * 1024), 16, 0, 0); \
    _Pragma("unroll") for (int _i = 0; _i < 4; ++_i) __builtin_amdgcn_global_load_lds((const unsigned*)(_vp + vof[_i]), (LAS unsigned*)(lds + (bv) * W_SHM_V + (wid + 8 * _i) * 1024), 16, 0, 0); } while (0)
  W_DMA(0, 0, 0);
  asm volatile("s_waitcnt vmcnt(0)" ::: "memory"); __builtin_amdgcn_s_barrier(); asm volatile("" ::: "memory");
#pragma unroll
  for (int d0 = 0; d0 < 8; ++d0) asm volatile("" : "+v"(qr[d0]));
#if defined(W_PRIO)
  if (wid >= 4) __builtin_amdgcn_s_setprio(1);
#endif
  const bool lagB = wid >= 4;
  bf16x8 pa0 = {}, pa1 = {}, pa2 = {}, pa3 = {};
#define W_PV(vbx) do { const int _vb = (vbx); VF fa, fb; vf_load<0>(fa, _vb); \
    vf_load<1>(fb, _vb); VF_WAIT(8, fa); vf_mma(o[0], fa, pa0, pa1, pa2, pa3); \
    vf_load<2>(fa, _vb); VF_WAIT(8, fb); vf_mma(o[1], fb, pa0, pa1, pa2, pa3); \
    vf_load<3>(fb, _vb); VF_WAIT(8, fa); vf_mma(o[2], fa, pa0, pa1, pa2, pa3); \
    vf_load<4>(fa, _vb); VF_WAIT(8, fb); vf_mma(o[3], fb, pa0, pa1, pa2, pa3); \
    vf_load<5>(fb, _vb); VF_WAIT(8, fa); vf_mma(o[4], fa, pa0, pa1, pa2, pa3); \
    vf_load<6>(fa, _vb); VF_WAIT(8, fb); vf_mma(o[5], fb, pa0, pa1, pa2, pa3); \
    vf_load<7>(fb, _vb); VF_WAIT(8, fa); vf_mma(o[6], fa, pa0, pa1, pa2, pa3); \
    VF_WAIT(0, fb); vf_mma(o[7], fb, pa0, pa1, pa2, pa3); } while (0)
#pragma unroll 1
  for (int j = 0; j <= NT; ++j) {
    if (j + 1 < NT) W_DMA((j + 1) * KVBLK, (j + 1) & 1, (j + 1) % 3);
    if (lagB && j >= 1) { W_PV(vb0 + ((j - 1) % 3) * W_SHM_V); SBAR(); }
    if (j < NT) {
      f32x16 p0 = {}, p1 = {}; float mn, alpha;
      const int krow = krow0 + (j & 1) * W_SHM_K;
      { bf16x8 ka0, kb0, ka1, kb1, ka2, kb2;
        KF_RD(ka0, kb0, 0); KF_RD(ka1, kb1, 1);
        KF_RD(ka2, kb2, 2); KF_WAIT(4, ka0, kb0); KF_MMA(ka0, kb0, 0);
        KF_RD(ka0, kb0, 3); KF_WAIT(4, ka1, kb1); KF_MMA(ka1, kb1, 1);
        KF_RD(ka1, kb1, 4); KF_WAIT(4, ka2, kb2); KF_MMA(ka2, kb2, 2);
        KF_RD(ka2, kb2, 5); KF_WAIT(4, ka0, kb0); KF_MMA(ka0, kb0, 3);
        KF_RD(ka0, kb0, 6); KF_WAIT(4, ka1, kb1); KF_MMA(ka1, kb1, 4);
        KF_RD(ka1, kb1, 7); KF_WAIT(4, ka2, kb2); KF_MMA(ka2, kb2, 5);
        KF_WAIT(2, ka0, kb0); KF_MMA(ka0, kb0, 6);
        KF_WAIT(0, ka1, kb1); KF_MMA(ka1, kb1, 7); }
      partialSM(p0, p1, m_reg, mn, alpha);
      if (__any(alpha < 1.f)) { if (hi == 0) al_l[r32] = alpha; asm volatile("s_waitcnt lgkmcnt(0)" ::: "memory");
#pragma unroll
        for (int d = 0; d < 8; ++d)
#pragma unroll
          for (int r = 0; r < 16; ++r) o[d][r] *= al_l[crow(r, hi)]; }
      finishSM(p0, p1, alpha, l_reg, pa0, pa1, pa2, pa3); SBAR();
      if (!lagB) W_PV(vb0 + (j % 3) * W_SHM_V);
    }
    asm volatile("s_waitcnt vmcnt(0) lgkmcnt(0)" ::: "memory"); __builtin_amdgcn_s_barrier(); asm volatile("" ::: "memory");
  }
#undef W_PV
#if defined(W_PRIO)
  __builtin_amdgcn_s_setprio(0);
#endif
  if (hi == 0) li_l[r32] = l_reg; asm volatile("s_waitcnt lgkmcnt(0)" ::: "memory");
  float rli[16];
#pragma unroll
  for (int r = 0; r < 16; ++r) rli[r] = __builtin_amdgcn_rcpf(li_l[crow(r, hi)]);
  bf16_t* Ow = Ob + (long)(wid * QBLK) * ldo;
  if (!comb) {
#pragma unroll
    for (int r = 0; r < 16; ++r) { const int orow = crow(r, hi);
#pragma unroll
      for (int d0 = 0; d0 < 8; ++d0) Ow[(long)orow * ldo + d0 * 32 + r32] = (bf16_t)f2bf(o[d0][r] * rli[r]); }
  } else {
    bf16_t* Cw = Cb + (long)(wid * QBLK) * ldc;
#pragma unroll
    for (int r = 0; r < 16; ++r) { const int orow = crow(r, hi); float ss = 0.f;
#pragma unroll
      for (int d0 = 0; d0 < 8; ++d0) { const float v = bf2f((unsigned)Ow[(long)orow * ldo + d0 * 32 + r32]) - lam * (o[d0][r] * rli[r]); o[d0][r] = v; ss += v * v; }
      ss += __shfl_xor(ss, 1); ss += __shfl_xor(ss, 2); ss += __shfl_xor(ss, 4); ss += __shfl_xor(ss, 8); ss += __shfl_xor(ss, 16);
      const float rstd = __builtin_amdgcn_rsqf(ss * (1.0f / 256.0f) + NORM_EPS) * gscale;
#pragma unroll
      for (int d0 = 0; d0 < 8; ++d0) o[d0][r] *= rstd; }
#pragma unroll
    for (int d0 = 0; d0 < 8; ++d0) { const float gsub = subln[d0 * 32 + r32];
#pragma unroll
      for (int r = 0; r < 16; ++r) Cw[(long)crow(r, hi) * ldc + d0 * 32 + r32] = (bf16_t)f2bf(o[d0][r] * gsub); }
  }
#undef W_DMA
}
__device__ __forceinline__ float pmax16(const f32x4 (&P)[4]) {
  float m = P[0][0];
#pragma unroll
  for (int kb = 0; kb < 4; ++kb)
#pragma unroll
    for (int t2 = 0; t2 < 4; ++t2) if (kb | t2) m = fmaxf(m, P[kb][t2]);
  return m;
}
#define PMAX16(P) pmax16(P)
template <int LAST, int S> __device__ __forceinline__ float bmask(float p, int w) {
  if constexpr (!LAST) { if constexpr (S >= 15) return p; else if constexpr (S < -12) return -3.0e4f; else return (w <= S) ? p : -3.0e4f; }
  else { if constexpr (S <= -12) return p; else if constexpr (S > 15) return -3.0e4f; else return (S <= w) ? p : -3.0e4f; }
}
#define BM1(ODD, LAST, A, KB, T) p[A][KB][T] = bmask<LAST, 16 * ((KB) - (A)) + (T) - 32 * (ODD)>(p[A][KB][T], wl);
#define BM4(ODD, LAST, A, KB) BM1(ODD, LAST, A, KB, 0) BM1(ODD, LAST, A, KB, 1) BM1(ODD, LAST, A, KB, 2) BM1(ODD, LAST, A, KB, 3)
#define BM16(ODD, LAST, A) BM4(ODD, LAST, A, 0) BM4(ODD, LAST, A, 1) BM4(ODD, LAST, A, 2) BM4(ODD, LAST, A, 3)
#define BMALL(ODD, LAST) do { BM16(ODD, LAST, 0) BM16(ODD, LAST, 1) } while (0)
__device__ __forceinline__ float xrow16_max(float x) {
  auto s = __builtin_amdgcn_permlane16_swap(__float_as_uint(x), __float_as_uint(x), false, false); x = fmaxf(__uint_as_float(s[0]), __uint_as_float(s[1]));
  auto u = __builtin_amdgcn_permlane32_swap(__float_as_uint(x), __float_as_uint(x), false, false); return fmaxf(__uint_as_float(u[0]), __uint_as_float(u[1]));
}
__device__ __forceinline__ float xrow16_sum(float x) {
  auto s = __builtin_amdgcn_permlane16_swap(__float_as_uint(x), __float_as_uint(x), false, false); x = __uint_as_float(s[0]) + __uint_as_float(s[1]);
  auto u = __builtin_amdgcn_permlane32_swap(__float_as_uint(x), __float_as_uint(x), false, false); return __uint_as_float(u[0]) + __uint_as_float(u[1]);
}
constexpr int w16_off(int s, int db, int second) { return s * 16384 + db * 256 + second * 8192; }
template <int S, int G4> __device__ __forceinline__ void vf16_load(VF& f, int vb) {
  f.l0 = tr_read<w16_off(S, 4 * G4 + 0, 0)>(vb); f.h0 = tr_read<w16_off(S, 4 * G4 + 0, 1)>(vb); f.l1 = tr_read<w16_off(S, 4 * G4 + 1, 0)>(vb); f.h1 = tr_read<w16_off(S, 4 * G4 + 1, 1)>(vb);
  f.l2 = tr_read<w16_off(S, 4 * G4 + 2, 0)>(vb); f.h2 = tr_read<w16_off(S, 4 * G4 + 2, 1)>(vb); f.l3 = tr_read<w16_off(S, 4 * G4 + 3, 0)>(vb); f.h3 = tr_read<w16_off(S, 4 * G4 + 3, 1)>(vb);
}
__device__ __forceinline__ void vf16_mma(f32x4* o0, f32x4* o1, const VF& f, bf16x8 pb0, bf16x8 pb1) {
#define PK(L, H) (bf16x8){L[0], L[1], L[2], L[3], H[0], H[1], H[2], H[3]}
  o0[0] = __builtin_amdgcn_mfma_f32_16x16x32_bf16(PK(f.l0, f.h0), pb0, o0[0], 0, 0, 0); o1[0] = __builtin_amdgcn_mfma_f32_16x16x32_bf16(PK(f.l0, f.h0), pb1, o1[0], 0, 0, 0);
  o0[1] = __builtin_amdgcn_mfma_f32_16x16x32_bf16(PK(f.l1, f.h1), pb0, o0[1], 0, 0, 0); o1[1] = __builtin_amdgcn_mfma_f32_16x16x32_bf16(PK(f.l1, f.h1), pb1, o1[1], 0, 0, 0);
  o0[2] = __builtin_amdgcn_mfma_f32_16x16x32_bf16(PK(f.l2, f.h2), pb0, o0[2], 0, 0, 0); o1[2] = __builtin_amdgcn_mfma_f32_16x16x32_bf16(PK(f.l2, f.h2), pb1, o1[2], 0, 0, 0);
  o0[3] = __builtin_amdgcn_mfma_f32_16x16x32_bf16(PK(f.l3, f.h3), pb0, o0[3], 0, 0, 0); o1[3] = __builtin_amdgcn_mfma_f32_16x16x32_bf16(PK(f.l3, f.h3), pb1, o1[3], 0, 0, 0);
#undef PK
}
__device__ __forceinline__ void attn_wide16_body(const bf16_t* __restrict__ Qb, const bf16_t* __restrict__ Kh, const bf16_t* __restrict__ Vh, const int ld, const int NT,
                                                 bf16_t* __restrict__ Ob, const int ldo, char* lds,
                                                 const bool comb, const float lam, const float gscale, const float* __restrict__ subln, bf16_t* __restrict__ Cb, const int ldc) {
  int tid = threadIdx.x; asm volatile("" : "+v"(tid));
  const int wid = __builtin_amdgcn_readfirstlane(tid >> 6), lane = tid & 63, c16 = lane & 15, g = lane >> 4;
  constexpr float C = SCALE * 1.4426950408889634f;
  float m0 = -1e30f, m1 = -1e30f, l0 = 0.f, l1 = 0.f; f32x4 o[2][16]; bf16x8 qr[2][4];
#pragma unroll
  for (int a = 0; a < 2; ++a)
#pragma unroll
    for (int b = 0; b < 16; ++b) o[a][b] = f32x4{0.f, 0.f, 0.f, 0.f};
#pragma unroll
  for (int qb = 0; qb < 2; ++qb)
#pragma unroll
    for (int d0 = 0; d0 < 4; ++d0) qr[qb][d0] = *reinterpret_cast<const bf16x8*>(Qb + (long)(wid * QBLK + qb * 16 + c16) * ld + d0 * 32 + g * 8);
  const int krw = 4 * wid + (lane >> 4); const unsigned kof0 = (unsigned)(krw * ld + ((lane & 15) ^ (krw & 15)) * 8), kstep = 32u * (unsigned)ld;
  const unsigned vof0 = (unsigned)((8 * (wid >> 2) + ((lane & 15) >> 1)) * ld + (4 * (wid & 3) + (lane >> 4)) * 16 + (lane & 1) * 8), vstep = 16u * (unsigned)ld;
#define W16_DMA(k0, b) do { const bf16_t* _kp = Kh + (long)(k0) * ld; const bf16_t* _vp = Vh + (long)(k0) * ld; \
    _Pragma("unroll") for (int _i = 0; _i < 2; ++_i) __builtin_amdgcn_global_load_lds((const unsigned*)(_kp + kof0 + _i * kstep), (LAS unsigned*)(lds + W_OFF_K + (b) * W_SHM_K + (wid + 8 * _i) * 1024), 16, 0, 0); \
    _Pragma("unroll") for (int _i = 0; _i < 4; ++_i) __builtin_amdgcn_global_load_lds((const unsigned*)(_vp + vof0 + _i * vstep), (LAS unsigned*)(lds + (b) * W_SHM_V + (wid + 8 * _i) * 1024), 16, 0, 0); } while (0)
  const int kx = (g ^ c16) << 4, kq0 = (int)(uintptr_t)lds + W_OFF_K + c16 * 256;
  const int vb0 = (int)(uintptr_t)lds + (g >> 1) * 4096 + (4 * (g & 1) + (c16 >> 2)) * 32 + (c16 & 3) * 8;
  W16_DMA(0, 0);
  asm volatile("s_waitcnt vmcnt(0)" ::: "memory"); __builtin_amdgcn_s_barrier(); asm volatile("" ::: "memory");
#pragma unroll
  for (int qb = 0; qb < 2; ++qb)
#pragma unroll
    for (int d0 = 0; d0 < 4; ++d0) asm volatile("" : "+v"(qr[qb][d0]));
#pragma unroll 1
  for (int j = 0; j < NT; ++j) {
    const int b = j & 1;
    if (j + 1 < NT) W16_DMA((j + 1) * KVBLK, b ^ 1);
    f32x4 p[2][4];
    { const int kq = kq0 + b * W_SHM_K; const int ka0 = kq + (0 ^ kx), ka1 = kq + (64 ^ kx), ka2 = kq + (128 ^ kx), ka3 = kq + (192 ^ kx);
      bf16x8 f0, f1, f2;
#define K16_RD(F, IDX) F = ds_rd128<((IDX) >> 2) * 4096>(((IDX) & 3) == 0 ? ka0 : ((IDX) & 3) == 1 ? ka1 : ((IDX) & 3) == 2 ? ka2 : ka3)
#define K16_WAIT(N, F) asm volatile("s_waitcnt lgkmcnt(" #N ")" : "+v"(F) :: "memory")
#define K16_MMA(F, IDX) do { p[0][(IDX) >> 2] = __builtin_amdgcn_mfma_f32_16x16x32_bf16(F, qr[0][(IDX) & 3], ((IDX) & 3) ? p[0][(IDX) >> 2] : f32x4{0.f, 0.f, 0.f, 0.f}, 0, 0, 0); \
                             p[1][(IDX) >> 2] = __builtin_amdgcn_mfma_f32_16x16x32_bf16(F, qr[1][(IDX) & 3], ((IDX) & 3) ? p[1][(IDX) >> 2] : f32x4{0.f, 0.f, 0.f, 0.f}, 0, 0, 0); } while (0)
      K16_RD(f0, 0); K16_RD(f1, 1);
      K16_RD(f2, 2); K16_WAIT(2, f0); K16_MMA(f0, 0);
      K16_RD(f0, 3); K16_WAIT(2, f1); K16_MMA(f1, 1);
      K16_RD(f1, 4); K16_WAIT(2, f2); K16_MMA(f2, 2);
      K16_RD(f2, 5); K16_WAIT(2, f0); K16_MMA(f0, 3);
      K16_RD(f0, 6); K16_WAIT(2, f1); K16_MMA(f1, 4);
      K16_RD(f1, 7); K16_WAIT(2, f2); K16_MMA(f2, 5);
      K16_RD(f2, 8); K16_WAIT(2, f0); K16_MMA(f0, 6);
      K16_RD(f0, 9); K16_WAIT(2, f1); K16_MMA(f1, 7);
      K16_RD(f1, 10); K16_WAIT(2, f2); K16_MMA(f2, 8);
      K16_RD(f2, 11); K16_WAIT(2, f0); K16_MMA(f0, 9);
      K16_RD(f0, 12); K16_WAIT(2, f1); K16_MMA(f1, 10);
      K16_RD(f1, 13); K16_WAIT(2, f2); K16_MMA(f2, 11);
      K16_RD(f2, 14); K16_WAIT(2, f0); K16_MMA(f0, 12);
      K16_RD(f0, 15); K16_WAIT(2, f1); K16_MMA(f1, 13);
      K16_WAIT(1, f2); K16_MMA(f2, 14);
      K16_WAIT(0, f0); K16_MMA(f0, 15);
#undef K16_RD
#undef K16_WAIT
#undef K16_MMA
    }
    float pm0 = PMAX16(p[0]), pm1 = PMAX16(p[1]);
    pm0 = xrow16_max(pm0); pm1 = xrow16_max(pm1);
    float al0 = 1.f, al1 = 1.f;
    if (!__builtin_expect(__all((pm0 - m0 <= THR / SCALE) & (pm1 - m1 <= THR / SCALE)), 1)) {
      const float n0 = fmaxf(m0, pm0), n1 = fmaxf(m1, pm1); al0 = __builtin_amdgcn_exp2f((m0 - n0) * C); al1 = __builtin_amdgcn_exp2f((m1 - n1) * C); m0 = n0; m1 = n1;
#pragma unroll
      for (int db = 0; db < 16; ++db) { o[0][db] = o[0][db] * al0; o[1][db] = o[1][db] * al1; } }
    const float mc0 = -m0 * C, mc1 = -m1 * C; float ps0 = 0.f, ps1 = 0.f;
#pragma unroll
    for (int kb = 0; kb < 4; ++kb)
#pragma unroll
      for (int t2 = 0; t2 < 4; ++t2) { p[0][kb][t2] = __builtin_amdgcn_exp2f(fmaf(p[0][kb][t2], C, mc0)); p[1][kb][t2] = __builtin_amdgcn_exp2f(fmaf(p[1][kb][t2], C, mc1)); ps0 += p[0][kb][t2]; ps1 += p[1][kb][t2]; }
    ps0 = xrow16_sum(ps0); ps1 = xrow16_sum(ps1); l0 = l0 * al0 + ps0; l1 = l1 * al1 + ps1;
    bf16x8 pb[2][2];
#pragma unroll
    for (int a = 0; a < 2; ++a)
#pragma unroll
      for (int s = 0; s < 2; ++s) { u32x4 w = {cvtpk(p[a][2 * s][0], p[a][2 * s][1]), cvtpk(p[a][2 * s][2], p[a][2 * s][3]), cvtpk(p[a][2 * s + 1][0], p[a][2 * s + 1][1]), cvtpk(p[a][2 * s + 1][2], p[a][2 * s + 1][3])};
        pb[a][s] = *reinterpret_cast<bf16x8*>(&w); }
    SBAR();
    { const int vb = vb0 + b * W_SHM_V; VF fa, fb;
      vf16_load<0, 0>(fa, vb);
      vf16_load<0, 1>(fb, vb); VF_WAIT(8, fa); vf16_mma(&o[0][0], &o[1][0], fa, pb[0][0], pb[1][0]);
      vf16_load<0, 2>(fa, vb); VF_WAIT(8, fb); vf16_mma(&o[0][4], &o[1][4], fb, pb[0][0], pb[1][0]);
      vf16_load<0, 3>(fb, vb); VF_WAIT(8, fa); vf16_mma(&o[0][8], &o[1][8], fa, pb[0][0], pb[1][0]);
      vf16_load<1, 0>(fa, vb); VF_WAIT(8, fb); vf16_mma(&o[0][12], &o[1][12], fb, pb[0][0], pb[1][0]);
      vf16_load<1, 1>(fb, vb); VF_WAIT(8, fa); vf16_mma(&o[0][0], &o[1][0], fa, pb[0][1], pb[1][1]);
      vf16_load<1, 2>(fa, vb); VF_WAIT(8, fb); vf16_mma(&o[0][4], &o[1][4], fb, pb[0][1], pb[1][1]);
      vf16_load<1, 3>(fb, vb); VF_WAIT(8, fa); vf16_mma(&o[0][8], &o[1][8], fa, pb[0][1], pb[1][1]);
      VF_WAIT(0, fb); vf16_mma(&o[0][12], &o[1][12], fb, pb[0][1], pb[1][1]); }
    asm volatile("s_waitcnt vmcnt(0) lgkmcnt(0)" ::: "memory"); __builtin_amdgcn_s_barrier(); asm volatile("" ::: "memory");
  }
  const float rl0 = __builtin_amdgcn_rcpf(l0), rl1 = __builtin_amdgcn_rcpf(l1);
#pragma unroll
  for (int qb = 0; qb < 2; ++qb) { const float rl = qb ? rl1 : rl0;
    bf16_t* Or = Ob + (long)(wid * QBLK + qb * 16 + c16) * ldo + 4 * g;
    if (!comb) {
#pragma unroll
      for (int db = 0; db < 16; ++db) { const u32x2 w = {cvtpk(o[qb][db][0] * rl, o[qb][db][1] * rl), cvtpk(o[qb][db][2] * rl, o[qb][db][3] * rl)}; *reinterpret_cast<u32x2*>(Or + db * 16) = w; }
    } else {
      bf16_t* Cr = Cb + (long)(wid * QBLK + qb * 16 + c16) * ldc + 4 * g; float ss = 0.f;
#pragma unroll
      for (int db = 0; db < 16; ++db) { const u32x2 w = *reinterpret_cast<const u32x2*>(Or + db * 16);
        const float v0 = bf2f(w.x & 0xffffu) - lam * (o[qb][db][0] * rl), v1 = bf2f(w.x >> 16) - lam * (o[qb][db][1] * rl), v2 = bf2f(w.y & 0xffffu) - lam * (o[qb][db][2] * rl), v3 = bf2f(w.y >> 16) - lam * (o[qb][db][3] * rl);
        o[qb][db] = f32x4{v0, v1, v2, v3}; ss += (v0 * v0 + v1 * v1) + (v2 * v2 + v3 * v3); }
      ss = xrow16_sum(ss);
      const float rstd = __builtin_amdgcn_rsqf(ss * (1.0f / 256.0f) + NORM_EPS) * gscale;
#pragma unroll
      for (int db = 0; db < 16; ++db) { const f32x4 gs = *reinterpret_cast<const f32x4*>(subln + db * 16 + 4 * g);
        const u32x2 w = {cvtpk(o[qb][db][0] * rstd * gs[0], o[qb][db][1] * rstd * gs[1]), cvtpk(o[qb][db][2] * rstd * gs[2], o[qb][db][3] * rstd * gs[3])}; *reinterpret_cast<u32x2*>(Cr + db * 16) = w; }
    }
  }
#undef W16_DMA
}
constexpr int wb16_off(int s, int db, int second) { return s * 8192 + db * 256 + second * 4096; }
template <int S, int G4> __device__ __forceinline__ void vfb16_load(VF& f, int vb) {
  f.l0 = tr_read<wb16_off(S, 4 * G4 + 0, 0)>(vb); f.h0 = tr_read<wb16_off(S, 4 * G4 + 0, 1)>(vb); f.l1 = tr_read<wb16_off(S, 4 * G4 + 1, 0)>(vb); f.h1 = tr_read<wb16_off(S, 4 * G4 + 1, 1)>(vb);
  f.l2 = tr_read<wb16_off(S, 4 * G4 + 2, 0)>(vb); f.h2 = tr_read<wb16_off(S, 4 * G4 + 2, 1)>(vb); f.l3 = tr_read<wb16_off(S, 4 * G4 + 3, 0)>(vb); f.h3 = tr_read<wb16_off(S, 4 * G4 + 3, 1)>(vb);
}
template <class UF>
__device__ __forceinline__ void attn_band16_stream(const int U, UF unit_of, char* lds) {
  int tid = threadIdx.x; asm volatile("" : "+v"(tid));
  const int wid = __builtin_amdgcn_readfirstlane(tid >> 6), lane = tid & 63, c16 = lane & 15, g = lane >> 4;
  constexpr float C = SCALE * 1.4426950408889634f;
  constexpr int TILE = 32768, OFF_B = 3 * TILE, OFF_WS = 4 * TILE;
  const int jlo = wid >> 1, qi0 = wid * QBLK + c16;
  const int kx = (g ^ c16) << 4;
  const int kq_l = (int)(uintptr_t)lds + 16384 + c16 * 256, vb_l = (int)(uintptr_t)lds + (g >> 1) * 2048 + (4 * (g & 1) + (c16 >> 2)) * 32 + (c16 & 3) * 8;
  const int krow0 = 4 * wid + (lane >> 4), kch = ((lane & 15) ^ (krow0 & 15)) * 8;
  const int vkey0 = 8 * (wid >> 1) + ((lane & 15) >> 1), vcol = (4 * (wid & 1) + (lane >> 4)) * 16 + (lane & 1) * 8;
#define BS_DMA(bu, j, boff) do { const int _kb = (bu).kfirst + 64 * (j); const int _sh = (bu).lsh;     \
    _Pragma("unroll") for (int _i = 0; _i < 2; ++_i) { const unsigned _ro = (__umul24((unsigned)min(max(_kb + krow0 + 32 * _i, 0), (bu).Mr - 1), 6144u) << _sh) + kch; \
      __builtin_amdgcn_global_load_lds((const unsigned*)((bu).K + _ro), (LAS unsigned*)(lds + (boff) + 16384 + (wid + 8 * _i) * 1024), 16, 0, 0); } \
    _Pragma("unroll") for (int _i = 0; _i < 2; ++_i) { const unsigned _ro = (__umul24((unsigned)min(max(_kb + vkey0 + 32 * _i, 0), (bu).Mr - 1), 6144u) << _sh) + vcol; \
      __builtin_amdgcn_global_load_lds((const unsigned*)((bu).V + _ro), (LAS unsigned*)(lds + (boff) + (wid + 8 * _i) * 1024), 16, 0, 0); } } while (0)
#define BS_QLOAD(bu) do { const bf16_t* _q = (bu).Q + (long)qi0 * (bu).ld + g * 8; const bf16_t* _q2 = _q + 16L * (bu).ld; \
    asm volatile("global_load_dwordx4 %0, %8, off\n\tglobal_load_dwordx4 %1, %8, off offset:64\n\tglobal_load_dwordx4 %2, %8, off offset:128\n\tglobal_load_dwordx4 %3, %8, off offset:192\n\t" \
                 "global_load_dwordx4 %4, %9, off\n\tglobal_load_dwordx4 %5, %9, off offset:64\n\tglobal_load_dwordx4 %6, %9, off offset:128\n\tglobal_load_dwordx4 %7, %9, off offset:192" \
                 : "=&v"(qr[0]), "=&v"(qr[1]), "=&v"(qr[2]), "=&v"(qr[3]), "=&v"(qr[4]), "=&v"(qr[5]), "=&v"(qr[6]), "=&v"(qr[7]) : "v"(_q), "v"(_q2) : "memory"); } while (0)
#define BS_POS_DMA(gq) do { const int _un = (gq) / 5, _jn = (gq) - 5 * _un; \
    if ((gq) <= 5 * U) { \
      if (_un < U) { const BandUnit _bn = unit_of(_un); BS_DMA(_bn, _jn, ((gq) % 3) * TILE); ndma += 4; } \
      if (_jn == 0 && _un >= 1) { const BandUnit _bp = unit_of(_un - 1); BS_DMA(_bp, 5, OFF_B); ndma += 4; } } } while (0)
  float m0 = -1e30f, m1 = -1e30f, l0 = 0.f, l1 = 0.f; f32x4 o[2][8]; bf16x8 qr[8];
#pragma unroll
  for (int a = 0; a < 2; ++a)
#pragma unroll
    for (int b = 0; b < 8; ++b) o[a][b] = f32x4{0.f, 0.f, 0.f, 0.f};
  { int ndma = 0; if (U > 0) { const BandUnit b0 = unit_of(0); BS_QLOAD(b0); } else {
#pragma unroll
      for (int d0 = 0; d0 < 8; ++d0) qr[d0] = bf16x8{}; }
    BS_POS_DMA(0); BS_POS_DMA(1); }
  asm volatile("s_waitcnt vmcnt(0)" ::: "memory");
#pragma unroll
  for (int d0 = 0; d0 < 8; ++d0) asm volatile("" : "+v"(qr[d0]));
  __builtin_amdgcn_s_barrier(); asm volatile("" ::: "memory");
#pragma unroll 1
  for (int gg = 0; gg <= 5 * U + 2; ++gg) {
    const int rel = gg - jlo, uw = rel >= 0 ? rel / 5 : -1, jr = rel - 5 * uw;
    int ndma = 0;
    if (uw >= 0 && jr >= 3 && uw < U) {
      const BandUnit bu = unit_of(uw);
      if (jr == 3) {
        const float rl0 = __builtin_amdgcn_rcpf(l0), rl1 = __builtin_amdgcn_rcpf(l1);
#pragma unroll
        for (int qb = 0; qb < 2; ++qb) { const float rl = qb ? rl1 : rl0; bf16_t* Or = bu.O + (long)(qi0 + 16 * qb) * bu.ldo + 4 * g;
#pragma unroll
          for (int db = 0; db < 8; ++db) { const u32x2 w = {cvtpk(o[qb][db][0] * rl, o[qb][db][1] * rl), cvtpk(o[qb][db][2] * rl, o[qb][db][3] * rl)}; *reinterpret_cast<u32x2*>(Or + db * 16) = w; } }
        if (g == 0) { bu.L[(long)qi0 * bu.ldl] = m0 * SCALE + __logf(l0); bu.L[(long)(qi0 + 16) * bu.ldl] = m1 * SCALE + __logf(l1); } }
      asm volatile("s_waitcnt vmcnt(0)" ::: "memory");
      if (jr == 3 && uw + 1 < U) { const BandUnit bn = unit_of(uw + 1); BS_QLOAD(bn); ndma += 8; }
      BS_POS_DMA(gg + 2);
    } else {
    BS_POS_DMA(gg + 2);
    if (uw >= 0 && jr <= 2 && uw < U) {
      const BandUnit bu = unit_of(uw);
      const int j = jlo + jr, boff = (j == 5) ? OFF_B : (gg % 3) * TILE;
      if (jr == 0) { m0 = m1 = -1e30f; l0 = l1 = 0.f;
#pragma unroll
        for (int a = 0; a < 2; ++a)
#pragma unroll
          for (int b = 0; b < 8; ++b) o[a][b] = f32x4{0.f, 0.f, 0.f, 0.f}; }
      if ((bu.kfirst + 64 * j >= 0) & (bu.kfirst + 64 * j + 64 <= bu.Mr)) {
      f32x4 p[2][4];
      { int kxo = kx; asm volatile("" : "+v"(kxo));
        const int kq = kq_l + boff; const int ka0 = kq + (0 ^ kxo), ka1 = kq + (64 ^ kxo), ka2 = kq + (128 ^ kxo), ka3 = kq + (192 ^ kxo);
        bf16x8 f0, f1;
#define K16_RD(F, IDX) F = dsb_rd128<((IDX) >> 2) * 4096>(((IDX) & 3) == 0 ? ka0 : ((IDX) & 3) == 1 ? ka1 : ((IDX) & 3) == 2 ? ka2 : ka3)
#define K16_WAIT(N, F) asm volatile("s_waitcnt lgkmcnt(" #N ")" : "+v"(F) :: "memory")
#define K16_MMA(F, IDX) do { p[0][(IDX) >> 2] = __builtin_amdgcn_mfma_f32_16x16x32_bf16(F, qr[(IDX) & 3], ((IDX) & 3) ? p[0][(IDX) >> 2] : f32x4{0.f, 0.f, 0.f, 0.f}, 0, 0, 0); \
                             p[1][(IDX) >> 2] = __builtin_amdgcn_mfma_f32_16x16x32_bf16(F, qr[4 + ((IDX) & 3)], ((IDX) & 3) ? p[1][(IDX) >> 2] : f32x4{0.f, 0.f, 0.f, 0.f}, 0, 0, 0); } while (0)
        K16_RD(f0, 0);
        K16_RD(f1, 1); K16_WAIT(1, f0); K16_MMA(f0, 0);
        K16_RD(f0, 2); K16_WAIT(1, f1); K16_MMA(f1, 1);
        K16_RD(f1, 3); K16_WAIT(1, f0); K16_MMA(f0, 2);
        K16_RD(f0, 4); K16_WAIT(1, f1); K16_MMA(f1, 3);
        K16_RD(f1, 5); K16_WAIT(1, f0); K16_MMA(f0, 4);
        K16_RD(f0, 6); K16_WAIT(1, f1); K16_MMA(f1, 5);
        K16_RD(f1, 7); K16_WAIT(1, f0); K16_MMA(f0, 6);
        K16_RD(f0, 8); K16_WAIT(1, f1); K16_MMA(f1, 7);
        K16_RD(f1, 9); K16_WAIT(1, f0); K16_MMA(f0, 8);
        K16_RD(f0, 10); K16_WAIT(1, f1); K16_MMA(f1, 9);
        K16_RD(f1, 11); K16_WAIT(1, f0); K16_MMA(f0, 10);
        K16_RD(f0, 12); K16_WAIT(1, f1); K16_MMA(f1, 11);
        K16_RD(f1, 13); K16_WAIT(1, f0); K16_MMA(f0, 12);
        K16_RD(f0, 14); K16_WAIT(1, f1); K16_MMA(f1, 13);
        K16_RD(f1, 15); K16_WAIT(1, f0); K16_MMA(f0, 14);
        K16_WAIT(0, f1); K16_MMA(f1, 15);
#undef K16_RD
#undef K16_WAIT
#undef K16_MMA
      }
      if (jr != 1) {
        const int wl = c16 - 4 * g;
        if (wid & 1) { if (jr == 0) BMALL(1, 0); else BMALL(1, 1); } else { if (jr == 0) BMALL(0, 0); else BMALL(0, 1); } }
      float pm0 = PMAX16(p[0]), pm1 = PMAX16(p[1]);
      pm0 = xrow16_max(pm0); pm1 = xrow16_max(pm1);
      float al0 = 1.f, al1 = 1.f;
      if (!__builtin_expect(__all((pm0 - m0 <= THR / SCALE) & (pm1 - m1 <= THR / SCALE)), 1)) {
        const float n0 = fmaxf(m0, pm0), n1 = fmaxf(m1, pm1); al0 = __builtin_amdgcn_exp2f((m0 - n0) * C); al1 = __builtin_amdgcn_exp2f((m1 - n1) * C); m0 = n0; m1 = n1;
        if (jr != 0) {
#pragma unroll
          for (int db = 0; db < 8; ++db) { o[0][db] = o[0][db] * al0; o[1][db] = o[1][db] * al1; } } }
      const float mc0 = -m0 * C, mc1 = -m1 * C; float ps0 = 0.f, ps1 = 0.f;
#pragma unroll
      for (int kb = 0; kb < 4; ++kb)
#pragma unroll
        for (int t2 = 0; t2 < 4; ++t2) { p[0][kb][t2] = __builtin_amdgcn_exp2f(fmaf(p[0][kb][t2], C, mc0)); p[1][kb][t2] = __builtin_amdgcn_exp2f(fmaf(p[1][kb][t2], C, mc1)); ps0 += p[0][kb][t2]; ps1 += p[1][kb][t2]; }
      ps0 = xrow16_sum(ps0); ps1 = xrow16_sum(ps1); l0 = l0 * al0 + ps0; l1 = l1 * al1 + ps1;
      bf16x8 pb[2][2];
#pragma unroll
      for (int a = 0; a < 2; ++a)
#pragma unroll
        for (int s = 0; s < 2; ++s) { u32x4 w = {cvtpk(p[a][2 * s][0], p[a][2 * s][1]), cvtpk(p[a][2 * s][2], p[a][2 * s][3]), cvtpk(p[a][2 * s + 1][0], p[a][2 * s + 1][1]), cvtpk(p[a][2 * s + 1][2], p[a][2 * s + 1][3])};
          pb[a][s] = *reinterpret_cast<bf16x8*>(&w); }
      SBAR();
      { int vb = vb_l + boff; asm volatile("" : "+v"(vb)); VF fa;
        vfb16_load<0, 0>(fa, vb); VF_WAIT(0, fa); vf16_mma(&o[0][0], &o[1][0], fa, pb[0][0], pb[1][0]);
        vfb16_load<0, 1>(fa, vb); VF_WAIT(0, fa); vf16_mma(&o[0][4], &o[1][4], fa, pb[0][0], pb[1][0]);
        vfb16_load<1, 0>(fa, vb); VF_WAIT(0, fa); vf16_mma(&o[0][0], &o[1][0], fa, pb[0][1], pb[1][1]);
        vfb16_load<1, 1>(fa, vb); VF_WAIT(0, fa); vf16_mma(&o[0][4], &o[1][4], fa, pb[0][1], pb[1][1]); }
      }
    } }
    asm volatile("s_waitcnt lgkmcnt(0)" ::: "memory");
#define BS_VMW(n) case n: asm volatile("s_waitcnt vmcnt(" #n ")" ::: "memory"); break;
    switch (ndma) { BS_VMW(4) BS_VMW(8) BS_VMW(12) BS_VMW(16) default: asm volatile("s_waitcnt vmcnt(0)" ::: "memory"); break; }
#undef BS_VMW
    __builtin_amdgcn_s_barrier(); asm volatile("" ::: "memory");
  }
#undef BS_DMA
#undef BS_QLOAD
#undef BS_POS_DMA
}
}

struct Frame { LAS unsigned char* lds; int wave, vcu, G; };
#define FRAME_TID() int f_tid = threadIdx.x; asm volatile("" : "+v"(f_tid)); const int f_lane = f_tid & 63; (void)f_lane

constexpr int TP_SCR = 64 * 65 * 4;
struct TpDesc { const float* W; bf16_t* WT; const float* gain; int K, N, mode, item; };
__device__ __forceinline__ void tp_load(const TpDesc& d, f32x4 (&v)[16], int lane) {
    const int nblk = d.N / 64, kb = d.item / nblk, nb = d.item % nblk, k0 = 64 * kb, n0 = 64 * nb, r = lane >> 4, q = lane & 15;
#pragma unroll
    for (int i = 0; i < 16; ++i) v[i] = *(const f32x4*)(d.W + (size_t)(k0 + 4 * i + r) * d.N + n0 + 4 * q);
}
__device__ __forceinline__ void tp_finish(const TpDesc& d, const f32x4 (&v)[16], LAS float* scr, int lane) {
    const int nblk = d.N / 64, kb = d.item / nblk, nb = d.item % nblk, k0 = 64 * kb, n0 = 64 * nb, r = lane >> 4, q = lane & 15;
#pragma unroll
    for (int i = 0; i < 16; ++i) { const int kk = 4 * i + r; f32x4 w = v[i]; if (d.gain) w = w * d.gain[k0 + kk];
        LAS float* p = scr + kk * 65 + 4 * q; p[0] = w[0]; p[1] = w[1]; p[2] = w[2]; p[3] = w[3]; }
    LDS_WAIT(); asm volatile("" ::: "memory");
    int d0 = n0;
    if (d.mode == 1) { const int half = n0 / FFN, j = n0 % FFN; d0 = (j / 128) * 256 + half * 128 + (j % 128); }
    const int c = lane & 7;
#pragma unroll
    for (int j = 0; j < 8; ++j) { const int n = (lane >> 3) + 8 * j; const LAS float* s = scr + (8 * c) * 65 + n;
        u32x4 o; o.x = cvt_pk_bf16(s[0 * 65], s[1 * 65]); o.y = cvt_pk_bf16(s[2 * 65], s[3 * 65]); o.z = cvt_pk_bf16(s[4 * 65], s[5 * 65]); o.w = cvt_pk_bf16(s[6 * 65], s[7 * 65]);
        *(u32x4*)(d.WT + (size_t)(d0 + n) * d.K + k0 + 8 * c) = o; }
    LDS_WAIT(); asm volatile("" ::: "memory");
}

struct Args { const float* in[28]; float* out; unsigned char* ws; };
#define P_x (P.in[0])
#define P_mem (P.in[1])
#define P_mix_g (P.in[2])
#define P_xa_g (P.in[3])
#define P_mem_g (P.in[4])
#define P_wq (P.in[5])
#define P_wkv (P.in[6])
#define P_wo (P.in[7])
#define P_ffn_g (P.in[8])
#define P_w13 (P.in[9])
#define P_w2 (P.in[10])
#define P_w_in (P.in[11])
#define P_w_abo (P.in[12])
#define P_lam_re (P.in[13])
#define P_lam_im (P.in[14])
#define P_log_step (P.in[15])
#define P_b_re (P.in[16])
#define P_b_im (P.in[17])
#define P_c_re (P.in[18])
#define P_c_im (P.in[19])
#define P_s5_d (P.in[20])
#define P_glu_w (P.in[21])
#define P_glu_b (P.in[22])
#define P_dlam (P.in[23])
#define P_subln (P.in[24])
#define P_wqkv (P.in[25])
#define P_wco (P.in[26])
#define P_fin_g (P.in[27])
typedef Args Ptrs;

__device__ __forceinline__ void p0_prologue(const Frame& F, const Ptrs& P) {
    FRAME_TID();
    unsigned char* ws = P.ws;
    LAS float* scr = (LAS float*)(F.lds + F.wave * TP_SCR);
    const int gw = F.vcu * 8 + F.wave, NGW = F.G * 8;
    const long gt = (long)F.vcu * 512 + f_tid, NGT = (long)F.G * 512;
    constexpr int I_IN = 32 * 64, I_SQ = 32 * 32, I_GLU = 16 * 16, I_QKV = 32 * 96, I_KV = 32 * 64, I_13 = 32 * 176, I_2 = 88 * 32;
    constexpr int NITEMS = 2 * I_IN + 2 * I_SQ + 2 * I_GLU + 2 * I_QKV + 2 * I_SQ + 4 * I_KV + 4 * I_SQ + 4 * I_13 + 4 * I_2;
    auto decode = [&](int it, TpDesc& d) {
        int r = it;
        if (r < 2 * I_IN) { const int mi = r / I_IN; d = TpDesc{P_w_in + (size_t)mi * 2048 * 4096, (bf16_t*)(ws + WS_W_IN) + (size_t)mi * 2048 * 4096, P_mix_g + (2 * mi) * 2048, 2048, 4096, 0, r % I_IN}; return; } r -= 2 * I_IN;
        if (r < 2 * I_SQ) { const int mi = r / I_SQ; d = TpDesc{P_w_abo + (size_t)mi * 2048 * 2048, (bf16_t*)(ws + WS_W_ABO) + (size_t)mi * 2048 * 2048, nullptr, 2048, 2048, 0, r % I_SQ}; return; } r -= 2 * I_SQ;
        if (r < 2 * I_GLU) { const int mi = r / I_GLU; d = TpDesc{P_glu_w + (size_t)mi * 1024 * 1024, (bf16_t*)(ws + WS_W_GLU) + (size_t)mi * 1024 * 1024, nullptr, 1024, 1024, 0, r % I_GLU}; return; } r -= 2 * I_GLU;
        if (r < 2 * I_QKV) { const int mi = r / I_QKV; d = TpDesc{P_wqkv + (size_t)mi * 2048 * 6144, (bf16_t*)(ws + WS_W_QKV) + (size_t)mi * 2048 * 6144, P_mix_g + (2 * mi + 1) * 2048, 2048, 6144, 0, r % I_QKV}; return; } r -= 2 * I_QKV;
        if (r < 2 * I_SQ) { const int mi = r / I_SQ; d = TpDesc{P_wco + (size_t)mi * 2048 * 2048, (bf16_t*)(ws + WS_W_CO) + (size_t)mi * 2048 * 2048, nullptr, 2048, 2048, 0, r % I_SQ}; return; } r -= 2 * I_SQ;
        if (r < 4 * I_KV) { const int mi = r / I_KV; d = TpDesc{P_wkv + (size_t)mi * 2048 * 4096, (bf16_t*)(ws + WS_WKV_T) + (size_t)mi * 2048 * 4096, P_mem_g + mi * 2048, 2048, 4096, 0, r % I_KV}; return; } r -= 4 * I_KV;
        if (r < 4 * I_SQ) { const int mi = r / I_SQ; d = TpDesc{P_wo + (size_t)mi * 2048 * 2048, (bf16_t*)(ws + WS_WO_T) + (size_t)mi * 2048 * 2048, nullptr, 2048, 2048, 0, r % I_SQ}; return; } r -= 4 * I_SQ;
        if (r < 4 * I_13) { const int mi = r / I_13; d = TpDesc{P_w13 + (size_t)mi * 2048 * 11264, (bf16_t*)(ws + WS_W13) + (size_t)mi * 2048 * 11264, P_ffn_g + mi * 2048, 2048, 11264, 1, r % I_13}; return; } r -= 4 * I_13;
        { const int mi = r / I_2; d = TpDesc{P_w2 + (size_t)mi * 5632 * 2048, (bf16_t*)(ws + WS_W2) + (size_t)mi * 5632 * 2048, nullptr, 5632, 2048, 0, r % I_2}; }
    };
    {
        TpDesc dc, dn; f32x4 va[16], vb[16];
        int it = gw;
        if (it < NITEMS) { decode(NITEMS - 1 - it, dc); tp_load(dc, va, f_lane); }
#pragma unroll 1
        for (; it < NITEMS; it += 2 * NGW) {
            const int it1 = it + NGW, it2 = it + 2 * NGW;
            if (it1 < NITEMS) { decode(NITEMS - 1 - it1, dn); tp_load(dn, vb, f_lane); }
            tp_finish(dc, va, scr, f_lane);
            if (it1 < NITEMS) { if (it2 < NITEMS) { decode(NITEMS - 1 - it2, dc); tp_load(dc, va, f_lane); } tp_finish(dn, vb, scr, f_lane); }
        }
    }
    { const f32x8* src = (const f32x8*)P_wq; u32x4* dst = (u32x4*)(ws + WS_WQ_B);
      for (long i = gt; i < (long)4 * 2048 * 2048 / 8; i += 4 * NGT) { f32x8 v[4];
#pragma unroll
          for (int u = 0; u < 4; ++u) v[u] = src[min(i + u * NGT, (long)4 * 2048 * 2048 / 8 - 1)];
#pragma unroll
          for (int u = 0; u < 4; ++u) if (i + u * NGT < (long)4 * 2048 * 2048 / 8) { u32x4 o; o.x = cvt_pk_bf16(v[u][0], v[u][1]); o.y = cvt_pk_bf16(v[u][2], v[u][3]); o.z = cvt_pk_bf16(v[u][4], v[u][5]); o.w = cvt_pk_bf16(v[u][6], v[u][7]); dst[i + u * NGT] = o; } } }
    { bf16_t* HB = (bf16_t*)(ws + WS_HB); float* rss0 = (float*)(ws + WS_RSSP);
      for (int row = gw; row < MTOK; row += NGW) { const f32x4* xr = (const f32x4*)(P_x + (size_t)row * DM) + f_lane; float ss = 0.f; f32x4 xv[8];
#pragma unroll
          for (int j = 0; j < 8; ++j) xv[j] = xr[64 * j];
#pragma unroll
          for (int j = 0; j < 8; ++j) { const f32x4 v = xv[j]; ss += (v[0] * v[0] + v[1] * v[1]) + (v[2] * v[2] + v[3] * v[3]); *(u32x2*)(HB + (size_t)row * DM + (j * 64 + f_lane) * 4) = pack4(v); }
          ss = wave_sum(ss); if (f_lane < 32) rss0[(size_t)row * 32 + f_lane] = f_lane == 0 ? ss : 0.f; } }
    { bf16_t* MN = (bf16_t*)(ws + WS_MEMN);
      for (int row = gw; row < BATCH * MEML; row += NGW) { const f32x4* xr = (const f32x4*)(P_mem + (size_t)row * DM) + f_lane; f32x4 v[8]; float ss = 0.f;
#pragma unroll
          for (int j = 0; j < 8; ++j) { v[j] = xr[64 * j]; ss += (v[j][0] * v[j][0] + v[j][1] * v[j][1]) + (v[j][2] * v[j][2] + v[j][3] * v[j][3]); }
          const float rstd = 1.0f / sqrtf(wave_sum(ss) * (1.0f / DM) + NORM_EPS);
#pragma unroll
          for (int j = 0; j < 8; ++j) *(u32x2*)(MN + (size_t)row * DM + (j * 64 + f_lane) * 4) = pack4(v[j] * rstd); } }
}


__device__ __forceinline__ void s5_tables_task(const Frame& F, const Ptrs& P, int i, int g) {
    FRAME_TID();
    unsigned char* ws = P.ws;
    LAS f32x2* LPs = (LAS f32x2*)(F.lds);
    LAS f32x2* BBs = (LAS f32x2*)(F.lds + 33792);
    LAS f32x2* CCs = (LAS f32x2*)(F.lds + 50176);
    LAS float* KTs = (LAS float*)(F.lds + 66560);
    LAS f32x2* Qs = (LAS f32x2*)(F.lds + 132096);
    const int t = f_tid;
    for (int e = t; e < 2 * 64 * 33; e += 512) { const int d = e / (64 * 33), rem = e - d * (64 * 33), p = rem / 33, tau = rem - p * 33; const int gd = (i * 2 + d) * 64 + g, idx = gd * 64 + p;
        const float st = expf(P_log_step[gd]), a = P_lam_re[idx] * st, b = P_lam_im[idx] * st; const float mag = expf((float)tau * a), ang = (float)tau * b; LPs[e] = (f32x2){mag * cosf(ang), mag * sinf(ang)}; }
    if (t < 128) { const int d = t >> 6, p = t & 63, gd = (i * 2 + d) * 64 + g, idx = gd * 64 + p; const float st = expf(P_log_step[gd]), lr = P_lam_re[idx], li = P_lam_im[idx], a = lr * st, b = li * st;
        const float sh = sinf(0.5f * b), nr = expm1f(a) * cosf(b) - 2.0f * sh * sh, ni = expf(a) * sinf(b), den = lr * lr + li * li;
        Qs[t] = (f32x2){(nr * lr + ni * li) / den, (ni * lr - nr * li) / den}; }
    for (int e = t; e < 2048; e += 512) { const int d = e >> 10, n = (e >> 6) & 15, p = e & 63; const size_t ci = ((size_t)((i * 2 + d) * 64 + g) * 16 + n) * 64 + p; CCs[e] = (f32x2){P_c_re[ci], P_c_im[ci]}; }
    LDS_WAIT(); __syncthreads();
    for (int e = t; e < 2048; e += 512) { const int d = e >> 10, p = (e >> 4) & 63, n = e & 15; const size_t bi = ((size_t)((i * 2 + d) * 64 + g) * 64 + p) * 16 + n; const f32x2 q = Qs[d * 64 + p];
        const float br = P_b_re[bi], bim = P_b_im[bi]; BBs[e] = (f32x2){q.x * br - q.y * bim, q.x * bim + q.y * br}; }
    if (t < 128) { const int d = t >> 6, p = t & 63; ((f32x2*)(ws + WS_LP))[((size_t)(i * 2 + d) * 64 + g) * 64 + p] = LPs[(d * 64 + p) * 33 + 32]; }
    LDS_WAIT(); __syncthreads();
    {
        const int d = t >> 8, no = (t >> 4) & 15, ni = t & 15; float acc[32];
#pragma unroll
        for (int tau = 0; tau < 32; ++tau) acc[tau] = 0.f;
#pragma unroll 2
        for (int p = 0; p < 64; ++p) { const f32x2 c = CCs[(d * 16 + no) * 64 + p], bb = BBs[(d * 64 + p) * 16 + ni]; const float wr = c.x * bb.x - c.y * bb.y, wi = c.x * bb.y + c.y * bb.x;
            const LAS f32x2* lp = LPs + (d * 64 + p) * 33;
#pragma unroll
            for (int tau = 0; tau < 32; ++tau) { const f32x2 L = lp[tau]; acc[tau] += wr * L.x - wi * L.y; } }
#pragma unroll
        for (int tau = 0; tau < 32; ++tau) KTs[(d * 32 + tau) * 256 + no * 16 + ni] = acc[tau];
    }
    LDS_WAIT(); __syncthreads();
    bf16_t* BTE = (bf16_t*)(ws + WS_BTE) + (size_t)(i * 64 + g) * 256 * 512;
    for (int c8 = t; c8 < 256 * 64; c8 += 512) { const int k8 = c8 & 63, j = c8 >> 6, s = k8 >> 1, n0 = (k8 & 1) * 8, which = j >> 6, p = j & 63, d = which >> 1, ex = d == 0 ? 31 - s : s;
        const f32x2 lp = LPs[(d * 64 + p) * 33 + ex]; float v[8];
#pragma unroll
        for (int q = 0; q < 8; ++q) { const f32x2 bb = BBs[(d * 64 + p) * 16 + n0 + q]; v[q] = (which & 1) ? (lp.x * bb.y + lp.y * bb.x) : (lp.x * bb.x - lp.y * bb.y); }
        u32x4 o; o.x = cvt_pk_bf16(v[0], v[1]); o.y = cvt_pk_bf16(v[2], v[3]); o.z = cvt_pk_bf16(v[4], v[5]); o.w = cvt_pk_bf16(v[6], v[7]);
        *(u32x4*)(BTE + (size_t)j * 512 + k8 * 8) = o; }
    bf16_t* BTT = (bf16_t*)(ws + WS_BTT) + (size_t)(i * 64 + g) * 512 * S5KT;
    for (int c8 = t; c8 < 512 * 32; c8 += 512) { const int j8 = c8 & 31, row = c8 >> 5, tt = row >> 4, no = row & 15, j0 = j8 * 8, which = j0 >> 6, p0 = j0 & 63, d = which >> 1, ex = d == 0 ? tt + 1 : 32 - tt; float v[8];
#pragma unroll
        for (int q = 0; q < 8; ++q) { const int p = p0 + q; const f32x2 lp = LPs[(d * 64 + p) * 33 + ex], c = CCs[(d * 16 + no) * 64 + p]; v[q] = (which & 1) ? -(c.x * lp.y + c.y * lp.x) : (c.x * lp.x - c.y * lp.y); }
        u32x4 o; o.x = cvt_pk_bf16(v[0], v[1]); o.y = cvt_pk_bf16(v[2], v[3]); o.z = cvt_pk_bf16(v[4], v[5]); o.w = cvt_pk_bf16(v[6], v[7]);
        *(u32x4*)(BTT + (size_t)row * S5KT + 512 + j0) = o; }
    for (int c8 = t; c8 < 512 * 64; c8 += 512) { const int k8 = c8 & 63, row = c8 >> 6, tt = row >> 4, no = row & 15, s = k8 >> 1, ni0 = (k8 & 1) * 8; float v[8];
        if (s < tt) {
#pragma unroll
            for (int q = 0; q < 8; ++q) v[q] = KTs[(0 * 32 + (tt - s)) * 256 + no * 16 + ni0 + q];
        } else if (s > tt) {
#pragma unroll
            for (int q = 0; q < 8; ++q) v[q] = KTs[(1 * 32 + (s - tt)) * 256 + no * 16 + ni0 + q];
        } else { const float dv = P_s5_d[i * 1024 + g * 16 + no];
#pragma unroll
            for (int q = 0; q < 8; ++q) v[q] = KTs[no * 16 + ni0 + q] + KTs[32 * 256 + no * 16 + ni0 + q] + ((ni0 + q == no) ? dv : 0.f); }
        u32x4 o; o.x = cvt_pk_bf16(v[0], v[1]); o.y = cvt_pk_bf16(v[2], v[3]); o.z = cvt_pk_bf16(v[4], v[5]); o.w = cvt_pk_bf16(v[6], v[7]);
        *(u32x4*)(BTT + (size_t)row * S5KT + k8 * 8) = o; }
}

__device__ __forceinline__ void p1_thin(const Frame& F, const Ptrs& P) {
    FRAME_TID();
    unsigned char* ws = P.ws; const long gt = (long)F.vcu * 512 + f_tid, NGT = (long)F.G * 512;
    const f32x2* LP = (const f32x2*)(ws + WS_LP); const f32x2* BB = (const f32x2*)(ws + WS_BBAR);
    float* KT = (float*)(ws + WS_KTAB);
    for (long e = gt; e < (long)2 * 2 * 64 * 32 * 256; e += NGT) {
        const int ni = (int)(e & 15), no = (int)((e >> 4) & 15), tau = (int)((e >> 8) & 31); const long igd = e >> 13;
        float acc = 0.f;
#pragma unroll 4
        for (int p = 0; p < 64; ++p) { const long idx = igd * 64 + p; const f32x2 lp = LP[idx * 33 + tau], bb = BB[idx * 16 + ni];
            const float xr = lp.x * bb.x - lp.y * bb.y, xi = lp.x * bb.y + lp.y * bb.x;
            const float cr = P_c_re[(igd * 16 + no) * 64 + p], ci = P_c_im[(igd * 16 + no) * 64 + p];
            acc += cr * xr - ci * xi; }
        KT[e] = acc;
    }
    bf16_t* BTE = (bf16_t*)(ws + WS_BTE);
    for (long e = gt; e < (long)2 * 64 * 256 * 64; e += NGT) {
        const int k8 = (int)(e & 63), j = (int)((e >> 6) & 255), g = (int)((e >> 14) & 63), i = (int)(e >> 20);
        const int s = k8 >> 1, n0 = (k8 & 1) * 8, which = j >> 6, p = j & 63, d = which >> 1, ex = d == 0 ? 31 - s : s;
        const long idx = ((long)(i * 2 + d) * 64 + g) * 64 + p; const f32x2 lp = LP[idx * 33 + ex];
        float v[8];
#pragma unroll
        for (int q = 0; q < 8; ++q) { const f32x2 bb = BB[idx * 16 + n0 + q]; v[q] = (which & 1) ? (lp.x * bb.y + lp.y * bb.x) : (lp.x * bb.x - lp.y * bb.y); }
        u32x4 o; o.x = cvt_pk_bf16(v[0], v[1]); o.y = cvt_pk_bf16(v[2], v[3]); o.z = cvt_pk_bf16(v[4], v[5]); o.w = cvt_pk_bf16(v[6], v[7]);
        *(u32x4*)(BTE + (((size_t)(i * 64 + g) * 256 + j) * 512 + k8 * 8)) = o;
    }
    bf16_t* BTT = (bf16_t*)(ws + WS_BTT);
    for (long e = gt; e < (long)2 * 64 * 512 * 32; e += NGT) {
        const int j8 = (int)(e & 31), row = (int)((e >> 5) & 511), g = (int)((e >> 14) & 63), i = (int)(e >> 20);
        const int t = row >> 4, no = row & 15, j0 = j8 * 8, which = j0 >> 6, p0 = j0 & 63, d = which >> 1, ex = d == 0 ? t + 1 : 32 - t;
        const long igd = (long)(i * 2 + d) * 64 + g;
        float v[8];
#pragma unroll
        for (int q = 0; q < 8; ++q) { const int p = p0 + q; const f32x2 lp = LP[(igd * 64 + p) * 33 + ex];
            const float cr = P_c_re[(igd * 16 + no) * 64 + p], ci = P_c_im[(igd * 16 + no) * 64 + p];
            v[q] = (which & 1) ? -(cr * lp.y + ci * lp.x) : (cr * lp.x - ci * lp.y); }
        u32x4 o; o.x = cvt_pk_bf16(v[0], v[1]); o.y = cvt_pk_bf16(v[2], v[3]); o.z = cvt_pk_bf16(v[4], v[5]); o.w = cvt_pk_bf16(v[6], v[7]);
        *(u32x4*)(BTT + (((size_t)(i * 64 + g) * 512 + row) * S5KT + 512 + j0)) = o;
    }
}
__device__ __forceinline__ void p2_thin(const Frame& F, const Ptrs& P) {
    FRAME_TID();
    unsigned char* ws = P.ws; const long gt = (long)F.vcu * 512 + f_tid, NGT = (long)F.G * 512;
    const float* KT = (const float*)(ws + WS_KTAB); bf16_t* BTT = (bf16_t*)(ws + WS_BTT);
    for (long e = gt; e < (long)2 * 64 * 512 * 64; e += NGT) {
        const int k8 = (int)(e & 63), row = (int)((e >> 6) & 511), g = (int)((e >> 15) & 63), i = (int)(e >> 21);
        const int t = row >> 4, no = row & 15, s = k8 >> 1, ni0 = (k8 & 1) * 8;
        f32x8 v;
        if (s < t) v = *(const f32x8*)(KT + ((((size_t)(i * 2 + 0) * 64 + g) * 32 + (t - s)) * 256 + no * 16 + ni0));
        else if (s > t) v = *(const f32x8*)(KT + ((((size_t)(i * 2 + 1) * 64 + g) * 32 + (s - t)) * 256 + no * 16 + ni0));
        else { v = *(const f32x8*)(KT + ((((size_t)(i * 2 + 0) * 64 + g) * 32) * 256 + no * 16 + ni0)) + *(const f32x8*)(KT + ((((size_t)(i * 2 + 1) * 64 + g) * 32) * 256 + no * 16 + ni0));
            const float dv = P_s5_d[i * 1024 + g * 16 + no];
#pragma unroll
            for (int q = 0; q < 8; ++q) v[q] += (ni0 + q == no) ? dv : 0.f; }
        u32x4 o; o.x = cvt_pk_bf16(v[0], v[1]); o.y = cvt_pk_bf16(v[2], v[3]); o.z = cvt_pk_bf16(v[4], v[5]); o.w = cvt_pk_bf16(v[6], v[7]);
        *(u32x4*)(BTT + (((size_t)(i * 64 + g) * 512 + row) * S5KT + k8 * 8)) = o;
    }
}
__device__ __forceinline__ void s5_scan(const Frame& F, const Ptrs& P, int i) {
    FRAME_TID();
    unsigned char* ws = P.ws;
    if (F.wave != 0) return;
    const f32x2* LP = (const f32x2*)(ws + WS_LP); const float* E = (const float*)(ws + WS_E); bf16_t* U2 = (bf16_t*)(ws + WS_U2);
    for (int w = F.vcu; w < 256; w += F.G) {
        const int b = w >> 7, g = (w >> 1) & 63, d = w & 1, p = f_lane;
        const f32x2 a = LP[(((long)(i * 2 + d) * 64 + g) * 64 + p)];
        const size_t r0 = (size_t)g * S5NCH + b * 256;
        float cr = 0.f, ci = 0.f;
        if (d == 0) {
#pragma unroll 8
            for (int c = 0; c < 256; ++c) { const size_t r = r0 + c;
                U2[r * S5KT + 512 + p] = (bf16_t)f2bf(cr); U2[r * S5KT + 576 + p] = (bf16_t)f2bf(ci);
                const float er = E[r * 256 + p], ei = E[r * 256 + 64 + p];
                const float nr = a.x * cr - a.y * ci + er, nim = a.x * ci + a.y * cr + ei; cr = nr; ci = nim; }
        } else {
#pragma unroll 8
            for (int c = 255; c >= 0; --c) { const size_t r = r0 + c;
                U2[r * S5KT + 640 + p] = (bf16_t)f2bf(cr); U2[r * S5KT + 704 + p] = (bf16_t)f2bf(ci);
                const float er = E[r * 256 + 128 + p], ei = E[r * 256 + 192 + p];
                const float nr = a.x * cr - a.y * ci + er, nim = a.x * ci + a.y * cr + ei; cr = nr; ci = nim; }
        }
    }
}
__device__ __forceinline__ void s5_scan_local(const Frame& F, const Ptrs& P, int i, int b, int g) {
    FRAME_TID();
    unsigned char* ws = P.ws;
    if (F.wave > 1) return;
    const f32x2* LP = (const f32x2*)(ws + WS_LP); const float* E = (const float*)(ws + WS_E); bf16_t* U2 = (bf16_t*)(ws + WS_U2);
    const int d = F.wave, p = f_lane;
    const f32x2 a = LP[(((long)(i * 2 + d) * 64 + g) * 64 + p)];
    const size_t r0 = (size_t)g * S5NCH + b * 256;
    float cr = 0.f, ci = 0.f;
    float era[16], eia[16], erb[16], eib[16];
#define S5_LD(ER, EI, blk) do { _Pragma("unroll") for (int q = 0; q < 16; ++q) { const int c = d == 0 ? (blk) * 16 + q : 255 - ((blk) * 16 + q); const size_t r = r0 + c; \
        ER[q] = E[r * 256 + d * 128 + p]; EI[q] = E[r * 256 + d * 128 + 64 + p]; } } while (0)
#define S5_SCAN(ER, EI, blk) do { _Pragma("unroll") for (int q = 0; q < 16; ++q) { const int c = d == 0 ? (blk) * 16 + q : 255 - ((blk) * 16 + q); const size_t r = r0 + c; \
        U2[r * S5KT + 512 + d * 128 + p] = (bf16_t)f2bf(cr); U2[r * S5KT + 576 + d * 128 + p] = (bf16_t)f2bf(ci); \
        const float nr = a.x * cr - a.y * ci + ER[q], nim = a.x * ci + a.y * cr + EI[q]; cr = nr; ci = nim; } } while (0)
    S5_LD(era, eia, 0);
#pragma unroll 1
    for (int blk = 0; blk < 16; blk += 2) {
        S5_LD(erb, eib, blk + 1);
        S5_SCAN(era, eia, blk);
        if (blk + 2 < 16) S5_LD(era, eia, blk + 2);
        S5_SCAN(erb, eib, blk + 1);
    }
#undef S5_LD
#undef S5_SCAN
}
__device__ __forceinline__ void diff_combine(const Frame& F, const Ptrs& P, int i, int layer) {
    FRAME_TID();
    unsigned char* ws = P.ws; const int gw = F.vcu * 8 + F.wave, NGW = F.G * 8;
    const float* lv = P_dlam + i * 512;
    float d01 = lv[f_lane] * lv[128 + f_lane] + lv[64 + f_lane] * lv[192 + f_lane], d23 = lv[256 + f_lane] * lv[384 + f_lane] + lv[320 + f_lane] * lv[448 + f_lane];
    d01 = wave_sum(d01); d23 = wave_sum(d23);
    int ly_ = layer; asm volatile("" : "+s"(ly_));
    const float linit = ly_ == 0 ? 2.000000000e-01f : ly_ == 1 ? 3.555090676e-01f : ly_ == 2 ? 4.707130183e-01f : 5.560582042e-01f;
    const float lam = __builtin_bit_cast(float, __builtin_amdgcn_readfirstlane(__builtin_bit_cast(int, expf(d01) - expf(d23) + linit)));
    const bf16_t* O1 = (const bf16_t*)(ws + WS_O12); const bf16_t* O2 = O1 + (size_t)MTOK * 1024; bf16_t* CAT = (bf16_t*)(ws + WS_CAT);
    for (int task = gw; task < MTOK * 4; task += NGW) {
        const int tok = task >> 2, h = task & 3; const size_t off = (size_t)tok * 1024 + h * 256 + f_lane * 4;
        const u32x2 a = *(const u32x2*)(O1 + off), b = *(const u32x2*)(O2 + off);
        f32x4 v; v[0] = bf2f(a.x & 0xffffu) - lam * bf2f(b.x & 0xffffu); v[1] = bf2f(a.x >> 16) - lam * bf2f(b.x >> 16); v[2] = bf2f(a.y & 0xffffu) - lam * bf2f(b.y & 0xffffu); v[3] = bf2f(a.y >> 16) - lam * bf2f(b.y >> 16);
        const float ss = wave_sum((v[0] * v[0] + v[1] * v[1]) + (v[2] * v[2] + v[3] * v[3]));
        const float rstd = 1.0f / sqrtf(ss * (1.0f / 256.0f) + NORM_EPS);
        const f32x4 gsub = *(const f32x4*)(P_subln + i * 256 + f_lane * 4) * (1.0f - linit);
        *(u32x2*)(CAT + (size_t)tok * DM + 1024 + h * 256 + f_lane * 4) = pack4(v * rstd * gsub);
    }
}
__device__ __forceinline__ void dilated_merge(const Frame& F, const Ptrs& P) {
    FRAME_TID();
    unsigned char* ws = P.ws; const int gw = F.vcu * 8 + F.wave, NGW = F.G * 8;
    const bf16_t* OB = (const bf16_t*)(ws + WS_OB); const float* LSE = (const float*)(ws + WS_LSE); bf16_t* CAT = (bf16_t*)(ws + WS_CAT);
    const int pmg = (F.G == 256) ? (8 * ((int)blockIdx.x & 7) + (((int)blockIdx.x >> 3) & 7)) * 256 + ((int)blockIdx.x >> 6) * 64 : -1;
    for (int it = 0; it < (pmg >= 0 ? 8 : (MTOK + NGW - 1) / NGW); ++it) { const int tok = pmg >= 0 ? pmg + it * 8 + F.wave : gw + it * NGW; if (tok >= MTOK) break;
        u32x4 av[4], bv[4], cv[4]; float l0v[4], l1v[4], l2v[4];
#pragma unroll
        for (int k = 0; k < 4; ++k) { const int ci = f_lane + 64 * k, col = ci * 8, h = ci >> 4;
            l0v[k] = LSE[(size_t)tok * 16 + h]; l1v[k] = LSE[((size_t)MTOK + tok) * 16 + h]; l2v[k] = LSE[((size_t)2 * MTOK + tok) * 16 + h];
            av[k] = *(const u32x4*)(OB + (size_t)tok * DM + col); bv[k] = *(const u32x4*)(OB + ((size_t)MTOK + tok) * DM + col); cv[k] = *(const u32x4*)(OB + ((size_t)2 * MTOK + tok) * DM + col); }
#pragma unroll
        for (int k = 0; k < 4; ++k) { const int ci = f_lane + 64 * k, col = ci * 8;
            const float l0 = l0v[k], l1 = l1v[k], l2 = l2v[k];
            const float mx = fmaxf(l0, fmaxf(l1, l2)); float w0 = __expf(l0 - mx), w1 = __expf(l1 - mx), w2 = __expf(l2 - mx); const float inv = 1.0f / (w0 + w1 + w2); w0 *= inv; w1 *= inv; w2 *= inv;
            const u32x4 a = av[k], b = bv[k], c = cv[k];
            u32x4 o;
#pragma unroll
            for (int q = 0; q < 4; ++q) { const float lo = w0 * bf2f(a[q] & 0xffffu) + w1 * bf2f(b[q] & 0xffffu) + w2 * bf2f(c[q] & 0xffffu), hi = w0 * bf2f(a[q] >> 16) + w1 * bf2f(b[q] >> 16) + w2 * bf2f(c[q] >> 16); o[q] = cvt_pk_bf16(lo, hi); }
            *(u32x4*)(CAT + (size_t)tok * DM + col) = o; }
    }
}
__device__ __forceinline__ void final_norm(const Frame& F, const Ptrs& P) {
    FRAME_TID();
    unsigned char* ws = P.ws; const int gw = F.vcu * 8 + F.wave, NGW = F.G * 8;
    const bf16_t* HB = (const bf16_t*)(ws + WS_HB); const float* rss = (const float*)(ws + WS_RSSP) + (size_t)12 * MTOK * 32;
    f32x4 gn[8];
#pragma unroll
    for (int j = 0; j < 8; ++j) gn[j] = *(const f32x4*)(P_fin_g + (j * 64 + f_lane) * 4);
    for (int row = gw; row < MTOK; row += NGW) {
        u32x2 w[8]; const float part = f_lane < 32 ? rss[(size_t)row * 32 + f_lane] : 0.f;
#pragma unroll
        for (int j = 0; j < 8; ++j) w[j] = *(const u32x2*)(HB + (size_t)row * DM + (j * 64 + f_lane) * 4);
        const float rstd = 1.0f / sqrtf(wave_sum(part) * (1.0f / DM) + NORM_EPS);
#pragma unroll
        for (int j = 0; j < 8; ++j) { const f32x4 h = {bf2f(w[j].x & 0xffffu), bf2f(w[j].x >> 16), bf2f(w[j].y & 0xffffu), bf2f(w[j].y >> 16)};
            *(f32x4*)(P.out + (size_t)row * DM + (j * 64 + f_lane) * 4) = h * rstd * gn[j]; } }
}
#ifndef SITES
#define SITES 0xFFFFFFFF
#endif


struct ListOrder {
    int n, pm, g; const char* A; size_t astep; const char* B; size_t bstep; int pn0;
    __device__ __forceinline__ bool next(int i, pg8::Unit& u) const { if (i >= n) return false; u.pm = pm; u.pn = pn0 + i; u.g = g; u.a = A + (size_t)i * astep; u.b = B + (size_t)(pn0 + i) * bstep; return true; }
};
struct WqKOrder {
    int G, c; const char* KV; const char* WQ;
    __device__ __forceinline__ bool next(int i, pg8::Unit& u) const {
        const int L = i * G + c; if (L >= 256) return false;
        u.g = L >> 3; u.pn = L & 7; u.pm = 0; const int l = u.g >> 3, b = (u.g >> 2) & 1, h = u.g & 3;
        u.a = KV + ((size_t)(b * 256) * 16384 + l * 4096 + h * 512) * 2;
        u.b = WQ + ((size_t)l * 2048 * 2048 + (size_t)u.pn * 256 * 2048 + h * 512) * 2; return true; }
};
struct VWoOrder {
    int G, c; const char* KV; const char* WO;
    __device__ __forceinline__ bool next(int i, pg8::Unit& u) const {
        const int L = i * G + c; if (L >= 256) return false;
        u.g = L >> 3; u.pm = L & 7; u.pn = 0; const int l = u.g >> 3, b = (u.g >> 2) & 1, h = u.g & 3;
        u.a = WO + ((size_t)l * 2048 * 2048 + (size_t)u.pm * 256 * 2048 + h * 512) * 2;
        u.b = KV + ((size_t)(b * 256) * 16384 + l * 4096 + 2048 + h * 512) * 2; return true; }
};


#ifndef DBG_RT
#define DBG_RT 0
#endif
#ifndef REP_P0
#define REP_P0 1
#endif
#ifndef REP_F1
#define REP_F1 1
#endif
#ifndef REP_DATT
#define REP_DATT 1
#endif
#ifndef REP_DIL
#define REP_DIL 1
#endif
#ifndef REP_PROJ
#define REP_PROJ 1
#endif
#ifndef REP_X1
#define REP_X1 1
#endif
#ifndef REP_S5
#define REP_S5 1
#endif
#ifndef REP_P12
#define REP_P12 1
#endif
#ifndef USE_GROUP_SYNC
#define USE_GROUP_SYNC 1
#endif
#ifndef REP_THIN
#define REP_THIN 1
#endif
#ifndef REP_DIL_IN
#define REP_DIL_IN 1
#endif
#ifndef DBG_STOP
#define DBG_STOP 0
#endif
#ifndef DBG_LAYER
#define DBG_LAYER 0
#endif
#ifndef DBG_SUB
#define DBG_SUB 0
#endif
#if DBG_RT
#ifndef DBG_X
#define DBG_X 0
#endif
__device__ int g_dbg[4] = {DBG_STOP, DBG_LAYER, DBG_SUB, DBG_X};
#endif
__device__ __forceinline__ void dbg_dump_bf(float* out, const bf16_t* a, size_t na, const bf16_t* b, size_t nb, int vcu, int G) {
    for (size_t j = (size_t)vcu * 512 + threadIdx.x; j < (size_t)MTOK * DM; j += (size_t)G * 512) { float v = bf2f(a[j % na]); if (b) v += bf2f(b[j % nb]); out[j] = v; }
}
__device__ __forceinline__ void dbg_dump_f32(float* out, const float* a, int vcu, int G) {
    for (size_t j = (size_t)vcu * 512 + threadIdx.x; j < (size_t)MTOK * DM; j += (size_t)G * 512) out[j] = a[j];
}
__global__ void __launch_bounds__(512, 2) mega_fwd(Args args) {
    extern __shared__ __attribute__((aligned(16))) unsigned char lds_raw[];
    Frame F; F.lds = (LAS unsigned char*)lds_raw; F.wave = __builtin_amdgcn_readfirstlane((int)threadIdx.x >> 6);
    F.G = gridDim.x; { const int bx = blockIdx.x; F.vcu = (F.G % 8 == 0) ? (bx % 8) * (F.G / 8) + bx / 8 : bx; }
    const Args& P = args;
    typedef __attribute__((address_space(1))) unsigned char gws_t;
    gws_t* const ws0 = (gws_t*)args.ws; gws_t* ws = ws0;
    if (threadIdx.x < 16) ((LAS unsigned*)(F.lds + LDS_MISC))[threadIdx.x] = 0u;
    __syncthreads();
    XcdBarrier bar = xcd_barrier_post((unsigned*)(ws + WS_CTL), (volatile LAS unsigned*)(F.lds + LDS_MISC));
#if defined(BAR2)
#define GRID_BAR() do { xcd_barrier(bar); xcd_barrier(bar); } while (0)
#else
#define GRID_BAR() xcd_barrier(bar)
#endif
    if (threadIdx.x == 0) __hip_atomic_store((unsigned*)(ws + WS_CTL) + GS_XCC_WORD + blockIdx.x, xb_xcc_id() + 1u, __ATOMIC_RELAXED, __HIP_MEMORY_SCOPE_AGENT);
    const int bx = (int)blockIdx.x;
#if DBG_RT
    const int dbg_stop = __builtin_amdgcn_readfirstlane(((volatile int*)g_dbg)[0]), dbg_layer = __builtin_amdgcn_readfirstlane(((volatile int*)g_dbg)[1]), dbg_sub = __builtin_amdgcn_readfirstlane(((volatile int*)g_dbg)[2]), dbg_x = __builtin_amdgcn_readfirstlane(((volatile int*)g_dbg)[3]);
#endif
    float* RSS = (float*)(ws + WS_RSSP);
    bf16_t* HB = (bf16_t*)(ws + WS_HB); float* H = (float*)(ws + WS_H); bf16_t* CAT = (bf16_t*)(ws + WS_CAT); bf16_t* XP = (bf16_t*)(ws + WS_XP);
    const float* rc = (const float*)(ws + WS_ROPE); const float* rs = rc + SEQ * 16;

#if defined(DBG_FILL)
    { u32x4* p = (u32x4*)(ws + MiB); const size_t n = (WS_END - MiB) / 16; const unsigned pat = DBG_FILL; for (size_t j = (size_t)F.vcu * 512 + threadIdx.x; j < n; j += (size_t)F.G * 512) p[j] = (u32x4){pat, pat, pat, pat}; }
    GRID_BAR();
#endif

#if (SITES >> 0) & 1
#if !defined(S5TAB_IN_P1)
    if (bx < 128) { s5_tables_task(F, P, bx >> 6, bx & 63); asm volatile("s_waitcnt vmcnt(0) lgkmcnt(0)" ::: "memory"); __syncthreads(); }
#endif
    _Pragma("unroll 1") for (int rp = 0; rp < REP_P0; ++rp) p0_prologue(F, P);
#endif

    GRID_BAR();
    bool use_group;
    {   int t_ = threadIdx.x; asm volatile("" : "+v"(t_));
        int okv = 1;
        if (t_ < 256) { const unsigned* xw = (const unsigned*)(ws + WS_CTL) + GS_XCC_WORD; const unsigned a = __hip_atomic_load(xw + t_, __ATOMIC_RELAXED, __HIP_MEMORY_SCOPE_AGENT), b0 = __hip_atomic_load(xw + (t_ & 63), __ATOMIC_RELAXED, __HIP_MEMORY_SCOPE_AGENT); okv = (a == b0) && (a != 0u); }
        use_group = (__syncthreads_and(okv) != 0) && (F.G == 256) && (USE_GROUP_SYNC != 0); }
    unsigned gs_epoch = 0;
    const int gs_gid = bx & 63;
#define CHAIN_BAR() do { if (use_group) { ++gs_epoch; group_sync((unsigned*)(ws + WS_CTL), gs_gid, 4u * gs_epoch); } else { GRID_BAR(); } } while (0)
    _Pragma("unroll 1") for (int rp12 = 0; rp12 < REP_P12; ++rp12) {

#if defined(S5TAB_IN_P1)
    if (bx < 128) s5_tables_task(F, P, bx >> 6, bx & 63);
    else
#else
    if (bx >= 128)
#endif
    {   pg8::DenseOrder S; S.init((const void*)(ws + WS_MEMN), 2048, (const void*)(ws + WS_WKV_T), 2048, BATCH * MEML, 16384, F.G - 128, bx - 128);
        EpiBf16Plain E{(bf16_t*)(ws + WS_KVALL), 16384, nullptr, 1.0f};
        pg8::gemm_phase(F.lds, 2048, 2048, 2048, S, E); }

    GRID_BAR();

#if (SITES >> 3) & 1
    {   WqKOrder S{F.G, bx, (const char*)(ws + WS_KVALL), (const char*)(ws + WS_WQ_B)}; EpiWqK E{(bf16_t*)(ws + WS_WQK), P_xa_g};
        pg8::gemm_phase(F.lds, 512, 16384, 2048, S, E); }
#endif


#if (SITES >> 4) & 1
    {   VWoOrder S{F.G, bx, (const char*)(ws + WS_KVALL), (const char*)(ws + WS_WO_T)}; EpiVWo E{(bf16_t*)(ws + WS_VWO)};
        pg8::gemm_phase(F.lds, 512, 2048, 16384, S, E); }
#endif


    GRID_BAR();
    }
#if DBG_RT
    if (dbg_stop == 1) {
    dbg_dump_bf(args.out, (const bf16_t*)(ws + WS_WQK), (size_t)16 << 20, (const bf16_t*)(ws + WS_VWO), (size_t)16 << 20, F.vcu, F.G); return;
    }
#endif
#if DBG_RT
    if (dbg_stop == 13) {
    dbg_dump_bf(args.out, (const bf16_t*)(ws + WS_W13) + (size_t)dbg_layer * 11264 * 2048, (size_t)11264 * 2048, (const bf16_t*)(ws + WS_W2) + (size_t)dbg_layer * 2048 * 5632, (size_t)2048 * 5632, F.vcu, F.G); return;
    }
#endif
#if DBG_RT
    if (dbg_stop == 14) {
    { const bf16_t* a = (const bf16_t*)(ws + WS_W13) + (size_t)dbg_layer * 11264 * 2048; const bf16_t* b = (const bf16_t*)(ws + WS_W2) + (size_t)dbg_layer * 2048 * 5632; for (size_t j = (size_t)F.vcu * 512 + threadIdx.x; j < (size_t)MTOK * DM; j += (size_t)F.G * 512) args.out[j] = 30.0f * (bf2f(a[j % ((size_t)11264 * 2048)]) + bf2f(b[j % ((size_t)2048 * 5632)])); return; }
    }
#endif
#if DBG_RT
    if (dbg_stop == 7) {
    dbg_dump_bf(args.out, (const bf16_t*)(ws + WS_BTT), (size_t)48 << 20, (const bf16_t*)(ws + WS_BTE), (size_t)16 << 20, F.vcu, F.G); return;
    }
#endif
#if DBG_RT
    if (dbg_stop == 8) {
    dbg_dump_bf(args.out, (const bf16_t*)(ws + WS_W13), (size_t)88 << 20, (const bf16_t*)(ws + WS_W2), (size_t)44 << 20, F.vcu, F.G); return;
    }
#endif

#pragma unroll 1
    for (int layer = 0; layer < DEPTH; ++layer) {
        const int i = layer >> 1; const bool even = (layer & 1) == 0;
#pragma unroll 1
        for (int sub = 0; sub < 3; ++sub) {
            gws_t* ws = ws0; asm volatile("" : "+s"(ws));
            const float* rss_cur = RSS + (size_t)(3 * layer + sub) * MTOK * 32; float* rss_next = RSS + (size_t)(3 * layer + sub + 1) * MTOK * 32;
            if (sub == 0) {

#if (SITES >> 6) & 1
#if DBG_RT
                const int nrep = ((dbg_x & 1) && layer == dbg_layer) ? 2 : 1, iw = ((dbg_x & 2) && layer == dbg_layer) ? 0 : i;
                if ((dbg_x & 4) && layer == dbg_layer) GRID_BAR();
#else
                const int nrep = REP_PROJ, iw = i;
#endif
#pragma unroll 1
                for (int rep = 0; rep < nrep; ++rep)
                {   const bf16_t* Bt = even ? (const bf16_t*)(ws + WS_W_IN) + (size_t)iw * 4096 * 2048 : (const bf16_t*)(ws + WS_W_QKV) + (size_t)iw * 6144 * 2048;
                    pg8::DenseOrder S; S.init(HB, 2048, Bt, 2048, MTOK, even ? 4096 : 6144, F.G, bx);
                    const float* rss_p = rss_cur;
#if DBG_RT
                    if ((dbg_x & 8) && layer == dbg_layer) rss_p = RSS + (size_t)6 * MTOK * 32;
#endif
                    { pg8::Unit u0; if (S.next(0, u0)) fill_rstd_tab(rss_p, u0.pm, (LAS float*)(F.lds + LDS_RSTD)); }
                    EpiProj E{(LAS const float*)(F.lds + LDS_RSTD), rc, rs, even ? (bf16_t*)(ws + WS_QKVE) : (bf16_t*)(ws + WS_QKVO), even ? 3072 : 6144, (bf16_t*)(ws + WS_U2), even ? 4 : 0, even ? 4 : 0, even ? 12 : 16};
                    pg8::gemm_phase(F.lds, 2048, 2048, 2048, S, E); }
#endif

                GRID_BAR();
#if DBG_RT
    if (dbg_stop == 10) {
                if (layer == dbg_layer) { unsigned* q = (unsigned*)(ws + WS_QKVO); for (size_t j = (size_t)F.vcu * 512 + threadIdx.x; j < (size_t)MTOK * DM / 2; j += (size_t)F.G * 512) { const unsigned w = __hip_atomic_fetch_or(q + j, 0u, __ATOMIC_RELAXED, __HIP_MEMORY_SCOPE_AGENT); args.out[2 * j] = bf2f(w & 0xffffu); args.out[2 * j + 1] = bf2f(w >> 16); } return; }
    }
#endif
#if DBG_RT
    if (dbg_stop == 2) {
                if (layer == dbg_layer) { if (even) dbg_dump_bf(args.out, (const bf16_t*)(ws + WS_U2), (size_t)24 << 20, (const bf16_t*)(ws + WS_QKVE), (size_t)48 << 20, F.vcu, F.G); else dbg_dump_bf(args.out, (const bf16_t*)(ws + WS_QKVO), (size_t)96 << 20, nullptr, 1, F.vcu, F.G); return; }
    }
#endif
                if (even) {
                    _Pragma("unroll 1") for (int rps = 0; rps < REP_S5; ++rps) {
                    {
                        const int pm = (bx >> 1) & 127, hf = bx & 1, g = pm >> 1, b = pm & 1;
                        {   ListOrder S{1, pm, g, (const char*)(ws + WS_U2) + (size_t)pm * 256 * S5KT * 2, 0, (const char*)((const bf16_t*)(ws + WS_BTE) + ((size_t)i * 64 + g) * 256 * 512), 0, 0};
                            EpiF32 E{(float*)(ws + WS_E), 256};
                            pg8::gemm_phase(F.lds, 512, S5KT, 512, S, E); }
                        asm volatile("s_waitcnt vmcnt(0)" ::: "memory"); __syncthreads();
                        s5_scan_local(F, P, i, b, g);
                        asm volatile("s_waitcnt vmcnt(0)" ::: "memory"); __syncthreads();
                        {   ListOrder S{1, pm, g, (const char*)(ws + WS_U2) + (size_t)pm * 256 * S5KT * 2, 0, (const char*)((const bf16_t*)(ws + WS_BTT) + ((size_t)i * 64 + g) * 512 * S5KT), (size_t)256 * S5KT * 2, hf};
                            EpiS5Y E{(bf16_t*)(ws + WS_G)};
                            pg8::gemm_phase(F.lds, S5KT, S5KT, S5KT, S, E); }
                    }
                    GRID_BAR();

#if (SITES >> 10) & 1
                    {   pg8::DenseOrder S; S.init((const void*)(ws + WS_G), 1024, (const bf16_t*)(ws + WS_W_GLU) + (size_t)i * 1024 * 1024, 1024, MTOK, 1024, F.G, bx);
                        EpiGlu E{(const bf16_t*)(ws + WS_G), P_glu_b + i * 1024, CAT};
                        pg8::gemm_phase(F.lds, 1024, 1024, 1024, S, E); }
#endif

                    if (rps + 1 < REP_S5) GRID_BAR();
                    }

#if (SITES >> 11) & 1
                    {   const bf16_t* QKV = (const bf16_t*)(ws + WS_QKVE); bf16_t* O12 = (bf16_t*)(ws + WS_O12);
                        float lam, gscale;
                        {   int t_ = threadIdx.x; asm volatile("" : "+v"(t_)); const int ln = t_ & 63; const float* lv = P_dlam + i * 512;
                            const float d01 = wave_sum(lv[ln] * lv[128 + ln] + lv[64 + ln] * lv[192 + ln]), d23 = wave_sum(lv[256 + ln] * lv[384 + ln] + lv[320 + ln] * lv[448 + ln]);
                            int ly_ = layer; asm volatile("" : "+s"(ly_)); const float linit = __builtin_bit_cast(float, ly_ == 0 ? 0x3e4ccccdu : 0x3ef1014cu);
                            lam = __builtin_bit_cast(float, __builtin_amdgcn_readfirstlane(__builtin_bit_cast(int, expf(d01) - expf(d23) + linit))); gscale = 1.0f - linit; }
                        _Pragma("unroll 1") for (int rp = 0; rp < REP_DATT; ++rp)
                        for (int unit = F.vcu; unit < 256; unit += F.G) {
                            const int binst = unit >> 5, qb = unit & 31, b = binst >> 2, h = binst & 3;
                            const bf16_t* Vh = QKV + (size_t)(b * SEQ) * 3072 + 2048 + h * 256;
                            bf16_t* Ob = O12 + ((size_t)b * SEQ + qb * 256) * 1024 + h * 256;
                            bf16_t* Cb = CAT + ((size_t)b * SEQ + qb * 256) * DM + 1024 + h * 256;
                            _Pragma("unroll 1") for (int c = 0; c < 2; ++c) {
                                const bf16_t* Qb = QKV + (size_t)(b * SEQ + qb * 256) * 3072 + (h * 2 + c) * 128;
                                const bf16_t* Kh = QKV + (size_t)(b * SEQ) * 3072 + 1024 + (h * 2 + c) * 128;
                                asm volatile("s_waitcnt vmcnt(0)" ::: "memory"); __syncthreads();
#if defined(W32)
                                att::attn_wide_body(Qb, Kh, Vh, 3072, SEQ / 64, Ob, 1024, (char*)lds_raw, c == 1, lam, gscale, P_subln + i * 256, Cb, DM);
#else
                                att::attn_wide16_body(Qb, Kh, Vh, 3072, SEQ / 64, Ob, 1024, (char*)lds_raw, c == 1, lam, gscale, P_subln + i * 256, Cb, DM);
#endif
                            }
                        } }
#endif

                    GRID_BAR();
                } else {

#if (SITES >> 13) & 1
#if !defined(BAND_WG) && !defined(BAND_WAVE)
                    {   const bf16_t* QKV = (const bf16_t*)(ws + WS_QKVO); bf16_t* OB = (bf16_t*)(ws + WS_OB); float* LSE = (float*)(ws + WS_LSE);
                        const int vcu_ = F.vcu, G_ = F.G;
                        auto unit_of = [=](int i) -> att::BandUnit {
                            int br, b, h, r, qb2;
                            if (G_ == 256) { const int x = vcu_ >> 5, Lx = i * 32 + (vcu_ & 31), c48 = Lx / 48, cg = x * 8 + c48, m = Lx - c48 * 48, qs = m & 15, half = cg & 1; br = m >> 4; b = cg >> 5; h = (cg >> 1) & 15;
                                const int sh = 2 * br; qb2 = (half << (4 - sh)) + (qs >> sh); r = qs & ((1 << sh) - 1); }
                            else { const int unit = vcu_ + i * G_, g32 = unit >> 5, rq = unit & 31; br = g32 >> 5; b = (g32 >> 4) & 1; h = g32 & 15; const int sh = 2 * br; r = rq >> (5 - sh); qb2 = rq & ((32 >> sh) - 1); }
                            const int sh2 = 2 * br, dil = 1 << sh2, Mr = SEQ >> sh2;
                            const size_t tok0 = (size_t)b * SEQ + r, tokq = tok0 + ((size_t)(qb2 * 256) << sh2);
                            att::BandUnit u; u.Q = QKV + tokq * 6144 + h * 128; u.K = QKV + tok0 * 6144 + 2048 + h * 128; u.V = QKV + tok0 * 6144 + 4096 + h * 128;
                            u.O = OB + ((size_t)br * MTOK + tokq) * DM + h * 128; u.L = LSE + ((size_t)br * MTOK + tokq) * 16 + h;
                            u.ld = dil * 6144; u.ldo = dil * DM; u.ldl = dil * 16; u.kfirst = qb2 * 256 - 64; u.Mr = Mr; u.lsh = sh2; return u; };
                        const int U = vcu_ < 3072 ? (3072 - vcu_ + G_ - 1) / G_ : 0;
                        _Pragma("unroll 1") for (int rp = 0; rp < REP_DIL; ++rp) { __syncthreads(); att::attn_band16_stream(U, unit_of, (char*)lds_raw); } }
#else
                    {   const bf16_t* QKV = (const bf16_t*)(ws + WS_QKVO); bf16_t* OB = (bf16_t*)(ws + WS_OB); float* LSE = (float*)(ws + WS_LSE);
                        _Pragma("unroll 1") for (int rp = 0; rp < REP_DIL; ++rp)
                        for (int unit = F.vcu; unit < 3072; unit += F.G) {
                            const int g32 = unit >> 5, rq = unit & 31, br = g32 >> 5, b = (g32 >> 4) & 1, h = g32 & 15;
                            const int dil = 1 << (2 * br), Mr = SEQ / dil, nqb = Mr / 256, r = rq / nqb, qb2 = rq % nqb;
                            const size_t tok0 = (size_t)b * SEQ + r;
                            const size_t tokq = tok0 + (size_t)(qb2 * 256) * dil;
                            const bf16_t* Qb = QKV + tokq * 6144 + h * 128;
                            const bf16_t* Kh = QKV + tok0 * 6144 + 2048 + h * 128;
                            const bf16_t* Vh = QKV + tok0 * 6144 + 4096 + h * 128;
                            bf16_t* Ob = OB + ((size_t)br * MTOK + tokq) * DM + h * 128;
                            float* ls = LSE + ((size_t)br * MTOK + tokq) * 16 + h;
                            _Pragma("unroll 1") for (int rpi = 0; rpi < REP_DIL_IN; ++rpi) {
#if defined(DIL_PROBE)
                            att::attn_band_wave(Qb, 6144L, Kh, Vh, 6144L, qb2 * 256 - 64, Mr, (bf16_t*)(ws + WS_HID) + (size_t)(unit & 2047) * 32768, 128L, (float*)(ws + WS_HID + (160u << 20)) + (size_t)unit * 256, 1L, (char*)lds_raw);
#endif
#if defined(BAND_WG)
                            __syncthreads();
                            att::attn_band_body(Qb, (long)dil * 6144, Kh, Vh, (long)dil * 6144, qb2 * 256 - 64, Mr, Ob, (long)dil * DM, ls, (long)dil * 16, (char*)lds_raw);
#else
                            att::attn_band_wave(Qb, (long)dil * 6144, Kh, Vh, (long)dil * 6144, qb2 * 256 - 64, Mr, Ob, (long)dil * DM, ls, (long)dil * 16, (char*)lds_raw);
#endif
                            }
                        } }
#endif
#endif

                    GRID_BAR();

#if (SITES >> 14) & 1
                    _Pragma("unroll 1") for (int rpt = 0; rpt < REP_THIN; ++rpt) dilated_merge(F, P);
#endif

                    CHAIN_BAR();
                }
            } else if (sub == 1) {

#if (SITES >> 15) & 1
                _Pragma("unroll 1") for (int rp = 0; rp < REP_X1; ++rp)
                {   pg8::DenseOrder S; S.init(HB, 2048, (const bf16_t*)(ws + WS_WQK) + (size_t)layer * 2 * 1024 * 2048, 2048, MTOK, 1024, F.G, bx, 32, (size_t)1024 * 2048 * 2);
                    { pg8::Unit u0; if (S.next(0, u0)) fill_rstd_tab(rss_cur, u0.pm, (LAS float*)(F.lds + LDS_RSTD)); }
                    EpiSoftmax E{(LAS const float*)(F.lds + LDS_RSTD), XP, (LAS float*)(F.lds + LDS_EPI)};
                    pg8::gemm_phase(F.lds, 2048, 2048, 2048, S, E); }
#endif

                CHAIN_BAR();
            } else {

#if (SITES >> 16) & 1
                _Pragma("unroll 1") for (int rp = 0; rp < REP_F1; ++rp)
                {   pg8::DenseOrder S; S.init(HB, 2048, (const bf16_t*)(ws + WS_W13) + (size_t)layer * 11264 * 2048, 2048, MTOK, 11264, F.G, bx);
                    { pg8::Unit u0; if (S.next(0, u0)) fill_rstd_tab(rss_cur, u0.pm, (LAS float*)(F.lds + LDS_RSTD)); }
                    EpiSwiglu E{(LAS const float*)(F.lds + LDS_RSTD), (bf16_t*)(ws + WS_HID)};
                    pg8::gemm_phase(F.lds, 2048, 2048, 2048, S, E); }
#endif

                CHAIN_BAR();
            }
#if DBG_RT
    if (dbg_stop == 15) {
            if (layer == dbg_layer && sub == dbg_sub) { const bf16_t* a = (const bf16_t*)(ws + WS_W13) + (size_t)dbg_layer * 11264 * 2048; const bf16_t* b = (const bf16_t*)(ws + WS_W2) + (size_t)dbg_layer * 2048 * 5632; for (size_t j = (size_t)F.vcu * 512 + threadIdx.x; j < (size_t)MTOK * DM; j += (size_t)F.G * 512) args.out[j] = 30.0f * (bf2f(a[j % ((size_t)11264 * 2048)]) + bf2f(b[j % ((size_t)2048 * 5632)])); return; }
    }
#endif
#if DBG_RT
    if (dbg_stop == 3) {
            if (layer == dbg_layer && sub == dbg_sub) { if (sub == 0) dbg_dump_bf(args.out, CAT, (size_t)32 << 20, nullptr, 1, F.vcu, F.G); else if (sub == 1) dbg_dump_bf(args.out, XP, (size_t)16 << 20, nullptr, 1, F.vcu, F.G); else dbg_dump_bf(args.out, (const bf16_t*)(ws + WS_HID), (size_t)88 << 20, nullptr, 1, F.vcu, F.G); return; }
    }
#endif

#if (SITES >> 17) & 1
            {   const bf16_t* A; const bf16_t* Bt; int K, pmdiv = 1 << 30; size_t bgroup = 0;
                if (sub == 0) { A = CAT; K = 2048; Bt = even ? (const bf16_t*)(ws + WS_W_ABO) + (size_t)i * 2048 * 2048 : (const bf16_t*)(ws + WS_W_CO) + (size_t)i * 2048 * 2048; }
                else if (sub == 1) { A = XP; K = 1024; Bt = (const bf16_t*)(ws + WS_VWO) + (size_t)layer * 2 * 2048 * 1024; pmdiv = 32; bgroup = (size_t)2048 * 1024 * 2; }
                else { A = (const bf16_t*)(ws + WS_HID); K = FFN; Bt = (const bf16_t*)(ws + WS_W2) + (size_t)layer * 2048 * FFN; }
                pg8::DenseOrder S; S.init(A, K, Bt, K, MTOK, 2048, F.G, bx, pmdiv, bgroup);
                EpiRes E{(layer == 0 && sub == 0) ? P_x : (const float*)nullptr, HB, rss_next};
                pg8::gemm_phase(F.lds, K, K, K, S, E);
#if defined(REP_RES)
                { asm volatile("s_waitcnt vmcnt(0)" ::: "memory"); __syncthreads(); EpiRes E2 = E; E2.dry = true; pg8::gemm_phase(F.lds, K, K, K, S, E2); }
#endif
                }
#endif

            if (layer == DEPTH - 1 && sub == 2) { GRID_BAR(); } else { CHAIN_BAR(); }
#if DBG_RT
    if (dbg_stop == 12) {
            if (layer == dbg_layer && sub == dbg_sub) { for (size_t j = (size_t)F.vcu * 512 + threadIdx.x; j < (size_t)MTOK * DM; j += (size_t)F.G * 512) args.out[j] = 200.0f * (H[j] - P_x[j]); return; }
    }
#endif
#if DBG_RT
    if (dbg_stop == 16) {
            if (layer == dbg_layer && sub == dbg_sub) { for (size_t j = (size_t)F.vcu * 512 + threadIdx.x; j < (size_t)MTOK * DM; j += (size_t)F.G * 512) args.out[j] = 200.0f * bf2f(HB[j]); return; }
    }
#endif
#if DBG_RT
    if (dbg_stop == 17) {
            if (layer == dbg_layer && sub == dbg_sub) { unsigned* q = (unsigned*)HB; for (size_t j = (size_t)F.vcu * 512 + threadIdx.x; j < (size_t)MTOK * DM / 2; j += (size_t)F.G * 512) { const unsigned w = __hip_atomic_fetch_or(q + j, 0u, __ATOMIC_RELAXED, __HIP_MEMORY_SCOPE_AGENT); args.out[2 * j] = 200.0f * bf2f(w & 0xffffu); args.out[2 * j + 1] = 200.0f * bf2f(w >> 16); } return; }
    }
#endif
#if DBG_RT
    if (dbg_stop == 4) {
            if (layer == dbg_layer && sub == dbg_sub) { dbg_dump_f32(args.out, H, F.vcu, F.G); return; }
    }
#endif
#if DBG_RT
    if (dbg_stop == 5) {
            if (layer == dbg_layer && sub == dbg_sub) { dbg_dump_bf(args.out, HB, (size_t)32 << 20, nullptr, 1, F.vcu, F.G); __syncthreads(); if (blockIdx.x < 32) { const int j = blockIdx.x * 512 + threadIdx.x; args.out[j] = rss_next[j]; } return; }
    }
#endif
#if DBG_RT
    if (dbg_stop == 6) {
            if (layer == dbg_layer && sub == dbg_sub) { dbg_dump_bf(args.out, (const bf16_t*)(ws + WS_W_QKV), (size_t)24 << 20, nullptr, 1, F.vcu, F.G); return; }
    }
#endif
        }
    }

#if DBG_RT
    if (dbg_stop == 11) {
    { const unsigned* xc = (const unsigned*)(ws + WS_CTL) + 8192; bool ok = true; for (int b = 0; b < (int)gridDim.x; ++b) ok = ok && (xc[b] == ((xc[0] + (unsigned)b) & 7u)); const float v = ok ? 0.0f : 0.26f; for (size_t j = (size_t)F.vcu * 512 + threadIdx.x; j < (size_t)MTOK * DM; j += (size_t)F.G * 512) args.out[j] = v; return; }
    }
#endif
#if DBG_RT
    if (dbg_stop == 9) {
    { const unsigned tmo = xb_ld((unsigned*)(ws + WS_CTL) + XB_TMO); const float v = tmo ? 0.26f : 0.0f; for (size_t j = (size_t)F.vcu * 512 + threadIdx.x; j < (size_t)MTOK * DM; j += (size_t)F.G * 512) args.out[j] = v; return; }
    }
#endif
#if (SITES >> 18) & 1
    final_norm(F, P);
#endif

#undef GRID_BAR
}

extern "C" void kernel_launch(void* const* d_in, const int* in_sizes, int n_in, void* d_out, int out_size, void* d_ws, size_t ws_size, hipStream_t stream) {
    static int grid = 0;
    if (grid == 0) {
        if (n_in != 28 || in_sizes[0] != MTOK * DM || out_size != MTOK * DM || ws_size < WS_END) {
            fprintf(stderr, "kernel_launch: built for 28 inputs, x/out of %d floats and >= %zu bytes of workspace; got n_in %d, in0 %d, out %d, ws %zu; nothing launched\n", MTOK * DM, (size_t)WS_END, n_in, n_in > 0 ? in_sizes[0] : -1, out_size, ws_size);
            grid = -1; return; }
        int dev = 0, cus = 0, per_cu = 0;
        if (hipGetDevice(&dev) != hipSuccess || hipDeviceGetAttribute(&cus, hipDeviceAttributeMultiprocessorCount, dev) != hipSuccess) { grid = -1; return; }
        if (hipFuncSetAttribute((const void*)mega_fwd, hipFuncAttributeMaxDynamicSharedMemorySize, LDS_BYTES) != hipSuccess) { fprintf(stderr, "kernel_launch: hipFuncSetAttribute failed\n"); grid = -1; return; }
        if (hipOccupancyMaxActiveBlocksPerMultiprocessor(&per_cu, (const void*)mega_fwd, 512, LDS_BYTES) != hipSuccess || per_cu < 1)
            fprintf(stderr, "kernel_launch: note: occupancy query reports %d workgroups per CU\n", per_cu);
        (void)hipGetLastError();
        grid = cus;
    }
    if (grid < 0) return;
    if (hipMemsetAsync((char*)d_ws + WS_CTL, 0, CTL_BYTES, stream) != hipSuccess) { fprintf(stderr, "kernel_launch: hipMemsetAsync failed\n"); return; }
    Args a{};
    for (int i = 0; i < 28; ++i) a.in[i] = (const float*)d_in[i];
    a.out = (float*)d_out; a.ws = (unsigned char*)d_ws;
    hipLaunchKernelGGL(mega_fwd, dim3(grid), dim3(512), LDS_BYTES, stream, a);
    const hipError_t le = hipPeekAtLastError();
    if (le != hipSuccess) fprintf(stderr, "kernel_launch: launch failed: %s\n", hipGetErrorName(le));
}
```

```cpp
#include <hip/hip_runtime.h>
#include <cstdio>
#include <cstdint>

#define LAS __attribute__((address_space(3)))
typedef unsigned short bf16_t;
typedef short bf16x8 __attribute__((ext_vector_type(8)));
typedef short s16x4 __attribute__((ext_vector_type(4)));
typedef float f32x2 __attribute__((ext_vector_type(2)));
typedef float f32x4 __attribute__((ext_vector_type(4)));
typedef float f32x8 __attribute__((ext_vector_type(8)));
typedef float f32x16 __attribute__((ext_vector_type(16)));
typedef unsigned u32x2 __attribute__((ext_vector_type(2)));
typedef unsigned u32x4 __attribute__((ext_vector_type(4)));

constexpr int BATCH = 2, SEQ = 8192, DM = 2048, MTOK = BATCH * SEQ, DEPTH = 4, FFN = 5632, MEML = 256;
constexpr float NORM_EPS = 1e-6f;
constexpr int S5L = 32, S5KT = 768, S5NCH = MTOK / S5L;

constexpr size_t MiB = 1u << 20;
constexpr size_t WS_CTL = 0, CTL_BYTES = 65536;
constexpr size_t WS_ROPE = 1 * MiB;
constexpr size_t WS_LP = 2 * MiB;
constexpr size_t WS_BBAR = 7 * MiB;
constexpr size_t WS_KTAB = 9 * MiB;
constexpr size_t WS_MEMN = 17 * MiB;
constexpr size_t WS_W_IN = 20 * MiB;
constexpr size_t WS_W_ABO = WS_W_IN + 32 * MiB;
constexpr size_t WS_W_GLU = WS_W_ABO + 16 * MiB;
constexpr size_t WS_W_QKV = WS_W_GLU + 4 * MiB;
constexpr size_t WS_W_CO = WS_W_QKV + 48 * MiB;
constexpr size_t WS_W13 = WS_W_CO + 16 * MiB;
constexpr size_t WS_W2 = WS_W13 + 176 * MiB;
constexpr size_t WS_WQK = WS_W2 + 88 * MiB;
constexpr size_t WS_VWO = WS_WQK + 32 * MiB;
constexpr size_t WS_BTT = WS_VWO + 32 * MiB;
constexpr size_t WS_BTE = WS_BTT + 96 * MiB;
constexpr size_t WS_HID = WS_BTE + 32 * MiB;
constexpr size_t WS_H = WS_HID;
constexpr size_t WS_HB = WS_HID + 176 * MiB;
constexpr size_t WS_CAT = WS_HB + 64 * MiB;
constexpr size_t WS_XP = WS_CAT + 64 * MiB;
constexpr size_t WS_R1 = WS_XP + 32 * MiB;
constexpr size_t WS_R2 = WS_R1 + 192 * MiB;
constexpr size_t WS_RSSP = WS_R2 + 196 * MiB;
constexpr size_t WS_END = WS_RSSP + 26 * MiB;
constexpr size_t WS_QKVO = WS_R1;
constexpr size_t WS_U2 = WS_R1;
constexpr size_t WS_QKVE = WS_R1 + 48 * MiB;
constexpr size_t WS_WKV_T = WS_R1;
constexpr size_t WS_WQ_B = WS_R1 + 64 * MiB;
constexpr size_t WS_WO_T = WS_R1 + 96 * MiB;
constexpr size_t WS_KVALL = WS_R1 + 128 * MiB;
constexpr size_t WS_OB = WS_R2;
constexpr size_t WS_LSE = WS_R2 + 192 * MiB;
constexpr size_t WS_O12 = WS_R2;
constexpr size_t WS_E = WS_R2 + 64 * MiB;
constexpr size_t WS_G = WS_R2 + 96 * MiB;

constexpr int LDS_STAGE = 131072;
constexpr int LDS_EPI = LDS_STAGE;
constexpr int LDS_MISC = LDS_STAGE + 8192;
constexpr int LDS_RSTD = LDS_MISC + 256;
constexpr int LDS_BYTES = 147456;

__device__ __forceinline__ unsigned f2bf(float f) { unsigned u = __builtin_bit_cast(unsigned, f); return (u + 0x7fffu + ((u >> 16) & 1u)) >> 16; }
__device__ __forceinline__ float bf2f(unsigned h) { return __builtin_bit_cast(float, h << 16); }
__device__ __forceinline__ unsigned cvt_pk_bf16(float lo, float hi) { unsigned r; asm volatile("v_cvt_pk_bf16_f32 %0, %1, %2" : "=v"(r) : "v"(lo), "v"(hi)); return r; }
__device__ __forceinline__ u32x2 pack4(f32x4 v) { u32x2 w; w.x = cvt_pk_bf16(v[0], v[1]); w.y = cvt_pk_bf16(v[2], v[3]); return w; }
template <int CTRL> __device__ __forceinline__ float dpp_f(float x) { return __builtin_bit_cast(float, __builtin_amdgcn_update_dpp(0, __builtin_bit_cast(int, x), CTRL, 0xf, 0xf, true)); }
__device__ __forceinline__ float wave_sum(float v) {
    v += dpp_f<0xB1>(v); v += dpp_f<0x4E>(v); v += dpp_f<0x141>(v); v += dpp_f<0x128>(v);
    auto s = __builtin_amdgcn_permlane16_swap(__float_as_uint(v), __float_as_uint(v), false, false); v = __uint_as_float(s[0]) + __uint_as_float(s[1]);
    auto u = __builtin_amdgcn_permlane32_swap(__float_as_uint(v), __float_as_uint(v), false, false); return __uint_as_float(u[0]) + __uint_as_float(u[1]);
}
__device__ __forceinline__ float x16_sum(float x) {
    auto s = __builtin_amdgcn_permlane16_swap(__float_as_uint(x), __float_as_uint(x), false, false); x = __uint_as_float(s[0]) + __uint_as_float(s[1]);
    auto u = __builtin_amdgcn_permlane32_swap(__float_as_uint(x), __float_as_uint(x), false, false); return __uint_as_float(u[0]) + __uint_as_float(u[1]);
}
__device__ __forceinline__ float x16_max(float x) {
    auto s = __builtin_amdgcn_permlane16_swap(__float_as_uint(x), __float_as_uint(x), false, false); x = fmaxf(__uint_as_float(s[0]), __uint_as_float(s[1]));
    auto u = __builtin_amdgcn_permlane32_swap(__float_as_uint(x), __float_as_uint(x), false, false); return fmaxf(__uint_as_float(u[0]), __uint_as_float(u[1]));
}
__device__ __forceinline__ float row_rstd(const float* rssp, int row, int fq) {
    const f32x4 a = *(const f32x4*)(rssp + (size_t)row * 32 + fq * 8), b = *(const f32x4*)(rssp + (size_t)row * 32 + fq * 8 + 4);
    float s = ((a[0] + a[1]) + (a[2] + a[3])) + ((b[0] + b[1]) + (b[2] + b[3]));
    s += __shfl_xor(s, 16); s += __shfl_xor(s, 32);
    return 1.0f / sqrtf(s * (1.0f / DM) + NORM_EPS);
}
__device__ __forceinline__ void fill_rstd_tab(const float* rssp, int pm, LAS float* tab) {
    int t = threadIdx.x; asm volatile("" : "+v"(t));
    if (t < 256) { const f32x4* p = (const f32x4*)(rssp + ((size_t)pm * 256 + t) * 32); float s = 0.f;
#pragma unroll
        for (int j = 0; j < 8; ++j) { const f32x4 a = p[j]; s += (a[0] + a[1]) + (a[2] + a[3]); }
        tab[t] = __builtin_amdgcn_rsqf(s * (1.0f / DM) + NORM_EPS); }
}
#define LDS_WAIT() asm volatile("s_waitcnt lgkmcnt(0)" ::: "memory")
#define VM_WAIT() asm volatile("s_waitcnt vmcnt(0)" ::: "memory")

#define XB_TMO      128
#define XB_XCNT(j)  (256  + 64 * (j))
#define XB_XSUB(j)  (1280 + 64 * (j))
#define XB_XGEN(j)  (2304 + 64 * (j))
#define XB_TOP      3328
#define XB_TOPGEN   3392
#define XCD_BAR_WORDS 3456
#define XB_SPIN_CAP (1u << 20)

__device__ __forceinline__ unsigned xb_ld(unsigned* p)              { return __hip_atomic_load(p, __ATOMIC_RELAXED, __HIP_MEMORY_SCOPE_AGENT); }
__device__ __forceinline__ unsigned xb_add(unsigned* p, unsigned v) { return __hip_atomic_fetch_add(p, v, __ATOMIC_RELAXED, __HIP_MEMORY_SCOPE_AGENT); }
__device__ __forceinline__ unsigned xb_xcc_id() { return (unsigned)__builtin_amdgcn_s_getreg((3 << 11) | 20) & 0xFu; }
#define XB_SPIN(cond, bar) do { unsigned _sp = 0; while (cond) { __builtin_amdgcn_s_sleep(1); \
    if ((++_sp & 255u) == 0u) { if (xb_ld(&(bar)[XB_TMO])) break; if (_sp > XB_SPIN_CAP) { atomicAdd(&(bar)[XB_TMO], 1u); break; } } } } while (0)

struct XcdBarrier { unsigned* bar; unsigned x; volatile LAS unsigned* st; };

__device__ __forceinline__ XcdBarrier xcd_barrier_post(unsigned* bar, volatile LAS unsigned* st) {
    XcdBarrier b; b.bar = bar; b.x = xb_xcc_id(); b.st = st;
    if (threadIdx.x == 0) (void)xb_add(&bar[XB_XCNT(b.x)], 1u);
    return b;
}
__device__ __forceinline__ void xcd_barrier_complete(unsigned* bar, unsigned x, unsigned& nloc, unsigned& nx) {
    const unsigned G = gridDim.x * gridDim.y * gridDim.z;
    unsigned sum, cnt, mine, sp = 0u;
    for (;;) {
        sum = 0u; cnt = 0u;
#pragma unroll
        for (unsigned j = 0; j < 16; ++j) { const unsigned c = xb_ld(&bar[XB_XCNT(j)]); sum += c; cnt += (c > 0u) ? 1u : 0u; }
        mine = xb_ld(&bar[XB_XCNT(x)]);
        if (sum == G) break;
        __builtin_amdgcn_s_sleep(1);
        if ((++sp & 255u) == 0u) { if (xb_ld(&bar[XB_TMO])) break; if (sp > XB_SPIN_CAP) { atomicAdd(&bar[XB_TMO], 1u); break; } }
    }
    nloc = mine > 0u ? mine : 1u; nx = cnt > 0u ? cnt : 1u;
}
__device__ __forceinline__ void xcd_barrier(const XcdBarrier& b) {
    asm volatile("s_waitcnt vmcnt(0)" ::: "memory");
    __syncthreads();
    if (threadIdx.x == 0) {
        unsigned* bar = b.bar; unsigned bx_ = b.x; asm volatile("" : "+s"(bx_));
        __builtin_amdgcn_s_waitcnt(0);
        unsigned nloc = b.st[0], nx = b.st[1];
        if (nloc == 0u) { xcd_barrier_complete(bar, bx_, nloc, nx); b.st[0] = nloc; b.st[1] = nx; }
        const unsigned old = xb_add(&bar[XB_XSUB(bx_)], 1u);
        const unsigned gen = old / nloc;
        if (old + 1u == (gen + 1u) * nloc) {
            __builtin_amdgcn_fence(__ATOMIC_RELEASE, "agent");
            asm volatile("s_waitcnt vmcnt(0)" ::: "memory");
            const unsigned og = xb_add(&bar[XB_TOP], 1u);
            const unsigned tg = og / nx;
            if (og + 1u == (tg + 1u) * nx) xb_add(&bar[XB_TOPGEN], 1u);
            else XB_SPIN(xb_ld(&bar[XB_TOPGEN]) == tg, bar);
            __builtin_amdgcn_fence(__ATOMIC_ACQUIRE, "agent");
            xb_add(&bar[XB_XGEN(bx_)], 1u);
            asm volatile("s_waitcnt vmcnt(0)" ::: "memory");
        } else {
            XB_SPIN(xb_ld(&bar[XB_XGEN(bx_)]) == gen, bar);
            __builtin_amdgcn_fence(__ATOMIC_ACQUIRE, "agent");
            asm volatile("s_waitcnt vmcnt(0)" ::: "memory");
        }
    }
    __syncthreads();
}

#define GS_XCC_WORD 8192
#define GS_CNT_WORD 9216
__device__ __forceinline__ void group_sync(unsigned* ctl, int gid, unsigned need) {
    asm volatile("s_waitcnt vmcnt(0)" ::: "memory");
    __syncthreads();
    if (threadIdx.x == 0) {
        unsigned* c = ctl + GS_CNT_WORD + 64 * gid;
        (void)xb_add(c, 1u);
        XB_SPIN(xb_ld(c) < need, ctl);
        __builtin_amdgcn_fence(__ATOMIC_ACQUIRE, "agent");
        asm volatile("s_waitcnt vmcnt(0)" ::: "memory");
    }
    __syncthreads();
}

namespace pg8 {
constexpr int BM = 256, BK = 64, HALF = 128, HTB = HALF * BK * 2, STAGE_BYTES = 8 * HTB, NXCD = 8, WGM = 8;
__device__ __forceinline__ int lds_byte(int r, int c) { const int st = (r >> 4) * 2 + (c >> 5), rr = r & 15, cc = c & 31, ob = rr * 64 + cc * 2; return st * 1024 + (ob ^ (((ob >> 9) & 1) << 5)); }
__device__ __forceinline__ void stage_rc(int b, int& R, int& C) { const int st = b / 1024, sb = b % 1024, swz = sb ^ (((sb >> 9) & 1) << 5); R = (st >> 1) * 16 + swz / 64; C = (st & 1) * 32 + (swz % 64) / 2; }

struct Unit { int pm, pn, g; const char* a; const char* b; };

struct DenseOrder {
    int nM, nN, nwg, G, c, pmdiv; const char* A; const char* B; size_t tA, tB, bgroup;
    __device__ __forceinline__ void init(const void* A_, int lda, const void* B_, int ldb, int M, int N, int G_, int c_, int pmdiv_ = 1 << 30, size_t bgroup_ = 0) {
        nM = M / BM; nN = N / BM; nwg = nM * nN; G = G_; c = c_; A = (const char*)A_; B = (const char*)B_; tA = (size_t)BM * lda * 2; tB = (size_t)BM * ldb * 2; pmdiv = pmdiv_; bgroup = bgroup_; }
    __device__ __forceinline__ bool next(int i, Unit& u) const {
        const long L = (long)i * G + c; if (L >= nwg) return false;
        int wgid = (int)L; { const int q = nwg / NXCD, r = nwg % NXCD, xcd = wgid % NXCD, off = wgid / NXCD; wgid = (xcd < r ? xcd * (q + 1) : r * (q + 1) + (xcd - r) * q) + off; }
        const int nig = WGM * nN, gid = wgid / nig, fm = gid * WGM, gsz = (nM - fm) < WGM ? (nM - fm) : WGM;
        u.pm = fm + ((wgid % nig) % gsz); u.pn = (wgid % nig) / gsz; u.g = u.pm / pmdiv;
        u.a = A + (size_t)u.pm * tA; u.b = B + (size_t)u.pn * tB + (size_t)u.g * bgroup; return true;
    }
};

struct NoPre { __device__ __forceinline__ void operator()() const {} };
template <class Epi, class Sched, class Pre = NoPre>
__device__ __forceinline__ void gemm_phase(LAS unsigned char* lds, const int K, const int lda, const int ldb, const Sched& S, const Epi& E, const Pre& pre = Pre()) {
    int tid = threadIdx.x; asm volatile("" : "+v"(tid));
    const int wid = __builtin_amdgcn_readfirstlane(tid >> 6), lane = tid & 63, wr = wid >> 2, wc = wid & 3, fr = lane & 15, fq = lane >> 4;
    const int nt = K / BK;
    unsigned voffA[2], voffB[2];
#pragma unroll
    for (int i = 0; i < 2; ++i) { int R, C; stage_rc(tid * 16 + i * 8192, R, C);
        const int Rb = Epi::PERM ? ((R & ~31) + 8 * ((R & 15) >> 2) + 4 * ((R >> 4) & 1) + (R & 3)) : R;
        voffA[i] = (unsigned)(R * lda + C) * 2u; voffB[i] = (unsigned)(Rb * ldb + C) * 2u; }
    const size_t kstep = (size_t)(BK * 2);
    const size_t hstepA = (size_t)HALF * lda * 2, hstepB = (size_t)HALF * ldb * 2;
    const unsigned ldsw = (unsigned)wid * 1024u;
    const int aoff = lds_byte(wr * 64 + fr, fq * 8), boff = lds_byte(wc * 32 + fr, fq * 8);
#define PG8_SA(b, h) (((b) * 2 + (h)) * HTB)
#define PG8_SB(b, h) ((4 + (b) * 2 + (h)) * HTB)
#ifndef PG8_AUX_A
#define PG8_AUX_A 0
#endif
#ifndef PG8_AUX_B
#define PG8_AUX_B 0
#endif
#define PG8_STAGE_X(bufoff, gbase, voff, AUX) do { _Pragma("unroll") for (int _i = 0; _i < 2; ++_i) \
        __builtin_amdgcn_global_load_lds((const unsigned*)((const char*)(gbase) + (voff)[_i]), (LAS unsigned*)(lds + (bufoff) + ldsw + _i * 8192), 16, 0, AUX); } while (0)
#define PG8_STAGE_voffA(bufoff, gbase) PG8_STAGE_X(bufoff, gbase, voffA, PG8_AUX_A)
#define PG8_STAGE_voffB(bufoff, gbase) PG8_STAGE_X(bufoff, gbase, voffB, PG8_AUX_B)
#define PG8_STAGE(bufoff, gbase, voff) PG8_STAGE_##voff(bufoff, gbase)
#define PG8_LDA(dst, b, h) do { _Pragma("unroll") for (int m = 0; m < 4; ++m) _Pragma("unroll") for (int k = 0; k < 2; ++k) dst[m][k] = *(const LAS bf16x8*)(lds + PG8_SA(b, h) + aoff + m * 2048 + k * 1024); } while (0)
#define PG8_LDB(dst, b, h) do { _Pragma("unroll") for (int n = 0; n < 2; ++n) _Pragma("unroll") for (int k = 0; k < 2; ++k) dst[n][k] = *(const LAS bf16x8*)(lds + PG8_SB(b, h) + boff + n * 2048 + k * 1024); } while (0)
#define PG8_MMA(ai, bj, At, Bt) do { __builtin_amdgcn_s_setprio(1); _Pragma("unroll") for (int m = 0; m < 4; ++m) _Pragma("unroll") for (int n = 0; n < 2; ++n) _Pragma("unroll") for (int k = 0; k < 2; ++k) \
        acc[ai][bj][m][n] = __builtin_amdgcn_mfma_f32_16x16x32_bf16(Bt[n][k], At[m][k], acc[ai][bj][m][n], 0, 0, 0); __builtin_amdgcn_s_setprio(0); } while (0)
#define PG8_WAIT_V(n) asm volatile("s_waitcnt vmcnt(" #n ")" ::: "memory")
#define PG8_WAIT_L(n) asm volatile("s_waitcnt lgkmcnt(" #n ")" ::: "memory")
#define PG8_BAR __builtin_amdgcn_s_barrier()
#define PG8_SCHED __builtin_amdgcn_sched_barrier(0)
    Unit cur, nxt; int ui = 0;
    if (!S.next(0, cur)) return;
    f32x4 acc[2][2][4][2];
#pragma unroll
    for (int a = 0; a < 2; ++a)
#pragma unroll
        for (int b = 0; b < 2; ++b)
#pragma unroll
            for (int m = 0; m < 4; ++m)
#pragma unroll
                for (int n = 0; n < 2; ++n) acc[a][b][m][n] = (f32x4){0.f, 0.f, 0.f, 0.f};
    bf16x8 At[4][2], B0[2][2], B1[2][2];
    const char* cA = cur.a; const char* cB = cur.b;
    PG8_STAGE(PG8_SB(0, 0), cB, voffB); PG8_STAGE(PG8_SA(0, 0), cA, voffA); PG8_STAGE(PG8_SB(0, 1), cB + hstepB, voffB); PG8_STAGE(PG8_SA(0, 1), cA + hstepA, voffA);
    pre();
    if (wr == 1) PG8_BAR;
    PG8_WAIT_V(4); PG8_BAR;
    PG8_STAGE(PG8_SB(1, 0), cB + kstep, voffB); PG8_STAGE(PG8_SA(1, 0), cA + kstep, voffA); PG8_STAGE(PG8_SB(1, 1), cB + hstepB + kstep, voffB);
    PG8_WAIT_V(6); PG8_BAR;
    for (;;) {
        const bool has_next = S.next(ui + 1, nxt);
        const char* nA = has_next ? nxt.a : cA; const char* nB = has_next ? nxt.b : cB;
#if defined(KREP_DIAG)
        const int nt_eff = Epi::REPEATABLE ? 2 * nt : nt;
#else
        const int nt_eff = nt;
#endif
        for (int tt = 0; tt < nt_eff; tt += 2) {
            const bool last = (tt == nt_eff - 2);
            const int t = tt >= nt ? tt - nt : tt, t2 = (tt + 2 >= nt && tt + 2 < nt_eff) ? tt + 2 - nt : tt + 2;
            const char* a1 = cA + (size_t)(t + 1) * kstep;
            const char* a2 = last ? nA : cA + (size_t)t2 * kstep; const char* b2 = last ? nB : cB + (size_t)t2 * kstep;
            const char* a3 = a2 + kstep; const char* b3 = b2 + kstep;
            PG8_LDB(B0, 0, 0); PG8_SCHED; PG8_LDA(At, 0, 0); PG8_STAGE(PG8_SA(1, 1), a1 + hstepA, voffA);
            PG8_WAIT_L(8); PG8_BAR; PG8_WAIT_L(0); PG8_MMA(0, 0, At, B0); PG8_BAR; PG8_SCHED;
            PG8_LDB(B1, 0, 1); PG8_STAGE(PG8_SB(0, 0), b2, voffB);
            PG8_BAR; PG8_WAIT_L(0); PG8_MMA(0, 1, At, B1); PG8_BAR;
            PG8_LDA(At, 0, 1); PG8_STAGE(PG8_SA(0, 0), a2, voffA);
            PG8_BAR; PG8_WAIT_L(0); PG8_MMA(1, 0, At, B0); PG8_BAR; PG8_SCHED;
            PG8_STAGE(PG8_SB(0, 1), b2 + hstepB, voffB);
            PG8_WAIT_V(6); PG8_BAR; PG8_MMA(1, 1, At, B1); PG8_BAR;
            PG8_LDB(B0, 1, 0); PG8_SCHED; PG8_LDA(At, 1, 0); PG8_STAGE(PG8_SA(0, 1), a2 + hstepA, voffA);
            PG8_WAIT_L(8); PG8_BAR; PG8_WAIT_L(0); PG8_MMA(0, 0, At, B0); PG8_BAR; PG8_SCHED;
            PG8_LDB(B1, 1, 1); PG8_STAGE(PG8_SB(1, 0), b3, voffB);
            PG8_BAR; PG8_WAIT_L(0); PG8_MMA(0, 1, At, B1); PG8_BAR;
            PG8_LDA(At, 1, 1); PG8_STAGE(PG8_SA(1, 0), a3, voffA);
            PG8_BAR; PG8_WAIT_L(0); PG8_MMA(1, 0, At, B0); PG8_BAR; PG8_SCHED;
            PG8_STAGE(PG8_SB(1, 1), b3 + hstepB, voffB);
            PG8_WAIT_V(6); PG8_BAR; PG8_MMA(1, 1, At, B1); PG8_BAR;
        }
        E(acc, cur, wr, wc, fr, fq);
#if defined(REP_EPI)
        if constexpr (Epi::REPEATABLE) { asm volatile("" ::: "memory"); Epi E2 = E; E2.dry = true; E2(acc, cur, wr, wc, fr, fq); }
#endif
        if (!has_next) break;
#pragma unroll
        for (int a = 0; a < 2; ++a)
#pragma unroll
            for (int b = 0; b < 2; ++b)
#pragma unroll
                for (int m = 0; m < 4; ++m)
#pragma unroll
                    for (int n = 0; n < 2; ++n) acc[a][b][m][n] = (f32x4){0.f, 0.f, 0.f, 0.f};
        cur = nxt; cA = nA; cB = nB; ++ui;
    }
    PG8_WAIT_V(0);
    if (wr == 0) PG8_BAR;
    PG8_BAR;
#undef PG8_SA
#undef PG8_SB
#undef PG8_STAGE
#undef PG8_STAGE_X
#undef PG8_STAGE_voffA
#undef PG8_STAGE_voffB
#undef PG8_LDA
#undef PG8_LDB
#undef PG8_MMA
#undef PG8_WAIT_V
#undef PG8_WAIT_L
#undef PG8_BAR
#undef PG8_SCHED
}
}

typedef f32x4 acc_t[2][2][4][2];
#define EPI_ROWS(ai, m) _Pragma("unroll") for (int ai = 0; ai < 2; ++ai) _Pragma("unroll") for (int m = 0; m < 4; ++m)
#define EPI_COLS(bj, n) _Pragma("unroll") for (int bj = 0; bj < 2; ++bj) _Pragma("unroll") for (int n = 0; n < 2; ++n)

struct EpiBf16Plain {
    static constexpr bool REPEATABLE = false; static constexpr bool PERM = false;
    bf16_t* O; int ldo; const float* colscale; float scale;
    __device__ __forceinline__ void operator()(acc_t& acc, const pg8::Unit& u, int wr, int wc, int fr, int fq) const {
        const int row0 = u.pm * 256 + wr * 64 + fr, col0 = u.pn * 256 + wc * 32 + 4 * fq;
        f32x4 cs[2][2];
        EPI_COLS(bj, n) { cs[bj][n] = colscale ? *(const f32x4*)(colscale + col0 + bj * 128 + n * 16) * scale : (f32x4){scale, scale, scale, scale}; }
        EPI_ROWS(ai, m) { bf16_t* rowp = O + (size_t)(row0 + ai * 128 + m * 16) * ldo + col0;
            EPI_COLS(bj, n) { *(u32x2*)(rowp + bj * 128 + n * 16) = pack4(acc[ai][bj][m][n] * cs[bj][n]); } }
    }
};
struct EpiWqK {
    static constexpr bool REPEATABLE = false; static constexpr bool PERM = false;
    bf16_t* O; const float* gain;
    __device__ __forceinline__ void operator()(acc_t& acc, const pg8::Unit& u, int wr, int wc, int fr, int fq) const {
        const int l = u.g >> 3, lb = u.g >> 2, h = u.g & 3;
        const int row0 = wr * 64 + fr, col0 = u.pn * 256 + wc * 32 + 4 * fq;
        bf16_t* base = O + ((size_t)lb * 1024 + h * 256) * 2048;
        const float* gl = gain + l * 2048;
        f32x4 cs[2][2];
        EPI_COLS(bj, n) { cs[bj][n] = *(const f32x4*)(gl + col0 + bj * 128 + n * 16) * 0.04419417382415922f; }
        EPI_ROWS(ai, m) { bf16_t* rowp = base + (size_t)(row0 + ai * 128 + m * 16) * 2048 + col0;
            EPI_COLS(bj, n) { *(u32x2*)(rowp + bj * 128 + n * 16) = pack4(acc[ai][bj][m][n] * cs[bj][n]); } }
    }
};
struct EpiVWo {
    static constexpr bool REPEATABLE = false; static constexpr bool PERM = false;
    bf16_t* O;
    __device__ __forceinline__ void operator()(acc_t& acc, const pg8::Unit& u, int wr, int wc, int fr, int fq) const {
        const int lb = u.g >> 2, h = u.g & 3;
        const int row0 = u.pm * 256 + wr * 64 + fr, col0 = h * 256 + wc * 32 + 4 * fq;
        bf16_t* base = O + (size_t)lb * 2048 * 1024;
        EPI_ROWS(ai, m) { bf16_t* rowp = base + (size_t)(row0 + ai * 128 + m * 16) * 1024 + col0;
            EPI_COLS(bj, n) { *(u32x2*)(rowp + bj * 128 + n * 16) = pack4(acc[ai][bj][m][n]); } }
    }
};
struct EpiF32 {
    static constexpr bool REPEATABLE = false; static constexpr bool PERM = false;
    float* C; int ldc;
    __device__ __forceinline__ void operator()(acc_t& acc, const pg8::Unit& u, int wr, int wc, int fr, int fq) const {
        const int row0 = u.pm * 256 + wr * 64 + fr, col0 = u.pn * 256 + wc * 32 + 4 * fq;
        EPI_ROWS(ai, m) { float* rowp = C + (size_t)(row0 + ai * 128 + m * 16) * ldc + col0;
            EPI_COLS(bj, n) { *(f32x4*)(rowp + bj * 128 + n * 16) = acc[ai][bj][m][n]; } }
    }
};
struct EpiProj {
    static constexpr bool REPEATABLE = false; static constexpr bool PERM = false;
    LAS const float* rstd_tab; const float* rc; const float* rs; bf16_t* O; int ldo; bf16_t* U2; int u_tiles, rope_lo, rope_hi;
    __device__ __forceinline__ void operator()(acc_t& acc, const pg8::Unit& u, int wr, int wc, int fr, int fq) const {
        const int row0 = u.pm * 256 + wr * 64 + fr;
        const bool is_u = u.pn < u_tiles, rope = (u.pn >= rope_lo) && (u.pn < rope_hi) && (wc == 0);
        EPI_ROWS(ai, m) {
            const int row = row0 + ai * 128 + m * 16;
            const float rstd = rstd_tab[ai * 128 + wr * 64 + m * 16 + fr];
            f32x4 v[2][2];
            EPI_COLS(bj, n) { v[bj][n] = acc[ai][bj][m][n] * rstd; }
            if (rope) {
                const int pos = row & (SEQ - 1);
#if defined(ROPE_TABLE)
                const f32x4 c = *(const f32x4*)(rc + pos * 16 + 4 * fq), s = *(const f32x4*)(rs + pos * 16 + 4 * fq);
#else
                f32x4 c, s;
#pragma unroll
                for (int e = 0; e < 4; ++e) { const float invrev = __builtin_amdgcn_exp2f(-1.1832230355827609f * (float)(4 * fq + e) - 2.6514961294723187f);
                    const float fr_ = __builtin_amdgcn_fractf((float)pos * invrev); c[e] = __builtin_amdgcn_cosf(fr_); s[e] = __builtin_amdgcn_sinf(fr_); }
#endif
#pragma unroll
                for (int bj = 0; bj < 2; ++bj) { const f32x4 x1 = v[bj][0], x2 = v[bj][1]; v[bj][0] = x1 * c - x2 * s; v[bj][1] = x2 * c + x1 * s; }
            }
            if (is_u) {
                const int cg = row >> 5, t = row & 31;
                EPI_COLS(bj, n) { const int g = (u.pn * 256 + bj * 128 + wc * 32 + n * 16) >> 4;
                    *(u32x2*)(U2 + ((size_t)g * S5NCH + cg) * S5KT + t * 16 + 4 * fq) = pack4(v[bj][n]); }
            } else if (ldo == 0) {
                const int t = u.pn - u_tiles, which = t >> 3, b = row >> 13, pos = row & (SEQ - 1);
#pragma unroll
                for (int bj = 0; bj < 2; ++bj) { const int h = 2 * (t & 7) + bj;
                    bf16_t* rowp = O + (size_t)which * MTOK * DM + ((size_t)(b * 16 + h) * SEQ + pos) * 128 + wc * 32 + 4 * fq;
#pragma unroll
                    for (int n = 0; n < 2; ++n) *(u32x2*)(rowp + n * 16) = pack4(v[bj][n]); }
            } else {
                bf16_t* rowp = O + (size_t)row * ldo + (u.pn - u_tiles) * 256 + wc * 32 + 4 * fq;
                EPI_COLS(bj, n) { *(u32x2*)(rowp + bj * 128 + n * 16) = pack4(v[bj][n]); }
            }
        }
    }
};
struct EpiRes {
    static constexpr bool REPEATABLE = false; static constexpr bool PERM = true;
    const float* base32; bf16_t* HB; float* rss_next; bool dry = false;
    __device__ __forceinline__ void operator()(acc_t& acc, const pg8::Unit& u, int wr, int wc, int fr, int fq) const {
        const int row0 = u.pm * 256 + wr * 64 + fr, col0 = u.pn * 256 + wc * 32 + 8 * fq;
        EPI_ROWS(ai, m) {
            const int row = row0 + ai * 128 + m * 16; const size_t off = (size_t)row * DM + col0; float ss = 0.f;
            if (base32) {
                EPI_COLS(bj, n) { acc[ai][bj][m][n] += *(const f32x4*)(base32 + off + bj * 128 + n * 4); }
            } else {
#pragma unroll
                for (int bj = 0; bj < 2; ++bj) { const u32x4 w = *(const u32x4*)(HB + off + bj * 128);
                    acc[ai][bj][m][0] += (f32x4){bf2f(w.x & 0xffffu), bf2f(w.x >> 16), bf2f(w.y & 0xffffu), bf2f(w.y >> 16)};
                    acc[ai][bj][m][1] += (f32x4){bf2f(w.z & 0xffffu), bf2f(w.z >> 16), bf2f(w.w & 0xffffu), bf2f(w.w >> 16)}; }
            }
#pragma unroll
            for (int bj = 0; bj < 2; ++bj) { const f32x4 o0 = acc[ai][bj][m][0], o1 = acc[ai][bj][m][1]; const u32x2 w0 = pack4(o0), w1 = pack4(o1); const u32x4 w = {w0.x, w0.y, w1.x, w1.y};
                if (dry) { asm volatile("" :: "v"(w.x), "v"(w.y), "v"(w.z), "v"(w.w)); } else { *(u32x4*)(HB + off + bj * 128) = w; }
                ss += ((o0[0] * o0[0] + o0[1] * o0[1]) + (o0[2] * o0[2] + o0[3] * o0[3])) + ((o1[0] * o1[0] + o1[1] * o1[1]) + (o1[2] * o1[2] + o1[3] * o1[3])); }
            ss = x16_sum(ss);
            if (fq == 0 && !dry) rss_next[(size_t)row * 32 + u.pn * 4 + wc] = ss;
        }
    }
};
struct EpiSoftmax {
    static constexpr bool REPEATABLE = false; static constexpr bool PERM = false;
    LAS const float* rstd_tab; bf16_t* P; LAS float* xch;
    __device__ __forceinline__ void operator()(acc_t& acc, const pg8::Unit& u, int wr, int wc, int fr, int fq) const {
        const int row0 = u.pm * 256 + wr * 64 + fr;
        LAS float* xmax = xch; LAS float* xsum = xch + 1024;
        EPI_ROWS(ai, m) {
            const int rl = ai * 128 + wr * 64 + m * 16 + fr, row = u.pm * 256 + rl;
            const float rstd = rstd_tab[rl] * 1.4426950408889634f;
            float mx = -3.0e38f;
            EPI_COLS(bj, n) { const f32x4 s = acc[ai][bj][m][n] * rstd; acc[ai][bj][m][n] = s; mx = fmaxf(mx, fmaxf(fmaxf(s[0], s[1]), fmaxf(s[2], s[3]))); }
            mx = x16_max(mx);
            if (fq == 0) xmax[rl * 4 + wc] = mx;
        }
        LDS_WAIT(); __builtin_amdgcn_s_barrier(); asm volatile("" ::: "memory");
        EPI_ROWS(ai, m) {
            const int rl = ai * 128 + wr * 64 + m * 16 + fr;
            const f32x4 m4 = *(const LAS f32x4*)(xmax + rl * 4); const float mx = fmaxf(fmaxf(m4[0], m4[1]), fmaxf(m4[2], m4[3]));
            float sm = 0.f;
            EPI_COLS(bj, n) { f32x4 s = acc[ai][bj][m][n];
#pragma unroll
                for (int j = 0; j < 4; ++j) s[j] = __builtin_amdgcn_exp2f(s[j] - mx);
                acc[ai][bj][m][n] = s; sm += (s[0] + s[1]) + (s[2] + s[3]); }
            sm = x16_sum(sm);
            if (fq == 0) xsum[rl * 4 + wc] = sm;
        }
        LDS_WAIT(); __builtin_amdgcn_s_barrier(); asm volatile("" ::: "memory");
        EPI_ROWS(ai, m) {
            const int rl = ai * 128 + wr * 64 + m * 16 + fr;
            const f32x4 s4 = *(const LAS f32x4*)(xsum + rl * 4); const float inv = __builtin_amdgcn_rcpf((s4[0] + s4[1]) + (s4[2] + s4[3]));
            bf16_t* rowp = P + (size_t)(row0 + ai * 128 + m * 16) * 1024 + u.pn * 256 + wc * 32 + 4 * fq;
            EPI_COLS(bj, n) { *(u32x2*)(rowp + bj * 128 + n * 16) = pack4(acc[ai][bj][m][n] * inv); }
        }
    }
};
struct EpiSwiglu {
    static constexpr bool REPEATABLE = true; static constexpr bool PERM = true;
    LAS const float* rstd_tab; bf16_t* O; bool dry = false;
    __device__ __forceinline__ void operator()(acc_t& acc, const pg8::Unit& u, int wr, int wc, int fr, int fq) const {
        const int row0 = u.pm * 256 + wr * 64 + fr;
        EPI_ROWS(ai, m) {
            const int row = row0 + ai * 128 + m * 16;
#if defined(KREP_DIAG)
            const float rstd = 0.5f * rstd_tab[ai * 128 + wr * 64 + m * 16 + fr];
#else
            const float rstd = rstd_tab[ai * 128 + wr * 64 + m * 16 + fr];
#endif
            bf16_t* rowp = O + (size_t)row * FFN + u.pn * 128 + wc * 32 + 8 * fq;
            u32x2 wn[2];
#pragma unroll
            for (int n = 0; n < 2; ++n) { const f32x4 a = acc[ai][0][m][n] * rstd, b = acc[ai][1][m][n] * rstd; f32x4 o;
#pragma unroll
                for (int j = 0; j < 4; ++j) o[j] = a[j] * b[j] * __builtin_amdgcn_rcpf(1.0f + __builtin_amdgcn_exp2f(-1.4426950408889634f * a[j]));
                wn[n] = pack4(o); }
            { const u32x4 w = {wn[0].x, wn[0].y, wn[1].x, wn[1].y}; if (dry) { asm volatile("" :: "v"(w.x), "v"(w.y), "v"(w.z), "v"(w.w)); } else { *(u32x4*)rowp = w; } }
        }
    }
};
__device__ __forceinline__ float gelu_tanh(float x) { const float z = 0.7978845608028654f * (x + 0.044715f * x * x * x); const float e = __builtin_amdgcn_exp2f(2.8853900817779268f * z); return x * (1.0f - __builtin_amdgcn_rcpf(1.0f + e)); }
struct EpiS5Y {
    static constexpr bool REPEATABLE = false; static constexpr bool PERM = false;
    bf16_t* G;
    __device__ __forceinline__ void operator()(acc_t& acc, const pg8::Unit& u, int wr, int wc, int fr, int fq) const {
        const int g = u.pm >> 1;
        EPI_ROWS(ai, m) {
            const int cg = (u.pm & 1) * 256 + ai * 128 + wr * 64 + m * 16 + fr;
            EPI_COLS(bj, n) { const int t = (u.pn * 256 + bj * 128 + wc * 32 + n * 16) >> 4; const f32x4 y = acc[ai][bj][m][n]; f32x4 o;
#pragma unroll
                for (int j = 0; j < 4; ++j) o[j] = gelu_tanh(y[j]);
                *(u32x2*)(G + (size_t)(cg * S5L + t) * 1024 + g * 16 + 4 * fq) = pack4(o); }
        }
    }
};
struct EpiGlu {
    static constexpr bool REPEATABLE = false; static constexpr bool PERM = false;
    const bf16_t* G; const float* bias; bf16_t* O;
    __device__ __forceinline__ void operator()(acc_t& acc, const pg8::Unit& u, int wr, int wc, int fr, int fq) const {
        const int row0 = u.pm * 256 + wr * 64 + fr, col0 = u.pn * 256 + wc * 32 + 4 * fq;
        f32x4 bv[2][2];
        EPI_COLS(bj, n) { bv[bj][n] = *(const f32x4*)(bias + col0 + bj * 128 + n * 16); }
        EPI_ROWS(ai, m) {
            const int row = row0 + ai * 128 + m * 16;
            EPI_COLS(bj, n) { const int c = col0 + bj * 128 + n * 16; const u32x2 gw = *(const u32x2*)(G + (size_t)row * 1024 + c);
                const f32x4 s = acc[ai][bj][m][n] + bv[bj][n]; f32x4 o;
                const float g0 = bf2f(gw.x & 0xffffu), g1 = bf2f(gw.x >> 16), g2 = bf2f(gw.y & 0xffffu), g3 = bf2f(gw.y >> 16);
                o[0] = g0 * __builtin_amdgcn_rcpf(1.0f + __builtin_amdgcn_exp2f(-1.4426950408889634f * s[0])); o[1] = g1 * __builtin_amdgcn_rcpf(1.0f + __builtin_amdgcn_exp2f(-1.4426950408889634f * s[1])); o[2] = g2 * __builtin_amdgcn_rcpf(1.0f + __builtin_amdgcn_exp2f(-1.4426950408889634f * s[2])); o[3] = g3 * __builtin_amdgcn_rcpf(1.0f + __builtin_amdgcn_exp2f(-1.4426950408889634f * s[3]));
                *(u32x2*)(O + (size_t)row * DM + c) = pack4(o); }
        }
    }
};

namespace att {
constexpr int D = 128, NW = 8, QBLK = 32, KVBLK = 64;
constexpr float SCALE = 0.088388347648318440f;
constexpr float THR = 8.f;
constexpr size_t SHM_V = KVBLK * D * 2, SHM_K = KVBLK * D * 2, SHM_ATTN = 2 * SHM_V + 2 * SHM_K + NW * 64 * 4;
#define KSWZ(row, colB) ((row) * 256 + ((colB) ^ (((row) & 15) << 4)))
#define SBAR() __builtin_amdgcn_sched_barrier(0)
__device__ __forceinline__ int crow(int r, int hi) { return (r & 3) + 8 * (r >> 2) + 4 * hi; }
__device__ __forceinline__ unsigned cvtpk(float lo, float hi) { unsigned r; asm volatile("v_cvt_pk_bf16_f32 %0, %1, %2" : "=v"(r) : "v"(lo), "v"(hi)); return r; }

__device__ __forceinline__ void partialSM(f32x16& p0, f32x16& p1, float& m_reg, float& mn, float& alpha) {
  constexpr float C = SCALE * 1.4426950408889634f;
  float pmax = p0[0];
#pragma unroll
  for (int r = 1; r < 16; ++r) pmax = fmaxf(pmax, p0[r]);
#pragma unroll
  for (int r = 0; r < 16; ++r) pmax = fmaxf(pmax, p1[r]);
  { auto rr = __builtin_amdgcn_permlane32_swap(__float_as_uint(pmax), __float_as_uint(pmax), false, false);
    pmax = fmaxf(__uint_as_float(rr[0]), __uint_as_float(rr[1])); }
  if (__builtin_expect(__all(pmax - m_reg <= THR / SCALE), 1)) { mn = m_reg; alpha = 1.f; }
  else { mn = fmaxf(m_reg, pmax); alpha = __builtin_amdgcn_exp2f((m_reg - mn) * C); m_reg = mn; }
  float mnC = -mn * C;
#pragma unroll
  for (int r = 0; r < 16; ++r) p0[r] = fmaf(p0[r], C, mnC);
#pragma unroll
  for (int r = 0; r < 16; ++r) p1[r] = fmaf(p1[r], C, mnC);
#pragma unroll
  for (int r = 0; r < 16; ++r) p0[r] = __builtin_amdgcn_exp2f(p0[r]);
}
__device__ __forceinline__ void finishSM(f32x16& p0, f32x16& p1, float alpha, float& l_reg, bf16x8& pa0, bf16x8& pa1, bf16x8& pa2, bf16x8& pa3) {
#pragma unroll
  for (int r = 0; r < 16; ++r) p1[r] = __builtin_amdgcn_exp2f(p1[r]);
  float ps = 0;
#pragma unroll
  for (int r = 0; r < 16; ++r) ps += p0[r];
#pragma unroll
  for (int r = 0; r < 16; ++r) ps += p1[r];
  { auto rr = __builtin_amdgcn_permlane32_swap(__float_as_uint(ps), __float_as_uint(ps), false, false);
    ps = __uint_as_float(rr[0]) + __uint_as_float(rr[1]); }
  l_reg = l_reg * alpha + ps;
#define PK4(P, BASE, OUT) do { unsigned a0 = cvtpk(P[BASE + 0], P[BASE + 1]), a1 = cvtpk(P[BASE + 2], P[BASE + 3]);   \
    unsigned b0 = cvtpk(P[BASE + 4], P[BASE + 5]), b1 = cvtpk(P[BASE + 6], P[BASE + 7]);                              \
    auto r0 = __builtin_amdgcn_permlane32_swap(a0, b0, false, false); auto r1 = __builtin_amdgcn_permlane32_swap(a1, b1, false, false); \
    u32x4 w = {r0[0], r1[0], r0[1], r1[1]}; OUT = *reinterpret_cast<bf16x8*>(&w); } while (0)
  PK4(p0, 0, pa0); PK4(p0, 8, pa1); PK4(p1, 0, pa2); PK4(p1, 8, pa3);
#undef PK4
}
__device__ __forceinline__ void qkt(f32x16& p0, f32x16& p1, const char* Ks, const bf16x8* qr, int r32, int hi) {
  p0 = f32x16{}; p1 = f32x16{};
#pragma unroll
  for (int d0 = 0; d0 < 8; ++d0) { int cb = (d0 * 16 + hi * 8) * 2;
    bf16x8 b0 = *reinterpret_cast<const bf16x8*>(Ks + KSWZ(r32, cb));
    bf16x8 b1 = *reinterpret_cast<const bf16x8*>(Ks + KSWZ(32 + r32, cb));
    p0 = __builtin_amdgcn_mfma_f32_32x32x16_bf16(b0, qr[d0], p0, 0, 0, 0);
    p1 = __builtin_amdgcn_mfma_f32_32x32x16_bf16(b1, qr[d0], p1, 0, 0, 0); }
}
__device__ __forceinline__ void mask_tile(f32x16& p0, f32x16& p1, int tb, int kq, int Mr, int hi) {
#pragma unroll
  for (int r = 0; r < 16; ++r) { const int tt = tb + crow(r, hi);
    const bool ok0 = ((unsigned)tt <= 128u) && ((unsigned)(kq + tt) < (unsigned)Mr);
    const bool ok1 = ((unsigned)(tt + 32) <= 128u) && ((unsigned)(kq + tt + 32) < (unsigned)Mr);
    p0[r] = ok0 ? p0[r] : -3.0e4f; p1[r] = ok1 ? p1[r] : -3.0e4f; }
}
__device__ __forceinline__ int v_st(int k, int c) { const int kk = (k & ~0xC) | ((k & 4) << 1) | ((k & 8) >> 1); return ((kk >> 3) * 4 + (c >> 5)) * 512 + ((kk & 7) * 32 + (c & 31)) * 2; }
__device__ __forceinline__ int v_rd_base(int lane) { return ((lane & 3) << 3) | (((lane >> 2) & 3) << 6) | (((lane >> 4) & 1) << 5) | (((lane >> 5) & 1) << 8); }
constexpr int v_rd_off(int d0, int ks, int half) { return d0 * 512 + ks * 4096 + half * 2048; }
template <int OFF> __device__ __forceinline__ s16x4 tr_read(int vb) {
  s16x4 r; asm volatile("ds_read_b64_tr_b16 %0, %1 offset:%2" : "=&v"(r) : "v"(vb), "i"(OFF) : "memory"); return r;
}
template <int D0> __device__ __forceinline__ void pv_one(f32x16& od, int vb, bf16x8 pa0, bf16x8 pa1, bf16x8 pa2, bf16x8 pa3) {
  const s16x4 l0 = tr_read<v_rd_off(D0, 0, 0)>(vb), h0 = tr_read<v_rd_off(D0, 0, 1)>(vb), l1 = tr_read<v_rd_off(D0, 1, 0)>(vb), h1 = tr_read<v_rd_off(D0, 1, 1)>(vb);
  const s16x4 l2 = tr_read<v_rd_off(D0, 2, 0)>(vb), h2 = tr_read<v_rd_off(D0, 2, 1)>(vb), l3 = tr_read<v_rd_off(D0, 3, 0)>(vb), h3 = tr_read<v_rd_off(D0, 3, 1)>(vb);
  asm volatile("s_waitcnt lgkmcnt(0)" ::: "memory"); SBAR();
#define PK(L, H) (bf16x8){L[0], L[1], L[2], L[3], H[0], H[1], H[2], H[3]}
  od = __builtin_amdgcn_mfma_f32_32x32x16_bf16(pa0, PK(l0, h0), od, 0, 0, 0);
  od = __builtin_amdgcn_mfma_f32_32x32x16_bf16(pa1, PK(l1, h1), od, 0, 0, 0);
  od = __builtin_amdgcn_mfma_f32_32x32x16_bf16(pa2, PK(l2, h2), od, 0, 0, 0);
  od = __builtin_amdgcn_mfma_f32_32x32x16_bf16(pa3, PK(l3, h3), od, 0, 0, 0);
#undef PK
}
__device__ __forceinline__ void pv_d0(f32x16* o, int vb, bf16x8 pa0, bf16x8 pa1, bf16x8 pa2, bf16x8 pa3) {
  pv_one<0>(o[0], vb, pa0, pa1, pa2, pa3); pv_one<1>(o[1], vb, pa0, pa1, pa2, pa3); pv_one<2>(o[2], vb, pa0, pa1, pa2, pa3); pv_one<3>(o[3], vb, pa0, pa1, pa2, pa3);
}

template <bool MASK>
__device__ __forceinline__ void attn_body(const bf16_t* __restrict__ Qb, const long ldq, const bf16_t* __restrict__ Kh, const bf16_t* __restrict__ Vh, const long ldk,
                                          const int kfirst, const int Mr, const int NT, bf16_t* __restrict__ Ob, const long ldo, float* __restrict__ lse, const long ldlse, char* lds) {
  int tid = threadIdx.x; asm volatile("" : "+v"(tid));
  const int wid = tid >> 6, lane = tid & 63, r32 = lane & 31, hi = lane >> 5;
  char* V_lds = lds; char* K_lds = lds + 2 * SHM_V;
  float* ws = (float*)(lds + 2 * SHM_V + 2 * SHM_K) + wid * 64; float* li_l = ws; float* al_l = ws + 32;
  float m_reg = -1e30f, l_reg = 0; f32x16 o[4] = {}; bf16x8 qr[8];
  const bf16_t* Qw = Qb + (long)(wid * QBLK + r32) * ldq + hi * 8;
#pragma unroll
  for (int d0 = 0; d0 < 8; ++d0) qr[d0] = *reinterpret_cast<const bf16x8*>(Qw + d0 * 16);
  const int sr = tid >> 4, sc = (tid & 15) * 8, vst0 = v_st(sr, sc), vst1 = v_st(32 + sr, sc);
  const int vb0 = (int)(uintptr_t)V_lds + v_rd_base(lane);
  const int qi = wid * QBLK + r32;
  struct { bf16x8 vs0, vs1, ks0, ks1; } sr_[2];
#define KROW(k0, rr) (MASK ? (long)min(max(kfirst + (k0) + (rr), 0), Mr - 1) : (long)((k0) + (rr)))
#define SLOAD(i, k0) do { const long _r0 = KROW(k0, sr) * ldk + sc, _r1 = KROW(k0, 32 + sr) * ldk + sc; \
    sr_[i].vs0 = *reinterpret_cast<const bf16x8*>(Vh + _r0); sr_[i].vs1 = *reinterpret_cast<const bf16x8*>(Vh + _r1); \
    sr_[i].ks0 = *reinterpret_cast<const bf16x8*>(Kh + _r0); sr_[i].ks1 = *reinterpret_cast<const bf16x8*>(Kh + _r1); } while (0)
#define SWRITE(b, i) do { *(bf16x8*)(V_lds + (b) * SHM_V + vst0) = sr_[i].vs0;          \
    *(bf16x8*)(V_lds + (b) * SHM_V + vst1) = sr_[i].vs1; int kc = sc * 2;               \
    *(bf16x8*)(K_lds + (b) * SHM_K + KSWZ(sr, kc)) = sr_[i].ks0;                       \
    *(bf16x8*)(K_lds + (b) * SHM_K + KSWZ(32 + sr, kc)) = sr_[i].ks1; } while (0)
#define SWAIT() asm volatile("s_waitcnt vmcnt(4)" ::: "memory")
#define RESC(a) do { if (__any((a) < 1.f)) { if (hi == 0) al_l[r32] = (a); asm volatile("s_waitcnt lgkmcnt(0)" ::: "memory"); \
    _Pragma("unroll") for (int d = 0; d < 4; ++d) _Pragma("unroll") for (int r = 0; r < 16; ++r) o[d][r] *= al_l[crow(r, hi)]; } } while (0)
#define MASKT(P0, P1, j) do { if (MASK) mask_tile(P0, P1, (j) * KVBLK - qi, kfirst + qi, Mr, hi); } while (0)
  f32x16 pA0, pA1, pB0, pB1; float mnA, mnB, alA, alB; bf16x8 pa0, pa1, pa2, pa3;
  constexpr int SE = 0, SO = 1;
  SLOAD(SE, 0); asm volatile("s_waitcnt vmcnt(0)" ::: "memory"); SWRITE(0, SE); __syncthreads();
  qkt(pA0, pA1, K_lds, qr, r32, hi); MASKT(pA0, pA1, 0); partialSM(pA0, pA1, m_reg, mnA, alA);
  SLOAD(SO, KVBLK); if (2 < NT) SLOAD(SE, 2 * KVBLK);
  SWAIT(); SWRITE(1, SO); __syncthreads();
  for (int j = 1; j + 1 < NT; j += 2) {
    SBAR(); qkt(pB0, pB1, K_lds + SHM_K, qr, r32, hi);
    finishSM(pA0, pA1, alA, l_reg, pa0, pa1, pa2, pa3); SBAR();
    SLOAD(SO, (j + 2) * KVBLK); SBAR();
    pv_d0(o, vb0, pa0, pa1, pa2, pa3); MASKT(pB0, pB1, j); partialSM(pB0, pB1, m_reg, mnB, alB);
    __syncthreads(); SWAIT(); SWRITE(0, SE);
    RESC(alB); __syncthreads();
    SBAR(); qkt(pA0, pA1, K_lds, qr, r32, hi);
    finishSM(pB0, pB1, alB, l_reg, pa0, pa1, pa2, pa3); SBAR();
    if (j + 3 < NT) SLOAD(SE, (j + 3) * KVBLK); SBAR();
    pv_d0(o, vb0 + (int)SHM_V, pa0, pa1, pa2, pa3); MASKT(pA0, pA1, j + 1); partialSM(pA0, pA1, m_reg, mnA, alA);
    __syncthreads(); SWAIT(); SWRITE(1, SO);
    RESC(alA); __syncthreads();
  }
  SBAR(); qkt(pB0, pB1, K_lds + SHM_K, qr, r32, hi);
  finishSM(pA0, pA1, alA, l_reg, pa0, pa1, pa2, pa3); SBAR();
  pv_d0(o, vb0, pa0, pa1, pa2, pa3); MASKT(pB0, pB1, NT - 1); partialSM(pB0, pB1, m_reg, mnB, alB);
  __syncthreads(); RESC(alB);
  finishSM(pB0, pB1, alB, l_reg, pa0, pa1, pa2, pa3); SBAR();
  pv_d0(o, vb0 + (int)SHM_V, pa0, pa1, pa2, pa3);
  if (hi == 0) li_l[r32] = l_reg; asm volatile("s_waitcnt lgkmcnt(0)" ::: "memory");
  float rli[16];
#pragma unroll
  for (int r = 0; r < 16; ++r) rli[r] = __builtin_amdgcn_rcpf(li_l[crow(r, hi)]);
  bf16_t* Ow = Ob + (long)(wid * QBLK) * ldo;
#pragma unroll
  for (int r = 0; r < 16; ++r) { const int orow = crow(r, hi);
#pragma unroll
    for (int d0 = 0; d0 < 4; ++d0) Ow[(long)orow * ldo + d0 * 32 + r32] = (bf16_t)f2bf(o[d0][r] * rli[r]); }
  if (lse != nullptr && hi == 0) lse[(long)(wid * QBLK + r32) * ldlse] = m_reg * SCALE + __logf(l_reg);
#undef KROW
#undef SLOAD
#undef SWRITE
#undef SWAIT
#undef RESC
#undef MASKT
}

struct VFB { s16x4 l0, h0, l1, h1, l2, h2, l3, h3; };
template <int D0> __device__ __forceinline__ void vfb_load(VFB& f, int vb) {
  f.l0 = tr_read<v_rd_off(D0, 0, 0)>(vb); f.h0 = tr_read<v_rd_off(D0, 0, 1)>(vb); f.l1 = tr_read<v_rd_off(D0, 1, 0)>(vb); f.h1 = tr_read<v_rd_off(D0, 1, 1)>(vb);
  f.l2 = tr_read<v_rd_off(D0, 2, 0)>(vb); f.h2 = tr_read<v_rd_off(D0, 2, 1)>(vb); f.l3 = tr_read<v_rd_off(D0, 3, 0)>(vb); f.h3 = tr_read<v_rd_off(D0, 3, 1)>(vb);
}
#define VFB_WAIT(N, f) asm volatile("s_waitcnt lgkmcnt(" #N ")" : "+v"(f.l0), "+v"(f.h0), "+v"(f.l1), "+v"(f.h1), "+v"(f.l2), "+v"(f.h2), "+v"(f.l3), "+v"(f.h3) :: "memory")
__device__ __forceinline__ void vfb_mma(f32x16& od, const VFB& f, bf16x8 pa0, bf16x8 pa1, bf16x8 pa2, bf16x8 pa3) {
#define PK(L, H) (bf16x8){L[0], L[1], L[2], L[3], H[0], H[1], H[2], H[3]}
  od = __builtin_amdgcn_mfma_f32_32x32x16_bf16(pa0, PK(f.l0, f.h0), od, 0, 0, 0);
  od = __builtin_amdgcn_mfma_f32_32x32x16_bf16(pa1, PK(f.l1, f.h1), od, 0, 0, 0);
  od = __builtin_amdgcn_mfma_f32_32x32x16_bf16(pa2, PK(f.l2, f.h2), od, 0, 0, 0);
  od = __builtin_amdgcn_mfma_f32_32x32x16_bf16(pa3, PK(f.l3, f.h3), od, 0, 0, 0);
#undef PK
}
template <int OFF> __device__ __forceinline__ bf16x8 dsb_rd128(int a) { bf16x8 r; asm volatile("ds_read_b128 %0, %1 offset:%2" : "=&v"(r) : "v"(a), "i"(OFF) : "memory"); return r; }
#define KB_RD(A, B, d0) do { const int _a = (kx ^ ((d0) * 32)) + krow; A = dsb_rd128<0>(_a); B = dsb_rd128<8192>(_a); } while (0)
#define KB_WAIT(N, A, B) asm volatile("s_waitcnt lgkmcnt(" #N ")" : "+v"(A), "+v"(B) :: "memory")
#define KB_MMA(A, B, d0) do { p0 = __builtin_amdgcn_mfma_f32_32x32x16_bf16(A, qr[d0], p0, 0, 0, 0); p1 = __builtin_amdgcn_mfma_f32_32x32x16_bf16(B, qr[d0], p1, 0, 0, 0); } while (0)
__device__ __forceinline__ void attn_band_body(const bf16_t* __restrict__ Qb, const long ldq, const bf16_t* __restrict__ Kh, const bf16_t* __restrict__ Vh, const long ldk,
                                               const int kfirst, const int Mr, bf16_t* __restrict__ Ob, const long ldo, float* __restrict__ lse, const long ldlse, char* lds) {
  int tid = threadIdx.x; asm volatile("" : "+v"(tid));
  const int wid = __builtin_amdgcn_readfirstlane(tid >> 6), lane = tid & 63, r32 = lane & 31, hi = lane >> 5;
  char* V_lds = lds; char* K_lds = lds + 2 * SHM_V;
  float* ws = (float*)(lds + 2 * SHM_V + 2 * SHM_K) + wid * 64; float* li_l = ws; float* al_l = ws + 32;
  float m_reg = -1e30f, l_reg = 0; f32x16 o[4] = {}; bf16x8 qr[8];
  const bf16_t* Qw = Qb + (long)(wid * QBLK + r32) * ldq + hi * 8;
#pragma unroll
  for (int d0 = 0; d0 < 8; ++d0) qr[d0] = *reinterpret_cast<const bf16x8*>(Qw + d0 * 16);
  const int sr = tid >> 4, sc = (tid & 15) * 8, vst0 = v_st(sr, sc), vst1 = v_st(32 + sr, sc);
  const int vb0 = (int)(uintptr_t)V_lds + v_rd_base(lane);
  const int qi = wid * QBLK + r32;
  const int jlo = wid >> 1, jhi = (32 * wid + 159) >> 6;
  const int kx = (hi * 16) ^ ((r32 & 15) << 4), krow0 = (int)(uintptr_t)K_lds + r32 * 256;
  const bool edge = (kfirst < 0) | (kfirst + 384 > Mr);
  bf16x8 vs0, vs1, ks0, ks1;
#define KROW(k0, rr) ((long)min(max(kfirst + (k0) + (rr), 0), Mr - 1))
#define SLOAD(k0) do { const long _r0 = KROW(k0, sr) * ldk + sc, _r1 = KROW(k0, 32 + sr) * ldk + sc; \
    vs0 = *reinterpret_cast<const bf16x8*>(Vh + _r0); vs1 = *reinterpret_cast<const bf16x8*>(Vh + _r1); \
    ks0 = *reinterpret_cast<const bf16x8*>(Kh + _r0); ks1 = *reinterpret_cast<const bf16x8*>(Kh + _r1); } while (0)
#define SWRITE(b) do { *(bf16x8*)(V_lds + (b) * SHM_V + vst0) = vs0; *(bf16x8*)(V_lds + (b) * SHM_V + vst1) = vs1; const int kc = sc * 2; \
    *(bf16x8*)(K_lds + (b) * SHM_K + KSWZ(sr, kc)) = ks0; *(bf16x8*)(K_lds + (b) * SHM_K + KSWZ(32 + sr, kc)) = ks1; } while (0)
  SLOAD(0); SWRITE(0); __syncthreads();
#pragma unroll
  for (int d0 = 0; d0 < 8; ++d0) asm volatile("" : "+v"(qr[d0]));
#pragma unroll 1
  for (int j = 0; j < 6; ++j) {
    const int b = j & 1;
    if (j + 1 < 6) SLOAD((j + 1) * KVBLK);
    if (j >= jlo && j <= jhi) {
      f32x16 p0 = {}, p1 = {}; float mn, alpha; bf16x8 pa0, pa1, pa2, pa3;
      { const int krow = krow0 + b * (int)SHM_K; bf16x8 ka0, kb0, ka1, kb1, ka2, kb2;
        KB_RD(ka0, kb0, 0); KB_RD(ka1, kb1, 1);
        KB_RD(ka2, kb2, 2); KB_WAIT(4, ka0, kb0); KB_MMA(ka0, kb0, 0);
        KB_RD(ka0, kb0, 3); KB_WAIT(4, ka1, kb1); KB_MMA(ka1, kb1, 1);
        KB_RD(ka1, kb1, 4); KB_WAIT(4, ka2, kb2); KB_MMA(ka2, kb2, 2);
        KB_RD(ka2, kb2, 5); KB_WAIT(4, ka0, kb0); KB_MMA(ka0, kb0, 3);
        KB_RD(ka0, kb0, 6); KB_WAIT(4, ka1, kb1); KB_MMA(ka1, kb1, 4);
        KB_RD(ka1, kb1, 7); KB_WAIT(4, ka2, kb2); KB_MMA(ka2, kb2, 5);
        KB_WAIT(2, ka0, kb0); KB_MMA(ka0, kb0, 6);
        KB_WAIT(0, ka1, kb1); KB_MMA(ka1, kb1, 7); }
      if (edge | (j != jlo + 1)) mask_tile(p0, p1, j * KVBLK - qi, kfirst + qi, Mr, hi);
      partialSM(p0, p1, m_reg, mn, alpha);
      if (__any(alpha < 1.f)) { if (hi == 0) al_l[r32] = alpha; asm volatile("s_waitcnt lgkmcnt(0)" ::: "memory");
#pragma unroll
        for (int d = 0; d < 4; ++d)
#pragma unroll
          for (int r = 0; r < 16; ++r) o[d][r] *= al_l[crow(r, hi)]; }
      finishSM(p0, p1, alpha, l_reg, pa0, pa1, pa2, pa3); SBAR();
      { const int vb = vb0 + b * (int)SHM_V; VFB fa, fb;
        vfb_load<0>(fa, vb);
        vfb_load<1>(fb, vb); VFB_WAIT(8, fa); vfb_mma(o[0], fa, pa0, pa1, pa2, pa3);
        vfb_load<2>(fa, vb); VFB_WAIT(8, fb); vfb_mma(o[1], fb, pa0, pa1, pa2, pa3);
        vfb_load<3>(fb, vb); VFB_WAIT(8, fa); vfb_mma(o[2], fa, pa0, pa1, pa2, pa3);
        VFB_WAIT(0, fb); vfb_mma(o[3], fb, pa0, pa1, pa2, pa3); }
    }
    if (j + 1 < 6) SWRITE(b ^ 1);
    __syncthreads();
  }
  if (hi == 0) li_l[r32] = l_reg; asm volatile("s_waitcnt lgkmcnt(0)" ::: "memory");
  float rli[16];
#pragma unroll
  for (int r = 0; r < 16; ++r) rli[r] = __builtin_amdgcn_rcpf(li_l[crow(r, hi)]);
  bf16_t* Ow = Ob + (long)(wid * QBLK) * ldo;
#pragma unroll
  for (int r = 0; r < 16; ++r) { const int orow = crow(r, hi);
#pragma unroll
    for (int d0 = 0; d0 < 4; ++d0) Ow[(long)orow * ldo + d0 * 32 + r32] = (bf16_t)f2bf(o[d0][r] * rli[r]); }
  if (hi == 0) lse[(long)(wid * QBLK + r32) * ldlse] = m_reg * SCALE + __logf(l_reg);
#undef KROW
#undef SLOAD
#undef SWRITE
}

struct BandUnit { const bf16_t* Q; const bf16_t* K; const bf16_t* V; bf16_t* O; float* L; int ld, ldo, ldl, kfirst, Mr, lsh; };
template <class UF>
__device__ __forceinline__ void attn_band_stream(const int U, UF unit_of, char* lds) {
  int tid = threadIdx.x; asm volatile("" : "+v"(tid));
  const int wid = __builtin_amdgcn_readfirstlane(tid >> 6), lane = tid & 63, r32 = lane & 31, hi = lane >> 5, w32 = lane & 31;
  constexpr int TILE = 32768, OFF_B = 3 * TILE, OFF_WS = 4 * TILE;
  float* ws = (float*)(lds + OFF_WS) + wid * 64; float* li_l = ws; float* al_l = ws + 32;
  const int jlo = wid >> 1, qi = wid * QBLK + r32;
  const int kx = (hi * 16) ^ ((r32 & 15) << 4);
  const int krow_l = (int)(uintptr_t)lds + 16384 + r32 * 256, vb_l = (int)(uintptr_t)lds + v_rd_base(lane);
  const int krow0 = 4 * wid + (lane >> 4), kch = ((lane & 15) ^ (krow0 & 15)) * 8;
  const int vkk = (wid >> 1) * 8 + (w32 >> 2), vkey0 = (vkk & ~0xC) | ((vkk & 4) << 1) | ((vkk & 8) >> 1), vcol = (2 * (wid & 1) + (lane >> 5)) * 32 + (w32 & 3) * 8;
#define BS_DMA(bu, j, boff) do { const int _kb = (bu).kfirst + 64 * (j); const unsigned _ld = (unsigned)(bu).ld; \
    _Pragma("unroll") for (int _i = 0; _i < 2; ++_i) { const unsigned _ro = (unsigned)min(max(_kb + krow0 + 32 * _i, 0), (bu).Mr - 1) * _ld + kch; \
      __builtin_amdgcn_global_load_lds((const unsigned*)((bu).K + _ro), (LAS unsigned*)(lds + (boff) + 16384 + (wid + 8 * _i) * 1024), 16, 0, 0); } \
    _Pragma("unroll") for (int _i = 0; _i < 2; ++_i) { const unsigned _ro = (unsigned)min(max(_kb + vkey0 + 32 * _i, 0), (bu).Mr - 1) * _ld + vcol; \
      __builtin_amdgcn_global_load_lds((const unsigned*)((bu).V + _ro), (LAS unsigned*)(lds + (boff) + (wid + 8 * _i) * 1024), 16, 0, 0); } } while (0)
#define BS_QLOAD(bu) do { const bf16_t* _q = (bu).Q + (long)qi * (bu).ld + hi * 8; \
    asm volatile("global_load_dwordx4 %0, %8, off\n\tglobal_load_dwordx4 %1, %8, off offset:32\n\tglobal_load_dwordx4 %2, %8, off offset:64\n\tglobal_load_dwordx4 %3, %8, off offset:96\n\t" \
                 "global_load_dwordx4 %4, %8, off offset:128\n\tglobal_load_dwordx4 %5, %8, off offset:160\n\tglobal_load_dwordx4 %6, %8, off offset:192\n\tglobal_load_dwordx4 %7, %8, off offset:224" \
                 : "=&v"(qr[0]), "=&v"(qr[1]), "=&v"(qr[2]), "=&v"(qr[3]), "=&v"(qr[4]), "=&v"(qr[5]), "=&v"(qr[6]), "=&v"(qr[7]) : "v"(_q) : "memory"); } while (0)
#define BS_POS_DMA(gq) do { const int _un = (gq) / 5, _jn = (gq) - 5 * _un; \
    if ((gq) <= 5 * U) { \
      if (_un < U) { const BandUnit _bn = unit_of(_un); BS_DMA(_bn, _jn, ((gq) % 3) * TILE); ndma += 4; } \
      if (_jn == 0 && _un >= 1) { const BandUnit _bp = unit_of(_un - 1); BS_DMA(_bp, 5, OFF_B); ndma += 4; } } } while (0)
  float m_reg = -1e30f, l_reg = 0; f32x16 o[4] = {}; bf16x8 qr[8];
  { int ndma = 0; if (U > 0) { const BandUnit b0 = unit_of(0); BS_QLOAD(b0); } else {
#pragma unroll
      for (int d0 = 0; d0 < 8; ++d0) qr[d0] = bf16x8{}; }
    BS_POS_DMA(0); BS_POS_DMA(1); }
  asm volatile("s_waitcnt vmcnt(0)" ::: "memory");
#pragma unroll
  for (int d0 = 0; d0 < 8; ++d0) asm volatile("" : "+v"(qr[d0]));
  __builtin_amdgcn_s_barrier(); asm volatile("" ::: "memory");
#pragma unroll 1
  for (int g = 0; g <= 5 * U + 2; ++g) {
    const int rel = g - jlo, uw = rel >= 0 ? rel / 5 : -1, jr = rel - 5 * uw;
    int ndma = 0;
    if (uw >= 0 && jr >= 3 && uw < U) {
      const BandUnit bu = unit_of(uw);
      if (hi == 0) li_l[r32] = l_reg; asm volatile("s_waitcnt lgkmcnt(0)" ::: "memory");
      bf16_t* Ow = bu.O + (long)(wid * QBLK) * bu.ldo;
      const int rb = (jr - 3) * 8;
#pragma unroll
      for (int rr = 0; rr < 8; ++rr) { const int orow = ((rb + rr) & 3) + 8 * ((rb + rr) >> 2) + 4 * hi; const float rl = __builtin_amdgcn_rcpf(li_l[orow]);
#pragma unroll
        for (int d0 = 0; d0 < 4; ++d0) { const float v = jr == 3 ? o[d0][rr] : o[d0][8 + rr]; Ow[(long)orow * bu.ldo + d0 * 32 + r32] = (bf16_t)f2bf(v * rl); } }
      if (jr == 3 && hi == 0) bu.L[(long)qi * bu.ldl] = m_reg * SCALE + __logf(l_reg);
      asm volatile("s_waitcnt vmcnt(0)" ::: "memory");
      if (jr == 3 && uw + 1 < U) { const BandUnit bn = unit_of(uw + 1); BS_QLOAD(bn); ndma += 8; }
      BS_POS_DMA(g + 2);
    } else {
    BS_POS_DMA(g + 2);
    if (uw >= 0 && jr <= 2 && uw < U) {
      const BandUnit bu = unit_of(uw);
      const int j = jlo + jr, boff = (j == 5) ? OFF_B : (g % 3) * TILE;
      if (jr == 0) { m_reg = -1e30f; l_reg = 0.f;
#pragma unroll
        for (int d = 0; d < 4; ++d) o[d] = f32x16{}; }
      const bool edge = (bu.kfirst < 0) | (bu.kfirst + 384 > bu.Mr);
      f32x16 p0 = {}, p1 = {}; float mn, alpha; bf16x8 pa0, pa1, pa2, pa3;
      { const int krow = krow_l + boff; bf16x8 ka0, kb0, ka1, kb1, ka2, kb2;
        KB_RD(ka0, kb0, 0); KB_RD(ka1, kb1, 1);
        KB_RD(ka2, kb2, 2); KB_WAIT(4, ka0, kb0); KB_MMA(ka0, kb0, 0);
        KB_RD(ka0, kb0, 3); KB_WAIT(4, ka1, kb1); KB_MMA(ka1, kb1, 1);
        KB_RD(ka1, kb1, 4); KB_WAIT(4, ka2, kb2); KB_MMA(ka2, kb2, 2);
        KB_RD(ka2, kb2, 5); KB_WAIT(4, ka0, kb0); KB_MMA(ka0, kb0, 3);
        KB_RD(ka0, kb0, 6); KB_WAIT(4, ka1, kb1); KB_MMA(ka1, kb1, 4);
        KB_RD(ka1, kb1, 7); KB_WAIT(4, ka2, kb2); KB_MMA(ka2, kb2, 5);
        KB_WAIT(2, ka0, kb0); KB_MMA(ka0, kb0, 6);
        KB_WAIT(0, ka1, kb1); KB_MMA(ka1, kb1, 7); }
      if (edge | (jr != 1)) mask_tile(p0, p1, j * KVBLK - qi, bu.kfirst + qi, bu.Mr, hi);
      partialSM(p0, p1, m_reg, mn, alpha);
      if (jr != 0 && __any(alpha < 1.f)) { if (hi == 0) al_l[r32] = alpha; asm volatile("s_waitcnt lgkmcnt(0)" ::: "memory");
#pragma unroll
        for (int d = 0; d < 4; ++d)
#pragma unroll
          for (int r = 0; r < 16; ++r) o[d][r] *= al_l[crow(r, hi)]; }
      if (jr == 0) alpha = 0.f;
      finishSM(p0, p1, alpha, l_reg, pa0, pa1, pa2, pa3); SBAR();
      { const int vb = vb_l + boff; VFB fa, fb;
        vfb_load<0>(fa, vb);
        vfb_load<1>(fb, vb); VFB_WAIT(8, fa); vfb_mma(o[0], fa, pa0, pa1, pa2, pa3);
        vfb_load<2>(fa, vb); VFB_WAIT(8, fb); vfb_mma(o[1], fb, pa0, pa1, pa2, pa3);
        vfb_load<3>(fb, vb); VFB_WAIT(8, fa); vfb_mma(o[2], fa, pa0, pa1, pa2, pa3);
        VFB_WAIT(0, fb); vfb_mma(o[3], fb, pa0, pa1, pa2, pa3); }
    } }
    asm volatile("s_waitcnt lgkmcnt(0)" ::: "memory");
#define BS_VMW(n) case n: asm volatile("s_waitcnt vmcnt(" #n ")" ::: "memory"); break;
    switch (ndma) { BS_VMW(4) BS_VMW(8) BS_VMW(12) BS_VMW(16) default: asm volatile("s_waitcnt vmcnt(0)" ::: "memory"); break; }
#undef BS_VMW
    __builtin_amdgcn_s_barrier(); asm volatile("" ::: "memory");
  }
#undef BS_DMA
#undef BS_QLOAD
#undef BS_POS_DMA
}

__device__ __forceinline__ void partialSM1(f32x16& p0, float& m_reg, float& mn, float& alpha) {
  constexpr float C = SCALE * 1.4426950408889634f;
  float pmax = p0[0];
#pragma unroll
  for (int r = 1; r < 16; ++r) pmax = fmaxf(pmax, p0[r]);
  { auto rr = __builtin_amdgcn_permlane32_swap(__float_as_uint(pmax), __float_as_uint(pmax), false, false);
    pmax = fmaxf(__uint_as_float(rr[0]), __uint_as_float(rr[1])); }
  if (__builtin_expect(__all(pmax - m_reg <= THR / SCALE), 1)) { mn = m_reg; alpha = 1.f; }
  else { mn = fmaxf(m_reg, pmax); alpha = __builtin_amdgcn_exp2f((m_reg - mn) * C); m_reg = mn; }
  const float mnC = -mn * C;
#pragma unroll
  for (int r = 0; r < 16; ++r) p0[r] = __builtin_amdgcn_exp2f(fmaf(p0[r], C, mnC));
}
__device__ __forceinline__ void finishSM1(f32x16& p0, float alpha, float& l_reg, bf16x8& pa0, bf16x8& pa1) {
  float ps = 0;
#pragma unroll
  for (int r = 0; r < 16; ++r) ps += p0[r];
  { auto rr = __builtin_amdgcn_permlane32_swap(__float_as_uint(ps), __float_as_uint(ps), false, false);
    ps = __uint_as_float(rr[0]) + __uint_as_float(rr[1]); }
  l_reg = l_reg * alpha + ps;
#define PK4(P, BASE, OUT) do { unsigned a0 = cvtpk(P[BASE + 0], P[BASE + 1]), a1 = cvtpk(P[BASE + 2], P[BASE + 3]);   \
    unsigned b0 = cvtpk(P[BASE + 4], P[BASE + 5]), b1 = cvtpk(P[BASE + 6], P[BASE + 7]);                              \
    auto r0 = __builtin_amdgcn_permlane32_swap(a0, b0, false, false); auto r1 = __builtin_amdgcn_permlane32_swap(a1, b1, false, false); \
    u32x4 w = {r0[0], r1[0], r0[1], r1[1]}; OUT = *reinterpret_cast<bf16x8*>(&w); } while (0)
  PK4(p0, 0, pa0); PK4(p0, 8, pa1);
#undef PK4
}
struct VF2 { s16x4 l0, h0, l1, h1; };
template <int D0> __device__ __forceinline__ void vf2_load(VF2& f, int vb) {
  f.l0 = tr_read<v_rd_off(D0, 0, 0)>(vb); f.h0 = tr_read<v_rd_off(D0, 0, 1)>(vb); f.l1 = tr_read<v_rd_off(D0, 1, 0)>(vb); f.h1 = tr_read<v_rd_off(D0, 1, 1)>(vb);
}
#define VF2_WAIT(N, f) asm volatile("s_waitcnt lgkmcnt(" #N ")" : "+v"(f.l0), "+v"(f.h0), "+v"(f.l1), "+v"(f.h1) :: "memory")
__device__ __forceinline__ void vf2_mma(f32x16& od, const VF2& f, bf16x8 pa0, bf16x8 pa1) {
#define PK(L, H) (bf16x8){L[0], L[1], L[2], L[3], H[0], H[1], H[2], H[3]}
  od = __builtin_amdgcn_mfma_f32_32x32x16_bf16(pa0, PK(f.l0, f.h0), od, 0, 0, 0);
  od = __builtin_amdgcn_mfma_f32_32x32x16_bf16(pa1, PK(f.l1, f.h1), od, 0, 0, 0);
#undef PK
}
__device__ __forceinline__ void attn_band_wave(const bf16_t* __restrict__ Qb, const long ldq, const bf16_t* __restrict__ Kh, const bf16_t* __restrict__ Vh, const long ldk,
                                               const int kfirst, const int Mr, bf16_t* __restrict__ Ob, const long ldo, float* __restrict__ lse, const long ldlse, char* lds) {
  int tid = threadIdx.x; asm volatile("" : "+v"(tid));
  const int wid = __builtin_amdgcn_readfirstlane(tid >> 6), lane = tid & 63, r32 = lane & 31, hi = lane >> 5, w32 = lane & 31;
  char* Vw = lds + wid * 16384;
  float* ws = (float*)(lds + 131072) + wid * 64; float* li_l = ws; float* al_l = ws + 32;
  const int kf = kfirst + 32 * wid;
  const bool edge = (kf < 0) | (kf + 160 > Mr);
  float m_reg = -1e30f, l_reg = 0; f32x16 o[4] = {}; bf16x8 qr[8], kr[8];
  const bf16_t* Qw = Qb + (long)(wid * QBLK + r32) * ldq + hi * 8;
#pragma unroll
  for (int d0 = 0; d0 < 8; ++d0) qr[d0] = *reinterpret_cast<const bf16x8*>(Qw + d0 * 16);
  const int vb0 = (int)(uintptr_t)Vw + v_rd_base(lane);
  const int vkey = ((w32 >> 2) & 3) + 8 * ((w32 >> 4) & 1), vcol = (lane >> 5) * 32 + (w32 & 3) * 8;
  const unsigned ldku = (unsigned)ldk;
#define BW_KLOAD(s) do { const unsigned _ro = (unsigned)min(max(kf + 32 * (s) + r32, 0), Mr - 1) * ldku + hi * 8; const bf16_t* _kp = Kh + _ro; \
    asm volatile("global_load_dwordx4 %0, %8, off\n\tglobal_load_dwordx4 %1, %8, off offset:32\n\tglobal_load_dwordx4 %2, %8, off offset:64\n\tglobal_load_dwordx4 %3, %8, off offset:96\n\t" \
                 "global_load_dwordx4 %4, %8, off offset:128\n\tglobal_load_dwordx4 %5, %8, off offset:160\n\tglobal_load_dwordx4 %6, %8, off offset:192\n\tglobal_load_dwordx4 %7, %8, off offset:224" \
                 : "=&v"(kr[0]), "=&v"(kr[1]), "=&v"(kr[2]), "=&v"(kr[3]), "=&v"(kr[4]), "=&v"(kr[5]), "=&v"(kr[6]), "=&v"(kr[7]) : "v"(_kp) : "memory"); } while (0)
#define BW_KWAIT(N) asm volatile("s_waitcnt vmcnt(" #N ")" : "+v"(kr[0]), "+v"(kr[1]), "+v"(kr[2]), "+v"(kr[3]), "+v"(kr[4]), "+v"(kr[5]), "+v"(kr[6]), "+v"(kr[7]) :: "memory")
#define BW_VDMA(s, b) do { _Pragma("unroll") for (int kg = 0; kg < 4; ++kg) { \
      const unsigned _ro = (unsigned)min(max(kf + 32 * (s) + vkey + 4 * (kg & 1) + 16 * (kg >> 1), 0), Mr - 1) * ldku + vcol; \
      __builtin_amdgcn_global_load_lds((const unsigned*)(Vh + _ro), (LAS unsigned*)(Vw + (b) * 8192 + (2 * kg) * 1024), 16, 0, 0); \
      __builtin_amdgcn_global_load_lds((const unsigned*)(Vh + _ro + 64), (LAS unsigned*)(Vw + (b) * 8192 + (2 * kg + 1) * 1024), 16, 0, 0); } } while (0)
  BW_VDMA(0, 0); BW_KLOAD(0);
#pragma unroll
  for (int d0 = 0; d0 < 8; ++d0) asm volatile("" : "+v"(qr[d0]));
#define BW_STEP(s, LAST) do { const int b = (s) & 1; \
    if (!(LAST)) BW_VDMA((s) + 1, b ^ 1); \
    f32x16 p0 = {}; float mn, alpha; bf16x8 pa0, pa1; \
    if (!(LAST)) BW_KWAIT(8); else BW_KWAIT(0); \
    _Pragma("unroll") for (int d0 = 0; d0 < 8; ++d0) p0 = __builtin_amdgcn_mfma_f32_32x32x16_bf16(kr[d0], qr[d0], p0, 0, 0, 0); \
    SBAR(); \
    if (!(LAST)) BW_KLOAD((s) + 1); \
    if (edge | ((s) == 0) | ((s) == 4)) { \
      _Pragma("unroll") for (int r = 0; r < 16; ++r) { const int key = 32 * (s) + crow(r, hi); \
        const bool ok = ((unsigned)(key - r32) <= 128u) && ((unsigned)(kf + key) < (unsigned)Mr); \
        p0[r] = ok ? p0[r] : -3.0e4f; } } \
    partialSM1(p0, m_reg, mn, alpha); \
    if (__any(alpha < 1.f)) { if (hi == 0) al_l[r32] = alpha; asm volatile("s_waitcnt lgkmcnt(0)" ::: "memory"); \
      _Pragma("unroll") for (int d = 0; d < 4; ++d) \
        _Pragma("unroll") for (int r = 0; r < 16; ++r) o[d][r] *= al_l[crow(r, hi)]; } \
    finishSM1(p0, alpha, l_reg, pa0, pa1); \
    if (!(LAST)) asm volatile("s_waitcnt vmcnt(16)" ::: "memory"); else asm volatile("s_waitcnt vmcnt(0)" ::: "memory");     \
    SBAR(); \
    const int vb = vb0 + b * 8192; VF2 fa, fb; \
    vf2_load<0>(fa, vb); vf2_load<1>(fb, vb); VF2_WAIT(4, fa); vf2_mma(o[0], fa, pa0, pa1); \
    vf2_load<2>(fa, vb); VF2_WAIT(4, fb); vf2_mma(o[1], fb, pa0, pa1); \
    vf2_load<3>(fb, vb); VF2_WAIT(4, fa); vf2_mma(o[2], fa, pa0, pa1); \
    VF2_WAIT(0, fb); vf2_mma(o[3], fb, pa0, pa1); } while (0)
#pragma unroll 1
  for (int s = 0; s < 4; ++s) BW_STEP(s, false);
  BW_STEP(4, true);
#undef BW_STEP
  if (hi == 0) li_l[r32] = l_reg; asm volatile("s_waitcnt lgkmcnt(0)" ::: "memory");
  float rli[16];
#pragma unroll
  for (int r = 0; r < 16; ++r) rli[r] = __builtin_amdgcn_rcpf(li_l[crow(r, hi)]);
  bf16_t* Ow = Ob + (long)(wid * QBLK) * ldo;
#pragma unroll
  for (int r = 0; r < 16; ++r) { const int orow = crow(r, hi);
#pragma unroll
    for (int d0 = 0; d0 < 4; ++d0) Ow[(long)orow * ldo + d0 * 32 + r32] = (bf16_t)f2bf(o[d0][r] * rli[r]); }
  if (hi == 0) lse[(long)(wid * QBLK + r32) * ldlse] = m_reg * SCALE + __logf(l_reg);
#undef BW_KLOAD
#undef BW_KWAIT
#undef BW_VDMA
}

constexpr int W_SHM_V = KVBLK * 256 * 2, W_SHM_K = KVBLK * D * 2, W_OFF_K = 3 * W_SHM_V, W_OFF_WS = W_OFF_K + 2 * W_SHM_K, W_SHM_TOTAL = W_OFF_WS + NW * 64 * 4;
constexpr int w_rd_off(int d0, int ks, int half) { return d0 * 512 + ks * 8192 + half * 4096; }
template <int D0> __device__ __forceinline__ void pvw_one(f32x16& od, int vb, bf16x8 pa0, bf16x8 pa1, bf16x8 pa2, bf16x8 pa3) {
  const s16x4 l0 = tr_read<w_rd_off(D0, 0, 0)>(vb), h0 = tr_read<w_rd_off(D0, 0, 1)>(vb), l1 = tr_read<w_rd_off(D0, 1, 0)>(vb), h1 = tr_read<w_rd_off(D0, 1, 1)>(vb);
  const s16x4 l2 = tr_read<w_rd_off(D0, 2, 0)>(vb), h2 = tr_read<w_rd_off(D0, 2, 1)>(vb), l3 = tr_read<w_rd_off(D0, 3, 0)>(vb), h3 = tr_read<w_rd_off(D0, 3, 1)>(vb);
  asm volatile("s_waitcnt lgkmcnt(0)" ::: "memory"); SBAR();
#define PK(L, H) (bf16x8){L[0], L[1], L[2], L[3], H[0], H[1], H[2], H[3]}
  od = __builtin_amdgcn_mfma_f32_32x32x16_bf16(pa0, PK(l0, h0), od, 0, 0, 0);
  od = __builtin_amdgcn_mfma_f32_32x32x16_bf16(pa1, PK(l1, h1), od, 0, 0, 0);
  od = __builtin_amdgcn_mfma_f32_32x32x16_bf16(pa2, PK(l2, h2), od, 0, 0, 0);
  od = __builtin_amdgcn_mfma_f32_32x32x16_bf16(pa3, PK(l3, h3), od, 0, 0, 0);
#undef PK
}
struct VF { s16x4 l0, h0, l1, h1, l2, h2, l3, h3; };
template <int D0> __device__ __forceinline__ void vf_load(VF& f, int vb) {
  f.l0 = tr_read<w_rd_off(D0, 0, 0)>(vb); f.h0 = tr_read<w_rd_off(D0, 0, 1)>(vb); f.l1 = tr_read<w_rd_off(D0, 1, 0)>(vb); f.h1 = tr_read<w_rd_off(D0, 1, 1)>(vb);
  f.l2 = tr_read<w_rd_off(D0, 2, 0)>(vb); f.h2 = tr_read<w_rd_off(D0, 2, 1)>(vb); f.l3 = tr_read<w_rd_off(D0, 3, 0)>(vb); f.h3 = tr_read<w_rd_off(D0, 3, 1)>(vb);
}
#define VF_WAIT(N, f) asm volatile("s_waitcnt lgkmcnt(" #N ")" : "+v"(f.l0), "+v"(f.h0), "+v"(f.l1), "+v"(f.h1), "+v"(f.l2), "+v"(f.h2), "+v"(f.l3), "+v"(f.h3) :: "memory")
__device__ __forceinline__ void vf_mma(f32x16& od, const VF& f, bf16x8 pa0, bf16x8 pa1, bf16x8 pa2, bf16x8 pa3) {
#define PK(L, H) (bf16x8){L[0], L[1], L[2], L[3], H[0], H[1], H[2], H[3]}
  od = __builtin_amdgcn_mfma_f32_32x32x16_bf16(pa0, PK(f.l0, f.h0), od, 0, 0, 0);
  od = __builtin_amdgcn_mfma_f32_32x32x16_bf16(pa1, PK(f.l1, f.h1), od, 0, 0, 0);
  od = __builtin_amdgcn_mfma_f32_32x32x16_bf16(pa2, PK(f.l2, f.h2), od, 0, 0, 0);
  od = __builtin_amdgcn_mfma_f32_32x32x16_bf16(pa3, PK(f.l3, f.h3), od, 0, 0, 0);
#undef PK
}
template <int OFF> __device__ __forceinline__ bf16x8 ds_rd128(int a) { bf16x8 r; asm volatile("ds_read_b128 %0, %1 offset:%2" : "=&v"(r) : "v"(a), "i"(OFF) : "memory"); return r; }
#define KF_RD(A, B, d0) do { const int _a = (kx ^ ((d0) * 32)) + krow; A = ds_rd128<0>(_a); B = ds_rd128<8192>(_a); } while (0)
#define KF_WAIT(N, A, B) asm volatile("s_waitcnt lgkmcnt(" #N ")" : "+v"(A), "+v"(B) :: "memory")
#define KF_MMA(A, B, d0) do { p0 = __builtin_amdgcn_mfma_f32_32x32x16_bf16(A, qr[d0], p0, 0, 0, 0); p1 = __builtin_amdgcn_mfma_f32_32x32x16_bf16(B, qr[d0], p1, 0, 0, 0); } while (0)
__device__ __forceinline__ void attn_wide_body(const bf16_t* __restrict__ Qb, const bf16_t* __restrict__ Kh, const bf16_t* __restrict__ Vh, const int ld, const int NT,
                                               bf16_t* __restrict__ Ob, const int ldo, char* lds,
                                               const bool comb, const float lam, const float gscale, const float* __restrict__ subln, bf16_t* __restrict__ Cb, const int ldc) {
  int tid = threadIdx.x; asm volatile("" : "+v"(tid));
  const int wid = __builtin_amdgcn_readfirstlane(tid >> 6), lane = tid & 63, r32 = lane & 31, hi = lane >> 5;
  float* ws = (float*)(lds + W_OFF_WS) + wid * 64; float* li_l = ws; float* al_l = ws + 32;
  float m_reg = -1e30f, l_reg = 0; f32x16 o[8] = {}; bf16x8 qr[8];
  const bf16_t* Qw = Qb + (long)(wid * QBLK + r32) * ld + hi * 8;
#pragma unroll
  for (int d0 = 0; d0 < 8; ++d0) qr[d0] = *reinterpret_cast<const bf16x8*>(Qw + d0 * 16);
  unsigned kof[2], vof[4];
#pragma unroll
  for (int i = 0; i < 2; ++i) { const int g = wid + 8 * i, row = 4 * g + (lane >> 4), chunk = (lane & 15) ^ (row & 15); kof[i] = (unsigned)(row * ld + chunk * 8); }
#pragma unroll
  for (int i = 0; i < 4; ++i) { const int p = wid + 8 * i, sub = lane >> 5, w32 = lane & 31, kk = (p >> 2) * 8 + (w32 >> 2), k = (kk & ~0xC) | ((kk & 4) << 1) | ((kk & 8) >> 1);
    vof[i] = (unsigned)(k * ld + (2 * (p & 3) + sub) * 32 + (w32 & 3) * 8); }
  const int vb0 = (int)(uintptr_t)lds + v_rd_base(lane);
  const int kx = (hi * 16) ^ ((r32 & 15) << 4), krow0 = (int)(uintptr_t)lds + W_OFF_K + r32 * 256;
#define W_DMA(k0, b, bv) do { const bf16_t* _kp = Kh + (long)(k0) * ld; const bf16_t* _vp = Vh + (long)(k0) * ld; \
    _Pragma("unroll") for (int _i = 0; _i < 2; ++_i) __builtin_amdgcn_global_load_lds((const unsigned*)(_kp + kof[_i]), (LAS unsigned*)(lds + W_OFF_K + (b) * W_SHM_K + (wid + 8 * _i) * 1024), 16, 0, 0); \
    _Pragma("unroll") for (int _i = 0; _i < 4; ++_i) __builtin_amdgcn_global_load_lds((const unsigned*)(_vp + vof[_i]), (LAS unsigned*)(lds + (bv) * W_SHM_V + (wid + 8 * _i) * 1024), 16, 0, 0); } while (0)
  W_DMA(0, 0, 0);
  asm volatile("s_waitcnt vmcnt(0)" ::: "memory"); __builtin_amdgcn_s_barrier(); asm volatile("" ::: "memory");
#pragma unroll
  for (int d0 = 0; d0 < 8; ++d0) asm volatile("" : "+v"(qr[d0]));
#if defined(W_PRIO)
  if (wid >= 4) __builtin_amdgcn_s_setprio(1);
#endif
  const bool lagB = wid >= 4;
  bf16x8 pa0 = {}, pa1 = {}, pa2 = {}, pa3 = {};
#define W_PV(vbx) do { const int _vb = (vbx); VF fa, fb; vf_load<0>(fa, _vb); \
    vf_load<1>(fb, _vb); VF_WAIT(8, fa); vf_mma(o[0], fa, pa0, pa1, pa2, pa3); \
    vf_load<2>(fa, _vb); VF_WAIT(8, fb); vf_mma(o[1], fb, pa0, pa1, pa2, pa3); \
    vf_load<3>(fb, _vb); VF_WAIT(8, fa); vf_mma(o[2], fa, pa0, pa1, pa2, pa3); \
    vf_load<4>(fa, _vb); VF_WAIT(8, fb); vf_mma(o[3], fb, pa0, pa1, pa2, pa3); \
    vf_load<5>(fb, _vb); VF_WAIT(8, fa); vf_mma(o[4], fa, pa0, pa1, pa2, pa3); \
    vf_load<6>(fa, _vb); VF_WAIT(8, fb); vf_mma(o[5], fb, pa0, pa1, pa2, pa3); \
    vf_load<7>(fb, _vb); VF_WAIT(8, fa); vf_mma(o[6], fa, pa0, pa1, pa2, pa3); \
    VF_WAIT(0, fb); vf_mma(o[7], fb, pa0, pa1, pa2, pa3); } while (0)
#pragma unroll 1
  for (int j = 0; j <= NT; ++j) {
    if (j + 1 < NT) W_DMA((j + 1) * KVBLK, (j + 1) & 1, (j + 1) % 3);
    if (lagB && j >= 1) { W_PV(vb0 + ((j - 1) % 3) * W_SHM_V); SBAR(); }
    if (j < NT) {
      f32x16 p0 = {}, p1 = {}; float mn, alpha;
      const int krow = krow0 + (j & 1) * W_SHM_K;
      { bf16x8 ka0, kb0, ka1, kb1, ka2, kb2;
        KF_RD(ka0, kb0, 0); KF_RD(ka1, kb1, 1);
        KF_RD(ka2, kb2, 2); KF_WAIT(4, ka0, kb0); KF_MMA(ka0, kb0, 0);
        KF_RD(ka0, kb0, 3); KF_WAIT(4, ka1, kb1); KF_MMA(ka1, kb1, 1);
        KF_RD(ka1, kb1, 4); KF_WAIT(4, ka2, kb2); KF_MMA(ka2, kb2, 2);
        KF_RD(ka2, kb2, 5); KF_WAIT(4, ka0, kb0); KF_MMA(ka0, kb0, 3);
        KF_RD(ka0, kb0, 6); KF_WAIT(4, ka1, kb1); KF_MMA(ka1, kb1, 4);
        KF_RD(ka1, kb1, 7); KF_WAIT(4, ka2, kb2); KF_MMA(ka2, kb2, 5);
        KF_WAIT(2, ka0, kb0); KF_MMA(ka0, kb0, 6);
        KF_WAIT(0, ka1, kb1); KF_MMA(ka1, kb1, 7); }
      partialSM(p0, p1, m_reg, mn, alpha);
      if (__any(alpha < 1.f)) { if (hi == 0) al_l[r32] = alpha; asm volatile("s_waitcnt lgkmcnt(0)" ::: "memory");
#pragma unroll
        for (int d = 0; d < 8; ++d)
#pragma unroll
          for (int r = 0; r < 16; ++r) o[d][r] *= al_l[crow(r, hi)]; }
      finishSM(p0, p1, alpha, l_reg, pa0, pa1, pa2, pa3); SBAR();
      if (!lagB) W_PV(vb0 + (j % 3) * W_SHM_V);
    }
    asm volatile("s_waitcnt vmcnt(0) lgkmcnt(0)" ::: "memory"); __builtin_amdgcn_s_barrier(); asm volatile("" ::: "memory");
  }
#undef W_PV
#if defined(W_PRIO)
  __builtin_amdgcn_s_setprio(0);
#endif
  if (hi == 0) li_l[r32] = l_reg; asm volatile("s_waitcnt lgkmcnt(0)" ::: "memory");
  float rli[16];
#pragma unroll
  for (int r = 0; r < 16; ++r) rli[r] = __builtin_amdgcn_rcpf(li_l[crow(r, hi)]);
  bf16_t* Ow = Ob + (long)(wid * QBLK) * ldo;
  if (!comb) {
#pragma unroll
    for (int r = 0; r < 16; ++r) { const int orow = crow(r, hi);
#pragma unroll
      for (int d0 = 0; d0 < 8; ++d0) Ow[(long)orow * ldo + d0 * 32 + r32] = (bf16_t)f2bf(o[d0][r] * rli[r]); }
  } else {
    bf16_t* Cw = Cb + (long)(wid * QBLK) * ldc;
#pragma unroll
    for (int r = 0; r < 16; ++r) { const int orow = crow(r, hi); float ss = 0.f;
#pragma unroll
      for (int d0 = 0; d0 < 8; ++d0) { const float v = bf2f((unsigned)Ow[(long)orow * ldo + d0 * 32 + r32]) - lam * (o[d0][r] * rli[r]); o[d0][r] = v; ss += v * v; }
      ss += __shfl_xor(ss, 1); ss += __shfl_xor(ss, 2); ss += __shfl_xor(ss, 4); ss += __shfl_xor(ss, 8); ss += __shfl_xor(ss, 16);
      const float rstd = __builtin_amdgcn_rsqf(ss * (1.0f / 256.0f) + NORM_EPS) * gscale;
#pragma unroll
      for (int d0 = 0; d0 < 8; ++d0) o[d0][r] *= rstd; }
#pragma unroll
    for (int d0 = 0; d0 < 8; ++d0) { const float gsub = subln[d0 * 32 + r32];
#pragma unroll
      for (int r = 0; r < 16; ++r) Cw[(long)crow(r, hi) * ldc + d0 * 32 + r32] = (bf16_t)f2bf(o[d0][r] * gsub); }
  }
#undef W_DMA
}
__device__ __forceinline__ float pmax16(const f32x4 (&P)[4]) {
  float m = P[0][0];
#pragma unroll
  for (int kb = 0; kb < 4; ++kb)
#pragma unroll
    for (int t2 = 0; t2 < 4; ++t2) if (kb | t2) m = fmaxf(m, P[kb][t2]);
  return m;
}
#define PMAX16(P) pmax16(P)
template <int LAST, int S> __device__ __forceinline__ float bmask(float p, int w) {
  if constexpr (!LAST) { if constexpr (S >= 15) return p; else if constexpr (S < -12) return -3.0e4f; else return (w <= S) ? p : -3.0e4f; }
  else { if constexpr (S <= -12) return p; else if constexpr (S > 15) return -3.0e4f; else return (S <= w) ? p : -3.0e4f; }
}
#define BM1(ODD, LAST, A, KB, T) p[A][KB][T] = bmask<LAST, 16 * ((KB) - (A)) + (T) - 32 * (ODD)>(p[A][KB][T], wl);
#define BM4(ODD, LAST, A, KB) BM1(ODD, LAST, A, KB, 0) BM1(ODD, LAST, A, KB, 1) BM1(ODD, LAST, A, KB, 2) BM1(ODD, LAST, A, KB, 3)
#define BM16(ODD, LAST, A) BM4(ODD, LAST, A, 0) BM4(ODD, LAST, A, 1) BM4(ODD, LAST, A, 2) BM4(ODD, LAST, A, 3)
#define BMALL(ODD, LAST) do { BM16(ODD, LAST, 0) BM16(ODD, LAST, 1) } while (0)
__device__ __forceinline__ float xrow16_max(float x) {
  auto s = __builtin_amdgcn_permlane16_swap(__float_as_uint(x), __float_as_uint(x), false, false); x = fmaxf(__uint_as_float(s[0]), __uint_as_float(s[1]));
  auto u = __builtin_amdgcn_permlane32_swap(__float_as_uint(x), __float_as_uint(x), false, false); return fmaxf(__uint_as_float(u[0]), __uint_as_float(u[1]));
}
__device__ __forceinline__ float xrow16_sum(float x) {
  auto s = __builtin_amdgcn_permlane16_swap(__float_as_uint(x), __float_as_uint(x), false, false); x = __uint_as_float(s[0]) + __uint_as_float(s[1]);
  auto u = __builtin_amdgcn_permlane32_swap(__float_as_uint(x), __float_as_uint(x), false, false); return __uint_as_float(u[0]) + __uint_as_float(u[1]);
}
constexpr int w16_off(int s, int db, int second) { return s * 16384 + db * 256 + second * 8192; }
template <int S, int G4> __device__ __forceinline__ void vf16_load(VF& f, int vb) {
  f.l0 = tr_read<w16_off(S, 4 * G4 + 0, 0)>(vb); f.h0 = tr_read<w16_off(S, 4 * G4 + 0, 1)>(vb); f.l1 = tr_read<w16_off(S, 4 * G4 + 1, 0)>(vb); f.h1 = tr_read<w16_off(S, 4 * G4 + 1, 1)>(vb);
  f.l2 = tr_read<w16_off(S, 4 * G4 + 2, 0)>(vb); f.h2 = tr_read<w16_off(S, 4 * G4 + 2, 1)>(vb); f.l3 = tr_read<w16_off(S, 4 * G4 + 3, 0)>(vb); f.h3 = tr_read<w16_off(S, 4 * G4 + 3, 1)>(vb);
}
__device__ __forceinline__ void vf16_mma(f32x4* o0, f32x4* o1, const VF& f, bf16x8 pb0, bf16x8 pb1) {
#define PK(L, H) (bf16x8){L[0], L[1], L[2], L[3], H[0], H[1], H[2], H[3]}
  o0[0] = __builtin_amdgcn_mfma_f32_16x16x32_bf16(PK(f.l0, f.h0), pb0, o0[0], 0, 0, 0); o1[0] = __builtin_amdgcn_mfma_f32_16x16x32_bf16(PK(f.l0, f.h0), pb1, o1[0], 0, 0, 0);
  o0[1] = __builtin_amdgcn_mfma_f32_16x16x32_bf16(PK(f.l1, f.h1), pb0, o0[1], 0, 0, 0); o1[1] = __builtin_amdgcn_mfma_f32_16x16x32_bf16(PK(f.l1, f.h1), pb1, o1[1], 0, 0, 0);
  o0[2] = __builtin_amdgcn_mfma_f32_16x16x32_bf16(PK(f.l2, f.h2), pb0, o0[2], 0, 0, 0); o1[2] = __builtin_amdgcn_mfma_f32_16x16x32_bf16(PK(f.l2, f.h2), pb1, o1[2], 0, 0, 0);
  o0[3] = __builtin_amdgcn_mfma_f32_16x16x32_bf16(PK(f.l3, f.h3), pb0, o0[3], 0, 0, 0); o1[3] = __builtin_amdgcn_mfma_f32_16x16x32_bf16(PK(f.l3, f.h3), pb1, o1[3], 0, 0, 0);
#undef PK
}
__device__ __forceinline__ void attn_wide16_body(const bf16_t* __restrict__ Qb, const bf16_t* __restrict__ Kh, const bf16_t* __restrict__ Vh, const int ld, const int NT,
                                                 bf16_t* __restrict__ Ob, const int ldo, char* lds,
                                                 const bool comb, const float lam, const float gscale, const float* __restrict__ subln, bf16_t* __restrict__ Cb, const int ldc) {
  int tid = threadIdx.x; asm volatile("" : "+v"(tid));
  const int wid = __builtin_amdgcn_readfirstlane(tid >> 6), lane = tid & 63, c16 = lane & 15, g = lane >> 4;
  constexpr float C = SCALE * 1.4426950408889634f;
  float m0 = -1e30f, m1 = -1e30f, l0 = 0.f, l1 = 0.f; f32x4 o[2][16]; bf16x8 qr[2][4];
#pragma unroll
  for (int a = 0; a < 2; ++a)
#pragma unroll
    for (int b = 0; b < 16; ++b) o[a][b] = f32x4{0.f, 0.f, 0.f, 0.f};
#pragma unroll
  for (int qb = 0; qb < 2; ++qb)
#pragma unroll
    for (int d0 = 0; d0 < 4; ++d0) qr[qb][d0] = *reinterpret_cast<const bf16x8*>(Qb + (long)(wid * QBLK + qb * 16 + c16) * ld + d0 * 32 + g * 8);
  const int krw = 4 * wid + (lane >> 4); const unsigned kof0 = (unsigned)(krw * ld + ((lane & 15) ^ (krw & 15)) * 8), kstep = 32u * (unsigned)ld;
  const unsigned vof0 = (unsigned)((8 * (wid >> 2) + ((lane & 15) >> 1)) * ld + (4 * (wid & 3) + (lane >> 4)) * 16 + (lane & 1) * 8), vstep = 16u * (unsigned)ld;
#define W16_DMA(k0, b) do { const bf16_t* _kp = Kh + (long)(k0) * ld; const bf16_t* _vp = Vh + (long)(k0) * ld; \
    _Pragma("unroll") for (int _i = 0; _i < 2; ++_i) __builtin_amdgcn_global_load_lds((const unsigned*)(_kp + kof0 + _i * kstep), (LAS unsigned*)(lds + W_OFF_K + (b) * W_SHM_K + (wid + 8 * _i) * 1024), 16, 0, 0); \
    _Pragma("unroll") for (int _i = 0; _i < 4; ++_i) __builtin_amdgcn_global_load_lds((const unsigned*)(_vp + vof0 + _i * vstep), (LAS unsigned*)(lds + (b) * W_SHM_V + (wid + 8 * _i) * 1024), 16, 0, 0); } while (0)
  const int kx = (g ^ c16) << 4, kq0 = (int)(uintptr_t)lds + W_OFF_K + c16 * 256;
  const int vb0 = (int)(uintptr_t)lds + (g >> 1) * 4096 + (4 * (g & 1) + (c16 >> 2)) * 32 + (c16 & 3) * 8;
  W16_DMA(0, 0);
  asm volatile("s_waitcnt vmcnt(0)" ::: "memory"); __builtin_amdgcn_s_barrier(); asm volatile("" ::: "memory");
#pragma unroll
  for (int qb = 0; qb < 2; ++qb)
#pragma unroll
    for (int d0 = 0; d0 < 4; ++d0) asm volatile("" : "+v"(qr[qb][d0]));
#pragma unroll 1
  for (int j = 0; j < NT; ++j) {
    const int b = j & 1;
    if (j + 1 < NT) W16_DMA((j + 1) * KVBLK, b ^ 1);
    f32x4 p[2][4];
    { const int kq = kq0 + b * W_SHM_K; const int ka0 = kq + (0 ^ kx), ka1 = kq + (64 ^ kx), ka2 = kq + (128 ^ kx), ka3 = kq + (192 ^ kx);
      bf16x8 f0, f1, f2;
#define K16_RD(F, IDX) F = ds_rd128<((IDX) >> 2) * 4096>(((IDX) & 3) == 0 ? ka0 : ((IDX) & 3) == 1 ? ka1 : ((IDX) & 3) == 2 ? ka2 : ka3)
#define K16_WAIT(N, F) asm volatile("s_waitcnt lgkmcnt(" #N ")" : "+v"(F) :: "memory")
#define K16_MMA(F, IDX) do { p[0][(IDX) >> 2] = __builtin_amdgcn_mfma_f32_16x16x32_bf16(F, qr[0][(IDX) & 3], ((IDX) & 3) ? p[0][(IDX) >> 2] : f32x4{0.f, 0.f, 0.f, 0.f}, 0, 0, 0); \
                             p[1][(IDX) >> 2] = __builtin_amdgcn_mfma_f32_16x16x32_bf16(F, qr[1][(IDX) & 3], ((IDX) & 3) ? p[1][(IDX) >> 2] : f32x4{0.f, 0.f, 0.f, 0.f}, 0, 0, 0); } while (0)
      K16_RD(f0, 0); K16_RD(f1, 1);
      K16_RD(f2, 2); K16_WAIT(2, f0); K16_MMA(f0, 0);
      K16_RD(f0, 3); K16_WAIT(2, f1); K16_MMA(f1, 1);
      K16_RD(f1, 4); K16_WAIT(2, f2); K16_MMA(f2, 2);
      K16_RD(f2, 5); K16_WAIT(2, f0); K16_MMA(f0, 3);
      K16_RD(f0, 6); K16_WAIT(2, f1); K16_MMA(f1, 4);
      K16_RD(f1, 7); K16_WAIT(2, f2); K16_MMA(f2, 5);
      K16_RD(f2, 8); K16_WAIT(2, f0); K16_MMA(f0, 6);
      K16_RD(f0, 9); K16_WAIT(2, f1); K16_MMA(f1, 7);
      K16_RD(f1, 10); K16_WAIT(2, f2); K16_MMA(f2, 8);
      K16_RD(f2, 11); K16_WAIT(2, f0); K16_MMA(f0, 9);
      K16_RD(f0, 12); K16_WAIT(2, f1); K16_MMA(f1, 10);
      K16_RD(f1, 13); K16_WAIT(2, f2); K16_MMA(f2, 11);
      K16_RD(f2, 14); K16_WAIT(2, f0); K16_MMA(f0, 12);
      K16_RD(f0, 15); K16_WAIT(2, f1); K16_MMA(f1, 13);
      K16_WAIT(1, f2); K16_MMA(f2, 14);
      K16_WAIT(0, f0); K16_MMA(f0, 15);
#undef K16_RD
#undef K16_WAIT
#undef K16_MMA
    }
    float pm0 = PMAX16(p[0]), pm1 = PMAX16(p[1]);
    pm0 = xrow16_max(pm0); pm1 = xrow16_max(pm1);
    float al0 = 1.f, al1 = 1.f;
    if (!__builtin_expect(__all((pm0 - m0 <= THR / SCALE) & (pm1 - m1 <= THR / SCALE)), 1)) {
      const float n0 = fmaxf(m0, pm0), n1 = fmaxf(m1, pm1); al0 = __builtin_amdgcn_exp2f((m0 - n0) * C); al1 = __builtin_amdgcn_exp2f((m1 - n1) * C); m0 = n0; m1 = n1;
#pragma unroll
      for (int db = 0; db < 16; ++db) { o[0][db] = o[0][db] * al0; o[1][db] = o[1][db] * al1; } }
    const float mc0 = -m0 * C, mc1 = -m1 * C; float ps0 = 0.f, ps1 = 0.f;
#pragma unroll
    for (int kb = 0; kb < 4; ++kb)
#pragma unroll
      for (int t2 = 0; t2 < 4; ++t2) { p[0][kb][t2] = __builtin_amdgcn_exp2f(fmaf(p[0][kb][t2], C, mc0)); p[1][kb][t2] = __builtin_amdgcn_exp2f(fmaf(p[1][kb][t2], C, mc1)); ps0 += p[0][kb][t2]; ps1 += p[1][kb][t2]; }
    ps0 = xrow16_sum(ps0); ps1 = xrow16_sum(ps1); l0 = l0 * al0 + ps0; l1 = l1 * al1 + ps1;
    bf16x8 pb[2][2];
#pragma unroll
    for (int a = 0; a < 2; ++a)
#pragma unroll
      for (int s = 0; s < 2; ++s) { u32x4 w = {cvtpk(p[a][2 * s][0], p[a][2 * s][1]), cvtpk(p[a][2 * s][2], p[a][2 * s][3]), cvtpk(p[a][2 * s + 1][0], p[a][2 * s + 1][1]), cvtpk(p[a][2 * s + 1][2], p[a][2 * s + 1][3])};
        pb[a][s] = *reinterpret_cast<bf16x8*>(&w); }
    SBAR();
    { const int vb = vb0 + b * W_SHM_V; VF fa, fb;
      vf16_load<0, 0>(fa, vb);
      vf16_load<0, 1>(fb, vb); VF_WAIT(8, fa); vf16_mma(&o[0][0], &o[1][0], fa, pb[0][0], pb[1][0]);
      vf16_load<0, 2>(fa, vb); VF_WAIT(8, fb); vf16_mma(&o[0][4], &o[1][4], fb, pb[0][0], pb[1][0]);
      vf16_load<0, 3>(fb, vb); VF_WAIT(8, fa); vf16_mma(&o[0][8], &o[1][8], fa, pb[0][0], pb[1][0]);
      vf16_load<1, 0>(fa, vb); VF_WAIT(8, fb); vf16_mma(&o[0][12], &o[1][12], fb, pb[0][0], pb[1][0]);
      vf16_load<1, 1>(fb, vb); VF_WAIT(8, fa); vf16_mma(&o[0][0], &o[1][0], fa, pb[0][1], pb[1][1]);
      vf16_load<1, 2>(fa, vb); VF_WAIT(8, fb); vf16_mma(&o[0][4], &o[1][4], fb, pb[0][1], pb[1][1]);
      vf16_load<1, 3>(fb, vb); VF_WAIT(8, fa); vf16_mma(&o[0][8], &o[1][8], fa, pb[0][1], pb[1][1]);
      VF_WAIT(0, fb); vf16_mma(&o[0][12], &o[1][12], fb, pb[0][1], pb[1][1]); }
    asm volatile("s_waitcnt vmcnt(0) lgkmcnt(0)" ::: "memory"); __builtin_amdgcn_s_barrier(); asm volatile("" ::: "memory");
  }
  const float rl0 = __builtin_amdgcn_rcpf(l0), rl1 = __builtin_amdgcn_rcpf(l1);
#pragma unroll
  for (int qb = 0; qb < 2; ++qb) { const float rl = qb ? rl1 : rl0;
    bf16_t* Or = Ob + (long)(wid * QBLK + qb * 16 + c16) * ldo + 4 * g;
    if (!comb) {
#pragma unroll
      for (int db = 0; db < 16; ++db) { const u32x2 w = {cvtpk(o[qb][db][0] * rl, o[qb][db][1] * rl), cvtpk(o[qb][db][2] * rl, o[qb][db][3] * rl)}; *reinterpret_cast<u32x2*>(Or + db * 16) = w; }
    } else {
      bf16_t* Cr = Cb + (long)(wid * QBLK + qb * 16 + c16) * ldc + 4 * g; float ss = 0.f;
#pragma unroll
      for (int db = 0; db < 16; ++db) { const u32x2 w = *reinterpret_cast<const u32x2*>(Or + db * 16);
        const float v0 = bf2f(w.x & 0xffffu) - lam * (o[qb][db][0] * rl), v1 = bf2f(w.x >> 16) - lam * (o[qb][db][1] * rl), v2 = bf2f(w.y & 0xffffu) - lam * (o[qb][db][2] * rl), v3 = bf2f(w.y >> 16) - lam * (o[qb][db][3] * rl);
        o[qb][db] = f32x4{v0, v1, v2, v3}; ss += (v0 * v0 + v1 * v1) + (v2 * v2 + v3 * v3); }
      ss = xrow16_sum(ss);
      const float rstd = __builtin_amdgcn_rsqf(ss * (1.0f / 256.0f) + NORM_EPS) * gscale;
#pragma unroll
      for (int db = 0; db < 16; ++db) { const f32x4 gs = *reinterpret_cast<const f32x4*>(subln + db * 16 + 4 * g);
        const u32x2 w = {cvtpk(o[qb][db][0] * rstd * gs[0], o[qb][db][1] * rstd * gs[1]), cvtpk(o[qb][db][2] * rstd * gs[2], o[qb][db][3] * rstd * gs[3])}; *reinterpret_cast<u32x2*>(Cr + db * 16) = w; }
    }
  }
#undef W16_DMA
}
constexpr int wb16_off(int s, int db, int second) { return s * 8192 + db * 256 + second * 4096; }
template <int S, int G4> __device__ __forceinline__ void vfb16_load(VF& f, int vb) {
  f.l0 = tr_read<wb16_off(S, 4 * G4 + 0, 0)>(vb); f.h0 = tr_read<wb16_off(S, 4 * G4 + 0, 1)>(vb); f.l1 = tr_read<wb16_off(S, 4 * G4 + 1, 0)>(vb); f.h1 = tr_read<wb16_off(S, 4 * G4 + 1, 1)>(vb);
  f.l2 = tr_read<wb16_off(S, 4 * G4 + 2, 0)>(vb); f.h2 = tr_read<wb16_off(S, 4 * G4 + 2, 1)>(vb); f.l3 = tr_read<wb16_off(S, 4 * G4 + 3, 0)>(vb); f.h3 = tr_read<wb16_off(S, 4 * G4 + 3, 1)>(vb);
}
template <class UF>
__device__ __forceinline__ void attn_band16_stream(const int U, UF unit_of, char* lds) {
  int tid = threadIdx.x; asm volatile("" : "+v"(tid));
  const int wid = __builtin_amdgcn_readfirstlane(tid >> 6), lane = tid & 63, c16 = lane & 15, g = lane >> 4;
  constexpr float C = SCALE * 1.4426950408889634f;
  constexpr int TILE = 32768, OFF_B = 3 * TILE, OFF_WS = 4 * TILE;
  const int jlo = wid >> 1, qi0 = wid * QBLK + c16;
  const int kx = (g ^ c16) << 4;
  const int kq_l = (int)(uintptr_t)lds + 16384 + c16 * 256, vb_l = (int)(uintptr_t)lds + (g >> 1) * 2048 + (4 * (g & 1) + (c16 >> 2)) * 32 + (c16 & 3) * 8;
  const int krow0 = 4 * wid + (lane >> 4), kch = ((lane & 15) ^ (krow0 & 15)) * 8;
  const int vkey0 = 8 * (wid >> 1) + ((lane & 15) >> 1), vcol = (4 * (wid & 1) + (lane >> 4)) * 16 + (lane & 1) * 8;
#define BS_DMA(bu, j, boff) do { const int _kb = (bu).kfirst + 64 * (j); const int _sh = (bu).lsh;     \
    _Pragma("unroll") for (int _i = 0; _i < 2; ++_i) { const unsigned _ro = (__umul24((unsigned)min(max(_kb + krow0 + 32 * _i, 0), (bu).Mr - 1), 6144u) << _sh) + kch; \
      __builtin_amdgcn_global_load_lds((const unsigned*)((bu).K + _ro), (LAS unsigned*)(lds + (boff) + 16384 + (wid + 8 * _i) * 1024), 16, 0, 0); } \
    _Pragma("unroll") for (int _i = 0; _i < 2; ++_i) { const unsigned _ro = (__umul24((unsigned)min(max(_kb + vkey0 + 32 * _i, 0), (bu).Mr - 1), 6144u) << _sh) + vcol; \
      __builtin_amdgcn_global_load_lds((const unsigned*)((bu).V + _ro), (LAS unsigned*)(lds + (boff) + (wid + 8 * _i) * 1024), 16, 0, 0); } } while (0)
#define BS_QLOAD(bu) do { const bf16_t* _q = (bu).Q + (long)qi0 * (bu).ld + g * 8; const bf16_t* _q2 = _q + 16L * (bu).ld; \
    asm volatile("global_load_dwordx4 %0, %8, off\n\tglobal_load_dwordx4 %1, %8, off offset:64\n\tglobal_load_dwordx4 %2, %8, off offset:128\n\tglobal_load_dwordx4 %3, %8, off offset:192\n\t" \
                 "global_load_dwordx4 %4, %9, off\n\tglobal_load_dwordx4 %5, %9, off offset:64\n\tglobal_load_dwordx4 %6, %9, off offset:128\n\tglobal_load_dwordx4 %7, %9, off offset:192" \
                 : "=&v"(qr[0]), "=&v"(qr[1]), "=&v"(qr[2]), "=&v"(qr[3]), "=&v"(qr[4]), "=&v"(qr[5]), "=&v"(qr[6]), "=&v"(qr[7]) : "v"(_q), "v"(_q2) : "memory"); } while (0)
#define BS_POS_DMA(gq) do { const int _un = (gq) / 5, _jn = (gq) - 5 * _un; \
    if ((gq) <= 5 * U) { \
      if (_un < U) { const BandUnit _bn = unit_of(_un); BS_DMA(_bn, _jn, ((gq) % 3) * TILE); ndma += 4; } \
      if (_jn == 0 && _un >= 1) { const BandUnit _bp = unit_of(_un - 1); BS_DMA(_bp, 5, OFF_B); ndma += 4; } } } while (0)
  float m0 = -1e30f, m1 = -1e30f, l0 = 0.f, l1 = 0.f; f32x4 o[2][8]; bf16x8 qr[8];
#pragma unroll
  for (int a = 0; a < 2; ++a)
#pragma unroll
    for (int b = 0; b < 8; ++b) o[a][b] = f32x4{0.f, 0.f, 0.f, 0.f};
  { int ndma = 0; if (U > 0) { const BandUnit b0 = unit_of(0); BS_QLOAD(b0); } else {
#pragma unroll
      for (int d0 = 0; d0 < 8; ++d0) qr[d0] = bf16x8{}; }
    BS_POS_DMA(0); BS_POS_DMA(1); }
  asm volatile("s_waitcnt vmcnt(0)" ::: "memory");
#pragma unroll
  for (int d0 = 0; d0 < 8; ++d0) asm volatile("" : "+v"(qr[d0]));
  __builtin_amdgcn_s_barrier(); asm volatile("" ::: "memory");
#pragma unroll 1
  for (int gg = 0; gg <= 5 * U + 2; ++gg) {
    const int rel = gg - jlo, uw = rel >= 0 ? rel / 5 : -1, jr = rel - 5 * uw;
    int ndma = 0;
    if (uw >= 0 && jr >= 3 && uw < U) {
      const BandUnit bu = unit_of(uw);
      if (jr == 3) {
        const float rl0 = __builtin_amdgcn_rcpf(l0), rl1 = __builtin_amdgcn_rcpf(l1);
#pragma unroll
        for (int qb = 0; qb < 2; ++qb) { const float rl = qb ? rl1 : rl0; bf16_t* Or = bu.O + (long)(qi0 + 16 * qb) * bu.ldo + 4 * g;
#pragma unroll
          for (int db = 0; db < 8; ++db) { const u32x2 w = {cvtpk(o[qb][db][0] * rl, o[qb][db][1] * rl), cvtpk(o[qb][db][2] * rl, o[qb][db][3] * rl)}; *reinterpret_cast<u32x2*>(Or + db * 16) = w; } }
        if (g == 0) { bu.L[(long)qi0 * bu.ldl] = m0 * SCALE + __logf(l0); bu.L[(long)(qi0 + 16) * bu.ldl] = m1 * SCALE + __logf(l1); } }
      asm volatile("s_waitcnt vmcnt(0)" ::: "memory");
      if (jr == 3 && uw + 1 < U) { const BandUnit bn = unit_of(uw + 1); BS_QLOAD(bn); ndma += 8; }
      BS_POS_DMA(gg + 2);
    } else {
    BS_POS_DMA(gg + 2);
    if (uw >= 0 && jr <= 2 && uw < U) {
      const BandUnit bu = unit_of(uw);
      const int j = jlo + jr, boff = (j == 5) ? OFF_B : (gg % 3) * TILE;
      if (jr == 0) { m0 = m1 = -1e30f; l0 = l1 = 0.f;
#pragma unroll
        for (int a = 0; a < 2; ++a)
#pragma unroll
          for (int b = 0; b < 8; ++b) o[a][b] = f32x4{0.f, 0.f, 0.f, 0.f}; }
      if ((bu.kfirst + 64 * j >= 0) & (bu.kfirst + 64 * j + 64 <= bu.Mr)) {
      f32x4 p[2][4];
      { int kxo = kx; asm volatile("" : "+v"(kxo));
        const int kq = kq_l + boff; const int ka0 = kq + (0 ^ kxo), ka1 = kq + (64 ^ kxo), ka2 = kq + (128 ^ kxo), ka3 = kq + (192 ^ kxo);
        bf16x8 f0, f1;
#define K16_RD(F, IDX) F = dsb_rd128<((IDX) >> 2) * 4096>(((IDX) & 3) == 0 ? ka0 : ((IDX) & 3) == 1 ? ka1 : ((IDX) & 3) == 2 ? ka2 : ka3)
#define K16_WAIT(N, F) asm volatile("s_waitcnt lgkmcnt(" #N ")" : "+v"(F) :: "memory")
#define K16_MMA(F, IDX) do { p[0][(IDX) >> 2] = __builtin_amdgcn_mfma_f32_16x16x32_bf16(F, qr[(IDX) & 3], ((IDX) & 3) ? p[0][(IDX) >> 2] : f32x4{0.f, 0.f, 0.f, 0.f}, 0, 0, 0); \
                             p[1][(IDX) >> 2] = __builtin_amdgcn_mfma_f32_16x16x32_bf16(F, qr[4 + ((IDX) & 3)], ((IDX) & 3) ? p[1][(IDX) >> 2] : f32x4{0.f, 0.f, 0.f, 0.f}, 0, 0, 0); } while (0)
        K16_RD(f0, 0);
        K16_RD(f1, 1); K16_WAIT(1, f0); K16_MMA(f0, 0);
        K16_RD(f0, 2); K16_WAIT(1, f1); K16_MMA(f1, 1);
        K16_RD(f1, 3); K16_WAIT(1, f0); K16_MMA(f0, 2);
        K16_RD(f0, 4); K16_WAIT(1, f1); K16_MMA(f1, 3);
        K16_RD(f1, 5); K16_WAIT(1, f0); K16_MMA(f0, 4);
        K16_RD(f0, 6); K16_WAIT(1, f1); K16_MMA(f1, 5);
        K16_RD(f1, 7); K16_WAIT(1, f0); K16_MMA(f0, 6);
        K16_RD(f0, 8); K16_WAIT(1, f1); K16_MMA(f1, 7);
        K16_RD(f1, 9); K16_WAIT(1, f0); K16_MMA(f0, 8);
        K16_RD(f0, 10); K16_WAIT(1, f1); K16_MMA(f1, 9);
        K16_RD(f1, 11); K16_WAIT(1, f0); K16_MMA(f0, 10);
        K16_RD(f0, 12); K16_WAIT(1, f1); K16_MMA(f1, 11);
        K16_RD(f1, 13); K16_WAIT(1, f0); K16_MMA(f0, 12);
        K16_RD(f0, 14); K16_WAIT(1, f1); K16_MMA(f1, 13);
        K16_RD(f1, 15); K16_WAIT(1, f0); K16_MMA(f0, 14);
        K16_WAIT(0, f1); K16_MMA(f1, 15);
#undef K16_RD
#undef K16_WAIT
#undef K16_MMA
      }
      if (jr != 1) {
        const int wl = c16 - 4 * g;
        if (wid & 1) { if (jr == 0) BMALL(1, 0); else BMALL(1, 1); } else { if (jr == 0) BMALL(0, 0); else BMALL(0, 1); } }
      float pm0 = PMAX16(p[0]), pm1 = PMAX16(p[1]);
      pm0 = xrow16_max(pm0); pm1 = xrow16_max(pm1);
      float al0 = 1.f, al1 = 1.f;
      if (!__builtin_expect(__all((pm0 - m0 <= THR / SCALE) & (pm1 - m1 <= THR / SCALE)), 1)) {
        const float n0 = fmaxf(m0, pm0), n1 = fmaxf(m1, pm1); al0 = __builtin_amdgcn_exp2f((m0 - n0) * C); al1 = __builtin_amdgcn_exp2f((m1 - n1) * C); m0 = n0; m1 = n1;
        if (jr != 0) {
#pragma unroll
          for (int db = 0; db < 8; ++db) { o[0][db] = o[0][db] * al0; o[1][db] = o[1][db] * al1; } } }
      const float mc0 = -m0 * C, mc1 = -m1 * C; float ps0 = 0.f, ps1 = 0.f;
#pragma unroll
      for (int kb = 0; kb < 4; ++kb)
#pragma unroll
        for (int t2 = 0; t2 < 4; ++t2) { p[0][kb][t2] = __builtin_amdgcn_exp2f(fmaf(p[0][kb][t2], C, mc0)); p[1][kb][t2] = __builtin_amdgcn_exp2f(fmaf(p[1][kb][t2], C, mc1)); ps0 += p[0][kb][t2]; ps1 += p[1][kb][t2]; }
      ps0 = xrow16_sum(ps0); ps1 = xrow16_sum(ps1); l0 = l0 * al0 + ps0; l1 = l1 * al1 + ps1;
      bf16x8 pb[2][2];
#pragma unroll
      for (int a = 0; a < 2; ++a)
#pragma unroll
        for (int s = 0; s < 2; ++s) { u32x4 w = {cvtpk(p[a][2 * s][0], p[a][2 * s][1]), cvtpk(p[a][2 * s][2], p[a][2 * s][3]), cvtpk(p[a][2 * s + 1][0], p[a][2 * s + 1][1]), cvtpk(p[a][2 * s + 1][2], p[a][2 * s + 1][3])};
          pb[a][s] = *reinterpret_cast<bf16x8*>(&w); }
      SBAR();
      { int vb = vb_l + boff; asm volatile("" : "+v"(vb)); VF fa;
        vfb16_load<0, 0>(fa, vb); VF_WAIT(0, fa); vf16_mma(&o[0][0], &o[1][0], fa, pb[0][0], pb[1][0]);
        vfb16_load<0, 1>(fa, vb); VF_WAIT(0, fa); vf16_mma(&o[0][4], &o[1][4], fa, pb[0][0], pb[1][0]);
        vfb16_load<1, 0>(fa, vb); VF_WAIT(0, fa); vf16_mma(&o[0][0], &o[1][0], fa, pb[0][1], pb[1][1]);
        vfb16_load<1, 1>(fa, vb); VF_WAIT(0, fa); vf16_mma(&o[0][4], &o[1][4], fa, pb[0][1], pb[1][1]); }
      }
    } }
    asm volatile("s_waitcnt lgkmcnt(0)" ::: "memory");
#define BS_VMW(n) case n: asm volatile("s_waitcnt vmcnt(" #n ")" ::: "memory"); break;
    switch (ndma) { BS_VMW(4) BS_VMW(8) BS_VMW(12) BS_VMW(16) default: asm volatile("s_waitcnt vmcnt(0)" ::: "memory"); break; }
#undef BS_VMW
    __builtin_amdgcn_s_barrier(); asm volatile("" ::: "memory");
  }
#undef BS_DMA
#undef BS_QLOAD
#undef BS_POS_DMA
}
}

struct Frame { LAS unsigned char* lds; int wave, vcu, G; };
#define FRAME_TID() int f_tid = threadIdx.x; asm volatile("" : "+v"(f_tid)); const int f_lane = f_tid & 63; (void)f_lane

constexpr int TP_SCR = 64 * 65 * 4;
struct TpDesc { const float* W; bf16_t* WT; const float* gain; int K, N, mode, item; };
__device__ __forceinline__ void tp_load(const TpDesc& d, f32x4 (&v)[16], int lane) {
    const int nblk = d.N / 64, kb = d.item / nblk, nb = d.item % nblk, k0 = 64 * kb, n0 = 64 * nb, r = lane >> 4, q = lane & 15;
#pragma unroll
    for (int i = 0; i < 16; ++i) v[i] = *(const f32x4*)(d.W + (size_t)(k0 + 4 * i + r) * d.N + n0 + 4 * q);
}
__device__ __forceinline__ void tp_finish(const TpDesc& d, const f32x4 (&v)[16], LAS float* scr, int lane) {
    const int nblk = d.N / 64, kb = d.item / nblk, nb = d.item % nblk, k0 = 64 * kb, n0 = 64 * nb, r = lane >> 4, q = lane & 15;
#pragma unroll
    for (int i = 0; i < 16; ++i) { const int kk = 4 * i + r; f32x4 w = v[i]; if (d.gain) w = w * d.gain[k0 + kk];
        LAS float* p = scr + kk * 65 + 4 * q; p[0] = w[0]; p[1] = w[1]; p[2] = w[2]; p[3] = w[3]; }
    LDS_WAIT(); asm volatile("" ::: "memory");
    int d0 = n0;
    if (d.mode == 1) { const int half = n0 / FFN, j = n0 % FFN; d0 = (j / 128) * 256 + half * 128 + (j % 128); }
    const int c = lane & 7;
#pragma unroll
    for (int j = 0; j < 8; ++j) { const int n = (lane >> 3) + 8 * j; const LAS float* s = scr + (8 * c) * 65 + n;
        u32x4 o; o.x = cvt_pk_bf16(s[0 * 65], s[1 * 65]); o.y = cvt_pk_bf16(s[2 * 65], s[3 * 65]); o.z = cvt_pk_bf16(s[4 * 65], s[5 * 65]); o.w = cvt_pk_bf16(s[6 * 65], s[7 * 65]);
        *(u32x4*)(d.WT + (size_t)(d0 + n) * d.K + k0 + 8 * c) = o; }
    LDS_WAIT(); asm volatile("" ::: "memory");
}

struct Args { const float* in[28]; float* out; unsigned char* ws; };
#define P_x (P.in[0])
#define P_mem (P.in[1])
#define P_mix_g (P.in[2])
#define P_xa_g (P.in[3])
#define P_mem_g (P.in[4])
#define P_wq (P.in[5])
#define P_wkv (P.in[6])
#define P_wo (P.in[7])
#define P_ffn_g (P.in[8])
#define P_w13 (P.in[9])
#define P_w2 (P.in[10])
#define P_w_in (P.in[11])
#define P_w_abo (P.in[12])
#define P_lam_re (P.in[13])
#define P_lam_im (P.in[14])
#define P_log_step (P.in[15])
#define P_b_re (P.in[16])
#define P_b_im (P.in[17])
#define P_c_re (P.in[18])
#define P_c_im (P.in[19])
#define P_s5_d (P.in[20])
#define P_glu_w (P.in[21])
#define P_glu_b (P.in[22])
#define P_dlam (P.in[23])
#define P_subln (P.in[24])
#define P_wqkv (P.in[25])
#define P_wco (P.in[26])
#define P_fin_g (P.in[27])
typedef Args Ptrs;

__device__ __forceinline__ void p0_prologue(const Frame& F, const Ptrs& P) {
    FRAME_TID();
    unsigned char* ws = P.ws;
    LAS float* scr = (LAS float*)(F.lds + F.wave * TP_SCR);
    const int gw = F.vcu * 8 + F.wave, NGW = F.G * 8;
    const long gt = (long)F.vcu * 512 + f_tid, NGT = (long)F.G * 512;
    constexpr int I_IN = 32 * 64, I_SQ = 32 * 32, I_GLU = 16 * 16, I_QKV = 32 * 96, I_KV = 32 * 64, I_13 = 32 * 176, I_2 = 88 * 32;
    constexpr int NITEMS = 2 * I_IN + 2 * I_SQ + 2 * I_GLU + 2 * I_QKV + 2 * I_SQ + 4 * I_KV + 4 * I_SQ + 4 * I_13 + 4 * I_2;
    auto decode = [&](int it, TpDesc& d) {
        int r = it;
        if (r < 2 * I_IN) { const int mi = r / I_IN; d = TpDesc{P_w_in + (size_t)mi * 2048 * 4096, (bf16_t*)(ws + WS_W_IN) + (size_t)mi * 2048 * 4096, P_mix_g + (2 * mi) * 2048, 2048, 4096, 0, r % I_IN}; return; } r -= 2 * I_IN;
        if (r < 2 * I_SQ) { const int mi = r / I_SQ; d = TpDesc{P_w_abo + (size_t)mi * 2048 * 2048, (bf16_t*)(ws + WS_W_ABO) + (size_t)mi * 2048 * 2048, nullptr, 2048, 2048, 0, r % I_SQ}; return; } r -= 2 * I_SQ;
        if (r < 2 * I_GLU) { const int mi = r / I_GLU; d = TpDesc{P_glu_w + (size_t)mi * 1024 * 1024, (bf16_t*)(ws + WS_W_GLU) + (size_t)mi * 1024 * 1024, nullptr, 1024, 1024, 0, r % I_GLU}; return; } r -= 2 * I_GLU;
        if (r < 2 * I_QKV) { const int mi = r / I_QKV; d = TpDesc{P_wqkv + (size_t)mi * 2048 * 6144, (bf16_t*)(ws + WS_W_QKV) + (size_t)mi * 2048 * 6144, P_mix_g + (2 * mi + 1) * 2048, 2048, 6144, 0, r % I_QKV}; return; } r -= 2 * I_QKV;
        if (r < 2 * I_SQ) { const int mi = r / I_SQ; d = TpDesc{P_wco + (size_t)mi * 2048 * 2048, (bf16_t*)(ws + WS_W_CO) + (size_t)mi * 2048 * 2048, nullptr, 2048, 2048, 0, r % I_SQ}; return; } r -= 2 * I_SQ;
        if (r < 4 * I_KV) { const int mi = r / I_KV; d = TpDesc{P_wkv + (size_t)mi * 2048 * 4096, (bf16_t*)(ws + WS_WKV_T) + (size_t)mi * 2048 * 4096, P_mem_g + mi * 2048, 2048, 4096, 0, r % I_KV}; return; } r -= 4 * I_KV;
        if (r < 4 * I_SQ) { const int mi = r / I_SQ; d = TpDesc{P_wo + (size_t)mi * 2048 * 2048, (bf16_t*)(ws + WS_WO_T) + (size_t)mi * 2048 * 2048, nullptr, 2048, 2048, 0, r % I_SQ}; return; } r -= 4 * I_SQ;
        if (r < 4 * I_13) { const int mi = r / I_13; d = TpDesc{P_w13 + (size_t)mi * 2048 * 11264, (bf16_t*)(ws + WS_W13) + (size_t)mi * 2048 * 11264, P_ffn_g + mi * 2048, 2048, 11264, 1, r % I_13}; return; } r -= 4 * I_13;
        { const int mi = r / I_2; d = TpDesc{P_w2 + (size_t)mi * 5632 * 2048, (bf16_t*)(ws + WS_W2) + (size_t)mi * 5632 * 2048, nullptr, 5632, 2048, 0, r % I_2}; }
    };
    {
        TpDesc dc, dn; f32x4 va[16], vb[16];
        int it = gw;
        if (it < NITEMS) { decode(it, dc); tp_load(dc, va, f_lane); }
#pragma unroll 1
        for (; it < NITEMS; it += 2 * NGW) {
            const int it1 = it + NGW, it2 = it + 2 * NGW;
            if (it1 < NITEMS) { decode(it1, dn); tp_load(dn, vb, f_lane); }
            tp_finish(dc, va, scr, f_lane);
            if (it1 < NITEMS) { if (it2 < NITEMS) { decode(it2, dc); tp_load(dc, va, f_lane); } tp_finish(dn, vb, scr, f_lane); }
        }
    }
    { const f32x8* src = (const f32x8*)P_wq; u32x4* dst = (u32x4*)(ws + WS_WQ_B);
      for (long i = gt; i < (long)4 * 2048 * 2048 / 8; i += 4 * NGT) { f32x8 v[4];
#pragma unroll
          for (int u = 0; u < 4; ++u) v[u] = src[min(i + u * NGT, (long)4 * 2048 * 2048 / 8 - 1)];
#pragma unroll
          for (int u = 0; u < 4; ++u) if (i + u * NGT < (long)4 * 2048 * 2048 / 8) { u32x4 o; o.x = cvt_pk_bf16(v[u][0], v[u][1]); o.y = cvt_pk_bf16(v[u][2], v[u][3]); o.z = cvt_pk_bf16(v[u][4], v[u][5]); o.w = cvt_pk_bf16(v[u][6], v[u][7]); dst[i + u * NGT] = o; } } }
    { bf16_t* HB = (bf16_t*)(ws + WS_HB); float* rss0 = (float*)(ws + WS_RSSP);
      for (int row = gw; row < MTOK; row += NGW) { const f32x4* xr = (const f32x4*)(P_x + (size_t)row * DM) + f_lane; float ss = 0.f; f32x4 xv[8];
#pragma unroll
          for (int j = 0; j < 8; ++j) xv[j] = xr[64 * j];
#pragma unroll
          for (int j = 0; j < 8; ++j) { const f32x4 v = xv[j]; ss += (v[0] * v[0] + v[1] * v[1]) + (v[2] * v[2] + v[3] * v[3]); *(u32x2*)(HB + (size_t)row * DM + (j * 64 + f_lane) * 4) = pack4(v); }
          ss = wave_sum(ss); if (f_lane < 32) rss0[(size_t)row * 32 + f_lane] = f_lane == 0 ? ss : 0.f; } }
    { bf16_t* MN = (bf16_t*)(ws + WS_MEMN);
      for (int row = gw; row < BATCH * MEML; row += NGW) { const f32x4* xr = (const f32x4*)(P_mem + (size_t)row * DM) + f_lane; f32x4 v[8]; float ss = 0.f;
#pragma unroll
          for (int j = 0; j < 8; ++j) { v[j] = xr[64 * j]; ss += (v[j][0] * v[j][0] + v[j][1] * v[j][1]) + (v[j][2] * v[j][2] + v[j][3] * v[j][3]); }
          const float rstd = 1.0f / sqrtf(wave_sum(ss) * (1.0f / DM) + NORM_EPS);
#pragma unroll
          for (int j = 0; j < 8; ++j) *(u32x2*)(MN + (size_t)row * DM + (j * 64 + f_lane) * 4) = pack4(v[j] * rstd); } }
}


__device__ __forceinline__ void s5_tables_task(const Frame& F, const Ptrs& P, int i, int g) {
    FRAME_TID();
    unsigned char* ws = P.ws;
    LAS f32x2* LPs = (LAS f32x2*)(F.lds);
    LAS f32x2* BBs = (LAS f32x2*)(F.lds + 33792);
    LAS f32x2* CCs = (LAS f32x2*)(F.lds + 50176);
    LAS float* KTs = (LAS float*)(F.lds + 66560);
    LAS f32x2* Qs = (LAS f32x2*)(F.lds + 132096);
    const int t = f_tid;
    for (int e = t; e < 2 * 64 * 33; e += 512) { const int d = e / (64 * 33), rem = e - d * (64 * 33), p = rem / 33, tau = rem - p * 33; const int gd = (i * 2 + d) * 64 + g, idx = gd * 64 + p;
        const float st = expf(P_log_step[gd]), a = P_lam_re[idx] * st, b = P_lam_im[idx] * st; const float mag = expf((float)tau * a), ang = (float)tau * b; LPs[e] = (f32x2){mag * cosf(ang), mag * sinf(ang)}; }
    if (t < 128) { const int d = t >> 6, p = t & 63, gd = (i * 2 + d) * 64 + g, idx = gd * 64 + p; const float st = expf(P_log_step[gd]), lr = P_lam_re[idx], li = P_lam_im[idx], a = lr * st, b = li * st;
        const float sh = sinf(0.5f * b), nr = expm1f(a) * cosf(b) - 2.0f * sh * sh, ni = expf(a) * sinf(b), den = lr * lr + li * li;
        Qs[t] = (f32x2){(nr * lr + ni * li) / den, (ni * lr - nr * li) / den}; }
    for (int e = t; e < 2048; e += 512) { const int d = e >> 10, n = (e >> 6) & 15, p = e & 63; const size_t ci = ((size_t)((i * 2 + d) * 64 + g) * 16 + n) * 64 + p; CCs[e] = (f32x2){P_c_re[ci], P_c_im[ci]}; }
    LDS_WAIT(); __syncthreads();
    for (int e = t; e < 2048; e += 512) { const int d = e >> 10, p = (e >> 4) & 63, n = e & 15; const size_t bi = ((size_t)((i * 2 + d) * 64 + g) * 64 + p) * 16 + n; const f32x2 q = Qs[d * 64 + p];
        const float br = P_b_re[bi], bim = P_b_im[bi]; BBs[e] = (f32x2){q.x * br - q.y * bim, q.x * bim + q.y * br}; }
    if (t < 128) { const int d = t >> 6, p = t & 63; ((f32x2*)(ws + WS_LP))[((size_t)(i * 2 + d) * 64 + g) * 64 + p] = LPs[(d * 64 + p) * 33 + 32]; }
    LDS_WAIT(); __syncthreads();
    {
        const int d = t >> 8, no = (t >> 4) & 15, ni = t & 15; float acc[32];
#pragma unroll
        for (int tau = 0; tau < 32; ++tau) acc[tau] = 0.f;
#pragma unroll 2
        for (int p = 0; p < 64; ++p) { const f32x2 c = CCs[(d * 16 + no) * 64 + p], bb = BBs[(d * 64 + p) * 16 + ni]; const float wr = c.x * bb.x - c.y * bb.y, wi = c.x * bb.y + c.y * bb.x;
            const LAS f32x2* lp = LPs + (d * 64 + p) * 33;
#pragma unroll
            for (int tau = 0; tau < 32; ++tau) { const f32x2 L = lp[tau]; acc[tau] += wr * L.x - wi * L.y; } }
#pragma unroll
        for (int tau = 0; tau < 32; ++tau) KTs[(d * 32 + tau) * 256 + no * 16 + ni] = acc[tau];
    }
    LDS_WAIT(); __syncthreads();
    bf16_t* BTE = (bf16_t*)(ws + WS_BTE) + (size_t)(i * 64 + g) * 256 * 512;
    for (int c8 = t; c8 < 256 * 64; c8 += 512) { const int k8 = c8 & 63, j = c8 >> 6, s = k8 >> 1, n0 = (k8 & 1) * 8, which = j >> 6, p = j & 63, d = which >> 1, ex = d == 0 ? 31 - s : s;
        const f32x2 lp = LPs[(d * 64 + p) * 33 + ex]; float v[8];
#pragma unroll
        for (int q = 0; q < 8; ++q) { const f32x2 bb = BBs[(d * 64 + p) * 16 + n0 + q]; v[q] = (which & 1) ? (lp.x * bb.y + lp.y * bb.x) : (lp.x * bb.x - lp.y * bb.y); }
        u32x4 o; o.x = cvt_pk_bf16(v[0], v[1]); o.y = cvt_pk_bf16(v[2], v[3]); o.z = cvt_pk_bf16(v[4], v[5]); o.w = cvt_pk_bf16(v[6], v[7]);
        *(u32x4*)(BTE + (size_t)j * 512 + k8 * 8) = o; }
    bf16_t* BTT = (bf16_t*)(ws + WS_BTT) + (size_t)(i * 64 + g) * 512 * S5KT;
    for (int c8 = t; c8 < 512 * 32; c8 += 512) { const int j8 = c8 & 31, row = c8 >> 5, tt = row >> 4, no = row & 15, j0 = j8 * 8, which = j0 >> 6, p0 = j0 & 63, d = which >> 1, ex = d == 0 ? tt + 1 : 32 - tt; float v[8];
#pragma unroll
        for (int q = 0; q < 8; ++q) { const int p = p0 + q; const f32x2 lp = LPs[(d * 64 + p) * 33 + ex], c = CCs[(d * 16 + no) * 64 + p]; v[q] = (which & 1) ? -(c.x * lp.y + c.y * lp.x) : (c.x * lp.x - c.y * lp.y); }
        u32x4 o; o.x = cvt_pk_bf16(v[0], v[1]); o.y = cvt_pk_bf16(v[2], v[3]); o.z = cvt_pk_bf16(v[4], v[5]); o.w = cvt_pk_bf16(v[6], v[7]);
        *(u32x4*)(BTT + (size_t)row * S5KT + 512 + j0) = o; }
    for (int c8 = t; c8 < 512 * 64; c8 += 512) { const int k8 = c8 & 63, row = c8 >> 6, tt = row >> 4, no = row & 15, s = k8 >> 1, ni0 = (k8 & 1) * 8; float v[8];
        if (s < tt) {
#pragma unroll
            for (int q = 0; q < 8; ++q) v[q] = KTs[(0 * 32 + (tt - s)) * 256 + no * 16 + ni0 + q];
        } else if (s > tt) {
#pragma unroll
            for (int q = 0; q < 8; ++q) v[q] = KTs[(1 * 32 + (s - tt)) * 256 + no * 16 + ni0 + q];
        } else { const float dv = P_s5_d[i * 1024 + g * 16 + no];
#pragma unroll
            for (int q = 0; q < 8; ++q) v[q] = KTs[no * 16 + ni0 + q] + KTs[32 * 256 + no * 16 + ni0 + q] + ((ni0 + q == no) ? dv : 0.f); }
        u32x4 o; o.x = cvt_pk_bf16(v[0], v[1]); o.y = cvt_pk_bf16(v[2], v[3]); o.z = cvt_pk_bf16(v[4], v[5]); o.w = cvt_pk_bf16(v[6], v[7]);
        *(u32x4*)(BTT + (size_t)row * S5KT + k8 * 8) = o; }
}

__device__ __forceinline__ void p1_thin(const Frame& F, const Ptrs& P) {
    FRAME_TID();
    unsigned char* ws = P.ws; const long gt = (long)F.vcu * 512 + f_tid, NGT = (long)F.G * 512;
    const f32x2* LP = (const f32x2*)(ws + WS_LP); const f32x2* BB = (const f32x2*)(ws + WS_BBAR);
    float* KT = (float*)(ws + WS_KTAB);
    for (long e = gt; e < (long)2 * 2 * 64 * 32 * 256; e += NGT) {
        const int ni = (int)(e & 15), no = (int)((e >> 4) & 15), tau = (int)((e >> 8) & 31); const long igd = e >> 13;
        float acc = 0.f;
#pragma unroll 4
        for (int p = 0; p < 64; ++p) { const long idx = igd * 64 + p; const f32x2 lp = LP[idx * 33 + tau], bb = BB[idx * 16 + ni];
            const float xr = lp.x * bb.x - lp.y * bb.y, xi = lp.x * bb.y + lp.y * bb.x;
            const float cr = P_c_re[(igd * 16 + no) * 64 + p], ci = P_c_im[(igd * 16 + no) * 64 + p];
            acc += cr * xr - ci * xi; }
        KT[e] = acc;
    }
    bf16_t* BTE = (bf16_t*)(ws + WS_BTE);
    for (long e = gt; e < (long)2 * 64 * 256 * 64; e += NGT) {
        const int k8 = (int)(e & 63), j = (int)((e >> 6) & 255), g = (int)((e >> 14) & 63), i = (int)(e >> 20);
        const int s = k8 >> 1, n0 = (k8 & 1) * 8, which = j >> 6, p = j & 63, d = which >> 1, ex = d == 0 ? 31 - s : s;
        const long idx = ((long)(i * 2 + d) * 64 + g) * 64 + p; const f32x2 lp = LP[idx * 33 + ex];
        float v[8];
#pragma unroll
        for (int q = 0; q < 8; ++q) { const f32x2 bb = BB[idx * 16 + n0 + q]; v[q] = (which & 1) ? (lp.x * bb.y + lp.y * bb.x) : (lp.x * bb.x - lp.y * bb.y); }
        u32x4 o; o.x = cvt_pk_bf16(v[0], v[1]); o.y = cvt_pk_bf16(v[2], v[3]); o.z = cvt_pk_bf16(v[4], v[5]); o.w = cvt_pk_bf16(v[6], v[7]);
        *(u32x4*)(BTE + (((size_t)(i * 64 + g) * 256 + j) * 512 + k8 * 8)) = o;
    }
    bf16_t* BTT = (bf16_t*)(ws + WS_BTT);
    for (long e = gt; e < (long)2 * 64 * 512 * 32; e += NGT) {
        const int j8 = (int)(e & 31), row = (int)((e >> 5) & 511), g = (int)((e >> 14) & 63), i = (int)(e >> 20);
        const int t = row >> 4, no = row & 15, j0 = j8 * 8, which = j0 >> 6, p0 = j0 & 63, d = which >> 1, ex = d == 0 ? t + 1 : 32 - t;
        const long igd = (long)(i * 2 + d) * 64 + g;
        float v[8];
#pragma unroll
        for (int q = 0; q < 8; ++q) { const int p = p0 + q; const f32x2 lp = LP[(igd * 64 + p) * 33 + ex];
            const float cr = P_c_re[(igd * 16 + no) * 64 + p], ci = P_c_im[(igd * 16 + no) * 64 + p];
            v[q] = (which & 1) ? -(cr * lp.y + ci * lp.x) : (cr * lp.x - ci * lp.y); }
        u32x4 o; o.x = cvt_pk_bf16(v[0], v[1]); o.y = cvt_pk_bf16(v[2], v[3]); o.z = cvt_pk_bf16(v[4], v[5]); o.w = cvt_pk_bf16(v[6], v[7]);
        *(u32x4*)(BTT + (((size_t)(i * 64 + g) * 512 + row) * S5KT + 512 + j0)) = o;
    }
}
__device__ __forceinline__ void p2_thin(const Frame& F, const Ptrs& P) {
    FRAME_TID();
    unsigned char* ws = P.ws; const long gt = (long)F.vcu * 512 + f_tid, NGT = (long)F.G * 512;
    const float* KT = (const float*)(ws + WS_KTAB); bf16_t* BTT = (bf16_t*)(ws + WS_BTT);
    for (long e = gt; e < (long)2 * 64 * 512 * 64; e += NGT) {
        const int k8 = (int)(e & 63), row = (int)((e >> 6) & 511), g = (int)((e >> 15) & 63), i = (int)(e >> 21);
        const int t = row >> 4, no = row & 15, s = k8 >> 1, ni0 = (k8 & 1) * 8;
        f32x8 v;
        if (s < t) v = *(const f32x8*)(KT + ((((size_t)(i * 2 + 0) * 64 + g) * 32 + (t - s)) * 256 + no * 16 + ni0));
        else if (s > t) v = *(const f32x8*)(KT + ((((size_t)(i * 2 + 1) * 64 + g) * 32 + (s - t)) * 256 + no * 16 + ni0));
        else { v = *(const f32x8*)(KT + ((((size_t)(i * 2 + 0) * 64 + g) * 32) * 256 + no * 16 + ni0)) + *(const f32x8*)(KT + ((((size_t)(i * 2 + 1) * 64 + g) * 32) * 256 + no * 16 + ni0));
            const float dv = P_s5_d[i * 1024 + g * 16 + no];
#pragma unroll
            for (int q = 0; q < 8; ++q) v[q] += (ni0 + q == no) ? dv : 0.f; }
        u32x4 o; o.x = cvt_pk_bf16(v[0], v[1]); o.y = cvt_pk_bf16(v[2], v[3]); o.z = cvt_pk_bf16(v[4], v[5]); o.w = cvt_pk_bf16(v[6], v[7]);
        *(u32x4*)(BTT + (((size_t)(i * 64 + g) * 512 + row) * S5KT + k8 * 8)) = o;
    }
}
__device__ __forceinline__ void s5_scan(const Frame& F, const Ptrs& P, int i) {
    FRAME_TID();
    unsigned char* ws = P.ws;
    if (F.wave != 0) return;
    const f32x2* LP = (const f32x2*)(ws + WS_LP); const float* E = (const float*)(ws + WS_E); bf16_t* U2 = (bf16_t*)(ws + WS_U2);
    for (int w = F.vcu; w < 256; w += F.G) {
        const int b = w >> 7, g = (w >> 1) & 63, d = w & 1, p = f_lane;
        const f32x2 a = LP[(((long)(i * 2 + d) * 64 + g) * 64 + p)];
        const size_t r0 = (size_t)g * S5NCH + b * 256;
        float cr = 0.f, ci = 0.f;
        if (d == 0) {
#pragma unroll 8
            for (int c = 0; c < 256; ++c) { const size_t r = r0 + c;
                U2[r * S5KT + 512 + p] = (bf16_t)f2bf(cr); U2[r * S5KT + 576 + p] = (bf16_t)f2bf(ci);
                const float er = E[r * 256 + p], ei = E[r * 256 + 64 + p];
                const float nr = a.x * cr - a.y * ci + er, nim = a.x * ci + a.y * cr + ei; cr = nr; ci = nim; }
        } else {
#pragma unroll 8
            for (int c = 255; c >= 0; --c) { const size_t r = r0 + c;
                U2[r * S5KT + 640 + p] = (bf16_t)f2bf(cr); U2[r * S5KT + 704 + p] = (bf16_t)f2bf(ci);
                const float er = E[r * 256 + 128 + p], ei = E[r * 256 + 192 + p];
                const float nr = a.x * cr - a.y * ci + er, nim = a.x * ci + a.y * cr + ei; cr = nr; ci = nim; }
        }
    }
}
__device__ __forceinline__ void s5_scan_local(const Frame& F, const Ptrs& P, int i, int b, int g) {
    FRAME_TID();
    unsigned char* ws = P.ws;
    if (F.wave > 1) return;
    const f32x2* LP = (const f32x2*)(ws + WS_LP); const float* E = (const float*)(ws + WS_E); bf16_t* U2 = (bf16_t*)(ws + WS_U2);
    const int d = F.wave, p = f_lane;
    const f32x2 a = LP[(((long)(i * 2 + d) * 64 + g) * 64 + p)];
    const size_t r0 = (size_t)g * S5NCH + b * 256;
    float cr = 0.f, ci = 0.f;
    float era[16], eia[16], erb[16], eib[16];
#define S5_LD(ER, EI, blk) do { _Pragma("unroll") for (int q = 0; q < 16; ++q) { const int c = d == 0 ? (blk) * 16 + q : 255 - ((blk) * 16 + q); const size_t r = r0 + c; \
        ER[q] = E[r * 256 + d * 128 + p]; EI[q] = E[r * 256 + d * 128 + 64 + p]; } } while (0)
#define S5_SCAN(ER, EI, blk) do { _Pragma("unroll") for (int q = 0; q < 16; ++q) { const int c = d == 0 ? (blk) * 16 + q : 255 - ((blk) * 16 + q); const size_t r = r0 + c; \
        U2[r * S5KT + 512 + d * 128 + p] = (bf16_t)f2bf(cr); U2[r * S5KT + 576 + d * 128 + p] = (bf16_t)f2bf(ci); \
        const float nr = a.x * cr - a.y * ci + ER[q], nim = a.x * ci + a.y * cr + EI[q]; cr = nr; ci = nim; } } while (0)
    S5_LD(era, eia, 0);
#pragma unroll 1
    for (int blk = 0; blk < 16; blk += 2) {
        S5_LD(erb, eib, blk + 1);
        S5_SCAN(era, eia, blk);
        if (blk + 2 < 16) S5_LD(era, eia, blk + 2);
        S5_SCAN(erb, eib, blk + 1);
    }
#undef S5_LD
#undef S5_SCAN
}
__device__ __forceinline__ void diff_combine(const Frame& F, const Ptrs& P, int i, int layer) {
    FRAME_TID();
    unsigned char* ws = P.ws; const int gw = F.vcu * 8 + F.wave, NGW = F.G * 8;
    const float* lv = P_dlam + i * 512;
    float d01 = lv[f_lane] * lv[128 + f_lane] + lv[64 + f_lane] * lv[192 + f_lane], d23 = lv[256 + f_lane] * lv[384 + f_lane] + lv[320 + f_lane] * lv[448 + f_lane];
    d01 = wave_sum(d01); d23 = wave_sum(d23);
    int ly_ = layer; asm volatile("" : "+s"(ly_));
    const float linit = ly_ == 0 ? 2.000000000e-01f : ly_ == 1 ? 3.555090676e-01f : ly_ == 2 ? 4.707130183e-01f : 5.560582042e-01f;
    const float lam = __builtin_bit_cast(float, __builtin_amdgcn_readfirstlane(__builtin_bit_cast(int, expf(d01) - expf(d23) + linit)));
    const bf16_t* O1 = (const bf16_t*)(ws + WS_O12); const bf16_t* O2 = O1 + (size_t)MTOK * 1024; bf16_t* CAT = (bf16_t*)(ws + WS_CAT);
    for (int task = gw; task < MTOK * 4; task += NGW) {
        const int tok = task >> 2, h = task & 3; const size_t off = (size_t)tok * 1024 + h * 256 + f_lane * 4;
        const u32x2 a = *(const u32x2*)(O1 + off), b = *(const u32x2*)(O2 + off);
        f32x4 v; v[0] = bf2f(a.x & 0xffffu) - lam * bf2f(b.x & 0xffffu); v[1] = bf2f(a.x >> 16) - lam * bf2f(b.x >> 16); v[2] = bf2f(a.y & 0xffffu) - lam * bf2f(b.y & 0xffffu); v[3] = bf2f(a.y >> 16) - lam * bf2f(b.y >> 16);
        const float ss = wave_sum((v[0] * v[0] + v[1] * v[1]) + (v[2] * v[2] + v[3] * v[3]));
        const float rstd = 1.0f / sqrtf(ss * (1.0f / 256.0f) + NORM_EPS);
        const f32x4 gsub = *(const f32x4*)(P_subln + i * 256 + f_lane * 4) * (1.0f - linit);
        *(u32x2*)(CAT + (size_t)tok * DM + 1024 + h * 256 + f_lane * 4) = pack4(v * rstd * gsub);
    }
}
__device__ __forceinline__ void dilated_merge(const Frame& F, const Ptrs& P) {
    FRAME_TID();
    unsigned char* ws = P.ws; const int gw = F.vcu * 8 + F.wave, NGW = F.G * 8;
    const bf16_t* OB = (const bf16_t*)(ws + WS_OB); const float* LSE = (const float*)(ws + WS_LSE); bf16_t* CAT = (bf16_t*)(ws + WS_CAT);
    const int pmg = (F.G == 256) ? (8 * ((int)blockIdx.x & 7) + (((int)blockIdx.x >> 3) & 7)) * 256 + ((int)blockIdx.x >> 6) * 64 : -1;
    for (int it = 0; it < (pmg >= 0 ? 8 : (MTOK + NGW - 1) / NGW); ++it) { const int tok = pmg >= 0 ? pmg + it * 8 + F.wave : gw + it * NGW; if (tok >= MTOK) break;
        u32x4 av[4], bv[4], cv[4]; float l0v[4], l1v[4], l2v[4];
#pragma unroll
        for (int k = 0; k < 4; ++k) { const int ci = f_lane + 64 * k, col = ci * 8, h = ci >> 4;
            l0v[k] = LSE[(size_t)tok * 16 + h]; l1v[k] = LSE[((size_t)MTOK + tok) * 16 + h]; l2v[k] = LSE[((size_t)2 * MTOK + tok) * 16 + h];
            av[k] = *(const u32x4*)(OB + (size_t)tok * DM + col); bv[k] = *(const u32x4*)(OB + ((size_t)MTOK + tok) * DM + col); cv[k] = *(const u32x4*)(OB + ((size_t)2 * MTOK + tok) * DM + col); }
#pragma unroll
        for (int k = 0; k < 4; ++k) { const int ci = f_lane + 64 * k, col = ci * 8;
            const float l0 = l0v[k], l1 = l1v[k], l2 = l2v[k];
            const float mx = fmaxf(l0, fmaxf(l1, l2)); float w0 = __expf(l0 - mx), w1 = __expf(l1 - mx), w2 = __expf(l2 - mx); const float inv = 1.0f / (w0 + w1 + w2); w0 *= inv; w1 *= inv; w2 *= inv;
            const u32x4 a = av[k], b = bv[k], c = cv[k];
            u32x4 o;
#pragma unroll
            for (int q = 0; q < 4; ++q) { const float lo = w0 * bf2f(a[q] & 0xffffu) + w1 * bf2f(b[q] & 0xffffu) + w2 * bf2f(c[q] & 0xffffu), hi = w0 * bf2f(a[q] >> 16) + w1 * bf2f(b[q] >> 16) + w2 * bf2f(c[q] >> 16); o[q] = cvt_pk_bf16(lo, hi); }
            *(u32x4*)(CAT + (size_t)tok * DM + col) = o; }
    }
}
__device__ __forceinline__ void final_norm(const Frame& F, const Ptrs& P) {
    FRAME_TID();
    unsigned char* ws = P.ws; const int gw = F.vcu * 8 + F.wave, NGW = F.G * 8;
    const bf16_t* HB = (const bf16_t*)(ws + WS_HB); const float* rss = (const float*)(ws + WS_RSSP) + (size_t)12 * MTOK * 32;
    f32x4 gn[8];
#pragma unroll
    for (int j = 0; j < 8; ++j) gn[j] = *(const f32x4*)(P_fin_g + (j * 64 + f_lane) * 4);
    for (int row = gw; row < MTOK; row += NGW) {
        u32x2 w[8]; const float part = f_lane < 32 ? rss[(size_t)row * 32 + f_lane] : 0.f;
#pragma unroll
        for (int j = 0; j < 8; ++j) w[j] = *(const u32x2*)(HB + (size_t)row * DM + (j * 64 + f_lane) * 4);
        const float rstd = 1.0f / sqrtf(wave_sum(part) * (1.0f / DM) + NORM_EPS);
#pragma unroll
        for (int j = 0; j < 8; ++j) { const f32x4 h = {bf2f(w[j].x & 0xffffu), bf2f(w[j].x >> 16), bf2f(w[j].y & 0xffffu), bf2f(w[j].y >> 16)};
            *(f32x4*)(P.out + (size_t)row * DM + (j * 64 + f_lane) * 4) = h * rstd * gn[j]; } }
}
#ifndef SITES
#define SITES 0xFFFFFFFF
#endif


struct ListOrder {
    int n, pm, g; const char* A; size_t astep; const char* B; size_t bstep; int pn0;
    __device__ __forceinline__ bool next(int i, pg8::Unit& u) const { if (i >= n) return false; u.pm = pm; u.pn = pn0 + i; u.g = g; u.a = A + (size_t)i * astep; u.b = B + (size_t)(pn0 + i) * bstep; return true; }
};
struct WqKOrder {
    int G, c; const char* KV; const char* WQ;
    __device__ __forceinline__ bool next(int i, pg8::Unit& u) const {
        const int L = i * G + c; if (L >= 256) return false;
        u.g = L >> 3; u.pn = L & 7; u.pm = 0; const int l = u.g >> 3, b = (u.g >> 2) & 1, h = u.g & 3;
        u.a = KV + ((size_t)(b * 256) * 16384 + l * 4096 + h * 512) * 2;
        u.b = WQ + ((size_t)l * 2048 * 2048 + (size_t)u.pn * 256 * 2048 + h * 512) * 2; return true; }
};
struct VWoOrder {
    int G, c; const char* KV; const char* WO;
    __device__ __forceinline__ bool next(int i, pg8::Unit& u) const {
        const int L = i * G + c; if (L >= 256) return false;
        u.g = L >> 3; u.pm = L & 7; u.pn = 0; const int l = u.g >> 3, b = (u.g >> 2) & 1, h = u.g & 3;
        u.a = WO + ((size_t)l * 2048 * 2048 + (size_t)u.pm * 256 * 2048 + h * 512) * 2;
        u.b = KV + ((size_t)(b * 256) * 16384 + l * 4096 + 2048 + h * 512) * 2; return true; }
};


#ifndef DBG_RT
#define DBG_RT 0
#endif
#ifndef REP_P0
#define REP_P0 1
#endif
#ifndef REP_F1
#define REP_F1 1
#endif
#ifndef REP_DATT
#define REP_DATT 1
#endif
#ifndef REP_DIL
#define REP_DIL 1
#endif
#ifndef REP_PROJ
#define REP_PROJ 1
#endif
#ifndef REP_X1
#define REP_X1 1
#endif
#ifndef REP_S5
#define REP_S5 1
#endif
#ifndef REP_P12
#define REP_P12 1
#endif
#ifndef USE_GROUP_SYNC
#define USE_GROUP_SYNC 1
#endif
#ifndef REP_THIN
#define REP_THIN 1
#endif
#ifndef REP_DIL_IN
#define REP_DIL_IN 1
#endif
#ifndef DBG_STOP
#define DBG_STOP 0
#endif
#ifndef DBG_LAYER
#define DBG_LAYER 0
#endif
#ifndef DBG_SUB
#define DBG_SUB 0
#endif
#if DBG_RT
#ifndef DBG_X
#define DBG_X 0
#endif
__device__ int g_dbg[4] = {DBG_STOP, DBG_LAYER, DBG_SUB, DBG_X};
#endif
__device__ __forceinline__ void dbg_dump_bf(float* out, const bf16_t* a, size_t na, const bf16_t* b, size_t nb, int vcu, int G) {
    for (size_t j = (size_t)vcu * 512 + threadIdx.x; j < (size_t)MTOK * DM; j += (size_t)G * 512) { float v = bf2f(a[j % na]); if (b) v += bf2f(b[j % nb]); out[j] = v; }
}
__device__ __forceinline__ void dbg_dump_f32(float* out, const float* a, int vcu, int G) {
    for (size_t j = (size_t)vcu * 512 + threadIdx.x; j < (size_t)MTOK * DM; j += (size_t)G * 512) out[j] = a[j];
}
__global__ void __launch_bounds__(512, 2) mega_fwd(Args args) {
    extern __shared__ __attribute__((aligned(16))) unsigned char lds_raw[];
    Frame F; F.lds = (LAS unsigned char*)lds_raw; F.wave = __builtin_amdgcn_readfirstlane((int)threadIdx.x >> 6);
    F.G = gridDim.x; { const int bx = blockIdx.x; F.vcu = (F.G % 8 == 0) ? (bx % 8) * (F.G / 8) + bx / 8 : bx; }
    const Args& P = args;
    typedef __attribute__((address_space(1))) unsigned char gws_t;
    gws_t* const ws0 = (gws_t*)args.ws; gws_t* ws = ws0;
    if (threadIdx.x < 16) ((LAS unsigned*)(F.lds + LDS_MISC))[threadIdx.x] = 0u;
    __syncthreads();
    XcdBarrier bar = xcd_barrier_post((unsigned*)(ws + WS_CTL), (volatile LAS unsigned*)(F.lds + LDS_MISC));
#if defined(BAR2)
#define GRID_BAR() do { xcd_barrier(bar); xcd_barrier(bar); } while (0)
#else
#define GRID_BAR() xcd_barrier(bar)
#endif
    if (threadIdx.x == 0) __hip_atomic_store((unsigned*)(ws + WS_CTL) + GS_XCC_WORD + blockIdx.x, xb_xcc_id() + 1u, __ATOMIC_RELAXED, __HIP_MEMORY_SCOPE_AGENT);
    const int bx = (int)blockIdx.x;
#if DBG_RT
    const int dbg_stop = __builtin_amdgcn_readfirstlane(((volatile int*)g_dbg)[0]), dbg_layer = __builtin_amdgcn_readfirstlane(((volatile int*)g_dbg)[1]), dbg_sub = __builtin_amdgcn_readfirstlane(((volatile int*)g_dbg)[2]), dbg_x = __builtin_amdgcn_readfirstlane(((volatile int*)g_dbg)[3]);
#endif
    float* RSS = (float*)(ws + WS_RSSP);
    bf16_t* HB = (bf16_t*)(ws + WS_HB); float* H = (float*)(ws + WS_H); bf16_t* CAT = (bf16_t*)(ws + WS_CAT); bf16_t* XP = (bf16_t*)(ws + WS_XP);
    const float* rc = (const float*)(ws + WS_ROPE); const float* rs = rc + SEQ * 16;

#if defined(DBG_FILL)
    { u32x4* p = (u32x4*)(ws + MiB); const size_t n = (WS_END - MiB) / 16; const unsigned pat = DBG_FILL; for (size_t j = (size_t)F.vcu * 512 + threadIdx.x; j < n; j += (size_t)F.G * 512) p[j] = (u32x4){pat, pat, pat, pat}; }
    GRID_BAR();
#endif

#if (SITES >> 0) & 1
#if !defined(S5TAB_IN_P1)
    if (bx < 128) { s5_tables_task(F, P, bx >> 6, bx & 63); asm volatile("s_waitcnt vmcnt(0) lgkmcnt(0)" ::: "memory"); __syncthreads(); }
#endif
    _Pragma("unroll 1") for (int rp = 0; rp < REP_P0; ++rp) p0_prologue(F, P);
#endif

    GRID_BAR();
    bool use_group;
    {   int t_ = threadIdx.x; asm volatile("" : "+v"(t_));
        int okv = 1;
        if (t_ < 256) { const unsigned* xw = (const unsigned*)(ws + WS_CTL) + GS_XCC_WORD; const unsigned a = __hip_atomic_load(xw + t_, __ATOMIC_RELAXED, __HIP_MEMORY_SCOPE_AGENT), b0 = __hip_atomic_load(xw + (t_ & 63), __ATOMIC_RELAXED, __HIP_MEMORY_SCOPE_AGENT); okv = (a == b0) && (a != 0u); }
        use_group = (__syncthreads_and(okv) != 0) && (F.G == 256) && (USE_GROUP_SYNC != 0); }
    unsigned gs_epoch = 0;
    const int gs_gid = bx & 63;
#define CHAIN_BAR() do { if (use_group) { ++gs_epoch; group_sync((unsigned*)(ws + WS_CTL), gs_gid, 4u * gs_epoch); } else { GRID_BAR(); } } while (0)
    _Pragma("unroll 1") for (int rp12 = 0; rp12 < REP_P12; ++rp12) {

#if defined(S5TAB_IN_P1)
    if (bx < 128) s5_tables_task(F, P, bx >> 6, bx & 63);
    else
#else
    if (bx >= 128)
#endif
    {   pg8::DenseOrder S; S.init((const void*)(ws + WS_MEMN), 2048, (const void*)(ws + WS_WKV_T), 2048, BATCH * MEML, 16384, F.G - 128, bx - 128);
        EpiBf16Plain E{(bf16_t*)(ws + WS_KVALL), 16384, nullptr, 1.0f};
        pg8::gemm_phase(F.lds, 2048, 2048, 2048, S, E); }

    GRID_BAR();

#if (SITES >> 3) & 1
    {   WqKOrder S{F.G, bx, (const char*)(ws + WS_KVALL), (const char*)(ws + WS_WQ_B)}; EpiWqK E{(bf16_t*)(ws + WS_WQK), P_xa_g};
        pg8::gemm_phase(F.lds, 512, 16384, 2048, S, E); }
#endif


#if (SITES >> 4) & 1
    {   VWoOrder S{F.G, bx, (const char*)(ws + WS_KVALL), (const char*)(ws + WS_WO_T)}; EpiVWo E{(bf16_t*)(ws + WS_VWO)};
        pg8::gemm_phase(F.lds, 512, 2048, 16384, S, E); }
#endif


    GRID_BAR();
    }
#if DBG_RT
    if (dbg_stop == 1) {
    dbg_dump_bf(args.out, (const bf16_t*)(ws + WS_WQK), (size_t)16 << 20, (const bf16_t*)(ws + WS_VWO), (size_t)16 << 20, F.vcu, F.G); return;
    }
#endif
#if DBG_RT
    if (dbg_stop == 13) {
    dbg_dump_bf(args.out, (const bf16_t*)(ws + WS_W13) + (size_t)dbg_layer * 11264 * 2048, (size_t)11264 * 2048, (const bf16_t*)(ws + WS_W2) + (size_t)dbg_layer * 2048 * 5632, (size_t)2048 * 5632, F.vcu, F.G); return;
    }
#endif
#if DBG_RT
    if (dbg_stop == 14) {
    { const bf16_t* a = (const bf16_t*)(ws + WS_W13) + (size_t)dbg_layer * 11264 * 2048; const bf16_t* b = (const bf16_t*)(ws + WS_W2) + (size_t)dbg_layer * 2048 * 5632; for (size_t j = (size_t)F.vcu * 512 + threadIdx.x; j < (size_t)MTOK * DM; j += (size_t)F.G * 512) args.out[j] = 30.0f * (bf2f(a[j % ((size_t)11264 * 2048)]) + bf2f(b[j % ((size_t)2048 * 5632)])); return; }
    }
#endif
#if DBG_RT
    if (dbg_stop == 7) {
    dbg_dump_bf(args.out, (const bf16_t*)(ws + WS_BTT), (size_t)48 << 20, (const bf16_t*)(ws + WS_BTE), (size_t)16 << 20, F.vcu, F.G); return;
    }
#endif
#if DBG_RT
    if (dbg_stop == 8) {
    dbg_dump_bf(args.out, (const bf16_t*)(ws + WS_W13), (size_t)88 << 20, (const bf16_t*)(ws + WS_W2), (size_t)44 << 20, F.vcu, F.G); return;
    }
#endif

#pragma unroll 1
    for (int layer = 0; layer < DEPTH; ++layer) {
        const int i = layer >> 1; const bool even = (layer & 1) == 0;
#pragma unroll 1
        for (int sub = 0; sub < 3; ++sub) {
            gws_t* ws = ws0; asm volatile("" : "+s"(ws));
            const float* rss_cur = RSS + (size_t)(3 * layer + sub) * MTOK * 32; float* rss_next = RSS + (size_t)(3 * layer + sub + 1) * MTOK * 32;
            if (sub == 0) {

#if (SITES >> 6) & 1
#if DBG_RT
                const int nrep = ((dbg_x & 1) && layer == dbg_layer) ? 2 : 1, iw = ((dbg_x & 2) && layer == dbg_layer) ? 0 : i;
                if ((dbg_x & 4) && layer == dbg_layer) GRID_BAR();
#else
                const int nrep = REP_PROJ, iw = i;
#endif
#pragma unroll 1
                for (int rep = 0; rep < nrep; ++rep)
                {   const bf16_t* Bt = even ? (const bf16_t*)(ws + WS_W_IN) + (size_t)iw * 4096 * 2048 : (const bf16_t*)(ws + WS_W_QKV) + (size_t)iw * 6144 * 2048;
                    pg8::DenseOrder S; S.init(HB, 2048, Bt, 2048, MTOK, even ? 4096 : 6144, F.G, bx);
                    const float* rss_p = rss_cur;
#if DBG_RT
                    if ((dbg_x & 8) && layer == dbg_layer) rss_p = RSS + (size_t)6 * MTOK * 32;
#endif
                    pg8::Unit u0; const bool has0 = S.next(0, u0); const int pm0 = u0.pm; LAS float* rtab = (LAS float*)(F.lds + LDS_RSTD);
                    auto pre = [=]() { if (has0) fill_rstd_tab(rss_p, pm0, rtab); };
                    EpiProj E{(LAS const float*)(F.lds + LDS_RSTD), rc, rs, even ? (bf16_t*)(ws + WS_QKVE) : (bf16_t*)(ws + WS_QKVO), even ? 3072 : 6144, (bf16_t*)(ws + WS_U2), even ? 4 : 0, even ? 4 : 0, even ? 12 : 16};
                    pg8::gemm_phase(F.lds, 2048, 2048, 2048, S, E, pre); }
#endif

                GRID_BAR();
#if DBG_RT
    if (dbg_stop == 10) {
                if (layer == dbg_layer) { unsigned* q = (unsigned*)(ws + WS_QKVO); for (size_t j = (size_t)F.vcu * 512 + threadIdx.x; j < (size_t)MTOK * DM / 2; j += (size_t)F.G * 512) { const unsigned w = __hip_atomic_fetch_or(q + j, 0u, __ATOMIC_RELAXED, __HIP_MEMORY_SCOPE_AGENT); args.out[2 * j] = bf2f(w & 0xffffu); args.out[2 * j + 1] = bf2f(w >> 16); } return; }
    }
#endif
#if DBG_RT
    if (dbg_stop == 2) {
                if (layer == dbg_layer) { if (even) dbg_dump_bf(args.out, (const bf16_t*)(ws + WS_U2), (size_t)24 << 20, (const bf16_t*)(ws + WS_QKVE), (size_t)48 << 20, F.vcu, F.G); else dbg_dump_bf(args.out, (const bf16_t*)(ws + WS_QKVO), (size_t)96 << 20, nullptr, 1, F.vcu, F.G); return; }
    }
#endif
                if (even) {
                    _Pragma("unroll 1") for (int rps = 0; rps < REP_S5; ++rps) {
                    {
                        const int pm = (bx >> 1) & 127, hf = bx & 1, g = pm >> 1, b = pm & 1;
                        {   ListOrder S{1, pm, g, (const char*)(ws + WS_U2) + (size_t)pm * 256 * S5KT * 2, 0, (const char*)((const bf16_t*)(ws + WS_BTE) + ((size_t)i * 64 + g) * 256 * 512), 0, 0};
                            EpiF32 E{(float*)(ws + WS_E), 256};
                            pg8::gemm_phase(F.lds, 512, S5KT, 512, S, E); }
                        asm volatile("s_waitcnt vmcnt(0)" ::: "memory"); __syncthreads();
                        s5_scan_local(F, P, i, b, g);
                        asm volatile("s_waitcnt vmcnt(0)" ::: "memory"); __syncthreads();
                        {   ListOrder S{1, pm, g, (const char*)(ws + WS_U2) + (size_t)pm * 256 * S5KT * 2, 0, (const char*)((const bf16_t*)(ws + WS_BTT) + ((size_t)i * 64 + g) * 512 * S5KT), (size_t)256 * S5KT * 2, hf};
                            EpiS5Y E{(bf16_t*)(ws + WS_G)};
                            pg8::gemm_phase(F.lds, S5KT, S5KT, S5KT, S, E); }
                    }
                    GRID_BAR();

#if (SITES >> 10) & 1
                    {   pg8::DenseOrder S; S.init((const void*)(ws + WS_G), 1024, (const bf16_t*)(ws + WS_W_GLU) + (size_t)i * 1024 * 1024, 1024, MTOK, 1024, F.G, bx);
                        EpiGlu E{(const bf16_t*)(ws + WS_G), P_glu_b + i * 1024, CAT};
                        pg8::gemm_phase(F.lds, 1024, 1024, 1024, S, E); }
#endif

                    if (rps + 1 < REP_S5) GRID_BAR();
                    }

#if (SITES >> 11) & 1
                    {   const bf16_t* QKV = (const bf16_t*)(ws + WS_QKVE); bf16_t* O12 = (bf16_t*)(ws + WS_O12);
                        float lam, gscale;
                        {   int t_ = threadIdx.x; asm volatile("" : "+v"(t_)); const int ln = t_ & 63; const float* lv = P_dlam + i * 512;
                            const float d01 = wave_sum(lv[ln] * lv[128 + ln] + lv[64 + ln] * lv[192 + ln]), d23 = wave_sum(lv[256 + ln] * lv[384 + ln] + lv[320 + ln] * lv[448 + ln]);
                            int ly_ = layer; asm volatile("" : "+s"(ly_)); const float linit = __builtin_bit_cast(float, ly_ == 0 ? 0x3e4ccccdu : 0x3ef1014cu);
                            lam = __builtin_bit_cast(float, __builtin_amdgcn_readfirstlane(__builtin_bit_cast(int, expf(d01) - expf(d23) + linit))); gscale = 1.0f - linit; }
                        _Pragma("unroll 1") for (int rp = 0; rp < REP_DATT; ++rp)
                        for (int unit = F.vcu; unit < 256; unit += F.G) {
                            const int binst = unit >> 5, qb = unit & 31, b = binst >> 2, h = binst & 3;
                            const bf16_t* Vh = QKV + (size_t)(b * SEQ) * 3072 + 2048 + h * 256;
                            bf16_t* Ob = O12 + ((size_t)b * SEQ + qb * 256) * 1024 + h * 256;
                            bf16_t* Cb = CAT + ((size_t)b * SEQ + qb * 256) * DM + 1024 + h * 256;
                            _Pragma("unroll 1") for (int c = 0; c < 2; ++c) {
                                const bf16_t* Qb = QKV + (size_t)(b * SEQ + qb * 256) * 3072 + (h * 2 + c) * 128;
                                const bf16_t* Kh = QKV + (size_t)(b * SEQ) * 3072 + 1024 + (h * 2 + c) * 128;
                                asm volatile("s_waitcnt vmcnt(0)" ::: "memory"); __syncthreads();
#if defined(W32)
                                att::attn_wide_body(Qb, Kh, Vh, 3072, SEQ / 64, Ob, 1024, (char*)lds_raw, c == 1, lam, gscale, P_subln + i * 256, Cb, DM);
#else
                                att::attn_wide16_body(Qb, Kh, Vh, 3072, SEQ / 64, Ob, 1024, (char*)lds_raw, c == 1, lam, gscale, P_subln + i * 256, Cb, DM);
#endif
                            }
                        } }
#endif

                    GRID_BAR();
                } else {

#if (SITES >> 13) & 1
#if !defined(BAND_WG) && !defined(BAND_WAVE)
                    {   const bf16_t* QKV = (const bf16_t*)(ws + WS_QKVO); bf16_t* OB = (bf16_t*)(ws + WS_OB); float* LSE = (float*)(ws + WS_LSE);
                        const int vcu_ = F.vcu, G_ = F.G;
                        auto unit_of = [=](int i) -> att::BandUnit {
                            int br, b, h, r, qb2;
                            if (G_ == 256) { const int x = vcu_ >> 5, Lx = i * 32 + (vcu_ & 31), c48 = Lx / 48, cg = x * 8 + c48, m = Lx - c48 * 48, qs = m & 15, half = cg & 1; br = m >> 4; b = cg >> 5; h = (cg >> 1) & 15;
                                const int sh = 2 * br; qb2 = (half << (4 - sh)) + (qs >> sh); r = qs & ((1 << sh) - 1); }
                            else { const int unit = vcu_ + i * G_, g32 = unit >> 5, rq = unit & 31; br = g32 >> 5; b = (g32 >> 4) & 1; h = g32 & 15; const int sh = 2 * br; r = rq >> (5 - sh); qb2 = rq & ((32 >> sh) - 1); }
                            const int sh2 = 2 * br, dil = 1 << sh2, Mr = SEQ >> sh2;
                            const size_t tok0 = (size_t)b * SEQ + r, tokq = tok0 + ((size_t)(qb2 * 256) << sh2);
                            att::BandUnit u; u.Q = QKV + tokq * 6144 + h * 128; u.K = QKV + tok0 * 6144 + 2048 + h * 128; u.V = QKV + tok0 * 6144 + 4096 + h * 128;
                            u.O = OB + ((size_t)br * MTOK + tokq) * DM + h * 128; u.L = LSE + ((size_t)br * MTOK + tokq) * 16 + h;
                            u.ld = dil * 6144; u.ldo = dil * DM; u.ldl = dil * 16; u.kfirst = qb2 * 256 - 64; u.Mr = Mr; u.lsh = sh2; return u; };
                        const int U = vcu_ < 3072 ? (3072 - vcu_ + G_ - 1) / G_ : 0;
                        _Pragma("unroll 1") for (int rp = 0; rp < REP_DIL; ++rp) { __syncthreads(); att::attn_band16_stream(U, unit_of, (char*)lds_raw); } }
#else
                    {   const bf16_t* QKV = (const bf16_t*)(ws + WS_QKVO); bf16_t* OB = (bf16_t*)(ws + WS_OB); float* LSE = (float*)(ws + WS_LSE);
                        _Pragma("unroll 1") for (int rp = 0; rp < REP_DIL; ++rp)
                        for (int unit = F.vcu; unit < 3072; unit += F.G) {
                            const int g32 = unit >> 5, rq = unit & 31, br = g32 >> 5, b = (g32 >> 4) & 1, h = g32 & 15;
                            const int dil = 1 << (2 * br), Mr = SEQ / dil, nqb = Mr / 256, r = rq / nqb, qb2 = rq % nqb;
                            const size_t tok0 = (size_t)b * SEQ + r;
                            const size_t tokq = tok0 + (size_t)(qb2 * 256) * dil;
                            const bf16_t* Qb = QKV + tokq * 6144 + h * 128;
                            const bf16_t* Kh = QKV + tok0 * 6144 + 2048 + h * 128;
                            const bf16_t* Vh = QKV + tok0 * 6144 + 4096 + h * 128;
                            bf16_t* Ob = OB + ((size_t)br * MTOK + tokq) * DM + h * 128;
                            float* ls = LSE + ((size_t)br * MTOK + tokq) * 16 + h;
                            _Pragma("unroll 1") for (int rpi = 0; rpi < REP_DIL_IN; ++rpi) {
#if defined(DIL_PROBE)
                            att::attn_band_wave(Qb, 6144L, Kh, Vh, 6144L, qb2 * 256 - 64, Mr, (bf16_t*)(ws + WS_HID) + (size_t)(unit & 2047) * 32768, 128L, (float*)(ws + WS_HID + (160u << 20)) + (size_t)unit * 256, 1L, (char*)lds_raw);
#endif
#if defined(BAND_WG)
                            __syncthreads();
                            att::attn_band_body(Qb, (long)dil * 6144, Kh, Vh, (long)dil * 6144, qb2 * 256 - 64, Mr, Ob, (long)dil * DM, ls, (long)dil * 16, (char*)lds_raw);
#else
                            att::attn_band_wave(Qb, (long)dil * 6144, Kh, Vh, (long)dil * 6144, qb2 * 256 - 64, Mr, Ob, (long)dil * DM, ls, (long)dil * 16, (char*)lds_raw);
#endif
                            }
                        } }
#endif
#endif

                    GRID_BAR();

#if (SITES >> 14) & 1
                    _Pragma("unroll 1") for (int rpt = 0; rpt < REP_THIN; ++rpt) dilated_merge(F, P);
#endif

                    CHAIN_BAR();
                }
            } else if (sub == 1) {

#if (SITES >> 15) & 1
                _Pragma("unroll 1") for (int rp = 0; rp < REP_X1; ++rp)
                {   pg8::DenseOrder S; S.init(HB, 2048, (const bf16_t*)(ws + WS_WQK) + (size_t)layer * 2 * 1024 * 2048, 2048, MTOK, 1024, F.G, bx, 32, (size_t)1024 * 2048 * 2);
                    pg8::Unit u0; const bool has0 = S.next(0, u0); const int pm0 = u0.pm; LAS float* rtab = (LAS float*)(F.lds + LDS_RSTD);
                    auto pre = [=]() { if (has0) fill_rstd_tab(rss_cur, pm0, rtab); };
                    EpiSoftmax E{(LAS const float*)(F.lds + LDS_RSTD), XP, (LAS float*)(F.lds + LDS_EPI)};
                    pg8::gemm_phase(F.lds, 2048, 2048, 2048, S, E, pre); }
#endif

                CHAIN_BAR();
            } else {

#if (SITES >> 16) & 1
                _Pragma("unroll 1") for (int rp = 0; rp < REP_F1; ++rp)
                {   pg8::DenseOrder S; S.init(HB, 2048, (const bf16_t*)(ws + WS_W13) + (size_t)layer * 11264 * 2048, 2048, MTOK, 11264, F.G, bx);
                    pg8::Unit u0; const bool has0 = S.next(0, u0); const int pm0 = u0.pm; LAS float* rtab = (LAS float*)(F.lds + LDS_RSTD);
                    auto pre = [=]() { if (has0) fill_rstd_tab(rss_cur, pm0, rtab); };
                    EpiSwiglu E{(LAS const float*)(F.lds + LDS_RSTD), (bf16_t*)(ws + WS_HID)};
                    pg8::gemm_phase(F.lds, 2048, 2048, 2048, S, E, pre); }
#endif

                CHAIN_BAR();
            }
#if DBG_RT
    if (dbg_stop == 15) {
            if (layer == dbg_layer && sub == dbg_sub) { const bf16_t* a = (const bf16_t*)(ws + WS_W13) + (size_t)dbg_layer * 11264 * 2048; const bf16_t* b = (const bf16_t*)(ws + WS_W2) + (size_t)dbg_layer * 2048 * 5632; for (size_t j = (size_t)F.vcu * 512 + threadIdx.x; j < (size_t)MTOK * DM; j += (size_t)F.G * 512) args.out[j] = 30.0f * (bf2f(a[j % ((size_t)11264 * 2048)]) + bf2f(b[j % ((size_t)2048 * 5632)])); return; }
    }
#endif
#if DBG_RT
    if (dbg_stop == 3) {
            if (layer == dbg_layer && sub == dbg_sub) { if (sub == 0) dbg_dump_bf(args.out, CAT, (size_t)32 << 20, nullptr, 1, F.vcu, F.G); else if (sub == 1) dbg_dump_bf(args.out, XP, (size_t)16 << 20, nullptr, 1, F.vcu, F.G); else dbg_dump_bf(args.out, (const bf16_t*)(ws + WS_HID), (size_t)88 << 20, nullptr, 1, F.vcu, F.G); return; }
    }
#endif

#if (SITES >> 17) & 1
            {   const bf16_t* A; const bf16_t* Bt; int K, pmdiv = 1 << 30; size_t bgroup = 0;
                if (sub == 0) { A = CAT; K = 2048; Bt = even ? (const bf16_t*)(ws + WS_W_ABO) + (size_t)i * 2048 * 2048 : (const bf16_t*)(ws + WS_W_CO) + (size_t)i * 2048 * 2048; }
                else if (sub == 1) { A = XP; K = 1024; Bt = (const bf16_t*)(ws + WS_VWO) + (size_t)layer * 2 * 2048 * 1024; pmdiv = 32; bgroup = (size_t)2048 * 1024 * 2; }
                else { A = (const bf16_t*)(ws + WS_HID); K = FFN; Bt = (const bf16_t*)(ws + WS_W2) + (size_t)layer * 2048 * FFN; }
                pg8::DenseOrder S; S.init(A, K, Bt, K, MTOK, 2048, F.G, bx, pmdiv, bgroup);
                EpiRes E{(layer == 0 && sub == 0) ? P_x : (const float*)nullptr, HB, rss_next};
                pg8::gemm_phase(F.lds, K, K, K, S, E);
#if defined(REP_RES)
                { asm volatile("s_waitcnt vmcnt(0)" ::: "memory"); __syncthreads(); EpiRes E2 = E; E2.dry = true; pg8::gemm_phase(F.lds, K, K, K, S, E2); }
#endif
                }
#endif

            if (layer == DEPTH - 1 && sub == 2) { GRID_BAR(); } else { CHAIN_BAR(); }
#if DBG_RT
    if (dbg_stop == 12) {
            if (layer == dbg_layer && sub == dbg_sub) { for (size_t j = (size_t)F.vcu * 512 + threadIdx.x; j < (size_t)MTOK * DM; j += (size_t)F.G * 512) args.out[j] = 200.0f * (H[j] - P_x[j]); return; }
    }
#endif
#if DBG_RT
    if (dbg_stop == 16) {
            if (layer == dbg_layer && sub == dbg_sub) { for (size_t j = (size_t)F.vcu * 512 + threadIdx.x; j < (size_t)MTOK * DM; j += (size_t)F.G * 512) args.out[j] = 200.0f * bf2f(HB[j]); return; }
    }
#endif
#if DBG_RT
    if (dbg_stop == 17) {
            if (layer == dbg_layer && sub == dbg_sub) { unsigned* q = (unsigned*)HB; for (size_t j = (size_t)F.vcu * 512 + threadIdx.x; j < (size_t)MTOK * DM / 2; j += (size_t)F.G * 512) { const unsigned w = __hip_atomic_fetch_or(q + j, 0u, __ATOMIC_RELAXED, __HIP_MEMORY_SCOPE_AGENT); args.out[2 * j] = 200.0f * bf2f(w & 0xffffu); args.out[2 * j + 1] = 200.0f * bf2f(w >> 16); } return; }
    }
#endif
#if DBG_RT
    if (dbg_stop == 4) {
            if (layer == dbg_layer && sub == dbg_sub) { dbg_dump_f32(args.out, H, F.vcu, F.G); return; }
    }
#endif
#if DBG_RT
    if (dbg_stop == 5) {
            if (layer == dbg_layer && sub == dbg_sub) { dbg_dump_bf(args.out, HB, (size_t)32 << 20, nullptr, 1, F.vcu, F.G); __syncthreads(); if (blockIdx.x < 32) { const int j = blockIdx.x * 512 + threadIdx.x; args.out[j] = rss_next[j]; } return; }
    }
#endif
#if DBG_RT
    if (dbg_stop == 6) {
            if (layer == dbg_layer && sub == dbg_sub) { dbg_dump_bf(args.out, (const bf16_t*)(ws + WS_W_QKV), (size_t)24 << 20, nullptr, 1, F.vcu, F.G); return; }
    }
#endif
        }
    }

#if DBG_RT
    if (dbg_stop == 11) {
    { const unsigned* xc = (const unsigned*)(ws + WS_CTL) + 8192; bool ok = true; for (int b = 0; b < (int)gridDim.x; ++b) ok = ok && (xc[b] == ((xc[0] + (unsigned)b) & 7u)); const float v = ok ? 0.0f : 0.26f; for (size_t j = (size_t)F.vcu * 512 + threadIdx.x; j < (size_t)MTOK * DM; j += (size_t)F.G * 512) args.out[j] = v; return; }
    }
#endif
#if DBG_RT
    if (dbg_stop == 9) {
    { const unsigned tmo = xb_ld((unsigned*)(ws + WS_CTL) + XB_TMO); const float v = tmo ? 0.26f : 0.0f; for (size_t j = (size_t)F.vcu * 512 + threadIdx.x; j < (size_t)MTOK * DM; j += (size_t)F.G * 512) args.out[j] = v; return; }
    }
#endif
#if (SITES >> 18) & 1
    final_norm(F, P);
#endif

#undef GRID_BAR
}

extern "C" void kernel_launch(void* const* d_in, const int* in_sizes, int n_in, void* d_out, int out_size, void* d_ws, size_t ws_size, hipStream_t stream) {
    static int grid = 0;
    if (grid == 0) {
        if (n_in != 28 || in_sizes[0] != MTOK * DM || out_size != MTOK * DM || ws_size < WS_END) {
            fprintf(stderr, "kernel_launch: built for 28 inputs, x/out of %d floats and >= %zu bytes of workspace; got n_in %d, in0 %d, out %d, ws %zu; nothing launched\n", MTOK * DM, (size_t)WS_END, n_in, n_in > 0 ? in_sizes[0] : -1, out_size, ws_size);
            grid = -1; return; }
        int dev = 0, cus = 0, per_cu = 0;
        if (hipGetDevice(&dev) != hipSuccess || hipDeviceGetAttribute(&cus, hipDeviceAttributeMultiprocessorCount, dev) != hipSuccess) { grid = -1; return; }
        if (hipFuncSetAttribute((const void*)mega_fwd, hipFuncAttributeMaxDynamicSharedMemorySize, LDS_BYTES) != hipSuccess) { fprintf(stderr, "kernel_launch: hipFuncSetAttribute failed\n"); grid = -1; return; }
        if (hipOccupancyMaxActiveBlocksPerMultiprocessor(&per_cu, (const void*)mega_fwd, 512, LDS_BYTES) != hipSuccess || per_cu < 1)
            fprintf(stderr, "kernel_launch: note: occupancy query reports %d workgroups per CU\n", per_cu);
        (void)hipGetLastError();
        grid = cus;
    }
    if (grid < 0) return;
    if (hipMemsetAsync((char*)d_ws + WS_CTL, 0, CTL_BYTES, stream) != hipSuccess) { fprintf(stderr, "kernel_launch: hipMemsetAsync failed\n"); return; }
    Args a{};
    for (int i = 0; i < 28; ++i) a.in[i] = (const float*)d_in[i];
    a.out = (float*)d_out; a.ws = (unsigned char*)d_ws;
    hipLaunchKernelGGL(mega_fwd, dim3(grid), dim3(512), LDS_BYTES, stream, a);
    const hipError_t le = hipPeekAtLastError();
    if (le != hipSuccess) fprintf(stderr, "kernel_launch: launch failed: %s\n", hipGetErrorName(le));
}
```

```cpp
#include <hip/hip_runtime.h>
#include <cstdio>
#include <cstdint>

#define LAS __attribute__((address_space(3)))
typedef unsigned short bf16_t;
typedef short bf16x8 __attribute__((ext_vector_type(8)));
typedef short s16x4 __attribute__((ext_vector_type(4)));
typedef float f32x2 __attribute__((ext_vector_type(2)));
typedef float f32x4 __attribute__((ext_vector_type(4)));
typedef float f32x8 __attribute__((ext_vector_type(8)));
typedef float f32x16 __attribute__((ext_vector_type(16)));
typedef unsigned u32x2 __attribute__((ext_vector_type(2)));
typedef unsigned u32x4 __attribute__((ext_vector_type(4)));

constexpr int BATCH = 2, SEQ = 8192, DM = 2048, MTOK = BATCH * SEQ, DEPTH = 4, FFN = 5632, MEML = 256;
constexpr float NORM_EPS = 1e-6f;
constexpr int S5L = 32, S5KT = 768, S5NCH = MTOK / S5L;

constexpr size_t MiB = 1u << 20;
constexpr size_t WS_CTL = 0, CTL_BYTES = 65536;
constexpr size_t WS_ROPE = 1 * MiB;
constexpr size_t WS_LP = 2 * MiB;
constexpr size_t WS_BBAR = 7 * MiB;
constexpr size_t WS_KTAB = 9 * MiB;
constexpr size_t WS_MEMN = 17 * MiB;
constexpr size_t WS_W_IN = 20 * MiB;
constexpr size_t WS_W_ABO = WS_W_IN + 32 * MiB;
constexpr size_t WS_W_GLU = WS_W_ABO + 16 * MiB;
constexpr size_t WS_W_QKV = WS_W_GLU + 4 * MiB;
constexpr size_t WS_W_CO = WS_W_QKV + 48 * MiB;
constexpr size_t WS_W13 = WS_W_CO + 16 * MiB;
constexpr size_t WS_W2 = WS_W13 + 176 * MiB;
constexpr size_t WS_WQK = WS_W2 + 88 * MiB;
constexpr size_t WS_VWO = WS_WQK + 32 * MiB;
constexpr size_t WS_BTT = WS_VWO + 32 * MiB;
constexpr size_t WS_BTE = WS_BTT + 96 * MiB;
constexpr size_t WS_HID = WS_BTE + 32 * MiB;
constexpr size_t WS_H = WS_HID;
constexpr size_t WS_HB = WS_HID + 176 * MiB;
constexpr size_t WS_CAT = WS_HB + 64 * MiB;
constexpr size_t WS_XP = WS_CAT + 64 * MiB;
constexpr size_t WS_R1 = WS_XP + 32 * MiB;
constexpr size_t WS_R2 = WS_R1 + 192 * MiB;
constexpr size_t WS_RSSP = WS_R2 + 196 * MiB;
constexpr size_t WS_END = WS_RSSP + 26 * MiB;
constexpr size_t WS_QKVO = WS_R1;
constexpr size_t WS_U2 = WS_R1;
constexpr size_t WS_QKVE = WS_R1 + 48 * MiB;
constexpr size_t WS_WKV_T = WS_R1;
constexpr size_t WS_WQ_B = WS_R1 + 64 * MiB;
constexpr size_t WS_WO_T = WS_R1 + 96 * MiB;
constexpr size_t WS_KVALL = WS_R1 + 128 * MiB;
constexpr size_t WS_OB = WS_R2;
constexpr size_t WS_LSE = WS_R2 + 192 * MiB;
constexpr size_t WS_O12 = WS_R2;
constexpr size_t WS_E = WS_R2 + 64 * MiB;
constexpr size_t WS_G = WS_R2 + 96 * MiB;

constexpr int LDS_STAGE = 131072;
constexpr int LDS_EPI = LDS_STAGE;
constexpr int LDS_MISC = LDS_STAGE + 8192;
constexpr int LDS_RSTD = LDS_MISC + 256;
constexpr int LDS_BYTES = 147456;

__device__ __forceinline__ unsigned f2bf(float f) { unsigned u = __builtin_bit_cast(unsigned, f); return (u + 0x7fffu + ((u >> 16) & 1u)) >> 16; }
__device__ __forceinline__ float bf2f(unsigned h) { return __builtin_bit_cast(float, h << 16); }
__device__ __forceinline__ unsigned cvt_pk_bf16(float lo, float hi) { unsigned r; asm volatile("v_cvt_pk_bf16_f32 %0, %1, %2" : "=v"(r) : "v"(lo), "v"(hi)); return r; }
__device__ __forceinline__ u32x2 pack4(f32x4 v) { u32x2 w; w.x = cvt_pk_bf16(v[0], v[1]); w.y = cvt_pk_bf16(v[2], v[3]); return w; }
template <int CTRL> __device__ __forceinline__ float dpp_f(float x) { return __builtin_bit_cast(float, __builtin_amdgcn_update_dpp(0, __builtin_bit_cast(int, x), CTRL, 0xf, 0xf, true)); }
__device__ __forceinline__ float wave_sum(float v) {
    v += dpp_f<0xB1>(v); v += dpp_f<0x4E>(v); v += dpp_f<0x141>(v); v += dpp_f<0x128>(v);
    auto s = __builtin_amdgcn_permlane16_swap(__float_as_uint(v), __float_as_uint(v), false, false); v = __uint_as_float(s[0]) + __uint_as_float(s[1]);
    auto u = __builtin_amdgcn_permlane32_swap(__float_as_uint(v), __float_as_uint(v), false, false); return __uint_as_float(u[0]) + __uint_as_float(u[1]);
}
__device__ __forceinline__ float x16_sum(float x) {
    auto s = __builtin_amdgcn_permlane16_swap(__float_as_uint(x), __float_as_uint(x), false, false); x = __uint_as_float(s[0]) + __uint_as_float(s[1]);
    auto u = __builtin_amdgcn_permlane32_swap(__float_as_uint(x), __float_as_uint(x), false, false); return __uint_as_float(u[0]) + __uint_as_float(u[1]);
}
__device__ __forceinline__ float x16_max(float x) {
    auto s = __builtin_amdgcn_permlane16_swap(__float_as_uint(x), __float_as_uint(x), false, false); x = fmaxf(__uint_as_float(s[0]), __uint_as_float(s[1]));
    auto u = __builtin_amdgcn_permlane32_swap(__float_as_uint(x), __float_as_uint(x), false, false); return fmaxf(__uint_as_float(u[0]), __uint_as_float(u[1]));
}
__device__ __forceinline__ float row_rstd(const float* rssp, int row, int fq) {
    const f32x4 a = *(const f32x4*)(rssp + (size_t)row * 32 + fq * 8), b = *(const f32x4*)(rssp + (size_t)row * 32 + fq * 8 + 4);
    float s = ((a[0] + a[1]) + (a[2] + a[3])) + ((b[0] + b[1]) + (b[2] + b[3]));
    s += __shfl_xor(s, 16); s += __shfl_xor(s, 32);
    return 1.0f / sqrtf(s * (1.0f / DM) + NORM_EPS);
}
__device__ __forceinline__ void fill_rstd_tab(const float* rssp, int pm, LAS float* tab) {
    int t = threadIdx.x; asm volatile("" : "+v"(t));
    if (t < 256) { const f32x4* p = (const f32x4*)(rssp + ((size_t)pm * 256 + t) * 32); float s = 0.f;
#pragma unroll
        for (int j = 0; j < 8; ++j) { const f32x4 a = p[j]; s += (a[0] + a[1]) + (a[2] + a[3]); }
        tab[t] = __builtin_amdgcn_rsqf(s * (1.0f / DM) + NORM_EPS); }
}
#define LDS_WAIT() asm volatile("s_waitcnt lgkmcnt(0)" ::: "memory")
#define VM_WAIT() asm volatile("s_waitcnt vmcnt(0)" ::: "memory")

#define XB_TMO      128
#define XB_XCNT(j)  (256  + 64 * (j))
#define XB_XSUB(j)  (1280 + 64 * (j))
#define XB_XGEN(j)  (2304 + 64 * (j))
#define XB_TOP      3328
#define XB_TOPGEN   3392
#define XCD_BAR_WORDS 3456
#define XB_SPIN_CAP (1u << 20)

__device__ __forceinline__ unsigned xb_ld(unsigned* p)              { return __hip_atomic_load(p, __ATOMIC_RELAXED, __HIP_MEMORY_SCOPE_AGENT); }
__device__ __forceinline__ unsigned xb_add(unsigned* p, unsigned v) { return __hip_atomic_fetch_add(p, v, __ATOMIC_RELAXED, __HIP_MEMORY_SCOPE_AGENT); }
__device__ __forceinline__ unsigned xb_xcc_id() { return (unsigned)__builtin_amdgcn_s_getreg((3 << 11) | 20) & 0xFu; }
#define XB_SPIN(cond, bar) do { unsigned _sp = 0; while (cond) { __builtin_amdgcn_s_sleep(1); \
    if ((++_sp & 255u) == 0u) { if (xb_ld(&(bar)[XB_TMO])) break; if (_sp > XB_SPIN_CAP) { atomicAdd(&(bar)[XB_TMO], 1u); break; } } } } while (0)

struct XcdBarrier { unsigned* bar; unsigned x; volatile LAS unsigned* st; };

__device__ __forceinline__ XcdBarrier xcd_barrier_post(unsigned* bar, volatile LAS unsigned* st) {
    XcdBarrier b; b.bar = bar; b.x = xb_xcc_id(); b.st = st;
    if (threadIdx.x == 0) (void)xb_add(&bar[XB_XCNT(b.x)], 1u);
    return b;
}
__device__ __forceinline__ void xcd_barrier_complete(unsigned* bar, unsigned x, unsigned& nloc, unsigned& nx) {
    const unsigned G = gridDim.x * gridDim.y * gridDim.z;
    unsigned sum, cnt, mine, sp = 0u;
    for (;;) {
        sum = 0u; cnt = 0u;
#pragma unroll
        for (unsigned j = 0; j < 16; ++j) { const unsigned c = xb_ld(&bar[XB_XCNT(j)]); sum += c; cnt += (c > 0u) ? 1u : 0u; }
        mine = xb_ld(&bar[XB_XCNT(x)]);
        if (sum == G) break;
        __builtin_amdgcn_s_sleep(1);
        if ((++sp & 255u) == 0u) { if (xb_ld(&bar[XB_TMO])) break; if (sp > XB_SPIN_CAP) { atomicAdd(&bar[XB_TMO], 1u); break; } }
    }
    nloc = mine > 0u ? mine : 1u; nx = cnt > 0u ? cnt : 1u;
}
__device__ __forceinline__ void xcd_barrier(const XcdBarrier& b) {
    asm volatile("s_waitcnt vmcnt(0)" ::: "memory");
    __syncthreads();
    if (threadIdx.x == 0) {
        unsigned* bar = b.bar; unsigned bx_ = b.x; asm volatile("" : "+s"(bx_));
        __builtin_amdgcn_s_waitcnt(0);
        unsigned nloc = b.st[0], nx = b.st[1];
        if (nloc == 0u) { xcd_barrier_complete(bar, bx_, nloc, nx); b.st[0] = nloc; b.st[1] = nx; }
        const unsigned old = xb_add(&bar[XB_XSUB(bx_)], 1u);
        const unsigned gen = old / nloc;
        if (old + 1u == (gen + 1u) * nloc) {
            __builtin_amdgcn_fence(__ATOMIC_RELEASE, "agent");
            asm volatile("s_waitcnt vmcnt(0)" ::: "memory");
            const unsigned og = xb_add(&bar[XB_TOP], 1u);
            const unsigned tg = og / nx;
            if (og + 1u == (tg + 1u) * nx) xb_add(&bar[XB_TOPGEN], 1u);
            else XB_SPIN(xb_ld(&bar[XB_TOPGEN]) == tg, bar);
            __builtin_amdgcn_fence(__ATOMIC_ACQUIRE, "agent");
            xb_add(&bar[XB_XGEN(bx_)], 1u);
            asm volatile("s_waitcnt vmcnt(0)" ::: "memory");
        } else {
            XB_SPIN(xb_ld(&bar[XB_XGEN(bx_)]) == gen, bar);
            __builtin_amdgcn_fence(__ATOMIC_ACQUIRE, "agent");
            asm volatile("s_waitcnt vmcnt(0)" ::: "memory");
        }
    }
    __syncthreads();
}

#define GS_XCC_WORD 8192
#define GS_CNT_WORD 9216
__device__ __forceinline__ void group_sync(unsigned* ctl, int gid, unsigned need) {
    asm volatile("s_waitcnt vmcnt(0)" ::: "memory");
    __syncthreads();
    if (threadIdx.x == 0) {
        unsigned* c = ctl + GS_CNT_WORD + 64 * gid;
        (void)xb_add(c, 1u);
        XB_SPIN(xb_ld(c) < need, ctl);
        __builtin_amdgcn_fence(__ATOMIC_ACQUIRE, "agent");
        asm volatile("s_waitcnt vmcnt(0)" ::: "memory");
    }
    __syncthreads();
}

namespace pg8 {
constexpr int BM = 256, BK = 64, HALF = 128, HTB = HALF * BK * 2, STAGE_BYTES = 8 * HTB, NXCD = 8, WGM = 8;
__device__ __forceinline__ int lds_byte(int r, int c) { const int st = (r >> 4) * 2 + (c >> 5), rr = r & 15, cc = c & 31, ob = rr * 64 + cc * 2; return st * 1024 + (ob ^ (((ob >> 9) & 1) << 5)); }
__device__ __forceinline__ void stage_rc(int b, int& R, int& C) { const int st = b / 1024, sb = b % 1024, swz = sb ^ (((sb >> 9) & 1) << 5); R = (st >> 1) * 16 + swz / 64; C = (st & 1) * 32 + (swz % 64) / 2; }

struct Unit { int pm, pn, g; const char* a; const char* b; };

struct DenseOrder {
    int nM, nN, nwg, G, c, pmdiv; const char* A; const char* B; size_t tA, tB, bgroup;
    __device__ __forceinline__ void init(const void* A_, int lda, const void* B_, int ldb, int M, int N, int G_, int c_, int pmdiv_ = 1 << 30, size_t bgroup_ = 0) {
        nM = M / BM; nN = N / BM; nwg = nM * nN; G = G_; c = c_; A = (const char*)A_; B = (const char*)B_; tA = (size_t)BM * lda * 2; tB = (size_t)BM * ldb * 2; pmdiv = pmdiv_; bgroup = bgroup_; }
    __device__ __forceinline__ bool next(int i, Unit& u) const {
        const long L = (long)i * G + c; if (L >= nwg) return false;
        int wgid = (int)L; { const int q = nwg / NXCD, r = nwg % NXCD, xcd = wgid % NXCD, off = wgid / NXCD; wgid = (xcd < r ? xcd * (q + 1) : r * (q + 1) + (xcd - r) * q) + off; }
        const int nig = WGM * nN, gid = wgid / nig, fm = gid * WGM, gsz = (nM - fm) < WGM ? (nM - fm) : WGM;
        u.pm = fm + ((wgid % nig) % gsz); u.pn = (wgid % nig) / gsz; u.g = u.pm / pmdiv;
        u.a = A + (size_t)u.pm * tA; u.b = B + (size_t)u.pn * tB + (size_t)u.g * bgroup; return true;
    }
};

template <class Epi, class Sched>
__device__ __forceinline__ void gemm_phase(LAS unsigned char* lds, const int K, const int lda, const int ldb, const Sched& S, const Epi& E) {
    int tid = threadIdx.x; asm volatile("" : "+v"(tid));
    const int wid = __builtin_amdgcn_readfirstlane(tid >> 6), lane = tid & 63, wr = wid >> 2, wc = wid & 3, fr = lane & 15, fq = lane >> 4;
    const int nt = K / BK;
    unsigned voffA[2], voffB[2];
#pragma unroll
    for (int i = 0; i < 2; ++i) { int R, C; stage_rc(tid * 16 + i * 8192, R, C);
        const int Rb = Epi::PERM ? ((R & ~31) + 8 * ((R & 15) >> 2) + 4 * ((R >> 4) & 1) + (R & 3)) : R;
        voffA[i] = (unsigned)(R * lda + C) * 2u; voffB[i] = (unsigned)(Rb * ldb + C) * 2u; }
    const size_t kstep = (size_t)(BK * 2);
    const size_t hstepA = (size_t)HALF * lda * 2, hstepB = (size_t)HALF * ldb * 2;
    const unsigned ldsw = (unsigned)wid * 1024u;
    const int aoff = lds_byte(wr * 64 + fr, fq * 8), boff = lds_byte(wc * 32 + fr, fq * 8);
#define PG8_SA(b, h) (((b) * 2 + (h)) * HTB)
#define PG8_SB(b, h) ((4 + (b) * 2 + (h)) * HTB)
#ifndef PG8_AUX_A
#define PG8_AUX_A 0
#endif
#ifndef PG8_AUX_B
#define PG8_AUX_B 0
#endif
#define PG8_STAGE_X(bufoff, gbase, voff, AUX) do { _Pragma("unroll") for (int _i = 0; _i < 2; ++_i) \
        __builtin_amdgcn_global_load_lds((const unsigned*)((const char*)(gbase) + (voff)[_i]), (LAS unsigned*)(lds + (bufoff) + ldsw + _i * 8192), 16, 0, AUX); } while (0)
#define PG8_STAGE_voffA(bufoff, gbase) PG8_STAGE_X(bufoff, gbase, voffA, PG8_AUX_A)
#define PG8_STAGE_voffB(bufoff, gbase) PG8_STAGE_X(bufoff, gbase, voffB, PG8_AUX_B)
#define PG8_STAGE(bufoff, gbase, voff) PG8_STAGE_##voff(bufoff, gbase)
#define PG8_LDA(dst, b, h) do { _Pragma("unroll") for (int m = 0; m < 4; ++m) _Pragma("unroll") for (int k = 0; k < 2; ++k) dst[m][k] = *(const LAS bf16x8*)(lds + PG8_SA(b, h) + aoff + m * 2048 + k * 1024); } while (0)
#define PG8_LDB(dst, b, h) do { _Pragma("unroll") for (int n = 0; n < 2; ++n) _Pragma("unroll") for (int k = 0; k < 2; ++k) dst[n][k] = *(const LAS bf16x8*)(lds + PG8_SB(b, h) + boff + n * 2048 + k * 1024); } while (0)
#define PG8_MMA(ai, bj, At, Bt) do { __builtin_amdgcn_s_setprio(1); _Pragma("unroll") for (int m = 0; m < 4; ++m) _Pragma("unroll") for (int n = 0; n < 2; ++n) _Pragma("unroll") for (int k = 0; k < 2; ++k) \
        acc[ai][bj][m][n] = __builtin_amdgcn_mfma_f32_16x16x32_bf16(Bt[n][k], At[m][k], acc[ai][bj][m][n], 0, 0, 0); __builtin_amdgcn_s_setprio(0); } while (0)
#define PG8_WAIT_V(n) asm volatile("s_waitcnt vmcnt(" #n ")" ::: "memory")
#define PG8_WAIT_L(n) asm volatile("s_waitcnt lgkmcnt(" #n ")" ::: "memory")
#define PG8_BAR __builtin_amdgcn_s_barrier()
#define PG8_SCHED __builtin_amdgcn_sched_barrier(0)
    Unit cur, nxt; int ui = 0;
    if (!S.next(0, cur)) return;
    f32x4 acc[2][2][4][2];
#pragma unroll
    for (int a = 0; a < 2; ++a)
#pragma unroll
        for (int b = 0; b < 2; ++b)
#pragma unroll
            for (int m = 0; m < 4; ++m)
#pragma unroll
                for (int n = 0; n < 2; ++n) acc[a][b][m][n] = (f32x4){0.f, 0.f, 0.f, 0.f};
    bf16x8 At[4][2], B0[2][2], B1[2][2];
    const char* cA = cur.a; const char* cB = cur.b;
    PG8_STAGE(PG8_SB(0, 0), cB, voffB); PG8_STAGE(PG8_SA(0, 0), cA, voffA); PG8_STAGE(PG8_SB(0, 1), cB + hstepB, voffB); PG8_STAGE(PG8_SA(0, 1), cA + hstepA, voffA);
    if (wr == 1) PG8_BAR;
    PG8_WAIT_V(4); PG8_BAR;
    PG8_STAGE(PG8_SB(1, 0), cB + kstep, voffB); PG8_STAGE(PG8_SA(1, 0), cA + kstep, voffA); PG8_STAGE(PG8_SB(1, 1), cB + hstepB + kstep, voffB);
    PG8_WAIT_V(6); PG8_BAR;
    for (;;) {
        const bool has_next = S.next(ui + 1, nxt);
        const char* nA = has_next ? nxt.a : cA; const char* nB = has_next ? nxt.b : cB;
#if defined(KREP_DIAG)
        const int nt_eff = Epi::REPEATABLE ? 2 * nt : nt;
#else
        const int nt_eff = nt;
#endif
        for (int tt = 0; tt < nt_eff; tt += 2) {
            const bool last = (tt == nt_eff - 2);
            const int t = tt >= nt ? tt - nt : tt, t2 = (tt + 2 >= nt && tt + 2 < nt_eff) ? tt + 2 - nt : tt + 2;
            const char* a1 = cA + (size_t)(t + 1) * kstep;
            const char* a2 = last ? nA : cA + (size_t)t2 * kstep; const char* b2 = last ? nB : cB + (size_t)t2 * kstep;
            const char* a3 = a2 + kstep; const char* b3 = b2 + kstep;
            PG8_LDB(B0, 0, 0); PG8_SCHED; PG8_LDA(At, 0, 0); PG8_STAGE(PG8_SA(1, 1), a1 + hstepA, voffA);
            PG8_WAIT_L(8); PG8_BAR; PG8_WAIT_L(0); PG8_MMA(0, 0, At, B0); PG8_BAR; PG8_SCHED;
            PG8_LDB(B1, 0, 1); PG8_STAGE(PG8_SB(0, 0), b2, voffB);
            PG8_BAR; PG8_WAIT_L(0); PG8_MMA(0, 1, At, B1); PG8_BAR;
            PG8_LDA(At, 0, 1); PG8_STAGE(PG8_SA(0, 0), a2, voffA);
            PG8_BAR; PG8_WAIT_L(0); PG8_MMA(1, 0, At, B0); PG8_BAR; PG8_SCHED;
            PG8_STAGE(PG8_SB(0, 1), b2 + hstepB, voffB);
            PG8_WAIT_V(6); PG8_BAR; PG8_MMA(1, 1, At, B1); PG8_BAR;
            PG8_LDB(B0, 1, 0); PG8_SCHED; PG8_LDA(At, 1, 0); PG8_STAGE(PG8_SA(0, 1), a2 + hstepA, voffA);
            PG8_WAIT_L(8); PG8_BAR; PG8_WAIT_L(0); PG8_MMA(0, 0, At, B0); PG8_BAR; PG8_SCHED;
            PG8_LDB(B1, 1, 1); PG8_STAGE(PG8_SB(1, 0), b3, voffB);
            PG8_BAR; PG8_WAIT_L(0); PG8_MMA(0, 1, At, B1); PG8_BAR;
            PG8_LDA(At, 1, 1); PG8_STAGE(PG8_SA(1, 0), a3, voffA);
            PG8_BAR; PG8_WAIT_L(0); PG8_MMA(1, 0, At, B0); PG8_BAR; PG8_SCHED;
            PG8_STAGE(PG8_SB(1, 1), b3 + hstepB, voffB);
            PG8_WAIT_V(6); PG8_BAR; PG8_MMA(1, 1, At, B1); PG8_BAR;
        }
        E(acc, cur, wr, wc, fr, fq);
#if defined(REP_EPI)
        if constexpr (Epi::REPEATABLE) { asm volatile("" ::: "memory"); Epi E2 = E; E2.dry = true; E2(acc, cur, wr, wc, fr, fq); }
#endif
        if (!has_next) break;
#pragma unroll
        for (int a = 0; a < 2; ++a)
#pragma unroll
            for (int b = 0; b < 2; ++b)
#pragma unroll
                for (int m = 0; m < 4; ++m)
#pragma unroll
                    for (int n = 0; n < 2; ++n) acc[a][b][m][n] = (f32x4){0.f, 0.f, 0.f, 0.f};
        cur = nxt; cA = nA; cB = nB; ++ui;
    }
    PG8_WAIT_V(0);
    if (wr == 0) PG8_BAR;
    PG8_BAR;
#undef PG8_SA
#undef PG8_SB
#undef PG8_STAGE
#undef PG8_STAGE_X
#undef PG8_STAGE_voffA
#undef PG8_STAGE_voffB
#undef PG8_LDA
#undef PG8_LDB
#undef PG8_MMA
#undef PG8_WAIT_V
#undef PG8_WAIT_L
#undef PG8_BAR
#undef PG8_SCHED
}
}

typedef f32x4 acc_t[2][2][4][2];
#define EPI_ROWS(ai, m) _Pragma("unroll") for (int ai = 0; ai < 2; ++ai) _Pragma("unroll") for (int m = 0; m < 4; ++m)
#define EPI_COLS(bj, n) _Pragma("unroll") for (int bj = 0; bj < 2; ++bj) _Pragma("unroll") for (int n = 0; n < 2; ++n)

struct EpiBf16Plain {
    static constexpr bool REPEATABLE = false; static constexpr bool PERM = false;
    bf16_t* O; int ldo; const float* colscale; float scale;
    __device__ __forceinline__ void operator()(acc_t& acc, const pg8::Unit& u, int wr, int wc, int fr, int fq) const {
        const int row0 = u.pm * 256 + wr * 64 + fr, col0 = u.pn * 256 + wc * 32 + 4 * fq;
        f32x4 cs[2][2];
        EPI_COLS(bj, n) { cs[bj][n] = colscale ? *(const f32x4*)(colscale + col0 + bj * 128 + n * 16) * scale : (f32x4){scale, scale, scale, scale}; }
        EPI_ROWS(ai, m) { bf16_t* rowp = O + (size_t)(row0 + ai * 128 + m * 16) * ldo + col0;
            EPI_COLS(bj, n) { *(u32x2*)(rowp + bj * 128 + n * 16) = pack4(acc[ai][bj][m][n] * cs[bj][n]); } }
    }
};
struct EpiWqK {
    static constexpr bool REPEATABLE = false; static constexpr bool PERM = false;
    bf16_t* O; const float* gain;
    __device__ __forceinline__ void operator()(acc_t& acc, const pg8::Unit& u, int wr, int wc, int fr, int fq) const {
        const int l = u.g >> 3, lb = u.g >> 2, h = u.g & 3;
        const int row0 = wr * 64 + fr, col0 = u.pn * 256 + wc * 32 + 4 * fq;
        bf16_t* base = O + ((size_t)lb * 1024 + h * 256) * 2048;
        const float* gl = gain + l * 2048;
        f32x4 cs[2][2];
        EPI_COLS(bj, n) { cs[bj][n] = *(const f32x4*)(gl + col0 + bj * 128 + n * 16) * 0.04419417382415922f; }
        EPI_ROWS(ai, m) { bf16_t* rowp = base + (size_t)(row0 + ai * 128 + m * 16) * 2048 + col0;
            EPI_COLS(bj, n) { *(u32x2*)(rowp + bj * 128 + n * 16) = pack4(acc[ai][bj][m][n] * cs[bj][n]); } }
    }
};
struct EpiVWo {
    static constexpr bool REPEATABLE = false; static constexpr bool PERM = false;
    bf16_t* O;
    __device__ __forceinline__ void operator()(acc_t& acc, const pg8::Unit& u, int wr, int wc, int fr, int fq) const {
        const int lb = u.g >> 2, h = u.g & 3;
        const int row0 = u.pm * 256 + wr * 64 + fr, col0 = h * 256 + wc * 32 + 4 * fq;
        bf16_t* base = O + (size_t)lb * 2048 * 1024;
        EPI_ROWS(ai, m) { bf16_t* rowp = base + (size_t)(row0 + ai * 128 + m * 16) * 1024 + col0;
            EPI_COLS(bj, n) { *(u32x2*)(rowp + bj * 128 + n * 16) = pack4(acc[ai][bj][m][n]); } }
    }
};
struct EpiF32 {
    static constexpr bool REPEATABLE = false; static constexpr bool PERM = false;
    float* C; int ldc;
    __device__ __forceinline__ void operator()(acc_t& acc, const pg8::Unit& u, int wr, int wc, int fr, int fq) const {
        const int row0 = u.pm * 256 + wr * 64 + fr, col0 = u.pn * 256 + wc * 32 + 4 * fq;
        EPI_ROWS(ai, m) { float* rowp = C + (size_t)(row0 + ai * 128 + m * 16) * ldc + col0;
            EPI_COLS(bj, n) { *(f32x4*)(rowp + bj * 128 + n * 16) = acc[ai][bj][m][n]; } }
    }
};
struct EpiProj {
    static constexpr bool REPEATABLE = false; static constexpr bool PERM = false;
    LAS const float* rstd_tab; const float* rc; const float* rs; bf16_t* O; int ldo; bf16_t* U2; int u_tiles, rope_lo, rope_hi;
    __device__ __forceinline__ void operator()(acc_t& acc, const pg8::Unit& u, int wr, int wc, int fr, int fq) const {
        const int row0 = u.pm * 256 + wr * 64 + fr;
        const bool is_u = u.pn < u_tiles, rope = (u.pn >= rope_lo) && (u.pn < rope_hi) && (wc == 0);
        EPI_ROWS(ai, m) {
            const int row = row0 + ai * 128 + m * 16;
            const float rstd = rstd_tab[ai * 128 + wr * 64 + m * 16 + fr];
            f32x4 v[2][2];
            EPI_COLS(bj, n) { v[bj][n] = acc[ai][bj][m][n] * rstd; }
            if (rope) {
                const int pos = row & (SEQ - 1);
#if defined(ROPE_TABLE)
                const f32x4 c = *(const f32x4*)(rc + pos * 16 + 4 * fq), s = *(const f32x4*)(rs + pos * 16 + 4 * fq);
#else
                f32x4 c, s;
#pragma unroll
                for (int e = 0; e < 4; ++e) { const float invrev = __builtin_amdgcn_exp2f(-1.1832230355827609f * (float)(4 * fq + e) - 2.6514961294723187f);
                    const float fr_ = __builtin_amdgcn_fractf((float)pos * invrev); c[e] = __builtin_amdgcn_cosf(fr_); s[e] = __builtin_amdgcn_sinf(fr_); }
#endif
#pragma unroll
                for (int bj = 0; bj < 2; ++bj) { const f32x4 x1 = v[bj][0], x2 = v[bj][1]; v[bj][0] = x1 * c - x2 * s; v[bj][1] = x2 * c + x1 * s; }
            }
            if (is_u) {
                const int cg = row >> 5, t = row & 31;
                EPI_COLS(bj, n) { const int g = (u.pn * 256 + bj * 128 + wc * 32 + n * 16) >> 4;
                    *(u32x2*)(U2 + ((size_t)g * S5NCH + cg) * S5KT + t * 16 + 4 * fq) = pack4(v[bj][n]); }
            } else if (ldo == 0) {
                const int t = u.pn - u_tiles, which = t >> 3, b = row >> 13, pos = row & (SEQ - 1);
#pragma unroll
                for (int bj = 0; bj < 2; ++bj) { const int h = 2 * (t & 7) + bj;
                    bf16_t* rowp = O + (size_t)which * MTOK * DM + ((size_t)(b * 16 + h) * SEQ + pos) * 128 + wc * 32 + 4 * fq;
#pragma unroll
                    for (int n = 0; n < 2; ++n) *(u32x2*)(rowp + n * 16) = pack4(v[bj][n]); }
            } else {
                bf16_t* rowp = O + (size_t)row * ldo + (u.pn - u_tiles) * 256 + wc * 32 + 4 * fq;
                EPI_COLS(bj, n) { *(u32x2*)(rowp + bj * 128 + n * 16) = pack4(v[bj][n]); }
            }
        }
    }
};
struct EpiRes {
    static constexpr bool REPEATABLE = false; static constexpr bool PERM = true;
    const float* base32; bf16_t* HB; float* rss_next; bool dry = false;
    __device__ __forceinline__ void operator()(acc_t& acc, const pg8::Unit& u, int wr, int wc, int fr, int fq) const {
        const int row0 = u.pm * 256 + wr * 64 + fr, col0 = u.pn * 256 + wc * 32 + 8 * fq;
        EPI_ROWS(ai, m) {
            const int row = row0 + ai * 128 + m * 16; const size_t off = (size_t)row * DM + col0; float ss = 0.f;
            if (base32) {
                EPI_COLS(bj, n) { acc[ai][bj][m][n] += *(const f32x4*)(base32 + off + bj * 128 + n * 4); }
            } else {
#pragma unroll
                for (int bj = 0; bj < 2; ++bj) { const u32x4 w = *(const u32x4*)(HB + off + bj * 128);
                    acc[ai][bj][m][0] += (f32x4){bf2f(w.x & 0xffffu), bf2f(w.x >> 16), bf2f(w.y & 0xffffu), bf2f(w.y >> 16)};
                    acc[ai][bj][m][1] += (f32x4){bf2f(w.z & 0xffffu), bf2f(w.z >> 16), bf2f(w.w & 0xffffu), bf2f(w.w >> 16)}; }
            }
#pragma unroll
            for (int bj = 0; bj < 2; ++bj) { const f32x4 o0 = acc[ai][bj][m][0], o1 = acc[ai][bj][m][1]; const u32x2 w0 = pack4(o0), w1 = pack4(o1); const u32x4 w = {w0.x, w0.y, w1.x, w1.y};
                if (dry) { asm volatile("" :: "v"(w.x), "v"(w.y), "v"(w.z), "v"(w.w)); } else { *(u32x4*)(HB + off + bj * 128) = w; }
                ss += ((o0[0] * o0[0] + o0[1] * o0[1]) + (o0[2] * o0[2] + o0[3] * o0[3])) + ((o1[0] * o1[0] + o1[1] * o1[1]) + (o1[2] * o1[2] + o1[3] * o1[3])); }
            ss = x16_sum(ss);
            if (fq == 0 && !dry) rss_next[(size_t)row * 32 + u.pn * 4 + wc] = ss;
        }
    }
};
struct EpiSoftmax {
    static constexpr bool REPEATABLE = false; static constexpr bool PERM = false;
    LAS const float* rstd_tab; bf16_t* P; LAS float* xch;
    __device__ __forceinline__ void operator()(acc_t& acc, const pg8::Unit& u, int wr, int wc, int fr, int fq) const {
        const int row0 = u.pm * 256 + wr * 64 + fr;
        LAS float* xmax = xch; LAS float* xsum = xch + 1024;
        EPI_ROWS(ai, m) {
            const int rl = ai * 128 + wr * 64 + m * 16 + fr, row = u.pm * 256 + rl;
            const float rstd = rstd_tab[rl] * 1.4426950408889634f;
            float mx = -3.0e38f;
            EPI_COLS(bj, n) { const f32x4 s = acc[ai][bj][m][n] * rstd; acc[ai][bj][m][n] = s; mx = fmaxf(mx, fmaxf(fmaxf(s[0], s[1]), fmaxf(s[2], s[3]))); }
            mx = x16_max(mx);
            if (fq == 0) xmax[rl * 4 + wc] = mx;
        }
        LDS_WAIT(); __builtin_amdgcn_s_barrier(); asm volatile("" ::: "memory");
        EPI_ROWS(ai, m) {
            const int rl = ai * 128 + wr * 64 + m * 16 + fr;
            const f32x4 m4 = *(const LAS f32x4*)(xmax + rl * 4); const float mx = fmaxf(fmaxf(m4[0], m4[1]), fmaxf(m4[2], m4[3]));
            float sm = 0.f;
            EPI_COLS(bj, n) { f32x4 s = acc[ai][bj][m][n];
#pragma unroll
                for (int j = 0; j < 4; ++j) s[j] = __builtin_amdgcn_exp2f(s[j] - mx);
                acc[ai][bj][m][n] = s; sm += (s[0] + s[1]) + (s[2] + s[3]); }
            sm = x16_sum(sm);
            if (fq == 0) xsum[rl * 4 + wc] = sm;
        }
        LDS_WAIT(); __builtin_amdgcn_s_barrier(); asm volatile("" ::: "memory");
        EPI_ROWS(ai, m) {
            const int rl = ai * 128 + wr * 64 + m * 16 + fr;
            const f32x4 s4 = *(const LAS f32x4*)(xsum + rl * 4); const float inv = __builtin_amdgcn_rcpf((s4[0] + s4[1]) + (s4[2] + s4[3]));
            bf16_t* rowp = P + (size_t)(row0 + ai * 128 + m * 16) * 1024 + u.pn * 256 + wc * 32 + 4 * fq;
            EPI_COLS(bj, n) { *(u32x2*)(rowp + bj * 128 + n * 16) = pack4(acc[ai][bj][m][n] * inv); }
        }
    }
};
struct EpiSwiglu {
    static constexpr bool REPEATABLE = true; static constexpr bool PERM = true;
    LAS const float* rstd_tab; bf16_t* O; bool dry = false;
    __device__ __forceinline__ void operator()(acc_t& acc, const pg8::Unit& u, int wr, int wc, int fr, int fq) const {
        const int row0 = u.pm * 256 + wr * 64 + fr;
        EPI_ROWS(ai, m) {
            const int row = row0 + ai * 128 + m * 16;
#if defined(KREP_DIAG)
            const float rstd = 0.5f * rstd_tab[ai * 128 + wr * 64 + m * 16 + fr];
#else
            const float rstd = rstd_tab[ai * 128 + wr * 64 + m * 16 + fr];
#endif
            bf16_t* rowp = O + (size_t)row * FFN + u.pn * 128 + wc * 32 + 8 * fq;
            u32x2 wn[2];
            const float kk = -1.4426950408889634f * rstd, r2 = rstd * rstd;
            f32x4 e2[2], ab[2];
#pragma unroll
            for (int n = 0; n < 2; ++n)
#pragma unroll
                for (int j = 0; j < 4; ++j) e2[n][j] = __builtin_amdgcn_exp2f(acc[ai][0][m][n][j] * kk);
#pragma unroll
            for (int n = 0; n < 2; ++n) ab[n] = acc[ai][0][m][n] * acc[ai][1][m][n] * r2;
#pragma unroll
            for (int n = 0; n < 2; ++n)
#pragma unroll
                for (int j = 0; j < 4; ++j) e2[n][j] = __builtin_amdgcn_rcpf(1.0f + e2[n][j]);
#pragma unroll
            for (int n = 0; n < 2; ++n) wn[n] = pack4(ab[n] * e2[n]);
            { const u32x4 w = {wn[0].x, wn[0].y, wn[1].x, wn[1].y}; if (dry) { asm volatile("" :: "v"(w.x), "v"(w.y), "v"(w.z), "v"(w.w)); } else { *(u32x4*)rowp = w; } }
        }
    }
};
__device__ __forceinline__ float gelu_tanh(float x) { const float z = 0.7978845608028654f * (x + 0.044715f * x * x * x); const float e = __builtin_amdgcn_exp2f(2.8853900817779268f * z); return x * (1.0f - __builtin_amdgcn_rcpf(1.0f + e)); }
struct EpiS5Y {
    static constexpr bool REPEATABLE = false; static constexpr bool PERM = false;
    bf16_t* G;
    __device__ __forceinline__ void operator()(acc_t& acc, const pg8::Unit& u, int wr, int wc, int fr, int fq) const {
        const int g = u.pm >> 1;
        EPI_ROWS(ai, m) {
            const int cg = (u.pm & 1) * 256 + ai * 128 + wr * 64 + m * 16 + fr;
            EPI_COLS(bj, n) { const int t = (u.pn * 256 + bj * 128 + wc * 32 + n * 16) >> 4; const f32x4 y = acc[ai][bj][m][n]; f32x4 o;
#pragma unroll
                for (int j = 0; j < 4; ++j) o[j] = gelu_tanh(y[j]);
                *(u32x2*)(G + (size_t)(cg * S5L + t) * 1024 + g * 16 + 4 * fq) = pack4(o); }
        }
    }
};
struct EpiGlu {
    static constexpr bool REPEATABLE = false; static constexpr bool PERM = false;
    const bf16_t* G; const float* bias; bf16_t* O;
    __device__ __forceinline__ void operator()(acc_t& acc, const pg8::Unit& u, int wr, int wc, int fr, int fq) const {
        const int row0 = u.pm * 256 + wr * 64 + fr, col0 = u.pn * 256 + wc * 32 + 4 * fq;
        f32x4 bv[2][2];
        EPI_COLS(bj, n) { bv[bj][n] = *(const f32x4*)(bias + col0 + bj * 128 + n * 16); }
        EPI_ROWS(ai, m) {
            const int row = row0 + ai * 128 + m * 16;
            EPI_COLS(bj, n) { const int c = col0 + bj * 128 + n * 16; const u32x2 gw = *(const u32x2*)(G + (size_t)row * 1024 + c);
                const f32x4 s = acc[ai][bj][m][n] + bv[bj][n]; f32x4 o;
                const float g0 = bf2f(gw.x & 0xffffu), g1 = bf2f(gw.x >> 16), g2 = bf2f(gw.y & 0xffffu), g3 = bf2f(gw.y >> 16);
                o[0] = g0 * __builtin_amdgcn_rcpf(1.0f + __builtin_amdgcn_exp2f(-1.4426950408889634f * s[0])); o[1] = g1 * __builtin_amdgcn_rcpf(1.0f + __builtin_amdgcn_exp2f(-1.4426950408889634f * s[1])); o[2] = g2 * __builtin_amdgcn_rcpf(1.0f + __builtin_amdgcn_exp2f(-1.4426950408889634f * s[2])); o[3] = g3 * __builtin_amdgcn_rcpf(1.0f + __builtin_amdgcn_exp2f(-1.4426950408889634f * s[3]));
                *(u32x2*)(O + (size_t)row * DM + c) = pack4(o); }
        }
    }
};

namespace att {
constexpr int D = 128, NW = 8, QBLK = 32, KVBLK = 64;
constexpr float SCALE = 0.088388347648318440f;
constexpr float THR = 8.f;
constexpr size_t SHM_V = KVBLK * D * 2, SHM_K = KVBLK * D * 2, SHM_ATTN = 2 * SHM_V + 2 * SHM_K + NW * 64 * 4;
#define KSWZ(row, colB) ((row) * 256 + ((colB) ^ (((row) & 15) << 4)))
#define SBAR() __builtin_amdgcn_sched_barrier(0)
__device__ __forceinline__ int crow(int r, int hi) { return (r & 3) + 8 * (r >> 2) + 4 * hi; }
__device__ __forceinline__ unsigned cvtpk(float lo, float hi) { unsigned r; asm volatile("v_cvt_pk_bf16_f32 %0, %1, %2" : "=v"(r) : "v"(lo), "v"(hi)); return r; }

__device__ __forceinline__ void partialSM(f32x16& p0, f32x16& p1, float& m_reg, float& mn, float& alpha) {
  constexpr float C = SCALE * 1.4426950408889634f;
  float pmax = p0[0];
#pragma unroll
  for (int r = 1; r < 16; ++r) pmax = fmaxf(pmax, p0[r]);
#pragma unroll
  for (int r = 0; r < 16; ++r) pmax = fmaxf(pmax, p1[r]);
  { auto rr = __builtin_amdgcn_permlane32_swap(__float_as_uint(pmax), __float_as_uint(pmax), false, false);
    pmax = fmaxf(__uint_as_float(rr[0]), __uint_as_float(rr[1])); }
  if (__builtin_expect(__all(pmax - m_reg <= THR / SCALE), 1)) { mn = m_reg; alpha = 1.f; }
  else { mn = fmaxf(m_reg, pmax); alpha = __builtin_amdgcn_exp2f((m_reg - mn) * C); m_reg = mn; }
  float mnC = -mn * C;
#pragma unroll
  for (int r = 0; r < 16; ++r) p0[r] = fmaf(p0[r], C, mnC);
#pragma unroll
  for (int r = 0; r < 16; ++r) p1[r] = fmaf(p1[r], C, mnC);
#pragma unroll
  for (int r = 0; r < 16; ++r) p0[r] = __builtin_amdgcn_exp2f(p0[r]);
}
__device__ __forceinline__ void finishSM(f32x16& p0, f32x16& p1, float alpha, float& l_reg, bf16x8& pa0, bf16x8& pa1, bf16x8& pa2, bf16x8& pa3) {
#pragma unroll
  for (int r = 0; r < 16; ++r) p1[r] = __builtin_amdgcn_exp2f(p1[r]);
  float ps = 0;
#pragma unroll
  for (int r = 0; r < 16; ++r) ps += p0[r];
#pragma unroll
  for (int r = 0; r < 16; ++r) ps += p1[r];
  { auto rr = __builtin_amdgcn_permlane32_swap(__float_as_uint(ps), __float_as_uint(ps), false, false);
    ps = __uint_as_float(rr[0]) + __uint_as_float(rr[1]); }
  l_reg = l_reg * alpha + ps;
#define PK4(P, BASE, OUT) do { unsigned a0 = cvtpk(P[BASE + 0], P[BASE + 1]), a1 = cvtpk(P[BASE + 2], P[BASE + 3]);   \
    unsigned b0 = cvtpk(P[BASE + 4], P[BASE + 5]), b1 = cvtpk(P[BASE + 6], P[BASE + 7]);                              \
    auto r0 = __builtin_amdgcn_permlane32_swap(a0, b0, false, false); auto r1 = __builtin_amdgcn_permlane32_swap(a1, b1, false, false); \
    u32x4 w = {r0[0], r1[0], r0[1], r1[1]}; OUT = *reinterpret_cast<bf16x8*>(&w); } while (0)
  PK4(p0, 0, pa0); PK4(p0, 8, pa1); PK4(p1, 0, pa2); PK4(p1, 8, pa3);
#undef PK4
}
__device__ __forceinline__ void qkt(f32x16& p0, f32x16& p1, const char* Ks, const bf16x8* qr, int r32, int hi) {
  p0 = f32x16{}; p1 = f32x16{};
#pragma unroll
  for (int d0 = 0; d0 < 8; ++d0) { int cb = (d0 * 16 + hi * 8) * 2;
    bf16x8 b0 = *reinterpret_cast<const bf16x8*>(Ks + KSWZ(r32, cb));
    bf16x8 b1 = *reinterpret_cast<const bf16x8*>(Ks + KSWZ(32 + r32, cb));
    p0 = __builtin_amdgcn_mfma_f32_32x32x16_bf16(b0, qr[d0], p0, 0, 0, 0);
    p1 = __builtin_amdgcn_mfma_f32_32x32x16_bf16(b1, qr[d0], p1, 0, 0, 0); }
}
__device__ __forceinline__ void mask_tile(f32x16& p0, f32x16& p1, int tb, int kq, int Mr, int hi) {
#pragma unroll
  for (int r = 0; r < 16; ++r) { const int tt = tb + crow(r, hi);
    const bool ok0 = ((unsigned)tt <= 128u) && ((unsigned)(kq + tt) < (unsigned)Mr);
    const bool ok1 = ((unsigned)(tt + 32) <= 128u) && ((unsigned)(kq + tt + 32) < (unsigned)Mr);
    p0[r] = ok0 ? p0[r] : -3.0e4f; p1[r] = ok1 ? p1[r] : -3.0e4f; }
}
__device__ __forceinline__ int v_st(int k, int c) { const int kk = (k & ~0xC) | ((k & 4) << 1) | ((k & 8) >> 1); return ((kk >> 3) * 4 + (c >> 5)) * 512 + ((kk & 7) * 32 + (c & 31)) * 2; }
__device__ __forceinline__ int v_rd_base(int lane) { return ((lane & 3) << 3) | (((lane >> 2) & 3) << 6) | (((lane >> 4) & 1) << 5) | (((lane >> 5) & 1) << 8); }
constexpr int v_rd_off(int d0, int ks, int half) { return d0 * 512 + ks * 4096 + half * 2048; }
template <int OFF> __device__ __forceinline__ s16x4 tr_read(int vb) {
  s16x4 r; asm volatile("ds_read_b64_tr_b16 %0, %1 offset:%2" : "=&v"(r) : "v"(vb), "i"(OFF) : "memory"); return r;
}
template <int D0> __device__ __forceinline__ void pv_one(f32x16& od, int vb, bf16x8 pa0, bf16x8 pa1, bf16x8 pa2, bf16x8 pa3) {
  const s16x4 l0 = tr_read<v_rd_off(D0, 0, 0)>(vb), h0 = tr_read<v_rd_off(D0, 0, 1)>(vb), l1 = tr_read<v_rd_off(D0, 1, 0)>(vb), h1 = tr_read<v_rd_off(D0, 1, 1)>(vb);
  const s16x4 l2 = tr_read<v_rd_off(D0, 2, 0)>(vb), h2 = tr_read<v_rd_off(D0, 2, 1)>(vb), l3 = tr_read<v_rd_off(D0, 3, 0)>(vb), h3 = tr_read<v_rd_off(D0, 3, 1)>(vb);
  asm volatile("s_waitcnt lgkmcnt(0)" ::: "memory"); SBAR();
#define PK(L, H) (bf16x8){L[0], L[1], L[2], L[3], H[0], H[1], H[2], H[3]}
  od = __builtin_amdgcn_mfma_f32_32x32x16_bf16(pa0, PK(l0, h0), od, 0, 0, 0);
  od = __builtin_amdgcn_mfma_f32_32x32x16_bf16(pa1, PK(l1, h1), od, 0, 0, 0);
  od = __builtin_amdgcn_mfma_f32_32x32x16_bf16(pa2, PK(l2, h2), od, 0, 0, 0);
  od = __builtin_amdgcn_mfma_f32_32x32x16_bf16(pa3, PK(l3, h3), od, 0, 0, 0);
#undef PK
}
__device__ __forceinline__ void pv_d0(f32x16* o, int vb, bf16x8 pa0, bf16x8 pa1, bf16x8 pa2, bf16x8 pa3) {
  pv_one<0>(o[0], vb, pa0, pa1, pa2, pa3); pv_one<1>(o[1], vb, pa0, pa1, pa2, pa3); pv_one<2>(o[2], vb, pa0, pa1, pa2, pa3); pv_one<3>(o[3], vb, pa0, pa1, pa2, pa3);
}

template <bool MASK>
__device__ __forceinline__ void attn_body(const bf16_t* __restrict__ Qb, const long ldq, const bf16_t* __restrict__ Kh, const bf16_t* __restrict__ Vh, const long ldk,
                                          const int kfirst, const int Mr, const int NT, bf16_t* __restrict__ Ob, const long ldo, float* __restrict__ lse, const long ldlse, char* lds) {
  int tid = threadIdx.x; asm volatile("" : "+v"(tid));
  const int wid = tid >> 6, lane = tid & 63, r32 = lane & 31, hi = lane >> 5;
  char* V_lds = lds; char* K_lds = lds + 2 * SHM_V;
  float* ws = (float*)(lds + 2 * SHM_V + 2 * SHM_K) + wid * 64; float* li_l = ws; float* al_l = ws + 32;
  float m_reg = -1e30f, l_reg = 0; f32x16 o[4] = {}; bf16x8 qr[8];
  const bf16_t* Qw = Qb + (long)(wid * QBLK + r32) * ldq + hi * 8;
#pragma unroll
  for (int d0 = 0; d0 < 8; ++d0) qr[d0] = *reinterpret_cast<const bf16x8*>(Qw + d0 * 16);
  const int sr = tid >> 4, sc = (tid & 15) * 8, vst0 = v_st(sr, sc), vst1 = v_st(32 + sr, sc);
  const int vb0 = (int)(uintptr_t)V_lds + v_rd_base(lane);
  const int qi = wid * QBLK + r32;
  struct { bf16x8 vs0, vs1, ks0, ks1; } sr_[2];
#define KROW(k0, rr) (MASK ? (long)min(max(kfirst + (k0) + (rr), 0), Mr - 1) : (long)((k0) + (rr)))
#define SLOAD(i, k0) do { const long _r0 = KROW(k0, sr) * ldk + sc, _r1 = KROW(k0, 32 + sr) * ldk + sc; \
    sr_[i].vs0 = *reinterpret_cast<const bf16x8*>(Vh + _r0); sr_[i].vs1 = *reinterpret_cast<const bf16x8*>(Vh + _r1); \
    sr_[i].ks0 = *reinterpret_cast<const bf16x8*>(Kh + _r0); sr_[i].ks1 = *reinterpret_cast<const bf16x8*>(Kh + _r1); } while (0)
#define SWRITE(b, i) do { *(bf16x8*)(V_lds + (b) * SHM_V + vst0) = sr_[i].vs0;          \
    *(bf16x8*)(V_lds + (b) * SHM_V + vst1) = sr_[i].vs1; int kc = sc * 2;               \
    *(bf16x8*)(K_lds + (b) * SHM_K + KSWZ(sr, kc)) = sr_[i].ks0;                       \
    *(bf16x8*)(K_lds + (b) * SHM_K + KSWZ(32 + sr, kc)) = sr_[i].ks1; } while (0)
#define SWAIT() asm volatile("s_waitcnt vmcnt(4)" ::: "memory")
#define RESC(a) do { if (__any((a) < 1.f)) { if (hi == 0) al_l[r32] = (a); asm volatile("s_waitcnt lgkmcnt(0)" ::: "memory"); \
    _Pragma("unroll") for (int d = 0; d < 4; ++d) _Pragma("unroll") for (int r = 0; r < 16; ++r) o[d][r] *= al_l[crow(r, hi)]; } } while (0)
#define MASKT(P0, P1, j) do { if (MASK) mask_tile(P0, P1, (j) * KVBLK - qi, kfirst + qi, Mr, hi); } while (0)
  f32x16 pA0, pA1, pB0, pB1; float mnA, mnB, alA, alB; bf16x8 pa0, pa1, pa2, pa3;
  constexpr int SE = 0, SO = 1;
  SLOAD(SE, 0); asm volatile("s_waitcnt vmcnt(0)" ::: "memory"); SWRITE(0, SE); __syncthreads();
  qkt(pA0, pA1, K_lds, qr, r32, hi); MASKT(pA0, pA1, 0); partialSM(pA0, pA1, m_reg, mnA, alA);
  SLOAD(SO, KVBLK); if (2 < NT) SLOAD(SE, 2 * KVBLK);
  SWAIT(); SWRITE(1, SO); __syncthreads();
  for (int j = 1; j + 1 < NT; j += 2) {
    SBAR(); qkt(pB0, pB1, K_lds + SHM_K, qr, r32, hi);
    finishSM(pA0, pA1, alA, l_reg, pa0, pa1, pa2, pa3); SBAR();
    SLOAD(SO, (j + 2) * KVBLK); SBAR();
    pv_d0(o, vb0, pa0, pa1, pa2, pa3); MASKT(pB0, pB1, j); partialSM(pB0, pB1, m_reg, mnB, alB);
    __syncthreads(); SWAIT(); SWRITE(0, SE);
    RESC(alB); __syncthreads();
    SBAR(); qkt(pA0, pA1, K_lds, qr, r32, hi);
    finishSM(pB0, pB1, alB, l_reg, pa0, pa1, pa2, pa3); SBAR();
    if (j + 3 < NT) SLOAD(SE, (j + 3) * KVBLK); SBAR();
    pv_d0(o, vb0 + (int)SHM_V, pa0, pa1, pa2, pa3); MASKT(pA0, pA1, j + 1); partialSM(pA0, pA1, m_reg, mnA, alA);
    __syncthreads(); SWAIT(); SWRITE(1, SO);
    RESC(alA); __syncthreads();
  }
  SBAR(); qkt(pB0, pB1, K_lds + SHM_K, qr, r32, hi);
  finishSM(pA0, pA1, alA, l_reg, pa0, pa1, pa2, pa3); SBAR();
  pv_d0(o, vb0, pa0, pa1, pa2, pa3); MASKT(pB0, pB1, NT - 1); partialSM(pB0, pB1, m_reg, mnB, alB);
  __syncthreads(); RESC(alB);
  finishSM(pB0, pB1, alB, l_reg, pa0, pa1, pa2, pa3); SBAR();
  pv_d0(o, vb0 + (int)SHM_V, pa0, pa1, pa2, pa3);
  if (hi == 0) li_l[r32] = l_reg; asm volatile("s_waitcnt lgkmcnt(0)" ::: "memory");
  float rli[16];
#pragma unroll
  for (int r = 0; r < 16; ++r) rli[r] = __builtin_amdgcn_rcpf(li_l[crow(r, hi)]);
  bf16_t* Ow = Ob + (long)(wid * QBLK) * ldo;
#pragma unroll
  for (int r = 0; r < 16; ++r) { const int orow = crow(r, hi);
#pragma unroll
    for (int d0 = 0; d0 < 4; ++d0) Ow[(long)orow * ldo + d0 * 32 + r32] = (bf16_t)f2bf(o[d0][r] * rli[r]); }
  if (lse != nullptr && hi == 0) lse[(long)(wid * QBLK + r32) * ldlse] = m_reg * SCALE + __logf(l_reg);
#undef KROW
#undef SLOAD
#undef SWRITE
#undef SWAIT
#undef RESC
#undef MASKT
}

struct VFB { s16x4 l0, h0, l1, h1, l2, h2, l3, h3; };
template <int D0> __device__ __forceinline__ void vfb_load(VFB& f, int vb) {
  f.l0 = tr_read<v_rd_off(D0, 0, 0)>(vb); f.h0 = tr_read<v_rd_off(D0, 0, 1)>(vb); f.l1 = tr_read<v_rd_off(D0, 1, 0)>(vb); f.h1 = tr_read<v_rd_off(D0, 1, 1)>(vb);
  f.l2 = tr_read<v_rd_off(D0, 2, 0)>(vb); f.h2 = tr_read<v_rd_off(D0, 2, 1)>(vb); f.l3 = tr_read<v_rd_off(D0, 3, 0)>(vb); f.h3 = tr_read<v_rd_off(D0, 3, 1)>(vb);
}
#define VFB_WAIT(N, f) asm volatile("s_waitcnt lgkmcnt(" #N ")" : "+v"(f.l0), "+v"(f.h0), "+v"(f.l1), "+v"(f.h1), "+v"(f.l2), "+v"(f.h2), "+v"(f.l3), "+v"(f.h3) :: "memory")
__device__ __forceinline__ void vfb_mma(f32x16& od, const VFB& f, bf16x8 pa0, bf16x8 pa1, bf16x8 pa2, bf16x8 pa3) {
#define PK(L, H) (bf16x8){L[0], L[1], L[2], L[3], H[0], H[1], H[2], H[3]}
  od = __builtin_amdgcn_mfma_f32_32x32x16_bf16(pa0, PK(f.l0, f.h0), od, 0, 0, 0);
  od = __builtin_amdgcn_mfma_f32_32x32x16_bf16(pa1, PK(f.l1, f.h1), od, 0, 0, 0);
  od = __builtin_amdgcn_mfma_f32_32x32x16_bf16(pa2, PK(f.l2, f.h2), od, 0, 0, 0);
  od = __builtin_amdgcn_mfma_f32_32x32x16_bf16(pa3, PK(f.l3, f.h3), od, 0, 0, 0);
#undef PK
}
template <int OFF> __device__ __forceinline__ bf16x8 dsb_rd128(int a) { bf16x8 r; asm volatile("ds_read_b128 %0, %1 offset:%2" : "=&v"(r) : "v"(a), "i"(OFF) : "memory"); return r; }
#define KB_RD(A, B, d0) do { const int _a = (kx ^ ((d0) * 32)) + krow; A = dsb_rd128<0>(_a); B = dsb_rd128<8192>(_a); } while (0)
#define KB_WAIT(N, A, B) asm volatile("s_waitcnt lgkmcnt(" #N ")" : "+v"(A), "+v"(B) :: "memory")
#define KB_MMA(A, B, d0) do { p0 = __builtin_amdgcn_mfma_f32_32x32x16_bf16(A, qr[d0], p0, 0, 0, 0); p1 = __builtin_amdgcn_mfma_f32_32x32x16_bf16(B, qr[d0], p1, 0, 0, 0); } while (0)
__device__ __forceinline__ void attn_band_body(const bf16_t* __restrict__ Qb, const long ldq, const bf16_t* __restrict__ Kh, const bf16_t* __restrict__ Vh, const long ldk,
                                               const int kfirst, const int Mr, bf16_t* __restrict__ Ob, const long ldo, float* __restrict__ lse, const long ldlse, char* lds) {
  int tid = threadIdx.x; asm volatile("" : "+v"(tid));
  const int wid = __builtin_amdgcn_readfirstlane(tid >> 6), lane = tid & 63, r32 = lane & 31, hi = lane >> 5;
  char* V_lds = lds; char* K_lds = lds + 2 * SHM_V;
  float* ws = (float*)(lds + 2 * SHM_V + 2 * SHM_K) + wid * 64; float* li_l = ws; float* al_l = ws + 32;
  float m_reg = -1e30f, l_reg = 0; f32x16 o[4] = {}; bf16x8 qr[8];
  const bf16_t* Qw = Qb + (long)(wid * QBLK + r32) * ldq + hi * 8;
#pragma unroll
  for (int d0 = 0; d0 < 8; ++d0) qr[d0] = *reinterpret_cast<const bf16x8*>(Qw + d0 * 16);
  const int sr = tid >> 4, sc = (tid & 15) * 8, vst0 = v_st(sr, sc), vst1 = v_st(32 + sr, sc);
  const int vb0 = (int)(uintptr_t)V_lds + v_rd_base(lane);
  const int qi = wid * QBLK + r32;
  const int jlo = wid >> 1, jhi = (32 * wid + 159) >> 6;
  const int kx = (hi * 16) ^ ((r32 & 15) << 4), krow0 = (int)(uintptr_t)K_lds + r32 * 256;
  const bool edge = (kfirst < 0) | (kfirst + 384 > Mr);
  bf16x8 vs0, vs1, ks0, ks1;
#define KROW(k0, rr) ((long)min(max(kfirst + (k0) + (rr), 0), Mr - 1))
#define SLOAD(k0) do { const long _r0 = KROW(k0, sr) * ldk + sc, _r1 = KROW(k0, 32 + sr) * ldk + sc; \
    vs0 = *reinterpret_cast<const bf16x8*>(Vh + _r0); vs1 = *reinterpret_cast<const bf16x8*>(Vh + _r1); \
    ks0 = *reinterpret_cast<const bf16x8*>(Kh + _r0); ks1 = *reinterpret_cast<const bf16x8*>(Kh + _r1); } while (0)
#define SWRITE(b) do { *(bf16x8*)(V_lds + (b) * SHM_V + vst0) = vs0; *(bf16x8*)(V_lds + (b) * SHM_V + vst1) = vs1; const int kc = sc * 2; \
    *(bf16x8*)(K_lds + (b) * SHM_K + KSWZ(sr, kc)) = ks0; *(bf16x8*)(K_lds + (b) * SHM_K + KSWZ(32 + sr, kc)) = ks1; } while (0)
  SLOAD(0); SWRITE(0); __syncthreads();
#pragma unroll
  for (int d0 = 0; d0 < 8; ++d0) asm volatile("" : "+v"(qr[d0]));
#pragma unroll 1
  for (int j = 0; j < 6; ++j) {
    const int b = j & 1;
    if (j + 1 < 6) SLOAD((j + 1) * KVBLK);
    if (j >= jlo && j <= jhi) {
      f32x16 p0 = {}, p1 = {}; float mn, alpha; bf16x8 pa0, pa1, pa2, pa3;
      { const int krow = krow0 + b * (int)SHM_K; bf16x8 ka0, kb0, ka1, kb1, ka2, kb2;
        KB_RD(ka0, kb0, 0); KB_RD(ka1, kb1, 1);
        KB_RD(ka2, kb2, 2); KB_WAIT(4, ka0, kb0); KB_MMA(ka0, kb0, 0);
        KB_RD(ka0, kb0, 3); KB_WAIT(4, ka1, kb1); KB_MMA(ka1, kb1, 1);
        KB_RD(ka1, kb1, 4); KB_WAIT(4, ka2, kb2); KB_MMA(ka2, kb2, 2);
        KB_RD(ka2, kb2, 5); KB_WAIT(4, ka0, kb0); KB_MMA(ka0, kb0, 3);
        KB_RD(ka0, kb0, 6); KB_WAIT(4, ka1, kb1); KB_MMA(ka1, kb1, 4);
        KB_RD(ka1, kb1, 7); KB_WAIT(4, ka2, kb2); KB_MMA(ka2, kb2, 5);
        KB_WAIT(2, ka0, kb0); KB_MMA(ka0, kb0, 6);
        KB_WAIT(0, ka1, kb1); KB_MMA(ka1, kb1, 7); }
      if (edge | (j != jlo + 1)) mask_tile(p0, p1, j * KVBLK - qi, kfirst + qi, Mr, hi);
      partialSM(p0, p1, m_reg, mn, alpha);
      if (__any(alpha < 1.f)) { if (hi == 0) al_l[r32] = alpha; asm volatile("s_waitcnt lgkmcnt(0)" ::: "memory");
#pragma unroll
        for (int d = 0; d < 4; ++d)
#pragma unroll
          for (int r = 0; r < 16; ++r) o[d][r] *= al_l[crow(r, hi)]; }
      finishSM(p0, p1, alpha, l_reg, pa0, pa1, pa2, pa3); SBAR();
      { const int vb = vb0 + b * (int)SHM_V; VFB fa, fb;
        vfb_load<0>(fa, vb);
        vfb_load<1>(fb, vb); VFB_WAIT(8, fa); vfb_mma(o[0], fa, pa0, pa1, pa2, pa3);
        vfb_load<2>(fa, vb); VFB_WAIT(8, fb); vfb_mma(o[1], fb, pa0, pa1, pa2, pa3);
        vfb_load<3>(fb, vb); VFB_WAIT(8, fa); vfb_mma(o[2], fa, pa0, pa1, pa2, pa3);
        VFB_WAIT(0, fb); vfb_mma(o[3], fb, pa0, pa1, pa2, pa3); }
    }
    if (j + 1 < 6) SWRITE(b ^ 1);
    __syncthreads();
  }
  if (hi == 0) li_l[r32] = l_reg; asm volatile("s_waitcnt lgkmcnt(0)" ::: "memory");
  float rli[16];
#pragma unroll
  for (int r = 0; r < 16; ++r) rli[r] = __builtin_amdgcn_rcpf(li_l[crow(r, hi)]);
  bf16_t* Ow = Ob + (long)(wid * QBLK) * ldo;
#pragma unroll
  for (int r = 0; r < 16; ++r) { const int orow = crow(r, hi);
#pragma unroll
    for (int d0 = 0; d0 < 4; ++d0) Ow[(long)orow * ldo + d0 * 32 + r32] = (bf16_t)f2bf(o[d0][r] * rli[r]); }
  if (hi == 0) lse[(long)(wid * QBLK + r32) * ldlse] = m_reg * SCALE + __logf(l_reg);
#undef KROW
#undef SLOAD
#undef SWRITE
}

struct BandUnit { const bf16_t* Q; const bf16_t* K; const bf16_t* V; bf16_t* O; float* L; int ld, ldo, ldl, kfirst, Mr, lsh; };
template <class UF>
__device__ __forceinline__ void attn_band_stream(const int U, UF unit_of, char* lds) {
  int tid = threadIdx.x; asm volatile("" : "+v"(tid));
  const int wid = __builtin_amdgcn_readfirstlane(tid >> 6), lane = tid & 63, r32 = lane & 31, hi = lane >> 5, w32 = lane & 31;
  constexpr int TILE = 32768, OFF_B = 3 * TILE, OFF_WS = 4 * TILE;
  float* ws = (float*)(lds + OFF_WS) + wid * 64; float* li_l = ws; float* al_l = ws + 32;
  const int jlo = wid >> 1, qi = wid * QBLK + r32;
  const int kx = (hi * 16) ^ ((r32 & 15) << 4);
  const int krow_l = (int)(uintptr_t)lds + 16384 + r32 * 256, vb_l = (int)(uintptr_t)lds + v_rd_base(lane);
  const int krow0 = 4 * wid + (lane >> 4), kch = ((lane & 15) ^ (krow0 & 15)) * 8;
  const int vkk = (wid >> 1) * 8 + (w32 >> 2), vkey0 = (vkk & ~0xC) | ((vkk & 4) << 1) | ((vkk & 8) >> 1), vcol = (2 * (wid & 1) + (lane >> 5)) * 32 + (w32 & 3) * 8;
#define BS_DMA(bu, j, boff) do { const int _kb = (bu).kfirst + 64 * (j); const unsigned _ld = (unsigned)(bu).ld; \
    _Pragma("unroll") for (int _i = 0; _i < 2; ++_i) { const unsigned _ro = (unsigned)min(max(_kb + krow0 + 32 * _i, 0), (bu).Mr - 1) * _ld + kch; \
      __builtin_amdgcn_global_load_lds((const unsigned*)((bu).K + _ro), (LAS unsigned*)(lds + (boff) + 16384 + (wid + 8 * _i) * 1024), 16, 0, 0); } \
    _Pragma("unroll") for (int _i = 0; _i < 2; ++_i) { const unsigned _ro = (unsigned)min(max(_kb + vkey0 + 32 * _i, 0), (bu).Mr - 1) * _ld + vcol; \
      __builtin_amdgcn_global_load_lds((const unsigned*)((bu).V + _ro), (LAS unsigned*)(lds + (boff) + (wid + 8 * _i) * 1024), 16, 0, 0); } } while (0)
#define BS_QLOAD(bu) do { const bf16_t* _q = (bu).Q + (long)qi * (bu).ld + hi * 8; \
    asm volatile("global_load_dwordx4 %0, %8, off\n\tglobal_load_dwordx4 %1, %8, off offset:32\n\tglobal_load_dwordx4 %2, %8, off offset:64\n\tglobal_load_dwordx4 %3, %8, off offset:96\n\t" \
                 "global_load_dwordx4 %4, %8, off offset:128\n\tglobal_load_dwordx4 %5, %8, off offset:160\n\tglobal_load_dwordx4 %6, %8, off offset:192\n\tglobal_load_dwordx4 %7, %8, off offset:224" \
                 : "=&v"(qr[0]), "=&v"(qr[1]), "=&v"(qr[2]), "=&v"(qr[3]), "=&v"(qr[4]), "=&v"(qr[5]), "=&v"(qr[6]), "=&v"(qr[7]) : "v"(_q) : "memory"); } while (0)
#define BS_POS_DMA(gq) do { const int _un = (gq) / 5, _jn = (gq) - 5 * _un; \
    if ((gq) <= 5 * U) { \
      if (_un < U) { const BandUnit _bn = unit_of(_un); BS_DMA(_bn, _jn, ((gq) % 3) * TILE); ndma += 4; } \
      if (_jn == 0 && _un >= 1) { const BandUnit _bp = unit_of(_un - 1); BS_DMA(_bp, 5, OFF_B); ndma += 4; } } } while (0)
  float m_reg = -1e30f, l_reg = 0; f32x16 o[4] = {}; bf16x8 qr[8];
  { int ndma = 0; if (U > 0) { const BandUnit b0 = unit_of(0); BS_QLOAD(b0); } else {
#pragma unroll
      for (int d0 = 0; d0 < 8; ++d0) qr[d0] = bf16x8{}; }
    BS_POS_DMA(0); BS_POS_DMA(1); }
  asm volatile("s_waitcnt vmcnt(0)" ::: "memory");
#pragma unroll
  for (int d0 = 0; d0 < 8; ++d0) asm volatile("" : "+v"(qr[d0]));
  __builtin_amdgcn_s_barrier(); asm volatile("" ::: "memory");
#pragma unroll 1
  for (int g = 0; g <= 5 * U + 2; ++g) {
    const int rel = g - jlo, uw = rel >= 0 ? rel / 5 : -1, jr = rel - 5 * uw;
    int ndma = 0;
    if (uw >= 0 && jr >= 3 && uw < U) {
      const BandUnit bu = unit_of(uw);
      if (hi == 0) li_l[r32] = l_reg; asm volatile("s_waitcnt lgkmcnt(0)" ::: "memory");
      bf16_t* Ow = bu.O + (long)(wid * QBLK) * bu.ldo;
      const int rb = (jr - 3) * 8;
#pragma unroll
      for (int rr = 0; rr < 8; ++rr) { const int orow = ((rb + rr) & 3) + 8 * ((rb + rr) >> 2) + 4 * hi; const float rl = __builtin_amdgcn_rcpf(li_l[orow]);
#pragma unroll
        for (int d0 = 0; d0 < 4; ++d0) { const float v = jr == 3 ? o[d0][rr] : o[d0][8 + rr]; Ow[(long)orow * bu.ldo + d0 * 32 + r32] = (bf16_t)f2bf(v * rl); } }
      if (jr == 3 && hi == 0) bu.L[(long)qi * bu.ldl] = m_reg * SCALE + __logf(l_reg);
      asm volatile("s_waitcnt vmcnt(0)" ::: "memory");
      if (jr == 3 && uw + 1 < U) { const BandUnit bn = unit_of(uw + 1); BS_QLOAD(bn); ndma += 8; }
      BS_POS_DMA(g + 2);
    } else {
    BS_POS_DMA(g + 2);
    if (uw >= 0 && jr <= 2 && uw < U) {
      const BandUnit bu = unit_of(uw);
      const int j = jlo + jr, boff = (j == 5) ? OFF_B : (g % 3) * TILE;
      if (jr == 0) { m_reg = -1e30f; l_reg = 0.f;
#pragma unroll
        for (int d = 0; d < 4; ++d) o[d] = f32x16{}; }
      const bool edge = (bu.kfirst < 0) | (bu.kfirst + 384 > bu.Mr);
      f32x16 p0 = {}, p1 = {}; float mn, alpha; bf16x8 pa0, pa1, pa2, pa3;
      { const int krow = krow_l + boff; bf16x8 ka0, kb0, ka1, kb1, ka2, kb2;
        KB_RD(ka0, kb0, 0); KB_RD(ka1, kb1, 1);
        KB_RD(ka2, kb2, 2); KB_WAIT(4, ka0, kb0); KB_MMA(ka0, kb0, 0);
        KB_RD(ka0, kb0, 3); KB_WAIT(4, ka1, kb1); KB_MMA(ka1, kb1, 1);
        KB_RD(ka1, kb1, 4); KB_WAIT(4, ka2, kb2); KB_MMA(ka2, kb2, 2);
        KB_RD(ka2, kb2, 5); KB_WAIT(4, ka0, kb0); KB_MMA(ka0, kb0, 3);
        KB_RD(ka0, kb0, 6); KB_WAIT(4, ka1, kb1); KB_MMA(ka1, kb1, 4);
        KB_RD(ka1, kb1, 7); KB_WAIT(4, ka2, kb2); KB_MMA(ka2, kb2, 5);
        KB_WAIT(2, ka0, kb0); KB_MMA(ka0, kb0, 6);
        KB_WAIT(0, ka1, kb1); KB_MMA(ka1, kb1, 7); }
      if (edge | (jr != 1)) mask_tile(p0, p1, j * KVBLK - qi, bu.kfirst + qi, bu.Mr, hi);
      partialSM(p0, p1, m_reg, mn, alpha);
      if (jr != 0 && __any(alpha < 1.f)) { if (hi == 0) al_l[r32] = alpha; asm volatile("s_waitcnt lgkmcnt(0)" ::: "memory");
#pragma unroll
        for (int d = 0; d < 4; ++d)
#pragma unroll
          for (int r = 0; r < 16; ++r) o[d][r] *= al_l[crow(r, hi)]; }
      if (jr == 0) alpha = 0.f;
      finishSM(p0, p1, alpha, l_reg, pa0, pa1, pa2, pa3); SBAR();
      { const int vb = vb_l + boff; VFB fa, fb;
        vfb_load<0>(fa, vb);
        vfb_load<1>(fb, vb); VFB_WAIT(8, fa); vfb_mma(o[0], fa, pa0, pa1, pa2, pa3);
        vfb_load<2>(fa, vb); VFB_WAIT(8, fb); vfb_mma(o[1], fb, pa0, pa1, pa2, pa3);
        vfb_load<3>(fb, vb); VFB_WAIT(8, fa); vfb_mma(o[2], fa, pa0, pa1, pa2, pa3);
        VFB_WAIT(0, fb); vfb_mma(o[3], fb, pa0, pa1, pa2, pa3); }
    } }
    asm volatile("s_waitcnt lgkmcnt(0)" ::: "memory");
#define BS_VMW(n) case n: asm volatile("s_waitcnt vmcnt(" #n ")" ::: "memory"); break;
    switch (ndma) { BS_VMW(4) BS_VMW(8) BS_VMW(12) BS_VMW(16) default: asm volatile("s_waitcnt vmcnt(0)" ::: "memory"); break; }
#undef BS_VMW
    __builtin_amdgcn_s_barrier(); asm volatile("" ::: "memory");
  }
#undef BS_DMA
#undef BS_QLOAD
#undef BS_POS_DMA
}

__device__ __forceinline__ void partialSM1(f32x16& p0, float& m_reg, float& mn, float& alpha) {
  constexpr float C = SCALE * 1.4426950408889634f;
  float pmax = p0[0];
#pragma unroll
  for (int r = 1; r < 16; ++r) pmax = fmaxf(pmax, p0[r]);
  { auto rr = __builtin_amdgcn_permlane32_swap(__float_as_uint(pmax), __float_as_uint(pmax), false, false);
    pmax = fmaxf(__uint_as_float(rr[0]), __uint_as_float(rr[1])); }
  if (__builtin_expect(__all(pmax - m_reg <= THR / SCALE), 1)) { mn = m_reg; alpha = 1.f; }
  else { mn = fmaxf(m_reg, pmax); alpha = __builtin_amdgcn_exp2f((m_reg - mn) * C); m_reg = mn; }
  const float mnC = -mn * C;
#pragma unroll
  for (int r = 0; r < 16; ++r) p0[r] = __builtin_amdgcn_exp2f(fmaf(p0[r], C, mnC));
}
__device__ __forceinline__ void finishSM1(f32x16& p0, float alpha, float& l_reg, bf16x8& pa0, bf16x8& pa1) {
  float ps = 0;
#pragma unroll
  for (int r = 0; r < 16; ++r) ps += p0[r];
  { auto rr = __builtin_amdgcn_permlane32_swap(__float_as_uint(ps), __float_as_uint(ps), false, false);
    ps = __uint_as_float(rr[0]) + __uint_as_float(rr[1]); }
  l_reg = l_reg * alpha + ps;
#define PK4(P, BASE, OUT) do { unsigned a0 = cvtpk(P[BASE + 0], P[BASE + 1]), a1 = cvtpk(P[BASE + 2], P[BASE + 3]);   \
    unsigned b0 = cvtpk(P[BASE + 4], P[BASE + 5]), b1 = cvtpk(P[BASE + 6], P[BASE + 7]);                              \
    auto r0 = __builtin_amdgcn_permlane32_swap(a0, b0, false, false); auto r1 = __builtin_amdgcn_permlane32_swap(a1, b1, false, false); \
    u32x4 w = {r0[0], r1[0], r0[1], r1[1]}; OUT = *reinterpret_cast<bf16x8*>(&w); } while (0)
  PK4(p0, 0, pa0); PK4(p0, 8, pa1);
#undef PK4
}
struct VF2 { s16x4 l0, h0, l1, h1; };
template <int D0> __device__ __forceinline__ void vf2_load(VF2& f, int vb) {
  f.l0 = tr_read<v_rd_off(D0, 0, 0)>(vb); f.h0 = tr_read<v_rd_off(D0, 0, 1)>(vb); f.l1 = tr_read<v_rd_off(D0, 1, 0)>(vb); f.h1 = tr_read<v_rd_off(D0, 1, 1)>(vb);
}
#define VF2_WAIT(N, f) asm volatile("s_waitcnt lgkmcnt(" #N ")" : "+v"(f.l0), "+v"(f.h0), "+v"(f.l1), "+v"(f.h1) :: "memory")
__device__ __forceinline__ void vf2_mma(f32x16& od, const VF2& f, bf16x8 pa0, bf16x8 pa1) {
#define PK(L, H) (bf16x8){L[0], L[1], L[2], L[3], H[0], H[1], H[2], H[3]}
  od = __builtin_amdgcn_mfma_f32_32x32x16_bf16(pa0, PK(f.l0, f.h0), od, 0, 0, 0);
  od = __builtin_amdgcn_mfma_f32_32x32x16_bf16(pa1, PK(f.l1, f.h1), od, 0, 0, 0);
#undef PK
}
__device__ __forceinline__ void attn_band_wave(const bf16_t* __restrict__ Qb, const long ldq, const bf16_t* __restrict__ Kh, const bf16_t* __restrict__ Vh, const long ldk,
                                               const int kfirst, const int Mr, bf16_t* __restrict__ Ob, const long ldo, float* __restrict__ lse, const long ldlse, char* lds) {
  int tid = threadIdx.x; asm volatile("" : "+v"(tid));
  const int wid = __builtin_amdgcn_readfirstlane(tid >> 6), lane = tid & 63, r32 = lane & 31, hi = lane >> 5, w32 = lane & 31;
  char* Vw = lds + wid * 16384;
  float* ws = (float*)(lds + 131072) + wid * 64; float* li_l = ws; float* al_l = ws + 32;
  const int kf = kfirst + 32 * wid;
  const bool edge = (kf < 0) | (kf + 160 > Mr);
  float m_reg = -1e30f, l_reg = 0; f32x16 o[4] = {}; bf16x8 qr[8], kr[8];
  const bf16_t* Qw = Qb + (long)(wid * QBLK + r32) * ldq + hi * 8;
#pragma unroll
  for (int d0 = 0; d0 < 8; ++d0) qr[d0] = *reinterpret_cast<const bf16x8*>(Qw + d0 * 16);
  const int vb0 = (int)(uintptr_t)Vw + v_rd_base(lane);
  const int vkey = ((w32 >> 2) & 3) + 8 * ((w32 >> 4) & 1), vcol = (lane >> 5) * 32 + (w32 & 3) * 8;
  const unsigned ldku = (unsigned)ldk;
#define BW_KLOAD(s) do { const unsigned _ro = (unsigned)min(max(kf + 32 * (s) + r32, 0), Mr - 1) * ldku + hi * 8; const bf16_t* _kp = Kh + _ro; \
    asm volatile("global_load_dwordx4 %0, %8, off\n\tglobal_load_dwordx4 %1, %8, off offset:32\n\tglobal_load_dwordx4 %2, %8, off offset:64\n\tglobal_load_dwordx4 %3, %8, off offset:96\n\t" \
                 "global_load_dwordx4 %4, %8, off offset:128\n\tglobal_load_dwordx4 %5, %8, off offset:160\n\tglobal_load_dwordx4 %6, %8, off offset:192\n\tglobal_load_dwordx4 %7, %8, off offset:224" \
                 : "=&v"(kr[0]), "=&v"(kr[1]), "=&v"(kr[2]), "=&v"(kr[3]), "=&v"(kr[4]), "=&v"(kr[5]), "=&v"(kr[6]), "=&v"(kr[7]) : "v"(_kp) : "memory"); } while (0)
#define BW_KWAIT(N) asm volatile("s_waitcnt vmcnt(" #N ")" : "+v"(kr[0]), "+v"(kr[1]), "+v"(kr[2]), "+v"(kr[3]), "+v"(kr[4]), "+v"(kr[5]), "+v"(kr[6]), "+v"(kr[7]) :: "memory")
#define BW_VDMA(s, b) do { _Pragma("unroll") for (int kg = 0; kg < 4; ++kg) { \
      const unsigned _ro = (unsigned)min(max(kf + 32 * (s) + vkey + 4 * (kg & 1) + 16 * (kg >> 1), 0), Mr - 1) * ldku + vcol; \
      __builtin_amdgcn_global_load_lds((const unsigned*)(Vh + _ro), (LAS unsigned*)(Vw + (b) * 8192 + (2 * kg) * 1024), 16, 0, 0); \
      __builtin_amdgcn_global_load_lds((const unsigned*)(Vh + _ro + 64), (LAS unsigned*)(Vw + (b) * 8192 + (2 * kg + 1) * 1024), 16, 0, 0); } } while (0)
  BW_VDMA(0, 0); BW_KLOAD(0);
#pragma unroll
  for (int d0 = 0; d0 < 8; ++d0) asm volatile("" : "+v"(qr[d0]));
#define BW_STEP(s, LAST) do { const int b = (s) & 1; \
    if (!(LAST)) BW_VDMA((s) + 1, b ^ 1); \
    f32x16 p0 = {}; float mn, alpha; bf16x8 pa0, pa1; \
    if (!(LAST)) BW_KWAIT(8); else BW_KWAIT(0); \
    _Pragma("unroll") for (int d0 = 0; d0 < 8; ++d0) p0 = __builtin_amdgcn_mfma_f32_32x32x16_bf16(kr[d0], qr[d0], p0, 0, 0, 0); \
    SBAR(); \
    if (!(LAST)) BW_KLOAD((s) + 1); \
    if (edge | ((s) == 0) | ((s) == 4)) { \
      _Pragma("unroll") for (int r = 0; r < 16; ++r) { const int key = 32 * (s) + crow(r, hi); \
        const bool ok = ((unsigned)(key - r32) <= 128u) && ((unsigned)(kf + key) < (unsigned)Mr); \
        p0[r] = ok ? p0[r] : -3.0e4f; } } \
    partialSM1(p0, m_reg, mn, alpha); \
    if (__any(alpha < 1.f)) { if (hi == 0) al_l[r32] = alpha; asm volatile("s_waitcnt lgkmcnt(0)" ::: "memory"); \
      _Pragma("unroll") for (int d = 0; d < 4; ++d) \
        _Pragma("unroll") for (int r = 0; r < 16; ++r) o[d][r] *= al_l[crow(r, hi)]; } \
    finishSM1(p0, alpha, l_reg, pa0, pa1); \
    if (!(LAST)) asm volatile("s_waitcnt vmcnt(16)" ::: "memory"); else asm volatile("s_waitcnt vmcnt(0)" ::: "memory");     \
    SBAR(); \
    const int vb = vb0 + b * 8192; VF2 fa, fb; \
    vf2_load<0>(fa, vb); vf2_load<1>(fb, vb); VF2_WAIT(4, fa); vf2_mma(o[0], fa, pa0, pa1); \
    vf2_load<2>(fa, vb); VF2_WAIT(4, fb); vf2_mma(o[1], fb, pa0, pa1); \
    vf2_load<3>(fb, vb); VF2_WAIT(4, fa); vf2_mma(o[2], fa, pa0, pa1); \
    VF2_WAIT(0, fb); vf2_mma(o[3], fb, pa0, pa1); } while (0)
#pragma unroll 1
  for (int s = 0; s < 4; ++s) BW_STEP(s, false);
  BW_STEP(4, true);
#undef BW_STEP
  if (hi == 0) li_l[r32] = l_reg; asm volatile("s_waitcnt lgkmcnt(0)" ::: "memory");
  float rli[16];
#pragma unroll
  for (int r = 0; r < 16; ++r) rli[r] = __builtin_amdgcn_rcpf(li_l[crow(r, hi)]);
  bf16_t* Ow = Ob + (long)(wid * QBLK) * ldo;
#pragma unroll
  for (int r = 0; r < 16; ++r) { const int orow = crow(r, hi);
#pragma unroll
    for (int d0 = 0; d0 < 4; ++d0) Ow[(long)orow * ldo + d0 * 32 + r32] = (bf16_t)f2bf(o[d0][r] * rli[r]); }
  if (hi == 0) lse[(long)(wid * QBLK + r32) * ldlse] = m_reg * SCALE + __logf(l_reg);
#undef BW_KLOAD
#undef BW_KWAIT
#undef BW_VDMA
}

constexpr int W_SHM_V = KVBLK * 256 * 2, W_SHM_K = KVBLK * D * 2, W_OFF_K = 3 * W_SHM_V, W_OFF_WS = W_OFF_K + 2 * W_SHM_K, W_SHM_TOTAL = W_OFF_WS + NW * 64 * 4;
constexpr int w_rd_off(int d0, int ks, int half) { return d0 * 512 + ks * 8192 + half * 4096; }
template <int D0> __device__ __forceinline__ void pvw_one(f32x16& od, int vb, bf16x8 pa0, bf16x8 pa1, bf16x8 pa2, bf16x8 pa3) {
  const s16x4 l0 = tr_read<w_rd_off(D0, 0, 0)>(vb), h0 = tr_read<w_rd_off(D0, 0, 1)>(vb), l1 = tr_read<w_rd_off(D0, 1, 0)>(vb), h1 = tr_read<w_rd_off(D0, 1, 1)>(vb);
  const s16x4 l2 = tr_read<w_rd_off(D0, 2, 0)>(vb), h2 = tr_read<w_rd_off(D0, 2, 1)>(vb), l3 = tr_read<w_rd_off(D0, 3, 0)>(vb), h3 = tr_read<w_rd_off(D0, 3, 1)>(vb);
  asm volatile("s_waitcnt lgkmcnt(0)" ::: "memory"); SBAR();
#define PK(L, H) (bf16x8){L[0], L[1], L[2], L[3], H[0], H[1], H[2], H[3]}
  od = __builtin_amdgcn_mfma_f32_32x32x16_bf16(pa0, PK(l0, h0), od, 0, 0, 0);
  od = __builtin_amdgcn_mfma_f32_32x32x16_bf16(pa1, PK(l1, h1), od, 0, 0, 0);
  od = __builtin_amdgcn_mfma_f32_32x32x16_bf16(pa2, PK(l2, h2), od, 0, 0, 0);
  od = __builtin_amdgcn_mfma_f32_32x32x16_bf16(pa3, PK(l3, h3), od, 0, 0, 0);
#undef PK
}
struct VF { s16x4 l0, h0, l1, h1, l2, h2, l3, h3; };
template <int D0> __device__ __forceinline__ void vf_load(VF& f, int vb) {
  f.l0 = tr_read<w_rd_off(D0, 0, 0)>(vb); f.h0 = tr_read<w_rd_off(D0, 0, 1)>(vb); f.l1 = tr_read<w_rd_off(D0, 1, 0)>(vb); f.h1 = tr_read<w_rd_off(D0, 1, 1)>(vb);
  f.l2 = tr_read<w_rd_off(D0, 2, 0)>(vb); f.h2 = tr_read<w_rd_off(D0, 2, 1)>(vb); f.l3 = tr_read<w_rd_off(D0, 3, 0)>(vb); f.h3 = tr_read<w_rd_off(D0, 3, 1)>(vb);
}
#define VF_WAIT(N, f) asm volatile("s_waitcnt lgkmcnt(" #N ")" : "+v"(f.l0), "+v"(f.h0), "+v"(f.l1), "+v"(f.h1), "+v"(f.l2), "+v"(f.h2), "+v"(f.l3), "+v"(f.h3) :: "memory")
__device__ __forceinline__ void vf_mma(f32x16& od, const VF& f, bf16x8 pa0, bf16x8 pa1, bf16x8 pa2, bf16x8 pa3) {
#define PK(L, H) (bf16x8){L[0], L[1], L[2], L[3], H[0], H[1], H[2], H[3]}
  od = __builtin_amdgcn_mfma_f32_32x32x16_bf16(pa0, PK(f.l0, f.h0), od, 0, 0, 0);
  od = __builtin_amdgcn_mfma_f32_32x32x16_bf16(pa1, PK(f.l1, f.h1), od, 0, 0, 0);
  od = __builtin_amdgcn_mfma_f32_32x32x16_bf16(pa2, PK(f.l2, f.h2), od, 0, 0, 0);
  od = __builtin_amdgcn_mfma_f32_32x32x16_bf16(pa3, PK(f.l3, f.h3), od, 0, 0, 0);
#undef PK
}
template <int OFF> __device__ __forceinline__ bf16x8 ds_rd128(int a) { bf16x8 r; asm volatile("ds_read_b128 %0, %1 offset:%2" : "=&v"(r) : "v"(a), "i"(OFF) : "memory"); return r; }
#define KF_RD(A, B, d0) do { const int _a = (kx ^ ((d0) * 32)) + krow; A = ds_rd128<0>(_a); B = ds_rd128<8192>(_a); } while (0)
#define KF_WAIT(N, A, B) asm volatile("s_waitcnt lgkmcnt(" #N ")" : "+v"(A), "+v"(B) :: "memory")
#define KF_MMA(A, B, d0) do { p0 = __builtin_amdgcn_mfma_f32_32x32x16_bf16(A, qr[d0], p0, 0, 0, 0); p1 = __builtin_amdgcn_mfma_f32_32x32x16_bf16(B, qr[d0], p1, 0, 0, 0); } while (0)
__device__ __forceinline__ void attn_wide_body(const bf16_t* __restrict__ Qb, const bf16_t* __restrict__ Kh, const bf16_t* __restrict__ Vh, const int ld, const int NT,
                                               bf16_t* __restrict__ Ob, const int ldo, char* lds,
                                               const bool comb, const float lam, const float gscale, const float* __restrict__ subln, bf16_t* __restrict__ Cb, const int ldc) {
  int tid = threadIdx.x; asm volatile("" : "+v"(tid));
  const int wid = __builtin_amdgcn_readfirstlane(tid >> 6), lane = tid & 63, r32 = lane & 31, hi = lane >> 5;
  float* ws = (float*)(lds + W_OFF_WS) + wid * 64; float* li_l = ws; float* al_l = ws + 32;
  float m_reg = -1e30f, l_reg = 0; f32x16 o[8] = {}; bf16x8 qr[8];
  const bf16_t* Qw = Qb + (long)(wid * QBLK + r32) * ld + hi * 8;
#pragma unroll
  for (int d0 = 0; d0 < 8; ++d0) qr[d0] = *reinterpret_cast<const bf16x8*>(Qw + d0 * 16);
  unsigned kof[2], vof[4];
#pragma unroll
  for (int i = 0; i < 2; ++i) { const int g = wid + 8 * i, row = 4 * g + (lane >> 4), chunk = (lane & 15) ^ (row & 15); kof[i] = (unsigned)(row * ld + chunk * 8); }
#pragma unroll
  for (int i = 0; i < 4; ++i) { const int p = wid + 8 * i, sub = lane >> 5, w32 = lane & 31, kk = (p >> 2) * 8 + (w32 >> 2), k = (kk & ~0xC) | ((kk & 4) << 1) | ((kk & 8) >> 1);
    vof[i] = (unsigned)(k * ld + (2 * (p & 3) + sub) * 32 + (w32 & 3) * 8); }
  const int vb0 = (int)(uintptr_t)lds + v_rd_base(lane);
  const int kx = (hi * 16) ^ ((r32 & 15) << 4), krow0 = (int)(uintptr_t)lds + W_OFF_K + r32 * 256;
#define W_DMA(k0, b, bv) do { const bf16_t* _kp = Kh + (long)(k0) * ld; const bf16_t* _vp = Vh + (long)(k0) * ld; \
    _Pragma("unroll") for (int _i = 0; _i < 2; ++_i) __builtin_amdgcn_global_load_lds((const unsigned*)(_kp + kof[_i]), (LAS unsigned*)(lds + W_OFF_K + (b) * W_SHM_K + (wid + 8 * _i) * 1024), 16, 0, 0); \
    _Pragma("unroll") for (int _i = 0; _i < 4; ++_i) __builtin_amdgcn_global_load_lds((const unsigned*)(_vp + vof[_i]), (LAS unsigned*)(lds + (bv) * W_SHM_V + (wid + 8 * _i) * 1024), 16, 0, 0); } while (0)
  W_DMA(0, 0, 0);
  asm volatile("s_waitcnt vmcnt(0)" ::: "memory"); __builtin_amdgcn_s_barrier(); asm volatile("" ::: "memory");
#pragma unroll
  for (int d0 = 0; d0 < 8; ++d0) asm volatile("" : "+v"(qr[d0]));
#if defined(W_PRIO)
  if (wid >= 4) __builtin_amdgcn_s_setprio(1);
#endif
  const bool lagB = wid >= 4;
  bf16x8 pa0 = {}, pa1 = {}, pa2 = {}, pa3 = {};
#define W_PV(vbx) do { const int _vb = (vbx); VF fa, fb; vf_load<0>(fa, _vb); \
    vf_load<1>(fb, _vb); VF_WAIT(8, fa); vf_mma(o[0], fa, pa0, pa1, pa2, pa3); \
    vf_load<2>(fa, _vb); VF_WAIT(8, fb); vf_mma(o[1], fb, pa0, pa1, pa2, pa3); \
    vf_load<3>(fb, _vb); VF_WAIT(8, fa); vf_mma(o[2], fa, pa0, pa1, pa2, pa3); \
    vf_load<4>(fa, _vb); VF_WAIT(8, fb); vf_mma(o[3], fb, pa0, pa1, pa2, pa3); \
    vf_load<5>(fb, _vb); VF_WAIT(8, fa); vf_mma(o[4], fa, pa0, pa1, pa2, pa3); \
    vf_load<6>(fa, _vb); VF_WAIT(8, fb); vf_mma(o[5], fb, pa0, pa1, pa2, pa3); \
    vf_load<7>(fb, _vb); VF_WAIT(8, fa); vf_mma(o[6], fa, pa0, pa1, pa2, pa3); \
    VF_WAIT(0, fb); vf_mma(o[7], fb, pa0, pa1, pa2, pa3); } while (0)
#pragma unroll 1
  for (int j = 0; j <= NT; ++j) {
    if (j + 1 < NT) W_DMA((j + 1) * KVBLK, (j + 1) & 1, (j + 1) % 3);
    if (lagB && j >= 1) { W_PV(vb0 + ((j - 1) % 3) * W_SHM_V); SBAR(); }
    if (j < NT) {
      f32x16 p0 = {}, p1 = {}; float mn, alpha;
      const int krow = krow0 + (j & 1) * W_SHM_K;
      { bf16x8 ka0, kb0, ka1, kb1, ka2, kb2;
        KF_RD(ka0, kb0, 0); KF_RD(ka1, kb1, 1);
        KF_RD(ka2, kb2, 2); KF_WAIT(4, ka0, kb0); KF_MMA(ka0, kb0, 0);
        KF_RD(ka0, kb0, 3); KF_WAIT(4, ka1, kb1); KF_MMA(ka1, kb1, 1);
        KF_RD(ka1, kb1, 4); KF_WAIT(4, ka2, kb2); KF_MMA(ka2, kb2, 2);
        KF_RD(ka2, kb2, 5); KF_WAIT(4, ka0, kb0); KF_MMA(ka0, kb0, 3);
        KF_RD(ka0, kb0, 6); KF_WAIT(4, ka1, kb1); KF_MMA(ka1, kb1, 4);
        KF_RD(ka1, kb1, 7); KF_WAIT(4, ka2, kb2); KF_MMA(ka2, kb2, 5);
        KF_WAIT(2, ka0, kb0); KF_MMA(ka0, kb0, 6);
        KF_WAIT(0, ka1, kb1); KF_MMA(ka1, kb1, 7); }
      partialSM(p0, p1, m_reg, mn, alpha);
      if (__any(alpha < 1.f)) { if (hi == 0) al_l[r32] = alpha; asm volatile("s_waitcnt lgkmcnt(0)" ::: "memory");
#pragma unroll
        for (int d = 0; d < 8; ++d)
#pragma unroll
          for (int r = 0; r < 16; ++r) o[d][r] *= al_l[crow(r, hi)]; }
      finishSM(p0, p1, alpha, l_reg, pa0, pa1, pa2, pa3); SBAR();
      if (!lagB) W_PV(vb0 + (j % 3) * W_SHM_V);
    }
    asm volatile("s_waitcnt vmcnt(0) lgkmcnt(0)" ::: "memory"); __builtin_amdgcn_s_barrier(); asm volatile("" ::: "memory");
  }
#undef W_PV
#if defined(W_PRIO)
  __builtin_amdgcn_s_setprio(0);
#endif
  if (hi == 0) li_l[r32] = l_reg; asm volatile("s_waitcnt lgkmcnt(0)" ::: "memory");
  float rli[16];
#pragma unroll
  for (int r = 0; r < 16; ++r) rli[r] = __builtin_amdgcn_rcpf(li_l[crow(r, hi)]);
  bf16_t* Ow = Ob + (long)(wid * QBLK) * ldo;
  if (!comb) {
#pragma unroll
    for (int r = 0; r < 16; ++r) { const int orow = crow(r, hi);
#pragma unroll
      for (int d0 = 0; d0 < 8; ++d0) Ow[(long)orow * ldo + d0 * 32 + r32] = (bf16_t)f2bf(o[d0][r] * rli[r]); }
  } else {
    bf16_t* Cw = Cb + (long)(wid * QBLK) * ldc;
#pragma unroll
    for (int r = 0; r < 16; ++r) { const int orow = crow(r, hi); float ss = 0.f;
#pragma unroll
      for (int d0 = 0; d0 < 8; ++d0) { const float v = bf2f((unsigned)Ow[(long)orow * ldo + d0 * 32 + r32]) - lam * (o[d0][r] * rli[r]); o[d0][r] = v; ss += v * v; }
      ss += __shfl_xor(ss, 1); ss += __shfl_xor(ss, 2); ss += __shfl_xor(ss, 4); ss += __shfl_xor(ss, 8); ss += __shfl_xor(ss, 16);
      const float rstd = __builtin_amdgcn_rsqf(ss * (1.0f / 256.0f) + NORM_EPS) * gscale;
#pragma unroll
      for (int d0 = 0; d0 < 8; ++d0) o[d0][r] *= rstd; }
#pragma unroll
    for (int d0 = 0; d0 < 8; ++d0) { const float gsub = subln[d0 * 32 + r32];
#pragma unroll
      for (int r = 0; r < 16; ++r) Cw[(long)crow(r, hi) * ldc + d0 * 32 + r32] = (bf16_t)f2bf(o[d0][r] * gsub); }
  }
#undef W_DMA
}
__device__ __forceinline__ float pmax16(const f32x4 (&P)[4]) {
  float m = P[0][0];
#pragma unroll
  for (int kb = 0; kb < 4; ++kb)
#pragma unroll
    for (int t2 = 0; t2 < 4; ++t2) if (kb | t2) m = fmaxf(m, P[kb][t2]);
  return m;
}
#define PMAX16(P) pmax16(P)
template <int LAST, int S> __device__ __forceinline__ float bmask(float p, int w) {
  if constexpr (!LAST) { if constexpr (S >= 15) return p; else if constexpr (S < -12) return -3.0e4f; else return (w <= S) ? p : -3.0e4f; }
  else { if constexpr (S <= -12) return p; else if constexpr (S > 15) return -3.0e4f; else return (S <= w) ? p : -3.0e4f; }
}
#define BM1(ODD, LAST, A, KB, T) p[A][KB][T] = bmask<LAST, 16 * ((KB) - (A)) + (T) - 32 * (ODD)>(p[A][KB][T], wl);
#define BM4(ODD, LAST, A, KB) BM1(ODD, LAST, A, KB, 0) BM1(ODD, LAST, A, KB, 1) BM1(ODD, LAST, A, KB, 2) BM1(ODD, LAST, A, KB, 3)
#define BM16(ODD, LAST, A) BM4(ODD, LAST, A, 0) BM4(ODD, LAST, A, 1) BM4(ODD, LAST, A, 2) BM4(ODD, LAST, A, 3)
#define BMALL(ODD, LAST) do { BM16(ODD, LAST, 0) BM16(ODD, LAST, 1) } while (0)
__device__ __forceinline__ float xrow16_max(float x) {
  auto s = __builtin_amdgcn_permlane16_swap(__float_as_uint(x), __float_as_uint(x), false, false); x = fmaxf(__uint_as_float(s[0]), __uint_as_float(s[1]));
  auto u = __builtin_amdgcn_permlane32_swap(__float_as_uint(x), __float_as_uint(x), false, false); return fmaxf(__uint_as_float(u[0]), __uint_as_float(u[1]));
}
__device__ __forceinline__ float xrow16_sum(float x) {
  auto s = __builtin_amdgcn_permlane16_swap(__float_as_uint(x), __float_as_uint(x), false, false); x = __uint_as_float(s[0]) + __uint_as_float(s[1]);
  auto u = __builtin_amdgcn_permlane32_swap(__float_as_uint(x), __float_as_uint(x), false, false); return __uint_as_float(u[0]) + __uint_as_float(u[1]);
}
constexpr int w16_off(int s, int db, int second) { return s * 16384 + db * 256 + second * 8192; }
template <int S, int G4> __device__ __forceinline__ void vf16_load(VF& f, int vb) {
  f.l0 = tr_read<w16_off(S, 4 * G4 + 0, 0)>(vb); f.h0 = tr_read<w16_off(S, 4 * G4 + 0, 1)>(vb); f.l1 = tr_read<w16_off(S, 4 * G4 + 1, 0)>(vb); f.h1 = tr_read<w16_off(S, 4 * G4 + 1, 1)>(vb);
  f.l2 = tr_read<w16_off(S, 4 * G4 + 2, 0)>(vb); f.h2 = tr_read<w16_off(S, 4 * G4 + 2, 1)>(vb); f.l3 = tr_read<w16_off(S, 4 * G4 + 3, 0)>(vb); f.h3 = tr_read<w16_off(S, 4 * G4 + 3, 1)>(vb);
}
__device__ __forceinline__ void vf16_mma(f32x4* o0, f32x4* o1, const VF& f, bf16x8 pb0, bf16x8 pb1) {
#define PK(L, H) (bf16x8){L[0], L[1], L[2], L[3], H[0], H[1], H[2], H[3]}
  o0[0] = __builtin_amdgcn_mfma_f32_16x16x32_bf16(PK(f.l0, f.h0), pb0, o0[0], 0, 0, 0); o1[0] = __builtin_amdgcn_mfma_f32_16x16x32_bf16(PK(f.l0, f.h0), pb1, o1[0], 0, 0, 0);
  o0[1] = __builtin_amdgcn_mfma_f32_16x16x32_bf16(PK(f.l1, f.h1), pb0, o0[1], 0, 0, 0); o1[1] = __builtin_amdgcn_mfma_f32_16x16x32_bf16(PK(f.l1, f.h1), pb1, o1[1], 0, 0, 0);
  o0[2] = __builtin_amdgcn_mfma_f32_16x16x32_bf16(PK(f.l2, f.h2), pb0, o0[2], 0, 0, 0); o1[2] = __builtin_amdgcn_mfma_f32_16x16x32_bf16(PK(f.l2, f.h2), pb1, o1[2], 0, 0, 0);
  o0[3] = __builtin_amdgcn_mfma_f32_16x16x32_bf16(PK(f.l3, f.h3), pb0, o0[3], 0, 0, 0); o1[3] = __builtin_amdgcn_mfma_f32_16x16x32_bf16(PK(f.l3, f.h3), pb1, o1[3], 0, 0, 0);
#undef PK
}
__device__ __forceinline__ void attn_wide16_body(const bf16_t* __restrict__ Qb, const bf16_t* __restrict__ Kh, const bf16_t* __restrict__ Vh, const int ld, const int NT,
                                                 bf16_t* __restrict__ Ob, const int ldo, char* lds,
                                                 const bool comb, const float lam, const float gscale, const float* __restrict__ subln, bf16_t* __restrict__ Cb, const int ldc) {
  int tid = threadIdx.x; asm volatile("" : "+v"(tid));
  const int wid = __builtin_amdgcn_readfirstlane(tid >> 6), lane = tid & 63, c16 = lane & 15, g = lane >> 4;
  constexpr float C = SCALE * 1.4426950408889634f;
  float m0 = -1e30f, m1 = -1e30f, l0 = 0.f, l1 = 0.f; f32x4 o[2][16]; bf16x8 qr[2][4];
#pragma unroll
  for (int a = 0; a < 2; ++a)
#pragma unroll
    for (int b = 0; b < 16; ++b) o[a][b] = f32x4{0.f, 0.f, 0.f, 0.f};
#pragma unroll
  for (int qb = 0; qb < 2; ++qb)
#pragma unroll
    for (int d0 = 0; d0 < 4; ++d0) qr[qb][d0] = *reinterpret_cast<const bf16x8*>(Qb + (long)(wid * QBLK + qb * 16 + c16) * ld + d0 * 32 + g * 8);
  const int krw = 4 * wid + (lane >> 4); const unsigned kof0 = (unsigned)(krw * ld + ((lane & 15) ^ (krw & 15)) * 8), kstep = 32u * (unsigned)ld;
  const unsigned vof0 = (unsigned)((8 * (wid >> 2) + ((lane & 15) >> 1)) * ld + (4 * (wid & 3) + (lane >> 4)) * 16 + (lane & 1) * 8), vstep = 16u * (unsigned)ld;
#define W16_DMA(k0, b) do { const bf16_t* _kp = Kh + (long)(k0) * ld; const bf16_t* _vp = Vh + (long)(k0) * ld; \
    _Pragma("unroll") for (int _i = 0; _i < 2; ++_i) __builtin_amdgcn_global_load_lds((const unsigned*)(_kp + kof0 + _i * kstep), (LAS unsigned*)(lds + W_OFF_K + (b) * W_SHM_K + (wid + 8 * _i) * 1024), 16, 0, 0); \
    _Pragma("unroll") for (int _i = 0; _i < 4; ++_i) __builtin_amdgcn_global_load_lds((const unsigned*)(_vp + vof0 + _i * vstep), (LAS unsigned*)(lds + (b) * W_SHM_V + (wid + 8 * _i) * 1024), 16, 0, 0); } while (0)
  const int kx = (g ^ c16) << 4, kq0 = (int)(uintptr_t)lds + W_OFF_K + c16 * 256;
  const int vb0 = (int)(uintptr_t)lds + (g >> 1) * 4096 + (4 * (g & 1) + (c16 >> 2)) * 32 + (c16 & 3) * 8;
  W16_DMA(0, 0);
  asm volatile("s_waitcnt vmcnt(0)" ::: "memory"); __builtin_amdgcn_s_barrier(); asm volatile("" ::: "memory");
#pragma unroll
  for (int qb = 0; qb < 2; ++qb)
#pragma unroll
    for (int d0 = 0; d0 < 4; ++d0) asm volatile("" : "+v"(qr[qb][d0]));
#pragma unroll 1
  for (int j = 0; j < NT; ++j) {
    const int b = j & 1;
    if (j + 1 < NT) W16_DMA((j + 1) * KVBLK, b ^ 1);
    f32x4 p[2][4];
    { const int kq = kq0 + b * W_SHM_K; const int ka0 = kq + (0 ^ kx), ka1 = kq + (64 ^ kx), ka2 = kq + (128 ^ kx), ka3 = kq + (192 ^ kx);
      bf16x8 f0, f1, f2;
#define K16_RD(F, IDX) F = ds_rd128<((IDX) >> 2) * 4096>(((IDX) & 3) == 0 ? ka0 : ((IDX) & 3) == 1 ? ka1 : ((IDX) & 3) == 2 ? ka2 : ka3)
#define K16_WAIT(N, F) asm volatile("s_waitcnt lgkmcnt(" #N ")" : "+v"(F) :: "memory")
#define K16_MMA(F, IDX) do { p[0][(IDX) >> 2] = __builtin_amdgcn_mfma_f32_16x16x32_bf16(F, qr[0][(IDX) & 3], ((IDX) & 3) ? p[0][(IDX) >> 2] : f32x4{0.f, 0.f, 0.f, 0.f}, 0, 0, 0); \
                             p[1][(IDX) >> 2] = __builtin_amdgcn_mfma_f32_16x16x32_bf16(F, qr[1][(IDX) & 3], ((IDX) & 3) ? p[1][(IDX) >> 2] : f32x4{0.f, 0.f, 0.f, 0.f}, 0, 0, 0); } while (0)
      K16_RD(f0, 0); K16_RD(f1, 1);
      K16_RD(f2, 2); K16_WAIT(2, f0); K16_MMA(f0, 0);
      K16_RD(f0, 3); K16_WAIT(2, f1); K16_MMA(f1, 1);
      K16_RD(f1, 4); K16_WAIT(2, f2); K16_MMA(f2, 2);
      K16_RD(f2, 5); K16_WAIT(2, f0); K16_MMA(f0, 3);
      K16_RD(f0, 6); K16_WAIT(2, f1); K16_MMA(f1, 4);
      K16_RD(f1, 7); K16_WAIT(2, f2); K16_MMA(f2, 5);
      K16_RD(f2, 8); K16_WAIT(2, f0); K16_MMA(f0, 6);
      K16_RD(f0, 9); K16_WAIT(2, f1); K16_MMA(f1, 7);
      K16_RD(f1, 10); K16_WAIT(2, f2); K16_MMA(f2, 8);
      K16_RD(f2, 11); K16_WAIT(2, f0); K16_MMA(f0, 9);
      K16_RD(f0, 12); K16_WAIT(2, f1); K16_MMA(f1, 10);
      K16_RD(f1, 13); K16_WAIT(2, f2); K16_MMA(f2, 11);
      K16_RD(f2, 14); K16_WAIT(2, f0); K16_MMA(f0, 12);
      K16_RD(f0, 15); K16_WAIT(2, f1); K16_MMA(f1, 13);
      K16_WAIT(1, f2); K16_MMA(f2, 14);
      K16_WAIT(0, f0); K16_MMA(f0, 15);
#undef K16_RD
#undef K16_WAIT
#undef K16_MMA
    }
    float pm0 = PMAX16(p[0]), pm1 = PMAX16(p[1]);
    pm0 = xrow16_max(pm0); pm1 = xrow16_max(pm1);
    float al0 = 1.f, al1 = 1.f;
    if (!__builtin_expect(__all((pm0 - m0 <= THR / SCALE) & (pm1 - m1 <= THR / SCALE)), 1)) {
      const float n0 = fmaxf(m0, pm0), n1 = fmaxf(m1, pm1); al0 = __builtin_amdgcn_exp2f((m0 - n0) * C); al1 = __builtin_amdgcn_exp2f((m1 - n1) * C); m0 = n0; m1 = n1;
#pragma unroll
      for (int db = 0; db < 16; ++db) { o[0][db] = o[0][db] * al0; o[1][db] = o[1][db] * al1; } }
    const float mc0 = -m0 * C, mc1 = -m1 * C; float ps0 = 0.f, ps1 = 0.f;
#pragma unroll
    for (int kb = 0; kb < 4; ++kb)
#pragma unroll
      for (int t2 = 0; t2 < 4; ++t2) { p[0][kb][t2] = __builtin_amdgcn_exp2f(fmaf(p[0][kb][t2], C, mc0)); p[1][kb][t2] = __builtin_amdgcn_exp2f(fmaf(p[1][kb][t2], C, mc1)); ps0 += p[0][kb][t2]; ps1 += p[1][kb][t2]; }
    ps0 = xrow16_sum(ps0); ps1 = xrow16_sum(ps1); l0 = l0 * al0 + ps0; l1 = l1 * al1 + ps1;
    bf16x8 pb[2][2];
#pragma unroll
    for (int a = 0; a < 2; ++a)
#pragma unroll
      for (int s = 0; s < 2; ++s) { u32x4 w = {cvtpk(p[a][2 * s][0], p[a][2 * s][1]), cvtpk(p[a][2 * s][2], p[a][2 * s][3]), cvtpk(p[a][2 * s + 1][0], p[a][2 * s + 1][1]), cvtpk(p[a][2 * s + 1][2], p[a][2 * s + 1][3])};
        pb[a][s] = *reinterpret_cast<bf16x8*>(&w); }
    SBAR();
    { const int vb = vb0 + b * W_SHM_V; VF fa, fb;
      vf16_load<0, 0>(fa, vb);
      vf16_load<0, 1>(fb, vb); VF_WAIT(8, fa); vf16_mma(&o[0][0], &o[1][0], fa, pb[0][0], pb[1][0]);
      vf16_load<0, 2>(fa, vb); VF_WAIT(8, fb); vf16_mma(&o[0][4], &o[1][4], fb, pb[0][0], pb[1][0]);
      vf16_load<0, 3>(fb, vb); VF_WAIT(8, fa); vf16_mma(&o[0][8], &o[1][8], fa, pb[0][0], pb[1][0]);
      vf16_load<1, 0>(fa, vb); VF_WAIT(8, fb); vf16_mma(&o[0][12], &o[1][12], fb, pb[0][0], pb[1][0]);
      vf16_load<1, 1>(fb, vb); VF_WAIT(8, fa); vf16_mma(&o[0][0], &o[1][0], fa, pb[0][1], pb[1][1]);
      vf16_load<1, 2>(fa, vb); VF_WAIT(8, fb); vf16_mma(&o[0][4], &o[1][4], fb, pb[0][1], pb[1][1]);
      vf16_load<1, 3>(fb, vb); VF_WAIT(8, fa); vf16_mma(&o[0][8], &o[1][8], fa, pb[0][1], pb[1][1]);
      VF_WAIT(0, fb); vf16_mma(&o[0][12], &o[1][12], fb, pb[0][1], pb[1][1]); }
    asm volatile("s_waitcnt vmcnt(0) lgkmcnt(0)" ::: "memory"); __builtin_amdgcn_s_barrier(); asm volatile("" ::: "memory");
  }
  const float rl0 = __builtin_amdgcn_rcpf(l0), rl1 = __builtin_amdgcn_rcpf(l1);
#pragma unroll
  for (int qb = 0; qb < 2; ++qb) { const float rl = qb ? rl1 : rl0;
    bf16_t* Or = Ob + (long)(wid * QBLK + qb * 16 + c16) * ldo + 4 * g;
    if (!comb) {
#pragma unroll
      for (int db = 0; db < 16; ++db) { const u32x2 w = {cvtpk(o[qb][db][0] * rl, o[qb][db][1] * rl), cvtpk(o[qb][db][2] * rl, o[qb][db][3] * rl)}; *reinterpret_cast<u32x2*>(Or + db * 16) = w; }
    } else {
      bf16_t* Cr = Cb + (long)(wid * QBLK + qb * 16 + c16) * ldc + 4 * g; float ss = 0.f;
#pragma unroll
      for (int db = 0; db < 16; ++db) { const u32x2 w = *reinterpret_cast<const u32x2*>(Or + db * 16);
        const float v0 = bf2f(w.x & 0xffffu) - lam * (o[qb][db][0] * rl), v1 = bf2f(w.x >> 16) - lam * (o[qb][db][1] * rl), v2 = bf2f(w.y & 0xffffu) - lam * (o[qb][db][2] * rl), v3 = bf2f(w.y >> 16) - lam * (o[qb][db][3] * rl);
        o[qb][db] = f32x4{v0, v1, v2, v3}; ss += (v0 * v0 + v1 * v1) + (v2 * v2 + v3 * v3); }
      ss = xrow16_sum(ss);
      const float rstd = __builtin_amdgcn_rsqf(ss * (1.0f / 256.0f) + NORM_EPS) * gscale;
#pragma unroll
      for (int db = 0; db < 16; ++db) { const f32x4 gs = *reinterpret_cast<const f32x4*>(subln + db * 16 + 4 * g);
        const u32x2 w = {cvtpk(o[qb][db][0] * rstd * gs[0], o[qb][db][1] * rstd * gs[1]), cvtpk(o[qb][db][2] * rstd * gs[2], o[qb][db][3] * rstd * gs[3])}; *reinterpret_cast<u32x2*>(Cr + db * 16) = w; }
    }
  }
#undef W16_DMA
}
constexpr int wb16_off(int s, int db, int second) { return s * 8192 + db * 256 + second * 4096; }
template <int S, int G4> __device__ __forceinline__ void vfb16_load(VF& f, int vb) {
  f.l0 = tr_read<wb16_off(S, 4 * G4 + 0, 0)>(vb); f.h0 = tr_read<wb16_off(S, 4 * G4 + 0, 1)>(vb); f.l1 = tr_read<wb16_off(S, 4 * G4 + 1, 0)>(vb); f.h1 = tr_read<wb16_off(S, 4 * G4 + 1, 1)>(vb);
  f.l2 = tr_read<wb16_off(S, 4 * G4 + 2, 0)>(vb); f.h2 = tr_read<wb16_off(S, 4 * G4 + 2, 1)>(vb); f.l3 = tr_read<wb16_off(S, 4 * G4 + 3, 0)>(vb); f.h3 = tr_read<wb16_off(S, 4 * G4 + 3, 1)>(vb);
}
template <class UF>
__device__ __forceinline__ void attn_band16_stream(const int U, UF unit_of, char* lds) {
  int tid = threadIdx.x; asm volatile("" : "+v"(tid));
  const int wid = __builtin_amdgcn_readfirstlane(tid >> 6), lane = tid & 63, c16 = lane & 15, g = lane >> 4;
  constexpr float C = SCALE * 1.4426950408889634f;
  constexpr int TILE = 32768, OFF_B = 3 * TILE, OFF_WS = 4 * TILE;
  const int jlo = wid >> 1, qi0 = wid * QBLK + c16;
  const int kx = (g ^ c16) << 4;
  const int kq_l = (int)(uintptr_t)lds + 16384 + c16 * 256, vb_l = (int)(uintptr_t)lds + (g >> 1) * 2048 + (4 * (g & 1) + (c16 >> 2)) * 32 + (c16 & 3) * 8;
  const int krow0 = 4 * wid + (lane >> 4), kch = ((lane & 15) ^ (krow0 & 15)) * 8;
  const int vkey0 = 8 * (wid >> 1) + ((lane & 15) >> 1), vcol = (4 * (wid & 1) + (lane >> 4)) * 16 + (lane & 1) * 8;
#define BS_DMA(bu, j, boff) do { const int _kb = (bu).kfirst + 64 * (j); const int _sh = (bu).lsh;     \
    _Pragma("unroll") for (int _i = 0; _i < 2; ++_i) { const unsigned _ro = (__umul24((unsigned)min(max(_kb + krow0 + 32 * _i, 0), (bu).Mr - 1), 6144u) << _sh) + kch; \
      __builtin_amdgcn_global_load_lds((const unsigned*)((bu).K + _ro), (LAS unsigned*)(lds + (boff) + 16384 + (wid + 8 * _i) * 1024), 16, 0, 0); } \
    _Pragma("unroll") for (int _i = 0; _i < 2; ++_i) { const unsigned _ro = (__umul24((unsigned)min(max(_kb + vkey0 + 32 * _i, 0), (bu).Mr - 1), 6144u) << _sh) + vcol; \
      __builtin_amdgcn_global_load_lds((const unsigned*)((bu).V + _ro), (LAS unsigned*)(lds + (boff) + (wid + 8 * _i) * 1024), 16, 0, 0); } } while (0)
#define BS_QLOAD(bu) do { const bf16_t* _q = (bu).Q + (long)qi0 * (bu).ld + g * 8; const bf16_t* _q2 = _q + 16L * (bu).ld; \
    asm volatile("global_load_dwordx4 %0, %8, off\n\tglobal_load_dwordx4 %1, %8, off offset:64\n\tglobal_load_dwordx4 %2, %8, off offset:128\n\tglobal_load_dwordx4 %3, %8, off offset:192\n\t" \
                 "global_load_dwordx4 %4, %9, off\n\tglobal_load_dwordx4 %5, %9, off offset:64\n\tglobal_load_dwordx4 %6, %9, off offset:128\n\tglobal_load_dwordx4 %7, %9, off offset:192" \
                 : "=&v"(qr[0]), "=&v"(qr[1]), "=&v"(qr[2]), "=&v"(qr[3]), "=&v"(qr[4]), "=&v"(qr[5]), "=&v"(qr[6]), "=&v"(qr[7]) : "v"(_q), "v"(_q2) : "memory"); } while (0)
#define BS_POS_DMA(gq) do { const int _un = (gq) / 5, _jn = (gq) - 5 * _un; \
    if ((gq) <= 5 * U) { \
      if (_un < U) { const BandUnit _bn = unit_of(_un); BS_DMA(_bn, _jn, ((gq) % 3) * TILE); ndma += 4; } \
      if (_jn == 0 && _un >= 1) { const BandUnit _bp = unit_of(_un - 1); BS_DMA(_bp, 5, OFF_B); ndma += 4; } } } while (0)
  float m0 = -1e30f, m1 = -1e30f, l0 = 0.f, l1 = 0.f; f32x4 o[2][8]; bf16x8 qr[8];
#pragma unroll
  for (int a = 0; a < 2; ++a)
#pragma unroll
    for (int b = 0; b < 8; ++b) o[a][b] = f32x4{0.f, 0.f, 0.f, 0.f};
  { int ndma = 0; if (U > 0) { const BandUnit b0 = unit_of(0); BS_QLOAD(b0); } else {
#pragma unroll
      for (int d0 = 0; d0 < 8; ++d0) qr[d0] = bf16x8{}; }
    BS_POS_DMA(0); BS_POS_DMA(1); }
  asm volatile("s_waitcnt vmcnt(0)" ::: "memory");
#pragma unroll
  for (int d0 = 0; d0 < 8; ++d0) asm volatile("" : "+v"(qr[d0]));
  __builtin_amdgcn_s_barrier(); asm volatile("" ::: "memory");
#pragma unroll 1
  for (int gg = 0; gg <= 5 * U + 2; ++gg) {
    const int rel = gg - jlo, uw = rel >= 0 ? rel / 5 : -1, jr = rel - 5 * uw;
    int ndma = 0;
    if (uw >= 0 && jr >= 3 && uw < U) {
      const BandUnit bu = unit_of(uw);
      if (jr == 3) {
        const float rl0 = __builtin_amdgcn_rcpf(l0), rl1 = __builtin_amdgcn_rcpf(l1);
#pragma unroll
        for (int qb = 0; qb < 2; ++qb) { const float rl = qb ? rl1 : rl0; bf16_t* Or = bu.O + (long)(qi0 + 16 * qb) * bu.ldo + 4 * g;
#pragma unroll
          for (int db = 0; db < 8; ++db) { const u32x2 w = {cvtpk(o[qb][db][0] * rl, o[qb][db][1] * rl), cvtpk(o[qb][db][2] * rl, o[qb][db][3] * rl)}; *reinterpret_cast<u32x2*>(Or + db * 16) = w; } }
        if (g == 0) { bu.L[(long)qi0 * bu.ldl] = m0 * SCALE + __logf(l0); bu.L[(long)(qi0 + 16) * bu.ldl] = m1 * SCALE + __logf(l1); } }
      asm volatile("s_waitcnt vmcnt(0)" ::: "memory");
      if (jr == 3 && uw + 1 < U) { const BandUnit bn = unit_of(uw + 1); BS_QLOAD(bn); ndma += 8; }
      BS_POS_DMA(gg + 2);
    } else {
    BS_POS_DMA(gg + 2);
    if (uw >= 0 && jr <= 2 && uw < U) {
      const BandUnit bu = unit_of(uw);
      const int j = jlo + jr, boff = (j == 5) ? OFF_B : (gg % 3) * TILE;
      if (jr == 0) { m0 = m1 = -1e30f; l0 = l1 = 0.f;
#pragma unroll
        for (int a = 0; a < 2; ++a)
#pragma unroll
          for (int b = 0; b < 8; ++b) o[a][b] = f32x4{0.f, 0.f, 0.f, 0.f}; }
      if ((bu.kfirst + 64 * j >= 0) & (bu.kfirst + 64 * j + 64 <= bu.Mr)) {
      f32x4 p[2][4];
      { int kxo = kx; asm volatile("" : "+v"(kxo));
        const int kq = kq_l + boff; const int ka0 = kq + (0 ^ kxo), ka1 = kq + (64 ^ kxo), ka2 = kq + (128 ^ kxo), ka3 = kq + (192 ^ kxo);
        bf16x8 f0, f1;
#define K16_RD(F, IDX) F = dsb_rd128<((IDX) >> 2) * 4096>(((IDX) & 3) == 0 ? ka0 : ((IDX) & 3) == 1 ? ka1 : ((IDX) & 3) == 2 ? ka2 : ka3)
#define K16_WAIT(N, F) asm volatile("s_waitcnt lgkmcnt(" #N ")" : "+v"(F) :: "memory")
#define K16_MMA(F, IDX) do { p[0][(IDX) >> 2] = __builtin_amdgcn_mfma_f32_16x16x32_bf16(F, qr[(IDX) & 3], ((IDX) & 3) ? p[0][(IDX) >> 2] : f32x4{0.f, 0.f, 0.f, 0.f}, 0, 0, 0); \
                             p[1][(IDX) >> 2] = __builtin_amdgcn_mfma_f32_16x16x32_bf16(F, qr[4 + ((IDX) & 3)], ((IDX) & 3) ? p[1][(IDX) >> 2] : f32x4{0.f, 0.f, 0.f, 0.f}, 0, 0, 0); } while (0)
        K16_RD(f0, 0);
        K16_RD(f1, 1); K16_WAIT(1, f0); K16_MMA(f0, 0);
        K16_RD(f0, 2); K16_WAIT(1, f1); K16_MMA(f1, 1);
        K16_RD(f1, 3); K16_WAIT(1, f0); K16_MMA(f0, 2);
        K16_RD(f0, 4); K16_WAIT(1, f1); K16_MMA(f1, 3);
        K16_RD(f1, 5); K16_WAIT(1, f0); K16_MMA(f0, 4);
        K16_RD(f0, 6); K16_WAIT(1, f1); K16_MMA(f1, 5);
        K16_RD(f1, 7); K16_WAIT(1, f0); K16_MMA(f0, 6);
        K16_RD(f0, 8); K16_WAIT(1, f1); K16_MMA(f1, 7);
        K16_RD(f1, 9); K16_WAIT(1, f0); K16_MMA(f0, 8);
        K16_RD(f0, 10); K16_WAIT(1, f1); K16_MMA(f1, 9);
        K16_RD(f1, 11); K16_WAIT(1, f0); K16_MMA(f0, 10);
        K16_RD(f0, 12); K16_WAIT(1, f1); K16_MMA(f1, 11);
        K16_RD(f1, 13); K16_WAIT(1, f0); K16_MMA(f0, 12);
        K16_RD(f0, 14); K16_WAIT(1, f1); K16_MMA(f1, 13);
        K16_RD(f1, 15); K16_WAIT(1, f0); K16_MMA(f0, 14);
        K16_WAIT(0, f1); K16_MMA(f1, 15);
#undef K16_RD
#undef K16_WAIT
#undef K16_MMA
      }
      if (jr != 1) {
        const int wl = c16 - 4 * g;
        if (wid & 1) { if (jr == 0) BMALL(1, 0); else BMALL(1, 1); } else { if (jr == 0) BMALL(0, 0); else BMALL(0, 1); } }
      float pm0 = PMAX16(p[0]), pm1 = PMAX16(p[1]);
      pm0 = xrow16_max(pm0); pm1 = xrow16_max(pm1);
      float al0 = 1.f, al1 = 1.f;
      if (!__builtin_expect(__all((pm0 - m0 <= THR / SCALE) & (pm1 - m1 <= THR / SCALE)), 1)) {
        const float n0 = fmaxf(m0, pm0), n1 = fmaxf(m1, pm1); al0 = __builtin_amdgcn_exp2f((m0 - n0) * C); al1 = __builtin_amdgcn_exp2f((m1 - n1) * C); m0 = n0; m1 = n1;
        if (jr != 0) {
#pragma unroll
          for (int db = 0; db < 8; ++db) { o[0][db] = o[0][db] * al0; o[1][db] = o[1][db] * al1; } } }
      const float mc0 = -m0 * C, mc1 = -m1 * C; float ps0 = 0.f, ps1 = 0.f;
#pragma unroll
      for (int kb = 0; kb < 4; ++kb)
#pragma unroll
        for (int t2 = 0; t2 < 4; ++t2) { p[0][kb][t2] = __builtin_amdgcn_exp2f(fmaf(p[0][kb][t2], C, mc0)); p[1][kb][t2] = __builtin_amdgcn_exp2f(fmaf(p[1][kb][t2], C, mc1)); ps0 += p[0][kb][t2]; ps1 += p[1][kb][t2]; }
      ps0 = xrow16_sum(ps0); ps1 = xrow16_sum(ps1); l0 = l0 * al0 + ps0; l1 = l1 * al1 + ps1;
      bf16x8 pb[2][2];
#pragma unroll
      for (int a = 0; a < 2; ++a)
#pragma unroll
        for (int s = 0; s < 2; ++s) { u32x4 w = {cvtpk(p[a][2 * s][0], p[a][2 * s][1]), cvtpk(p[a][2 * s][2], p[a][2 * s][3]), cvtpk(p[a][2 * s + 1][0], p[a][2 * s + 1][1]), cvtpk(p[a][2 * s + 1][2], p[a][2 * s + 1][3])};
          pb[a][s] = *reinterpret_cast<bf16x8*>(&w); }
      SBAR();
      { int vb = vb_l + boff; asm volatile("" : "+v"(vb)); VF fa;
        vfb16_load<0, 0>(fa, vb); VF_WAIT(0, fa); vf16_mma(&o[0][0], &o[1][0], fa, pb[0][0], pb[1][0]);
        vfb16_load<0, 1>(fa, vb); VF_WAIT(0, fa); vf16_mma(&o[0][4], &o[1][4], fa, pb[0][0], pb[1][0]);
        vfb16_load<1, 0>(fa, vb); VF_WAIT(0, fa); vf16_mma(&o[0][0], &o[1][0], fa, pb[0][1], pb[1][1]);
        vfb16_load<1, 1>(fa, vb); VF_WAIT(0, fa); vf16_mma(&o[0][4], &o[1][4], fa, pb[0][1], pb[1][1]); }
      }
    } }
    asm volatile("s_waitcnt lgkmcnt(0)" ::: "memory");
#define BS_VMW(n) case n: asm volatile("s_waitcnt vmcnt(" #n ")" ::: "memory"); break;
    switch (ndma) { BS_VMW(4) BS_VMW(8) BS_VMW(12) BS_VMW(16) default: asm volatile("s_waitcnt vmcnt(0)" ::: "memory"); break; }
#undef BS_VMW
    __builtin_amdgcn_s_barrier(); asm volatile("" ::: "memory");
  }
#undef BS_DMA
#undef BS_QLOAD
#undef BS_POS_DMA
}
}

struct Frame { LAS unsigned char* lds; int wave, vcu, G; };
#define FRAME_TID() int f_tid = threadIdx.x; asm volatile("" : "+v"(f_tid)); const int f_lane = f_tid & 63; (void)f_lane

constexpr int TP_SCR = 64 * 65 * 4;
struct TpDesc { const float* W; bf16_t* WT; const float* gain; int K, N, mode, item; };
__device__ __forceinline__ void tp_load(const TpDesc& d, f32x4 (&v)[16], int lane) {
    const int nblk = d.N / 64, kb = d.item / nblk, nb = d.item % nblk, k0 = 64 * kb, n0 = 64 * nb, r = lane >> 4, q = lane & 15;
#pragma unroll
    for (int i = 0; i < 16; ++i) v[i] = *(const f32x4*)(d.W + (size_t)(k0 + 4 * i + r) * d.N + n0 + 4 * q);
}
__device__ __forceinline__ void tp_finish(const TpDesc& d, const f32x4 (&v)[16], LAS float* scr, int lane) {
    const int nblk = d.N / 64, kb = d.item / nblk, nb = d.item % nblk, k0 = 64 * kb, n0 = 64 * nb, r = lane >> 4, q = lane & 15;
#pragma unroll
    for (int i = 0; i < 16; ++i) { const int kk = 4 * i + r; f32x4 w = v[i]; if (d.gain) w = w * d.gain[k0 + kk];
        LAS float* p = scr + kk * 65 + 4 * q; p[0] = w[0]; p[1] = w[1]; p[2] = w[2]; p[3] = w[3]; }
    LDS_WAIT(); asm volatile("" ::: "memory");
    int d0 = n0;
    if (d.mode == 1) { const int half = n0 / FFN, j = n0 % FFN; d0 = (j / 128) * 256 + half * 128 + (j % 128); }
    const int c = lane & 7;
#pragma unroll
    for (int j = 0; j < 8; ++j) { const int n = (lane >> 3) + 8 * j; const LAS float* s = scr + (8 * c) * 65 + n;
        u32x4 o; o.x = cvt_pk_bf16(s[0 * 65], s[1 * 65]); o.y = cvt_pk_bf16(s[2 * 65], s[3 * 65]); o.z = cvt_pk_bf16(s[4 * 65], s[5 * 65]); o.w = cvt_pk_bf16(s[6 * 65], s[7 * 65]);
        *(u32x4*)(d.WT + (size_t)(d0 + n) * d.K + k0 + 8 * c) = o; }
    LDS_WAIT(); asm volatile("" ::: "memory");
}

struct Args { const float* in[28]; float* out; unsigned char* ws; };
#define P_x (P.in[0])
#define P_mem (P.in[1])
#define P_mix_g (P.in[2])
#define P_xa_g (P.in[3])
#define P_mem_g (P.in[4])
#define P_wq (P.in[5])
#define P_wkv (P.in[6])
#define P_wo (P.in[7])
#define P_ffn_g (P.in[8])
#define P_w13 (P.in[9])
#define P_w2 (P.in[10])
#define P_w_in (P.in[11])
#define P_w_abo (P.in[12])
#define P_lam_re (P.in[13])
#define P_lam_im (P.in[14])
#define P_log_step (P.in[15])
#define P_b_re (P.in[16])
#define P_b_im (P.in[17])
#define P_c_re (P.in[18])
#define P_c_im (P.in[19])
#define P_s5_d (P.in[20])
#define P_glu_w (P.in[21])
#define P_glu_b (P.in[22])
#define P_dlam (P.in[23])
#define P_subln (P.in[24])
#define P_wqkv (P.in[25])
#define P_wco (P.in[26])
#define P_fin_g (P.in[27])
typedef Args Ptrs;

__device__ __forceinline__ void p0_prologue(const Frame& F, const Ptrs& P) {
    FRAME_TID();
    unsigned char* ws = P.ws;
    LAS float* scr = (LAS float*)(F.lds + F.wave * TP_SCR);
    const int gw = F.vcu * 8 + F.wave, NGW = F.G * 8;
    const long gt = (long)F.vcu * 512 + f_tid, NGT = (long)F.G * 512;
    constexpr int I_IN = 32 * 64, I_SQ = 32 * 32, I_GLU = 16 * 16, I_QKV = 32 * 96, I_KV = 32 * 64, I_13 = 32 * 176, I_2 = 88 * 32;
    constexpr int NITEMS = 2 * I_IN + 2 * I_SQ + 2 * I_GLU + 2 * I_QKV + 2 * I_SQ + 4 * I_KV + 4 * I_SQ + 4 * I_13 + 4 * I_2;
    auto decode = [&](int it, TpDesc& d) {
        int r = it;
        if (r < 2 * I_IN) { const int mi = r / I_IN; d = TpDesc{P_w_in + (size_t)mi * 2048 * 4096, (bf16_t*)(ws + WS_W_IN) + (size_t)mi * 2048 * 4096, P_mix_g + (2 * mi) * 2048, 2048, 4096, 0, r % I_IN}; return; } r -= 2 * I_IN;
        if (r < 2 * I_SQ) { const int mi = r / I_SQ; d = TpDesc{P_w_abo + (size_t)mi * 2048 * 2048, (bf16_t*)(ws + WS_W_ABO) + (size_t)mi * 2048 * 2048, nullptr, 2048, 2048, 0, r % I_SQ}; return; } r -= 2 * I_SQ;
        if (r < 2 * I_GLU) { const int mi = r / I_GLU; d = TpDesc{P_glu_w + (size_t)mi * 1024 * 1024, (bf16_t*)(ws + WS_W_GLU) + (size_t)mi * 1024 * 1024, nullptr, 1024, 1024, 0, r % I_GLU}; return; } r -= 2 * I_GLU;
        if (r < 2 * I_QKV) { const int mi = r / I_QKV; d = TpDesc{P_wqkv + (size_t)mi * 2048 * 6144, (bf16_t*)(ws + WS_W_QKV) + (size_t)mi * 2048 * 6144, P_mix_g + (2 * mi + 1) * 2048, 2048, 6144, 0, r % I_QKV}; return; } r -= 2 * I_QKV;
        if (r < 2 * I_SQ) { const int mi = r / I_SQ; d = TpDesc{P_wco + (size_t)mi * 2048 * 2048, (bf16_t*)(ws + WS_W_CO) + (size_t)mi * 2048 * 2048, nullptr, 2048, 2048, 0, r % I_SQ}; return; } r -= 2 * I_SQ;
        if (r < 4 * I_KV) { const int mi = r / I_KV; d = TpDesc{P_wkv + (size_t)mi * 2048 * 4096, (bf16_t*)(ws + WS_WKV_T) + (size_t)mi * 2048 * 4096, P_mem_g + mi * 2048, 2048, 4096, 0, r % I_KV}; return; } r -= 4 * I_KV;
        if (r < 4 * I_SQ) { const int mi = r / I_SQ; d = TpDesc{P_wo + (size_t)mi * 2048 * 2048, (bf16_t*)(ws + WS_WO_T) + (size_t)mi * 2048 * 2048, nullptr, 2048, 2048, 0, r % I_SQ}; return; } r -= 4 * I_SQ;
        if (r < 4 * I_13) { const int mi = r / I_13; d = TpDesc{P_w13 + (size_t)mi * 2048 * 11264, (bf16_t*)(ws + WS_W13) + (size_t)mi * 2048 * 11264, P_ffn_g + mi * 2048, 2048, 11264, 1, r % I_13}; return; } r -= 4 * I_13;
        { const int mi = r / I_2; d = TpDesc{P_w2 + (size_t)mi * 5632 * 2048, (bf16_t*)(ws + WS_W2) + (size_t)mi * 5632 * 2048, nullptr, 5632, 2048, 0, r % I_2}; }
    };
    {
        TpDesc dc, dn; f32x4 va[16], vb[16];
        int it = gw;
        if (it < NITEMS) { decode(it, dc); tp_load(dc, va, f_lane); }
#pragma unroll 1
        for (; it < NITEMS; it += 2 * NGW) {
            const int it1 = it + NGW, it2 = it + 2 * NGW;
            if (it1 < NITEMS) { decode(it1, dn); tp_load(dn, vb, f_lane); }
            tp_finish(dc, va, scr, f_lane);
            if (it1 < NITEMS) { if (it2 < NITEMS) { decode(it2, dc); tp_load(dc, va, f_lane); } tp_finish(dn, vb, scr, f_lane); }
        }
    }
    { const f32x8* src = (const f32x8*)P_wq; u32x4* dst = (u32x4*)(ws + WS_WQ_B);
      for (long i = gt; i < (long)4 * 2048 * 2048 / 8; i += 4 * NGT) { f32x8 v[4];
#pragma unroll
          for (int u = 0; u < 4; ++u) v[u] = src[min(i + u * NGT, (long)4 * 2048 * 2048 / 8 - 1)];
#pragma unroll
          for (int u = 0; u < 4; ++u) if (i + u * NGT < (long)4 * 2048 * 2048 / 8) { u32x4 o; o.x = cvt_pk_bf16(v[u][0], v[u][1]); o.y = cvt_pk_bf16(v[u][2], v[u][3]); o.z = cvt_pk_bf16(v[u][4], v[u][5]); o.w = cvt_pk_bf16(v[u][6], v[u][7]); dst[i + u * NGT] = o; } } }
    { bf16_t* HB = (bf16_t*)(ws + WS_HB); float* rss0 = (float*)(ws + WS_RSSP);
      for (int row = gw; row < MTOK; row += NGW) { const f32x4* xr = (const f32x4*)(P_x + (size_t)row * DM) + f_lane; float ss = 0.f; f32x4 xv[8];
#pragma unroll
          for (int j = 0; j < 8; ++j) xv[j] = xr[64 * j];
#pragma unroll
          for (int j = 0; j < 8; ++j) { const f32x4 v = xv[j]; ss += (v[0] * v[0] + v[1] * v[1]) + (v[2] * v[2] + v[3] * v[3]); *(u32x2*)(HB + (size_t)row * DM + (j * 64 + f_lane) * 4) = pack4(v); }
          ss = wave_sum(ss); if (f_lane < 32) rss0[(size_t)row * 32 + f_lane] = f_lane == 0 ? ss : 0.f; } }
    { bf16_t* MN = (bf16_t*)(ws + WS_MEMN);
      for (int row = gw; row < BATCH * MEML; row += NGW) { const f32x4* xr = (const f32x4*)(P_mem + (size_t)row * DM) + f_lane; f32x4 v[8]; float ss = 0.f;
#pragma unroll
          for (int j = 0; j < 8; ++j) { v[j] = xr[64 * j]; ss += (v[j][0] * v[j][0] + v[j][1] * v[j][1]) + (v[j][2] * v[j][2] + v[j][3] * v[j][3]); }
          const float rstd = 1.0f / sqrtf(wave_sum(ss) * (1.0f / DM) + NORM_EPS);
#pragma unroll
          for (int j = 0; j < 8; ++j) *(u32x2*)(MN + (size_t)row * DM + (j * 64 + f_lane) * 4) = pack4(v[j] * rstd); } }
}


__device__ __forceinline__ void s5_tables_task(const Frame& F, const Ptrs& P, int i, int g) {
    FRAME_TID();
    unsigned char* ws = P.ws;
    LAS f32x2* LPs = (LAS f32x2*)(F.lds);
    LAS f32x2* BBs = (LAS f32x2*)(F.lds + 33792);
    LAS f32x2* CCs = (LAS f32x2*)(F.lds + 50176);
    LAS float* KTs = (LAS float*)(F.lds + 66560);
    LAS f32x2* Qs = (LAS f32x2*)(F.lds + 132096);
    const int t = f_tid;
    for (int e = t; e < 2 * 64 * 33; e += 512) { const int d = e / (64 * 33), rem = e - d * (64 * 33), p = rem / 33, tau = rem - p * 33; const int gd = (i * 2 + d) * 64 + g, idx = gd * 64 + p;
        const float st = expf(P_log_step[gd]), a = P_lam_re[idx] * st, b = P_lam_im[idx] * st; const float mag = expf((float)tau * a), ang = (float)tau * b; LPs[e] = (f32x2){mag * cosf(ang), mag * sinf(ang)}; }
    if (t < 128) { const int d = t >> 6, p = t & 63, gd = (i * 2 + d) * 64 + g, idx = gd * 64 + p; const float st = expf(P_log_step[gd]), lr = P_lam_re[idx], li = P_lam_im[idx], a = lr * st, b = li * st;
        const float sh = sinf(0.5f * b), nr = expm1f(a) * cosf(b) - 2.0f * sh * sh, ni = expf(a) * sinf(b), den = lr * lr + li * li;
        Qs[t] = (f32x2){(nr * lr + ni * li) / den, (ni * lr - nr * li) / den}; }
    for (int e = t; e < 2048; e += 512) { const int d = e >> 10, n = (e >> 6) & 15, p = e & 63; const size_t ci = ((size_t)((i * 2 + d) * 64 + g) * 16 + n) * 64 + p; CCs[e] = (f32x2){P_c_re[ci], P_c_im[ci]}; }
    LDS_WAIT(); __syncthreads();
    for (int e = t; e < 2048; e += 512) { const int d = e >> 10, p = (e >> 4) & 63, n = e & 15; const size_t bi = ((size_t)((i * 2 + d) * 64 + g) * 64 + p) * 16 + n; const f32x2 q = Qs[d * 64 + p];
        const float br = P_b_re[bi], bim = P_b_im[bi]; BBs[e] = (f32x2){q.x * br - q.y * bim, q.x * bim + q.y * br}; }
    if (t < 128) { const int d = t >> 6, p = t & 63; ((f32x2*)(ws + WS_LP))[((size_t)(i * 2 + d) * 64 + g) * 64 + p] = LPs[(d * 64 + p) * 33 + 32]; }
    LDS_WAIT(); __syncthreads();
    {
        const int d = t >> 8, no = (t >> 4) & 15, ni = t & 15; float acc[32];
#pragma unroll
        for (int tau = 0; tau < 32; ++tau) acc[tau] = 0.f;
#pragma unroll 2
        for (int p = 0; p < 64; ++p) { const f32x2 c = CCs[(d * 16 + no) * 64 + p], bb = BBs[(d * 64 + p) * 16 + ni]; const float wr = c.x * bb.x - c.y * bb.y, wi = c.x * bb.y + c.y * bb.x;
            const LAS f32x2* lp = LPs + (d * 64 + p) * 33;
#pragma unroll
            for (int tau = 0; tau < 32; ++tau) { const f32x2 L = lp[tau]; acc[tau] += wr * L.x - wi * L.y; } }
#pragma unroll
        for (int tau = 0; tau < 32; ++tau) KTs[(d * 32 + tau) * 256 + no * 16 + ni] = acc[tau];
    }
    LDS_WAIT(); __syncthreads();
    bf16_t* BTE = (bf16_t*)(ws + WS_BTE) + (size_t)(i * 64 + g) * 256 * 512;
    for (int c8 = t; c8 < 256 * 64; c8 += 512) { const int k8 = c8 & 63, j = c8 >> 6, s = k8 >> 1, n0 = (k8 & 1) * 8, which = j >> 6, p = j & 63, d = which >> 1, ex = d == 0 ? 31 - s : s;
        const f32x2 lp = LPs[(d * 64 + p) * 33 + ex]; float v[8];
#pragma unroll
        for (int q = 0; q < 8; ++q) { const f32x2 bb = BBs[(d * 64 + p) * 16 + n0 + q]; v[q] = (which & 1) ? (lp.x * bb.y + lp.y * bb.x) : (lp.x * bb.x - lp.y * bb.y); }
        u32x4 o; o.x = cvt_pk_bf16(v[0], v[1]); o.y = cvt_pk_bf16(v[2], v[3]); o.z = cvt_pk_bf16(v[4], v[5]); o.w = cvt_pk_bf16(v[6], v[7]);
        *(u32x4*)(BTE + (size_t)j * 512 + k8 * 8) = o; }
    bf16_t* BTT = (bf16_t*)(ws + WS_BTT) + (size_t)(i * 64 + g) * 512 * S5KT;
    for (int c8 = t; c8 < 512 * 32; c8 += 512) { const int j8 = c8 & 31, row = c8 >> 5, tt = row >> 4, no = row & 15, j0 = j8 * 8, which = j0 >> 6, p0 = j0 & 63, d = which >> 1, ex = d == 0 ? tt + 1 : 32 - tt; float v[8];
#pragma unroll
        for (int q = 0; q < 8; ++q) { const int p = p0 + q; const f32x2 lp = LPs[(d * 64 + p) * 33 + ex], c = CCs[(d * 16 + no) * 64 + p]; v[q] = (which & 1) ? -(c.x * lp.y + c.y * lp.x) : (c.x * lp.x - c.y * lp.y); }
        u32x4 o; o.x = cvt_pk_bf16(v[0], v[1]); o.y = cvt_pk_bf16(v[2], v[3]); o.z = cvt_pk_bf16(v[4], v[5]); o.w = cvt_pk_bf16(v[6], v[7]);
        *(u32x4*)(BTT + (size_t)row * S5KT + 512 + j0) = o; }
    for (int c8 = t; c8 < 512 * 64; c8 += 512) { const int k8 = c8 & 63, row = c8 >> 6, tt = row >> 4, no = row & 15, s = k8 >> 1, ni0 = (k8 & 1) * 8; float v[8];
        if (s < tt) {
#pragma unroll
            for (int q = 0; q < 8; ++q) v[q] = KTs[(0 * 32 + (tt - s)) * 256 + no * 16 + ni0 + q];
        } else if (s > tt) {
#pragma unroll
            for (int q = 0; q < 8; ++q) v[q] = KTs[(1 * 32 + (s - tt)) * 256 + no * 16 + ni0 + q];
        } else { const float dv = P_s5_d[i * 1024 + g * 16 + no];
#pragma unroll
            for (int q = 0; q < 8; ++q) v[q] = KTs[no * 16 + ni0 + q] + KTs[32 * 256 + no * 16 + ni0 + q] + ((ni0 + q == no) ? dv : 0.f); }
        u32x4 o; o.x = cvt_pk_bf16(v[0], v[1]); o.y = cvt_pk_bf16(v[2], v[3]); o.z = cvt_pk_bf16(v[4], v[5]); o.w = cvt_pk_bf16(v[6], v[7]);
        *(u32x4*)(BTT + (size_t)row * S5KT + k8 * 8) = o; }
}

__device__ __forceinline__ void p1_thin(const Frame& F, const Ptrs& P) {
    FRAME_TID();
    unsigned char* ws = P.ws; const long gt = (long)F.vcu * 512 + f_tid, NGT = (long)F.G * 512;
    const f32x2* LP = (const f32x2*)(ws + WS_LP); const f32x2* BB = (const f32x2*)(ws + WS_BBAR);
    float* KT = (float*)(ws + WS_KTAB);
    for (long e = gt; e < (long)2 * 2 * 64 * 32 * 256; e += NGT) {
        const int ni = (int)(e & 15), no = (int)((e >> 4) & 15), tau = (int)((e >> 8) & 31); const long igd = e >> 13;
        float acc = 0.f;
#pragma unroll 4
        for (int p = 0; p < 64; ++p) { const long idx = igd * 64 + p; const f32x2 lp = LP[idx * 33 + tau], bb = BB[idx * 16 + ni];
            const float xr = lp.x * bb.x - lp.y * bb.y, xi = lp.x * bb.y + lp.y * bb.x;
            const float cr = P_c_re[(igd * 16 + no) * 64 + p], ci = P_c_im[(igd * 16 + no) * 64 + p];
            acc += cr * xr - ci * xi; }
        KT[e] = acc;
    }
    bf16_t* BTE = (bf16_t*)(ws + WS_BTE);
    for (long e = gt; e < (long)2 * 64 * 256 * 64; e += NGT) {
        const int k8 = (int)(e & 63), j = (int)((e >> 6) & 255), g = (int)((e >> 14) & 63), i = (int)(e >> 20);
        const int s = k8 >> 1, n0 = (k8 & 1) * 8, which = j >> 6, p = j & 63, d = which >> 1, ex = d == 0 ? 31 - s : s;
        const long idx = ((long)(i * 2 + d) * 64 + g) * 64 + p; const f32x2 lp = LP[idx * 33 + ex];
        float v[8];
#pragma unroll
        for (int q = 0; q < 8; ++q) { const f32x2 bb = BB[idx * 16 + n0 + q]; v[q] = (which & 1) ? (lp.x * bb.y + lp.y * bb.x) : (lp.x * bb.x - lp.y * bb.y); }
        u32x4 o; o.x = cvt_pk_bf16(v[0], v[1]); o.y = cvt_pk_bf16(v[2], v[3]); o.z = cvt_pk_bf16(v[4], v[5]); o.w = cvt_pk_bf16(v[6], v[7]);
        *(u32x4*)(BTE + (((size_t)(i * 64 + g) * 256 + j) * 512 + k8 * 8)) = o;
    }
    bf16_t* BTT = (bf16_t*)(ws + WS_BTT);
    for (long e = gt; e < (long)2 * 64 * 512 * 32; e += NGT) {
        const int j8 = (int)(e & 31), row = (int)((e >> 5) & 511), g = (int)((e >> 14) & 63), i = (int)(e >> 20);
        const int t = row >> 4, no = row & 15, j0 = j8 * 8, which = j0 >> 6, p0 = j0 & 63, d = which >> 1, ex = d == 0 ? t + 1 : 32 - t;
        const long igd = (long)(i * 2 + d) * 64 + g;
        float v[8];
#pragma unroll
        for (int q = 0; q < 8; ++q) { const int p = p0 + q; const f32x2 lp = LP[(igd * 64 + p) * 33 + ex];
            const float cr = P_c_re[(igd * 16 + no) * 64 + p], ci = P_c_im[(igd * 16 + no) * 64 + p];
            v[q] = (which & 1) ? -(cr * lp.y + ci * lp.x) : (cr * lp.x - ci * lp.y); }
        u32x4 o; o.x = cvt_pk_bf16(v[0], v[1]); o.y = cvt_pk_bf16(v[2], v[3]); o.z = cvt_pk_bf16(v[4], v[5]); o.w = cvt_pk_bf16(v[6], v[7]);
        *(u32x4*)(BTT + (((size_t)(i * 64 + g) * 512 + row) * S5KT + 512 + j0)) = o;
    }
}
__device__ __forceinline__ void p2_thin(const Frame& F, const Ptrs& P) {
    FRAME_TID();
    unsigned char* ws = P.ws; const long gt = (long)F.vcu * 512 + f_tid, NGT = (long)F.G * 512;
    const float* KT = (const float*)(ws + WS_KTAB); bf16_t* BTT = (bf16_t*)(ws + WS_BTT);
    for (long e = gt; e < (long)2 * 64 * 512 * 64; e += NGT) {
        const int k8 = (int)(e & 63), row = (int)((e >> 6) & 511), g = (int)((e >> 15) & 63), i = (int)(e >> 21);
        const int t = row >> 4, no = row & 15, s = k8 >> 1, ni0 = (k8 & 1) * 8;
        f32x8 v;
        if (s < t) v = *(const f32x8*)(KT + ((((size_t)(i * 2 + 0) * 64 + g) * 32 + (t - s)) * 256 + no * 16 + ni0));
        else if (s > t) v = *(const f32x8*)(KT + ((((size_t)(i * 2 + 1) * 64 + g) * 32 + (s - t)) * 256 + no * 16 + ni0));
        else { v = *(const f32x8*)(KT + ((((size_t)(i * 2 + 0) * 64 + g) * 32) * 256 + no * 16 + ni0)) + *(const f32x8*)(KT + ((((size_t)(i * 2 + 1) * 64 + g) * 32) * 256 + no * 16 + ni0));
            const float dv = P_s5_d[i * 1024 + g * 16 + no];
#pragma unroll
            for (int q = 0; q < 8; ++q) v[q] += (ni0 + q == no) ? dv : 0.f; }
        u32x4 o; o.x = cvt_pk_bf16(v[0], v[1]); o.y = cvt_pk_bf16(v[2], v[3]); o.z = cvt_pk_bf16(v[4], v[5]); o.w = cvt_pk_bf16(v[6], v[7]);
        *(u32x4*)(BTT + (((size_t)(i * 64 + g) * 512 + row) * S5KT + k8 * 8)) = o;
    }
}
__device__ __forceinline__ void s5_scan(const Frame& F, const Ptrs& P, int i) {
    FRAME_TID();
    unsigned char* ws = P.ws;
    if (F.wave != 0) return;
    const f32x2* LP = (const f32x2*)(ws + WS_LP); const float* E = (const float*)(ws + WS_E); bf16_t* U2 = (bf16_t*)(ws + WS_U2);
    for (int w = F.vcu; w < 256; w += F.G) {
        const int b = w >> 7, g = (w >> 1) & 63, d = w & 1, p = f_lane;
        const f32x2 a = LP[(((long)(i * 2 + d) * 64 + g) * 64 + p)];
        const size_t r0 = (size_t)g * S5NCH + b * 256;
        float cr = 0.f, ci = 0.f;
        if (d == 0) {
#pragma unroll 8
            for (int c = 0; c < 256; ++c) { const size_t r = r0 + c;
                U2[r * S5KT + 512 + p] = (bf16_t)f2bf(cr); U2[r * S5KT + 576 + p] = (bf16_t)f2bf(ci);
                const float er = E[r * 256 + p], ei = E[r * 256 + 64 + p];
                const float nr = a.x * cr - a.y * ci + er, nim = a.x * ci + a.y * cr + ei; cr = nr; ci = nim; }
        } else {
#pragma unroll 8
            for (int c = 255; c >= 0; --c) { const size_t r = r0 + c;
                U2[r * S5KT + 640 + p] = (bf16_t)f2bf(cr); U2[r * S5KT + 704 + p] = (bf16_t)f2bf(ci);
                const float er = E[r * 256 + 128 + p], ei = E[r * 256 + 192 + p];
                const float nr = a.x * cr - a.y * ci + er, nim = a.x * ci + a.y * cr + ei; cr = nr; ci = nim; }
        }
    }
}
__device__ __forceinline__ void s5_scan_local(const Frame& F, const Ptrs& P, int i, int b, int g) {
    FRAME_TID();
    unsigned char* ws = P.ws;
    if (F.wave > 1) return;
    const f32x2* LP = (const f32x2*)(ws + WS_LP); const float* E = (const float*)(ws + WS_E); bf16_t* U2 = (bf16_t*)(ws + WS_U2);
    const int d = F.wave, p = f_lane;
    const f32x2 a = LP[(((long)(i * 2 + d) * 64 + g) * 64 + p)];
    const size_t r0 = (size_t)g * S5NCH + b * 256;
    float cr = 0.f, ci = 0.f;
    float era[16], eia[16], erb[16], eib[16];
#define S5_LD(ER, EI, blk) do { _Pragma("unroll") for (int q = 0; q < 16; ++q) { const int c = d == 0 ? (blk) * 16 + q : 255 - ((blk) * 16 + q); const size_t r = r0 + c; \
        ER[q] = E[r * 256 + d * 128 + p]; EI[q] = E[r * 256 + d * 128 + 64 + p]; } } while (0)
#define S5_SCAN(ER, EI, blk) do { _Pragma("unroll") for (int q = 0; q < 16; ++q) { const int c = d == 0 ? (blk) * 16 + q : 255 - ((blk) * 16 + q); const size_t r = r0 + c; \
        U2[r * S5KT + 512 + d * 128 + p] = (bf16_t)f2bf(cr); U2[r * S5KT + 576 + d * 128 + p] = (bf16_t)f2bf(ci); \
        const float nr = a.x * cr - a.y * ci + ER[q], nim = a.x * ci + a.y * cr + EI[q]; cr = nr; ci = nim; } } while (0)
    S5_LD(era, eia, 0);
#pragma unroll 1
    for (int blk = 0; blk < 16; blk += 2) {
        S5_LD(erb, eib, blk + 1);
        S5_SCAN(era, eia, blk);
        if (blk + 2 < 16) S5_LD(era, eia, blk + 2);
        S5_SCAN(erb, eib, blk + 1);
    }
#undef S5_LD
#undef S5_SCAN
}
__device__ __forceinline__ void diff_combine(const Frame& F, const Ptrs& P, int i, int layer) {
    FRAME_TID();
    unsigned char* ws = P.ws; const int gw = F.vcu * 8 + F.wave, NGW = F.G * 8;
    const float* lv = P_dlam + i * 512;
    float d01 = lv[f_lane] * lv[128 + f_lane] + lv[64 + f_lane] * lv[192 + f_lane], d23 = lv[256 + f_lane] * lv[384 + f_lane] + lv[320 + f_lane] * lv[448 + f_lane];
    d01 = wave_sum(d01); d23 = wave_sum(d23);
    int ly_ = layer; asm volatile("" : "+s"(ly_));
    const float linit = ly_ == 0 ? 2.000000000e-01f : ly_ == 1 ? 3.555090676e-01f : ly_ == 2 ? 4.707130183e-01f : 5.560582042e-01f;
    const float lam = __builtin_bit_cast(float, __builtin_amdgcn_readfirstlane(__builtin_bit_cast(int, expf(d01) - expf(d23) + linit)));
    const bf16_t* O1 = (const bf16_t*)(ws + WS_O12); const bf16_t* O2 = O1 + (size_t)MTOK * 1024; bf16_t* CAT = (bf16_t*)(ws + WS_CAT);
    for (int task = gw; task < MTOK * 4; task += NGW) {
        const int tok = task >> 2, h = task & 3; const size_t off = (size_t)tok * 1024 + h * 256 + f_lane * 4;
        const u32x2 a = *(const u32x2*)(O1 + off), b = *(const u32x2*)(O2 + off);
        f32x4 v; v[0] = bf2f(a.x & 0xffffu) - lam * bf2f(b.x & 0xffffu); v[1] = bf2f(a.x >> 16) - lam * bf2f(b.x >> 16); v[2] = bf2f(a.y & 0xffffu) - lam * bf2f(b.y & 0xffffu); v[3] = bf2f(a.y >> 16) - lam * bf2f(b.y >> 16);
        const float ss = wave_sum((v[0] * v[0] + v[1] * v[1]) + (v[2] * v[2] + v[3] * v[3]));
        const float rstd = 1.0f / sqrtf(ss * (1.0f / 256.0f) + NORM_EPS);
        const f32x4 gsub = *(const f32x4*)(P_subln + i * 256 + f_lane * 4) * (1.0f - linit);
        *(u32x2*)(CAT + (size_t)tok * DM + 1024 + h * 256 + f_lane * 4) = pack4(v * rstd * gsub);
    }
}
__device__ __forceinline__ void dilated_merge(const Frame& F, const Ptrs& P) {
    FRAME_TID();
    unsigned char* ws = P.ws; const int gw = F.vcu * 8 + F.wave, NGW = F.G * 8;
    const bf16_t* OB = (const bf16_t*)(ws + WS_OB); const float* LSE = (const float*)(ws + WS_LSE); bf16_t* CAT = (bf16_t*)(ws + WS_CAT);
    const int pmg = (F.G == 256) ? (8 * ((int)blockIdx.x & 7) + (((int)blockIdx.x >> 3) & 7)) * 256 + ((int)blockIdx.x >> 6) * 64 : -1;
    for (int it = 0; it < (pmg >= 0 ? 8 : (MTOK + NGW - 1) / NGW); ++it) { const int tok = pmg >= 0 ? pmg + it * 8 + F.wave : gw + it * NGW; if (tok >= MTOK) break;
        u32x4 av[4], bv[4], cv[4]; float l0v[4], l1v[4], l2v[4];
#pragma unroll
        for (int k = 0; k < 4; ++k) { const int ci = f_lane + 64 * k, col = ci * 8, h = ci >> 4;
            l0v[k] = LSE[(size_t)tok * 16 + h]; l1v[k] = LSE[((size_t)MTOK + tok) * 16 + h]; l2v[k] = LSE[((size_t)2 * MTOK + tok) * 16 + h];
            av[k] = *(const u32x4*)(OB + (size_t)tok * DM + col); bv[k] = *(const u32x4*)(OB + ((size_t)MTOK + tok) * DM + col); cv[k] = *(const u32x4*)(OB + ((size_t)2 * MTOK + tok) * DM + col); }
#pragma unroll
        for (int k = 0; k < 4; ++k) { const int ci = f_lane + 64 * k, col = ci * 8;
            const float l0 = l0v[k], l1 = l1v[k], l2 = l2v[k];
            const float mx = fmaxf(l0, fmaxf(l1, l2)); float w0 = __expf(l0 - mx), w1 = __expf(l1 - mx), w2 = __expf(l2 - mx); const float inv = 1.0f / (w0 + w1 + w2); w0 *= inv; w1 *= inv; w2 *= inv;
            const u32x4 a = av[k], b = bv[k], c = cv[k];
            u32x4 o;
#pragma unroll
            for (int q = 0; q < 4; ++q) { const float lo = w0 * bf2f(a[q] & 0xffffu) + w1 * bf2f(b[q] & 0xffffu) + w2 * bf2f(c[q] & 0xffffu), hi = w0 * bf2f(a[q] >> 16) + w1 * bf2f(b[q] >> 16) + w2 * bf2f(c[q] >> 16); o[q] = cvt_pk_bf16(lo, hi); }
            *(u32x4*)(CAT + (size_t)tok * DM + col) = o; }
    }
}
__device__ __forceinline__ void final_norm(const Frame& F, const Ptrs& P) {
    FRAME_TID();
    unsigned char* ws = P.ws; const int gw = F.vcu * 8 + F.wave, NGW = F.G * 8;
    const bf16_t* HB = (const bf16_t*)(ws + WS_HB); const float* rss = (const float*)(ws + WS_RSSP) + (size_t)12 * MTOK * 32;
    f32x4 gn[8];
#pragma unroll
    for (int j = 0; j < 8; ++j) gn[j] = *(const f32x4*)(P_fin_g + (j * 64 + f_lane) * 4);
    for (int row = gw; row < MTOK; row += NGW) {
        u32x2 w[8]; const float part = f_lane < 32 ? rss[(size_t)row * 32 + f_lane] : 0.f;
#pragma unroll
        for (int j = 0; j < 8; ++j) w[j] = *(const u32x2*)(HB + (size_t)row * DM + (j * 64 + f_lane) * 4);
        const float rstd = 1.0f / sqrtf(wave_sum(part) * (1.0f / DM) + NORM_EPS);
#pragma unroll
        for (int j = 0; j < 8; ++j) { const f32x4 h = {bf2f(w[j].x & 0xffffu), bf2f(w[j].x >> 16), bf2f(w[j].y & 0xffffu), bf2f(w[j].y >> 16)};
            *(f32x4*)(P.out + (size_t)row * DM + (j * 64 + f_lane) * 4) = h * rstd * gn[j]; } }
}
#ifndef SITES
#define SITES 0xFFFFFFFF
#endif


struct ListOrder {
    int n, pm, g; const char* A; size_t astep; const char* B; size_t bstep; int pn0;
    __device__ __forceinline__ bool next(int i, pg8::Unit& u) const { if (i >= n) return false; u.pm = pm; u.pn = pn0 + i; u.g = g; u.a = A + (size_t)i * astep; u.b = B + (size_t)(pn0 + i) * bstep; return true; }
};
struct WqKOrder {
    int G, c; const char* KV; const char* WQ;
    __device__ __forceinline__ bool next(int i, pg8::Unit& u) const {
        const int L = i * G + c; if (L >= 256) return false;
        u.g = L >> 3; u.pn = L & 7; u.pm = 0; const int l = u.g >> 3, b = (u.g >> 2) & 1, h = u.g & 3;
        u.a = KV + ((size_t)(b * 256) * 16384 + l * 4096 + h * 512) * 2;
        u.b = WQ + ((size_t)l * 2048 * 2048 + (size_t)u.pn * 256 * 2048 + h * 512) * 2; return true; }
};
struct VWoOrder {
    int G, c; const char* KV; const char* WO;
    __device__ __forceinline__ bool next(int i, pg8::Unit& u) const {
        const int L = i * G + c; if (L >= 256) return false;
        u.g = L >> 3; u.pm = L & 7; u.pn = 0; const int l = u.g >> 3, b = (u.g >> 2) & 1, h = u.g & 3;
        u.a = WO + ((size_t)l * 2048 * 2048 + (size_t)u.pm * 256 * 2048 + h * 512) * 2;
        u.b = KV + ((size_t)(b * 256) * 16384 + l * 4096 + 2048 + h * 512) * 2; return true; }
};


#ifndef DBG_RT
#define DBG_RT 0
#endif
#ifndef REP_P0
#define REP_P0 1
#endif
#ifndef REP_F1
#define REP_F1 1
#endif
#ifndef REP_DATT
#define REP_DATT 1
#endif
#ifndef REP_DIL
#define REP_DIL 1
#endif
#ifndef REP_PROJ
#define REP_PROJ 1
#endif
#ifndef REP_X1
#define REP_X1 1
#endif
#ifndef REP_S5
#define REP_S5 1
#endif
#ifndef REP_P12
#define REP_P12 1
#endif
#ifndef USE_GROUP_SYNC
#define USE_GROUP_SYNC 1
#endif
#ifndef REP_THIN
#define REP_THIN 1
#endif
#ifndef REP_DIL_IN
#define REP_DIL_IN 1
#endif
#ifndef DBG_STOP
#define DBG_STOP 0
#endif
#ifndef DBG_LAYER
#define DBG_LAYER 0
#endif
#ifndef DBG_SUB
#define DBG_SUB 0
#endif
#if DBG_RT
#ifndef DBG_X
#define DBG_X 0
#endif
__device__ int g_dbg[4] = {DBG_STOP, DBG_LAYER, DBG_SUB, DBG_X};
#endif
__device__ __forceinline__ void dbg_dump_bf(float* out, const bf16_t* a, size_t na, const bf16_t* b, size_t nb, int vcu, int G) {
    for (size_t j = (size_t)vcu * 512 + threadIdx.x; j < (size_t)MTOK * DM; j += (size_t)G * 512) { float v = bf2f(a[j % na]); if (b) v += bf2f(b[j % nb]); out[j] = v; }
}
__device__ __forceinline__ void dbg_dump_f32(float* out, const float* a, int vcu, int G) {
    for (size_t j = (size_t)vcu * 512 + threadIdx.x; j < (size_t)MTOK * DM; j += (size_t)G * 512) out[j] = a[j];
}
__global__ void __launch_bounds__(512, 2) mega_fwd(Args args) {
    extern __shared__ __attribute__((aligned(16))) unsigned char lds_raw[];
    Frame F; F.lds = (LAS unsigned char*)lds_raw; F.wave = __builtin_amdgcn_readfirstlane((int)threadIdx.x >> 6);
    F.G = gridDim.x; { const int bx = blockIdx.x; F.vcu = (F.G % 8 == 0) ? (bx % 8) * (F.G / 8) + bx / 8 : bx; }
    const Args& P = args;
    typedef __attribute__((address_space(1))) unsigned char gws_t;
    gws_t* const ws0 = (gws_t*)args.ws; gws_t* ws = ws0;
    if (threadIdx.x < 16) ((LAS unsigned*)(F.lds + LDS_MISC))[threadIdx.x] = 0u;
    __syncthreads();
    XcdBarrier bar = xcd_barrier_post((unsigned*)(ws + WS_CTL), (volatile LAS unsigned*)(F.lds + LDS_MISC));
#if defined(BAR2)
#define GRID_BAR() do { xcd_barrier(bar); xcd_barrier(bar); } while (0)
#else
#define GRID_BAR() xcd_barrier(bar)
#endif
    if (threadIdx.x == 0) __hip_atomic_store((unsigned*)(ws + WS_CTL) + GS_XCC_WORD + blockIdx.x, xb_xcc_id() + 1u, __ATOMIC_RELAXED, __HIP_MEMORY_SCOPE_AGENT);
    const int bx = (int)blockIdx.x;
#if DBG_RT
    const int dbg_stop = __builtin_amdgcn_readfirstlane(((volatile int*)g_dbg)[0]), dbg_layer = __builtin_amdgcn_readfirstlane(((volatile int*)g_dbg)[1]), dbg_sub = __builtin_amdgcn_readfirstlane(((volatile int*)g_dbg)[2]), dbg_x = __builtin_amdgcn_readfirstlane(((volatile int*)g_dbg)[3]);
#endif
    float* RSS = (float*)(ws + WS_RSSP);
    bf16_t* HB = (bf16_t*)(ws + WS_HB); float* H = (float*)(ws + WS_H); bf16_t* CAT = (bf16_t*)(ws + WS_CAT); bf16_t* XP = (bf16_t*)(ws + WS_XP);
    const float* rc = (const float*)(ws + WS_ROPE); const float* rs = rc + SEQ * 16;

#if defined(DBG_FILL)
    { u32x4* p = (u32x4*)(ws + MiB); const size_t n = (WS_END - MiB) / 16; const unsigned pat = DBG_FILL; for (size_t j = (size_t)F.vcu * 512 + threadIdx.x; j < n; j += (size_t)F.G * 512) p[j] = (u32x4){pat, pat, pat, pat}; }
    GRID_BAR();
#endif

#if (SITES >> 0) & 1
#if !defined(S5TAB_IN_P1)
    if (bx < 128) { s5_tables_task(F, P, bx >> 6, bx & 63); asm volatile("s_waitcnt vmcnt(0) lgkmcnt(0)" ::: "memory"); __syncthreads(); }
#endif
    _Pragma("unroll 1") for (int rp = 0; rp < REP_P0; ++rp) p0_prologue(F, P);
#endif

    GRID_BAR();
    bool use_group;
    {   int t_ = threadIdx.x; asm volatile("" : "+v"(t_));
        int okv = 1;
        if (t_ < 256) { const unsigned* xw = (const unsigned*)(ws + WS_CTL) + GS_XCC_WORD; const unsigned a = __hip_atomic_load(xw + t_, __ATOMIC_RELAXED, __HIP_MEMORY_SCOPE_AGENT), b0 = __hip_atomic_load(xw + (t_ & 63), __ATOMIC_RELAXED, __HIP_MEMORY_SCOPE_AGENT); okv = (a == b0) && (a != 0u); }
        use_group = (__syncthreads_and(okv) != 0) && (F.G == 256) && (USE_GROUP_SYNC != 0); }
    unsigned gs_epoch = 0;
    const int gs_gid = bx & 63;
#define CHAIN_BAR() do { if (use_group) { ++gs_epoch; group_sync((unsigned*)(ws + WS_CTL), gs_gid, 4u * gs_epoch); } else { GRID_BAR(); } } while (0)
    _Pragma("unroll 1") for (int rp12 = 0; rp12 < REP_P12; ++rp12) {

#if defined(S5TAB_IN_P1)
    if (bx < 128) s5_tables_task(F, P, bx >> 6, bx & 63);
    else
#else
    if (bx >= 128)
#endif
    {   pg8::DenseOrder S; S.init((const void*)(ws + WS_MEMN), 2048, (const void*)(ws + WS_WKV_T), 2048, BATCH * MEML, 16384, F.G - 128, bx - 128);
        EpiBf16Plain E{(bf16_t*)(ws + WS_KVALL), 16384, nullptr, 1.0f};
        pg8::gemm_phase(F.lds, 2048, 2048, 2048, S, E); }

    GRID_BAR();

#if (SITES >> 3) & 1
    {   WqKOrder S{F.G, bx, (const char*)(ws + WS_KVALL), (const char*)(ws + WS_WQ_B)}; EpiWqK E{(bf16_t*)(ws + WS_WQK), P_xa_g};
        pg8::gemm_phase(F.lds, 512, 16384, 2048, S, E); }
#endif


#if (SITES >> 4) & 1
    {   VWoOrder S{F.G, bx, (const char*)(ws + WS_KVALL), (const char*)(ws + WS_WO_T)}; EpiVWo E{(bf16_t*)(ws + WS_VWO)};
        pg8::gemm_phase(F.lds, 512, 2048, 16384, S, E); }
#endif


    GRID_BAR();
    }
#if DBG_RT
    if (dbg_stop == 1) {
    dbg_dump_bf(args.out, (const bf16_t*)(ws + WS_WQK), (size_t)16 << 20, (const bf16_t*)(ws + WS_VWO), (size_t)16 << 20, F.vcu, F.G); return;
    }
#endif
#if DBG_RT
    if (dbg_stop == 13) {
    dbg_dump_bf(args.out, (const bf16_t*)(ws + WS_W13) + (size_t)dbg_layer * 11264 * 2048, (size_t)11264 * 2048, (const bf16_t*)(ws + WS_W2) + (size_t)dbg_layer * 2048 * 5632, (size_t)2048 * 5632, F.vcu, F.G); return;
    }
#endif
#if DBG_RT
    if (dbg_stop == 14) {
    { const bf16_t* a = (const bf16_t*)(ws + WS_W13) + (size_t)dbg_layer * 11264 * 2048; const bf16_t* b = (const bf16_t*)(ws + WS_W2) + (size_t)dbg_layer * 2048 * 5632; for (size_t j = (size_t)F.vcu * 512 + threadIdx.x; j < (size_t)MTOK * DM; j += (size_t)F.G * 512) args.out[j] = 30.0f * (bf2f(a[j % ((size_t)11264 * 2048)]) + bf2f(b[j % ((size_t)2048 * 5632)])); return; }
    }
#endif
#if DBG_RT
    if (dbg_stop == 7) {
    dbg_dump_bf(args.out, (const bf16_t*)(ws + WS_BTT), (size_t)48 << 20, (const bf16_t*)(ws + WS_BTE), (size_t)16 << 20, F.vcu, F.G); return;
    }
#endif
#if DBG_RT
    if (dbg_stop == 8) {
    dbg_dump_bf(args.out, (const bf16_t*)(ws + WS_W13), (size_t)88 << 20, (const bf16_t*)(ws + WS_W2), (size_t)44 << 20, F.vcu, F.G); return;
    }
#endif

#pragma unroll 1
    for (int layer = 0; layer < DEPTH; ++layer) {
        const int i = layer >> 1; const bool even = (layer & 1) == 0;
#pragma unroll 1
        for (int sub = 0; sub < 3; ++sub) {
            gws_t* ws = ws0; asm volatile("" : "+s"(ws));
            const float* rss_cur = RSS + (size_t)(3 * layer + sub) * MTOK * 32; float* rss_next = RSS + (size_t)(3 * layer + sub + 1) * MTOK * 32;
            if (sub == 0) {

#if (SITES >> 6) & 1
#if DBG_RT
                const int nrep = ((dbg_x & 1) && layer == dbg_layer) ? 2 : 1, iw = ((dbg_x & 2) && layer == dbg_layer) ? 0 : i;
                if ((dbg_x & 4) && layer == dbg_layer) GRID_BAR();
#else
                const int nrep = REP_PROJ, iw = i;
#endif
#pragma unroll 1
                for (int rep = 0; rep < nrep; ++rep)
                {   const bf16_t* Bt = even ? (const bf16_t*)(ws + WS_W_IN) + (size_t)iw * 4096 * 2048 : (const bf16_t*)(ws + WS_W_QKV) + (size_t)iw * 6144 * 2048;
                    pg8::DenseOrder S; S.init(HB, 2048, Bt, 2048, MTOK, even ? 4096 : 6144, F.G, bx);
                    const float* rss_p = rss_cur;
#if DBG_RT
                    if ((dbg_x & 8) && layer == dbg_layer) rss_p = RSS + (size_t)6 * MTOK * 32;
#endif
                    { pg8::Unit u0; if (S.next(0, u0)) fill_rstd_tab(rss_p, u0.pm, (LAS float*)(F.lds + LDS_RSTD)); }
                    EpiProj E{(LAS const float*)(F.lds + LDS_RSTD), rc, rs, even ? (bf16_t*)(ws + WS_QKVE) : (bf16_t*)(ws + WS_QKVO), even ? 3072 : 6144, (bf16_t*)(ws + WS_U2), even ? 4 : 0, even ? 4 : 0, even ? 12 : 16};
                    pg8::gemm_phase(F.lds, 2048, 2048, 2048, S, E); }
#endif

                GRID_BAR();
#if DBG_RT
    if (dbg_stop == 10) {
                if (layer == dbg_layer) { unsigned* q = (unsigned*)(ws + WS_QKVO); for (size_t j = (size_t)F.vcu * 512 + threadIdx.x; j < (size_t)MTOK * DM / 2; j += (size_t)F.G * 512) { const unsigned w = __hip_atomic_fetch_or(q + j, 0u, __ATOMIC_RELAXED, __HIP_MEMORY_SCOPE_AGENT); args.out[2 * j] = bf2f(w & 0xffffu); args.out[2 * j + 1] = bf2f(w >> 16); } return; }
    }
#endif
#if DBG_RT
    if (dbg_stop == 2) {
                if (layer == dbg_layer) { if (even) dbg_dump_bf(args.out, (const bf16_t*)(ws + WS_U2), (size_t)24 << 20, (const bf16_t*)(ws + WS_QKVE), (size_t)48 << 20, F.vcu, F.G); else dbg_dump_bf(args.out, (const bf16_t*)(ws + WS_QKVO), (size_t)96 << 20, nullptr, 1, F.vcu, F.G); return; }
    }
#endif
                if (even) {
                    _Pragma("unroll 1") for (int rps = 0; rps < REP_S5; ++rps) {
                    {
                        const int pm = (bx >> 1) & 127, hf = bx & 1, g = pm >> 1, b = pm & 1;
                        {   ListOrder S{1, pm, g, (const char*)(ws + WS_U2) + (size_t)pm * 256 * S5KT * 2, 0, (const char*)((const bf16_t*)(ws + WS_BTE) + ((size_t)i * 64 + g) * 256 * 512), 0, 0};
                            EpiF32 E{(float*)(ws + WS_E), 256};
                            pg8::gemm_phase(F.lds, 512, S5KT, 512, S, E); }
                        asm volatile("s_waitcnt vmcnt(0)" ::: "memory"); __syncthreads();
                        s5_scan_local(F, P, i, b, g);
                        asm volatile("s_waitcnt vmcnt(0)" ::: "memory"); __syncthreads();
                        {   ListOrder S{1, pm, g, (const char*)(ws + WS_U2) + (size_t)pm * 256 * S5KT * 2, 0, (const char*)((const bf16_t*)(ws + WS_BTT) + ((size_t)i * 64 + g) * 512 * S5KT), (size_t)256 * S5KT * 2, hf};
                            EpiS5Y E{(bf16_t*)(ws + WS_G)};
                            pg8::gemm_phase(F.lds, S5KT, S5KT, S5KT, S, E); }
                    }
                    GRID_BAR();

#if (SITES >> 10) & 1
                    {   pg8::DenseOrder S; S.init((const void*)(ws + WS_G), 1024, (const bf16_t*)(ws + WS_W_GLU) + (size_t)i * 1024 * 1024, 1024, MTOK, 1024, F.G, bx);
                        EpiGlu E{(const bf16_t*)(ws + WS_G), P_glu_b + i * 1024, CAT};
                        pg8::gemm_phase(F.lds, 1024, 1024, 1024, S, E); }
#endif

                    if (rps + 1 < REP_S5) GRID_BAR();
                    }

#if (SITES >> 11) & 1
                    {   const bf16_t* QKV = (const bf16_t*)(ws + WS_QKVE); bf16_t* O12 = (bf16_t*)(ws + WS_O12);
                        float lam, gscale;
                        {   int t_ = threadIdx.x; asm volatile("" : "+v"(t_)); const int ln = t_ & 63; const float* lv = P_dlam + i * 512;
                            const float d01 = wave_sum(lv[ln] * lv[128 + ln] + lv[64 + ln] * lv[192 + ln]), d23 = wave_sum(lv[256 + ln] * lv[384 + ln] + lv[320 + ln] * lv[448 + ln]);
                            int ly_ = layer; asm volatile("" : "+s"(ly_)); const float linit = __builtin_bit_cast(float, ly_ == 0 ? 0x3e4ccccdu : 0x3ef1014cu);
                            lam = __builtin_bit_cast(float, __builtin_amdgcn_readfirstlane(__builtin_bit_cast(int, expf(d01) - expf(d23) + linit))); gscale = 1.0f - linit; }
                        _Pragma("unroll 1") for (int rp = 0; rp < REP_DATT; ++rp)
                        for (int unit = F.vcu; unit < 256; unit += F.G) {
                            const int binst = unit >> 5, qb = unit & 31, b = binst >> 2, h = binst & 3;
                            const bf16_t* Vh = QKV + (size_t)(b * SEQ) * 3072 + 2048 + h * 256;
                            bf16_t* Ob = O12 + ((size_t)b * SEQ + qb * 256) * 1024 + h * 256;
                            bf16_t* Cb = CAT + ((size_t)b * SEQ + qb * 256) * DM + 1024 + h * 256;
                            _Pragma("unroll 1") for (int c = 0; c < 2; ++c) {
                                const bf16_t* Qb = QKV + (size_t)(b * SEQ + qb * 256) * 3072 + (h * 2 + c) * 128;
                                const bf16_t* Kh = QKV + (size_t)(b * SEQ) * 3072 + 1024 + (h * 2 + c) * 128;
                                asm volatile("s_waitcnt vmcnt(0)" ::: "memory"); __syncthreads();
#if defined(W32)
                                att::attn_wide_body(Qb, Kh, Vh, 3072, SEQ / 64, Ob, 1024, (char*)lds_raw, c == 1, lam, gscale, P_subln + i * 256, Cb, DM);
#else
                                att::attn_wide16_body(Qb, Kh, Vh, 3072, SEQ / 64, Ob, 1024, (char*)lds_raw, c == 1, lam, gscale, P_subln + i * 256, Cb, DM);
#endif
                            }
                        } }
#endif

                    GRID_BAR();
                } else {

#if (SITES >> 13) & 1
#if !defined(BAND_WG) && !defined(BAND_WAVE)
                    {   const bf16_t* QKV = (const bf16_t*)(ws + WS_QKVO); bf16_t* OB = (bf16_t*)(ws + WS_OB); float* LSE = (float*)(ws + WS_LSE);
                        const int vcu_ = F.vcu, G_ = F.G;
                        auto unit_of = [=](int i) -> att::BandUnit {
                            int br, b, h, r, qb2;
                            if (G_ == 256) { const int x = vcu_ >> 5, Lx = i * 32 + (vcu_ & 31), c48 = Lx / 48, cg = x * 8 + c48, m = Lx - c48 * 48, qs = m & 15, half = cg & 1; br = m >> 4; b = cg >> 5; h = (cg >> 1) & 15;
                                const int sh = 2 * br; qb2 = (half << (4 - sh)) + (qs >> sh); r = qs & ((1 << sh) - 1); }
                            else { const int unit = vcu_ + i * G_, g32 = unit >> 5, rq = unit & 31; br = g32 >> 5; b = (g32 >> 4) & 1; h = g32 & 15; const int sh = 2 * br; r = rq >> (5 - sh); qb2 = rq & ((32 >> sh) - 1); }
                            const int sh2 = 2 * br, dil = 1 << sh2, Mr = SEQ >> sh2;
                            const size_t tok0 = (size_t)b * SEQ + r, tokq = tok0 + ((size_t)(qb2 * 256) << sh2);
                            att::BandUnit u; u.Q = QKV + tokq * 6144 + h * 128; u.K = QKV + tok0 * 6144 + 2048 + h * 128; u.V = QKV + tok0 * 6144 + 4096 + h * 128;
                            u.O = OB + ((size_t)br * MTOK + tokq) * DM + h * 128; u.L = LSE + ((size_t)br * MTOK + tokq) * 16 + h;
                            u.ld = dil * 6144; u.ldo = dil * DM; u.ldl = dil * 16; u.kfirst = qb2 * 256 - 64; u.Mr = Mr; u.lsh = sh2; return u; };
                        const int U = vcu_ < 3072 ? (3072 - vcu_ + G_ - 1) / G_ : 0;
                        _Pragma("unroll 1") for (int rp = 0; rp < REP_DIL; ++rp) { __syncthreads(); att::attn_band16_stream(U, unit_of, (char*)lds_raw); } }
#else
                    {   const bf16_t* QKV = (const bf16_t*)(ws + WS_QKVO); bf16_t* OB = (bf16_t*)(ws + WS_OB); float* LSE = (float*)(ws + WS_LSE);
                        _Pragma("unroll 1") for (int rp = 0; rp < REP_DIL; ++rp)
                        for (int unit = F.vcu; unit < 3072; unit += F.G) {
                            const int g32 = unit >> 5, rq = unit & 31, br = g32 >> 5, b = (g32 >> 4) & 1, h = g32 & 15;
                            const int dil = 1 << (2 * br), Mr = SEQ / dil, nqb = Mr / 256, r = rq / nqb, qb2 = rq % nqb;
                            const size_t tok0 = (size_t)b * SEQ + r;
                            const size_t tokq = tok0 + (size_t)(qb2 * 256) * dil;
                            const bf16_t* Qb = QKV + tokq * 6144 + h * 128;
                            const bf16_t* Kh = QKV + tok0 * 6144 + 2048 + h * 128;
                            const bf16_t* Vh = QKV + tok0 * 6144 + 4096 + h * 128;
                            bf16_t* Ob = OB + ((size_t)br * MTOK + tokq) * DM + h * 128;
                            float* ls = LSE + ((size_t)br * MTOK + tokq) * 16 + h;
                            _Pragma("unroll 1") for (int rpi = 0; rpi < REP_DIL_IN; ++rpi) {
#if defined(DIL_PROBE)
                            att::attn_band_wave(Qb, 6144L, Kh, Vh, 6144L, qb2 * 256 - 64, Mr, (bf16_t*)(ws + WS_HID) + (size_t)(unit & 2047) * 32768, 128L, (float*)(ws + WS_HID + (160u << 20)) + (size_t)unit * 256, 1L, (char*)lds_raw);
#endif
#if defined(BAND_WG)
                            __syncthreads();
                            att::attn_band_body(Qb, (long)dil * 6144, Kh, Vh, (long)dil * 6144, qb2 * 256 - 64, Mr, Ob, (long)dil * DM, ls, (long)dil * 16, (char*)lds_raw);
#else
                            att::attn_band_wave(Qb, (long)dil * 6144, Kh, Vh, (long)dil * 6144, qb2 * 256 - 64, Mr, Ob, (long)dil * DM, ls, (long)dil * 16, (char*)lds_raw);
#endif
                            }
                        } }
#endif
#endif

                    GRID_BAR();

#if (SITES >> 14) & 1
                    _Pragma("unroll 1") for (int rpt = 0; rpt < REP_THIN; ++rpt) dilated_merge(F, P);
#endif

                    CHAIN_BAR();
                }
            } else if (sub == 1) {

#if (SITES >> 15) & 1
                _Pragma("unroll 1") for (int rp = 0; rp < REP_X1; ++rp)
                {   pg8::DenseOrder S; S.init(HB, 2048, (const bf16_t*)(ws + WS_WQK) + (size_t)layer * 2 * 1024 * 2048, 2048, MTOK, 1024, F.G, bx, 32, (size_t)1024 * 2048 * 2);
                    { pg8::Unit u0; if (S.next(0, u0)) fill_rstd_tab(rss_cur, u0.pm, (LAS float*)(F.lds + LDS_RSTD)); }
                    EpiSoftmax E{(LAS const float*)(F.lds + LDS_RSTD), XP, (LAS float*)(F.lds + LDS_EPI)};
                    pg8::gemm_phase(F.lds, 2048, 2048, 2048, S, E); }
#endif

                CHAIN_BAR();
            } else {

#if (SITES >> 16) & 1
                _Pragma("unroll 1") for (int rp = 0; rp < REP_F1; ++rp)
                {   pg8::DenseOrder S; S.init(HB, 2048, (const bf16_t*)(ws + WS_W13) + (size_t)layer * 11264 * 2048, 2048, MTOK, 11264, F.G, bx);
                    { pg8::Unit u0; if (S.next(0, u0)) fill_rstd_tab(rss_cur, u0.pm, (LAS float*)(F.lds + LDS_RSTD)); }
                    EpiSwiglu E{(LAS const float*)(F.lds + LDS_RSTD), (bf16_t*)(ws + WS_HID)};
                    pg8::gemm_phase(F.lds, 2048, 2048, 2048, S, E); }
#endif

                CHAIN_BAR();
            }
#if DBG_RT
    if (dbg_stop == 15) {
            if (layer == dbg_layer && sub == dbg_sub) { const bf16_t* a = (const bf16_t*)(ws + WS_W13) + (size_t)dbg_layer * 11264 * 2048; const bf16_t* b = (const bf16_t*)(ws + WS_W2) + (size_t)dbg_layer * 2048 * 5632; for (size_t j = (size_t)F.vcu * 512 + threadIdx.x; j < (size_t)MTOK * DM; j += (size_t)F.G * 512) args.out[j] = 30.0f * (bf2f(a[j % ((size_t)11264 * 2048)]) + bf2f(b[j % ((size_t)2048 * 5632)])); return; }
    }
#endif
#if DBG_RT
    if (dbg_stop == 3) {
            if (layer == dbg_layer && sub == dbg_sub) { if (sub == 0) dbg_dump_bf(args.out, CAT, (size_t)32 << 20, nullptr, 1, F.vcu, F.G); else if (sub == 1) dbg_dump_bf(args.out, XP, (size_t)16 << 20, nullptr, 1, F.vcu, F.G); else dbg_dump_bf(args.out, (const bf16_t*)(ws + WS_HID), (size_t)88 << 20, nullptr, 1, F.vcu, F.G); return; }
    }
#endif

#if (SITES >> 17) & 1
            {   const bf16_t* A; const bf16_t* Bt; int K, pmdiv = 1 << 30; size_t bgroup = 0;
                if (sub == 0) { A = CAT; K = 2048; Bt = even ? (const bf16_t*)(ws + WS_W_ABO) + (size_t)i * 2048 * 2048 : (const bf16_t*)(ws + WS_W_CO) + (size_t)i * 2048 * 2048; }
                else if (sub == 1) { A = XP; K = 1024; Bt = (const bf16_t*)(ws + WS_VWO) + (size_t)layer * 2 * 2048 * 1024; pmdiv = 32; bgroup = (size_t)2048 * 1024 * 2; }
                else { A = (const bf16_t*)(ws + WS_HID); K = FFN; Bt = (const bf16_t*)(ws + WS_W2) + (size_t)layer * 2048 * FFN; }
                pg8::DenseOrder S; S.init(A, K, Bt, K, MTOK, 2048, F.G, bx, pmdiv, bgroup);
                EpiRes E{(layer == 0 && sub == 0) ? P_x : (const float*)nullptr, HB, rss_next};
                pg8::gemm_phase(F.lds, K, K, K, S, E);
#if defined(REP_RES)
                { asm volatile("s_waitcnt vmcnt(0)" ::: "memory"); __syncthreads(); EpiRes E2 = E; E2.dry = true; pg8::gemm_phase(F.lds, K, K, K, S, E2); }
#endif
                }
#endif

            if (layer == DEPTH - 1 && sub == 2) { GRID_BAR(); } else { CHAIN_BAR(); }
#if DBG_RT
    if (dbg_stop == 12) {
            if (layer == dbg_layer && sub == dbg_sub) { for (size_t j = (size_t)F.vcu * 512 + threadIdx.x; j < (size_t)MTOK * DM; j += (size_t)F.G * 512) args.out[j] = 200.0f * (H[j] - P_x[j]); return; }
    }
#endif
#if DBG_RT
    if (dbg_stop == 16) {
            if (layer == dbg_layer && sub == dbg_sub) { for (size_t j = (size_t)F.vcu * 512 + threadIdx.x; j < (size_t)MTOK * DM; j += (size_t)F.G * 512) args.out[j] = 200.0f * bf2f(HB[j]); return; }
    }
#endif
#if DBG_RT
    if (dbg_stop == 17) {
            if (layer == dbg_layer && sub == dbg_sub) { unsigned* q = (unsigned*)HB; for (size_t j = (size_t)F.vcu * 512 + threadIdx.x; j < (size_t)MTOK * DM / 2; j += (size_t)F.G * 512) { const unsigned w = __hip_atomic_fetch_or(q + j, 0u, __ATOMIC_RELAXED, __HIP_MEMORY_SCOPE_AGENT); args.out[2 * j] = 200.0f * bf2f(w & 0xffffu); args.out[2 * j + 1] = 200.0f * bf2f(w >> 16); } return; }
    }
#endif
#if DBG_RT
    if (dbg_stop == 4) {
            if (layer == dbg_layer && sub == dbg_sub) { dbg_dump_f32(args.out, H, F.vcu, F.G); return; }
    }
#endif
#if DBG_RT
    if (dbg_stop == 5) {
            if (layer == dbg_layer && sub == dbg_sub) { dbg_dump_bf(args.out, HB, (size_t)32 << 20, nullptr, 1, F.vcu, F.G); __syncthreads(); if (blockIdx.x < 32) { const int j = blockIdx.x * 512 + threadIdx.x; args.out[j] = rss_next[j]; } return; }
    }
#endif
#if DBG_RT
    if (dbg_stop == 6) {
            if (layer == dbg_layer && sub == dbg_sub) { dbg_dump_bf(args.out, (const bf16_t*)(ws + WS_W_QKV), (size_t)24 << 20, nullptr, 1, F.vcu, F.G); return; }
    }
#endif
        }
    }

#if DBG_RT
    if (dbg_stop == 11) {
    { const unsigned* xc = (const unsigned*)(ws + WS_CTL) + 8192; bool ok = true; for (int b = 0; b < (int)gridDim.x; ++b) ok = ok && (xc[b] == ((xc[0] + (unsigned)b) & 7u)); const float v = ok ? 0.0f : 0.26f; for (size_t j = (size_t)F.vcu * 512 + threadIdx.x; j < (size_t)MTOK * DM; j += (size_t)F.G * 512) args.out[j] = v; return; }
    }
#endif
#if DBG_RT
    if (dbg_stop == 9) {
    { const unsigned tmo = xb_ld((unsigned*)(ws + WS_CTL) + XB_TMO); const float v = tmo ? 0.26f : 0.0f; for (size_t j = (size_t)F.vcu * 512 + threadIdx.x; j < (size_t)MTOK * DM; j += (size_t)F.G * 512) args.out[j] = v; return; }
    }
#endif
#if (SITES >> 18) & 1
    final_norm(F, P);
#endif

#undef GRID_BAR
}

extern "C" void kernel_launch(void* const* d_in, const int* in_sizes, int n_in, void* d_out, int out_size, void* d_ws, size_t ws_size, hipStream_t stream) {
    static int grid = 0;
    if (grid == 0) {
        if (n_in != 28 || in_sizes[0] != MTOK * DM || out_size != MTOK * DM || ws_size < WS_END) {
            fprintf(stderr, "kernel_launch: built for 28 inputs, x/out of %d floats and >= %zu bytes of workspace; got n_in %d, in0 %d, out %d, ws %zu; nothing launched\n", MTOK * DM, (size_t)WS_END, n_in, n_in > 0 ? in_sizes[0] : -1, out_size, ws_size);
            grid = -1; return; }
        int dev = 0, cus = 0, per_cu = 0;
        if (hipGetDevice(&dev) != hipSuccess || hipDeviceGetAttribute(&cus, hipDeviceAttributeMultiprocessorCount, dev) != hipSuccess) { grid = -1; return; }
        if (hipFuncSetAttribute((const void*)mega_fwd, hipFuncAttributeMaxDynamicSharedMemorySize, LDS_BYTES) != hipSuccess) { fprintf(stderr, "kernel_launch: hipFuncSetAttribute failed\n"); grid = -1; return; }
        if (hipOccupancyMaxActiveBlocksPerMultiprocessor(&per_cu, (const void*)mega_fwd, 512, LDS_BYTES) != hipSuccess || per_cu < 1)
            fprintf(stderr, "kernel_launch: note: occupancy query reports %d workgroups per CU\n", per_cu);
        (void)hipGetLastError();
        grid = cus;
    }
    if (grid < 0) return;
    if (hipMemsetAsync((char*)d_ws + WS_CTL, 0, CTL_BYTES, stream) != hipSuccess) { fprintf(stderr, "kernel_launch: hipMemsetAsync failed\n"); return; }
    Args a{};
    for (int i = 0; i < 28; ++i) a.in[i] = (const float*)d_in[i];
    a.out = (float*)d_out; a.ws = (unsigned char*)d_ws;
    hipLaunchKernelGGL(mega_fwd, dim3(grid), dim3(512), LDS_BYTES, stream, a);
    const hipError_t le = hipPeekAtLastError();
    if (le != hipSuccess) fprintf(stderr, "kernel_launch: launch failed: %s\n", hipGetErrorName(le));
}
```

```cpp
#include <hip/hip_runtime.h>
#include <cstdio>
#include <cstdint>

#define LAS __attribute__((address_space(3)))
typedef unsigned short bf16_t;
typedef short bf16x8 __attribute__((ext_vector_type(8)));
typedef short s16x4 __attribute__((ext_vector_type(4)));
typedef float f32x2 __attribute__((ext_vector_type(2)));
typedef float f32x4 __attribute__((ext_vector_type(4)));
typedef float f32x8 __attribute__((ext_vector_type(8)));
typedef float f32x16 __attribute__((ext_vector_type(16)));
typedef unsigned u32x2 __attribute__((ext_vector_type(2)));
typedef unsigned u32x4 __attribute__((ext_vector_type(4)));

constexpr int BATCH = 2, SEQ = 8192, DM = 2048, MTOK = BATCH * SEQ, DEPTH = 4, FFN = 5632, MEML = 256;
constexpr float NORM_EPS = 1e-6f;
constexpr int S5L = 32, S5KT = 768, S5NCH = MTOK / S5L;

constexpr size_t MiB = 1u << 20;
constexpr size_t WS_CTL = 0, CTL_BYTES = 65536;
constexpr size_t WS_ROPE = 1 * MiB;
constexpr size_t WS_LP = 2 * MiB;
constexpr size_t WS_BBAR = 7 * MiB;
constexpr size_t WS_KTAB = 9 * MiB;
constexpr size_t WS_MEMN = 17 * MiB;
constexpr size_t WS_W_IN = 20 * MiB;
constexpr size_t WS_W_ABO = WS_W_IN + 32 * MiB;
constexpr size_t WS_W_GLU = WS_W_ABO + 16 * MiB;
constexpr size_t WS_W_QKV = WS_W_GLU + 4 * MiB;
constexpr size_t WS_W_CO = WS_W_QKV + 48 * MiB;
constexpr size_t WS_W13 = WS_W_CO + 16 * MiB;
constexpr size_t WS_W2 = WS_W13 + 176 * MiB;
constexpr size_t WS_WQK = WS_W2 + 88 * MiB;
constexpr size_t WS_VWO = WS_WQK + 32 * MiB;
constexpr size_t WS_BTT = WS_VWO + 32 * MiB;
constexpr size_t WS_BTE = WS_BTT + 96 * MiB;
constexpr size_t WS_HID = WS_BTE + 32 * MiB;
constexpr size_t WS_H = WS_HID;
constexpr size_t WS_HB = WS_HID + 176 * MiB;
constexpr size_t WS_CAT = WS_HB + 64 * MiB;
constexpr size_t WS_XP = WS_CAT + 64 * MiB;
constexpr size_t WS_R1 = WS_XP + 32 * MiB;
constexpr size_t WS_R2 = WS_R1 + 192 * MiB;
constexpr size_t WS_RSSP = WS_R2 + 196 * MiB;
constexpr size_t WS_END = WS_RSSP + 26 * MiB;
constexpr size_t WS_QKVO = WS_R1;
constexpr size_t WS_U2 = WS_R1;
constexpr size_t WS_QKVE = WS_R1 + 48 * MiB;
constexpr size_t WS_WKV_T = WS_R1;
constexpr size_t WS_WQ_B = WS_R1 + 64 * MiB;
constexpr size_t WS_WO_T = WS_R1 + 96 * MiB;
constexpr size_t WS_KVALL = WS_R1 + 128 * MiB;
constexpr size_t WS_OB = WS_R2;
constexpr size_t WS_LSE = WS_R2 + 192 * MiB;
constexpr size_t WS_O12 = WS_R2;
constexpr size_t WS_E = WS_R2 + 64 * MiB;
constexpr size_t WS_G = WS_R2 + 96 * MiB;

constexpr int LDS_STAGE = 131072;
constexpr int LDS_EPI = LDS_STAGE;
constexpr int LDS_MISC = LDS_STAGE + 8192;
constexpr int LDS_RSTD = LDS_MISC + 256;
constexpr int LDS_BYTES = 147456;

__device__ __forceinline__ unsigned f2bf(float f) { unsigned u = __builtin_bit_cast(unsigned, f); return (u + 0x7fffu + ((u >> 16) & 1u)) >> 16; }
__device__ __forceinline__ float bf2f(unsigned h) { return __builtin_bit_cast(float, h << 16); }
__device__ __forceinline__ unsigned cvt_pk_bf16(float lo, float hi) { unsigned r; asm volatile("v_cvt_pk_bf16_f32 %0, %1, %2" : "=v"(r) : "v"(lo), "v"(hi)); return r; }
__device__ __forceinline__ u32x2 pack4(f32x4 v) { u32x2 w; w.x = cvt_pk_bf16(v[0], v[1]); w.y = cvt_pk_bf16(v[2], v[3]); return w; }
template <int CTRL> __device__ __forceinline__ float dpp_f(float x) { return __builtin_bit_cast(float, __builtin_amdgcn_update_dpp(0, __builtin_bit_cast(int, x), CTRL, 0xf, 0xf, true)); }
__device__ __forceinline__ float wave_sum(float v) {
    v += dpp_f<0xB1>(v); v += dpp_f<0x4E>(v); v += dpp_f<0x141>(v); v += dpp_f<0x128>(v);
    auto s = __builtin_amdgcn_permlane16_swap(__float_as_uint(v), __float_as_uint(v), false, false); v = __uint_as_float(s[0]) + __uint_as_float(s[1]);
    auto u = __builtin_amdgcn_permlane32_swap(__float_as_uint(v), __float_as_uint(v), false, false); return __uint_as_float(u[0]) + __uint_as_float(u[1]);
}
__device__ __forceinline__ float x16_sum(float x) {
    auto s = __builtin_amdgcn_permlane16_swap(__float_as_uint(x), __float_as_uint(x), false, false); x = __uint_as_float(s[0]) + __uint_as_float(s[1]);
    auto u = __builtin_amdgcn_permlane32_swap(__float_as_uint(x), __float_as_uint(x), false, false); return __uint_as_float(u[0]) + __uint_as_float(u[1]);
}
__device__ __forceinline__ float x16_max(float x) {
    auto s = __builtin_amdgcn_permlane16_swap(__float_as_uint(x), __float_as_uint(x), false, false); x = fmaxf(__uint_as_float(s[0]), __uint_as_float(s[1]));
    auto u = __builtin_amdgcn_permlane32_swap(__float_as_uint(x), __float_as_uint(x), false, false); return fmaxf(__uint_as_float(u[0]), __uint_as_float(u[1]));
}
__device__ __forceinline__ float row_rstd(const float* rssp, int row, int fq) {
    const f32x4 a = *(const f32x4*)(rssp + (size_t)row * 32 + fq * 8), b = *(const f32x4*)(rssp + (size_t)row * 32 + fq * 8 + 4);
    float s = ((a[0] + a[1]) + (a[2] + a[3])) + ((b[0] + b[1]) + (b[2] + b[3]));
    s += __shfl_xor(s, 16); s += __shfl_xor(s, 32);
    return 1.0f / sqrtf(s * (1.0f / DM) + NORM_EPS);
}
__device__ __forceinline__ void fill_rstd_tab(const float* rssp, int pm, LAS float* tab) {
    int t = threadIdx.x; asm volatile("" : "+v"(t));
    if (t < 256) { const f32x4* p = (const f32x4*)(rssp + ((size_t)pm * 256 + t) * 32); float s = 0.f;
#pragma unroll
        for (int j = 0; j < 8; ++j) { const f32x4 a = p[j]; s += (a[0] + a[1]) + (a[2] + a[3]); }
        tab[t] = __builtin_amdgcn_rsqf(s * (1.0f / DM) + NORM_EPS); }
}
#define LDS_WAIT() asm volatile("s_waitcnt lgkmcnt(0)" ::: "memory")
#define VM_WAIT() asm volatile("s_waitcnt vmcnt(0)" ::: "memory")

#define XB_TMO      128
#define XB_XCNT(j)  (256  + 64 * (j))
#define XB_XSUB(j)  (1280 + 64 * (j))
#define XB_XGEN(j)  (2304 + 64 * (j))
#define XB_TOP      3328
#define XB_TOPGEN   3392
#define XCD_BAR_WORDS 3456
#define XB_SPIN_CAP (1u << 20)

__device__ __forceinline__ unsigned xb_ld(unsigned* p)              { return __hip_atomic_load(p, __ATOMIC_RELAXED, __HIP_MEMORY_SCOPE_AGENT); }
__device__ __forceinline__ unsigned xb_add(unsigned* p, unsigned v) { return __hip_atomic_fetch_add(p, v, __ATOMIC_RELAXED, __HIP_MEMORY_SCOPE_AGENT); }
__device__ __forceinline__ unsigned xb_xcc_id() { return (unsigned)__builtin_amdgcn_s_getreg((3 << 11) | 20) & 0xFu; }
#define XB_SPIN(cond, bar) do { unsigned _sp = 0; while (cond) { __builtin_amdgcn_s_sleep(1); \
    if ((++_sp & 255u) == 0u) { if (xb_ld(&(bar)[XB_TMO])) break; if (_sp > XB_SPIN_CAP) { atomicAdd(&(bar)[XB_TMO], 1u); break; } } } } while (0)

struct XcdBarrier { unsigned* bar; unsigned x; volatile LAS unsigned* st; };

__device__ __forceinline__ XcdBarrier xcd_barrier_post(unsigned* bar, volatile LAS unsigned* st) {
    XcdBarrier b; b.bar = bar; b.x = xb_xcc_id(); b.st = st;
    if (threadIdx.x == 0) (void)xb_add(&bar[XB_XCNT(b.x)], 1u);
    return b;
}
__device__ __forceinline__ void xcd_barrier_complete(unsigned* bar, unsigned x, unsigned& nloc, unsigned& nx) {
    const unsigned G = gridDim.x * gridDim.y * gridDim.z;
    unsigned sum, cnt, mine, sp = 0u;
    for (;;) {
        sum = 0u; cnt = 0u;
#pragma unroll
        for (unsigned j = 0; j < 16; ++j) { const unsigned c = xb_ld(&bar[XB_XCNT(j)]); sum += c; cnt += (c > 0u) ? 1u : 0u; }
        mine = xb_ld(&bar[XB_XCNT(x)]);
        if (sum == G) break;
        __builtin_amdgcn_s_sleep(1);
        if ((++sp & 255u) == 0u) { if (xb_ld(&bar[XB_TMO])) break; if (sp > XB_SPIN_CAP) { atomicAdd(&bar[XB_TMO], 1u); break; } }
    }
    nloc = mine > 0u ? mine : 1u; nx = cnt > 0u ? cnt : 1u;
}
__device__ __forceinline__ void xcd_barrier(const XcdBarrier& b) {
    asm volatile("s_waitcnt vmcnt(0)" ::: "memory");
    __syncthreads();
    if (threadIdx.x == 0) {
        unsigned* bar = b.bar; unsigned bx_ = b.x; asm volatile("" : "+s"(bx_));
        __builtin_amdgcn_s_waitcnt(0);
        unsigned nloc = b.st[0], nx = b.st[1];
        if (nloc == 0u) { xcd_barrier_complete(bar, bx_, nloc, nx); b.st[0] = nloc; b.st[1] = nx; }
        const unsigned old = xb_add(&bar[XB_XSUB(bx_)], 1u);
        const unsigned gen = old / nloc;
        if (old + 1u == (gen + 1u) * nloc) {
            __builtin_amdgcn_fence(__ATOMIC_RELEASE, "agent");
            asm volatile("s_waitcnt vmcnt(0)" ::: "memory");
            const unsigned og = xb_add(&bar[XB_TOP], 1u);
            const unsigned tg = og / nx;
            if (og + 1u == (tg + 1u) * nx) xb_add(&bar[XB_TOPGEN], 1u);
            else XB_SPIN(xb_ld(&bar[XB_TOPGEN]) == tg, bar);
            __builtin_amdgcn_fence(__ATOMIC_ACQUIRE, "agent");
            xb_add(&bar[XB_XGEN(bx_)], 1u);
            asm volatile("s_waitcnt vmcnt(0)" ::: "memory");
        } else {
            XB_SPIN(xb_ld(&bar[XB_XGEN(bx_)]) == gen, bar);
            __builtin_amdgcn_fence(__ATOMIC_ACQUIRE, "agent");
            asm volatile("s_waitcnt vmcnt(0)" ::: "memory");
        }
    }
    __syncthreads();
}

#define GS_XCC_WORD 8192
#define GS_CNT_WORD 9216
__device__ __forceinline__ void group_sync(unsigned* ctl, int gid, unsigned need) {
    asm volatile("s_waitcnt vmcnt(0)" ::: "memory");
    __syncthreads();
    if (threadIdx.x == 0) {
        unsigned* c = ctl + GS_CNT_WORD + 64 * gid;
        (void)xb_add(c, 1u);
        XB_SPIN(xb_ld(c) < need, ctl);
        __builtin_amdgcn_fence(__ATOMIC_ACQUIRE, "agent");
        asm volatile("s_waitcnt vmcnt(0)" ::: "memory");
    }
    __syncthreads();
}

namespace pg8 {
constexpr int BM = 256, BK = 64, HALF = 128, HTB = HALF * BK * 2, STAGE_BYTES = 8 * HTB, NXCD = 8, WGM = 8;
__device__ __forceinline__ int lds_byte(int r, int c) { const int st = (r >> 4) * 2 + (c >> 5), rr = r & 15, cc = c & 31, ob = rr * 64 + cc * 2; return st * 1024 + (ob ^ (((ob >> 9) & 1) << 5)); }
__device__ __forceinline__ void stage_rc(int b, int& R, int& C) { const int st = b / 1024, sb = b % 1024, swz = sb ^ (((sb >> 9) & 1) << 5); R = (st >> 1) * 16 + swz / 64; C = (st & 1) * 32 + (swz % 64) / 2; }

struct Unit { int pm, pn, g; const char* a; const char* b; };

struct DenseOrder {
    int nM, nN, nwg, G, c, pmdiv; const char* A; const char* B; size_t tA, tB, bgroup;
    __device__ __forceinline__ void init(const void* A_, int lda, const void* B_, int ldb, int M, int N, int G_, int c_, int pmdiv_ = 1 << 30, size_t bgroup_ = 0) {
        nM = M / BM; nN = N / BM; nwg = nM * nN; G = G_; c = c_; A = (const char*)A_; B = (const char*)B_; tA = (size_t)BM * lda * 2; tB = (size_t)BM * ldb * 2; pmdiv = pmdiv_; bgroup = bgroup_; }
    __device__ __forceinline__ bool next(int i, Unit& u) const {
        const long L = (long)i * G + c; if (L >= nwg) return false;
        int wgid = (int)L; { const int q = nwg / NXCD, r = nwg % NXCD, xcd = wgid % NXCD, off = wgid / NXCD; wgid = (xcd < r ? xcd * (q + 1) : r * (q + 1) + (xcd - r) * q) + off; }
        const int nig = WGM * nN, gid = wgid / nig, fm = gid * WGM, gsz = (nM - fm) < WGM ? (nM - fm) : WGM;
        u.pm = fm + ((wgid % nig) % gsz); u.pn = (wgid % nig) / gsz; u.g = u.pm / pmdiv;
        u.a = A + (size_t)u.pm * tA; u.b = B + (size_t)u.pn * tB + (size_t)u.g * bgroup; return true;
    }
};

template <class Epi, class Sched>
__device__ __forceinline__ void gemm_phase(LAS unsigned char* lds, const int K, const int lda, const int ldb, const Sched& S, const Epi& E) {
    int tid = threadIdx.x; asm volatile("" : "+v"(tid));
    const int wid = __builtin_amdgcn_readfirstlane(tid >> 6), lane = tid & 63, wr = wid >> 2, wc = wid & 3, fr = lane & 15, fq = lane >> 4;
    const int nt = K / BK;
    unsigned voffA[2], voffB[2];
#pragma unroll
    for (int i = 0; i < 2; ++i) { int R, C; stage_rc(tid * 16 + i * 8192, R, C);
        const int Rb = Epi::PERM ? ((R & ~31) + 8 * ((R & 15) >> 2) + 4 * ((R >> 4) & 1) + (R & 3)) : R;
        voffA[i] = (unsigned)(R * lda + C) * 2u; voffB[i] = (unsigned)(Rb * ldb + C) * 2u; }
    const size_t kstep = (size_t)(BK * 2);
    const size_t hstepA = (size_t)HALF * lda * 2, hstepB = (size_t)HALF * ldb * 2;
    const unsigned ldsw = (unsigned)wid * 1024u;
    const int aoff = lds_byte(wr * 64 + fr, fq * 8), boff = lds_byte(wc * 32 + fr, fq * 8);
#define PG8_SA(b, h) (((b) * 2 + (h)) * HTB)
#define PG8_SB(b, h) ((4 + (b) * 2 + (h)) * HTB)
#ifndef PG8_AUX_A
#define PG8_AUX_A 0
#endif
#ifndef PG8_AUX_B
#define PG8_AUX_B 0
#endif
#define PG8_STAGE_X(bufoff, gbase, voff, AUX) do { _Pragma("unroll") for (int _i = 0; _i < 2; ++_i) \
        __builtin_amdgcn_global_load_lds((const unsigned*)((const char*)(gbase) + (voff)[_i]), (LAS unsigned*)(lds + (bufoff) + ldsw + _i * 8192), 16, 0, AUX); } while (0)
#define PG8_STAGE_voffA(bufoff, gbase) PG8_STAGE_X(bufoff, gbase, voffA, PG8_AUX_A)
#define PG8_STAGE_voffB(bufoff, gbase) PG8_STAGE_X(bufoff, gbase, voffB, PG8_AUX_B)
#define PG8_STAGE(bufoff, gbase, voff) PG8_STAGE_##voff(bufoff, gbase)
#define PG8_LDA(dst, b, h) do { _Pragma("unroll") for (int m = 0; m < 4; ++m) _Pragma("unroll") for (int k = 0; k < 2; ++k) dst[m][k] = *(const LAS bf16x8*)(lds + PG8_SA(b, h) + aoff + m * 2048 + k * 1024); } while (0)
#define PG8_LDB(dst, b, h) do { _Pragma("unroll") for (int n = 0; n < 2; ++n) _Pragma("unroll") for (int k = 0; k < 2; ++k) dst[n][k] = *(const LAS bf16x8*)(lds + PG8_SB(b, h) + boff + n * 2048 + k * 1024); } while (0)
#define PG8_MMA(ai, bj, At, Bt) do { __builtin_amdgcn_s_setprio(1); _Pragma("unroll") for (int m = 0; m < 4; ++m) _Pragma("unroll") for (int n = 0; n < 2; ++n) _Pragma("unroll") for (int k = 0; k < 2; ++k) \
        acc[ai][bj][m][n] = __builtin_amdgcn_mfma_f32_16x16x32_bf16(Bt[n][k], At[m][k], acc[ai][bj][m][n], 0, 0, 0); __builtin_amdgcn_s_setprio(0); } while (0)
#define PG8_WAIT_V(n) asm volatile("s_waitcnt vmcnt(" #n ")" ::: "memory")
#define PG8_WAIT_L(n) asm volatile("s_waitcnt lgkmcnt(" #n ")" ::: "memory")
#define PG8_BAR __builtin_amdgcn_s_barrier()
#define PG8_SCHED __builtin_amdgcn_sched_barrier(0)
    Unit cur, nxt; int ui = 0;
    if (!S.next(0, cur)) return;
    f32x4 acc[2][2][4][2];
#define PG8_ZERO4(X) do { typedef double f64x2_ __attribute__((ext_vector_type(2))); double _z0, _z1; asm volatile("v_mov_b64 %0, 0" : "=v"(_z0)); asm volatile("v_mov_b64 %0, 0" : "=v"(_z1)); \
        const f64x2_ _zz = {_z0, _z1}; X = __builtin_bit_cast(f32x4, _zz); } while (0)
#pragma unroll
    for (int a = 0; a < 2; ++a)
#pragma unroll
        for (int b = 0; b < 2; ++b)
#pragma unroll
            for (int m = 0; m < 4; ++m)
#pragma unroll
                for (int n = 0; n < 2; ++n) PG8_ZERO4(acc[a][b][m][n]);
    bf16x8 At[4][2], B0[2][2], B1[2][2];
    const char* cA = cur.a; const char* cB = cur.b;
    PG8_STAGE(PG8_SB(0, 0), cB, voffB); PG8_STAGE(PG8_SA(0, 0), cA, voffA); PG8_STAGE(PG8_SB(0, 1), cB + hstepB, voffB); PG8_STAGE(PG8_SA(0, 1), cA + hstepA, voffA);
    if (wr == 1) PG8_BAR;
    PG8_WAIT_V(4); PG8_BAR;
    PG8_STAGE(PG8_SB(1, 0), cB + kstep, voffB); PG8_STAGE(PG8_SA(1, 0), cA + kstep, voffA); PG8_STAGE(PG8_SB(1, 1), cB + hstepB + kstep, voffB);
    PG8_WAIT_V(6); PG8_BAR;
    for (;;) {
        const bool has_next = S.next(ui + 1, nxt);
        const char* nA = has_next ? nxt.a : cA; const char* nB = has_next ? nxt.b : cB;
#if defined(KREP_DIAG)
        const int nt_eff = Epi::REPEATABLE ? 2 * nt : nt;
#else
        const int nt_eff = nt;
#endif
        for (int tt = 0; tt < nt_eff; tt += 2) {
            const bool last = (tt == nt_eff - 2);
            const int t = tt >= nt ? tt - nt : tt, t2 = (tt + 2 >= nt && tt + 2 < nt_eff) ? tt + 2 - nt : tt + 2;
            const char* a1 = cA + (size_t)(t + 1) * kstep;
            const char* a2 = last ? nA : cA + (size_t)t2 * kstep; const char* b2 = last ? nB : cB + (size_t)t2 * kstep;
            const char* a3 = a2 + kstep; const char* b3 = b2 + kstep;
            PG8_LDB(B0, 0, 0); PG8_SCHED; PG8_LDA(At, 0, 0); PG8_STAGE(PG8_SA(1, 1), a1 + hstepA, voffA);
            PG8_WAIT_L(8); PG8_BAR; PG8_WAIT_L(0); PG8_MMA(0, 0, At, B0); PG8_BAR; PG8_SCHED;
            PG8_LDB(B1, 0, 1); PG8_STAGE(PG8_SB(0, 0), b2, voffB);
            PG8_BAR; PG8_WAIT_L(0); PG8_MMA(0, 1, At, B1); PG8_BAR;
            PG8_LDA(At, 0, 1); PG8_STAGE(PG8_SA(0, 0), a2, voffA);
            PG8_BAR; PG8_WAIT_L(0); PG8_MMA(1, 0, At, B0); PG8_BAR; PG8_SCHED;
            PG8_STAGE(PG8_SB(0, 1), b2 + hstepB, voffB);
            PG8_WAIT_V(6); PG8_BAR; PG8_MMA(1, 1, At, B1); PG8_BAR;
            PG8_LDB(B0, 1, 0); PG8_SCHED; PG8_LDA(At, 1, 0); PG8_STAGE(PG8_SA(0, 1), a2 + hstepA, voffA);
            PG8_WAIT_L(8); PG8_BAR; PG8_WAIT_L(0); PG8_MMA(0, 0, At, B0); PG8_BAR; PG8_SCHED;
            PG8_LDB(B1, 1, 1); PG8_STAGE(PG8_SB(1, 0), b3, voffB);
            PG8_BAR; PG8_WAIT_L(0); PG8_MMA(0, 1, At, B1); PG8_BAR;
            PG8_LDA(At, 1, 1); PG8_STAGE(PG8_SA(1, 0), a3, voffA);
            PG8_BAR; PG8_WAIT_L(0); PG8_MMA(1, 0, At, B0); PG8_BAR; PG8_SCHED;
            PG8_STAGE(PG8_SB(1, 1), b3 + hstepB, voffB);
            PG8_WAIT_V(6); PG8_BAR; PG8_MMA(1, 1, At, B1); PG8_BAR;
        }
        E(acc, cur, wr, wc, fr, fq);
#if defined(REP_EPI)
        if constexpr (Epi::REPEATABLE) { asm volatile("" ::: "memory"); Epi E2 = E; E2.dry = true; E2(acc, cur, wr, wc, fr, fq); }
#endif
        if (!has_next) break;
#pragma unroll
        for (int a = 0; a < 2; ++a)
#pragma unroll
            for (int b = 0; b < 2; ++b)
#pragma unroll
                for (int m = 0; m < 4; ++m)
#pragma unroll
                    for (int n = 0; n < 2; ++n) PG8_ZERO4(acc[a][b][m][n]);
        cur = nxt; cA = nA; cB = nB; ++ui;
    }
    PG8_WAIT_V(0);
    if (wr == 0) PG8_BAR;
    PG8_BAR;
#undef PG8_SA
#undef PG8_SB
#undef PG8_STAGE
#undef PG8_STAGE_X
#undef PG8_STAGE_voffA
#undef PG8_STAGE_voffB
#undef PG8_LDA
#undef PG8_LDB
#undef PG8_MMA
#undef PG8_ZERO4
#undef PG8_WAIT_V
#undef PG8_WAIT_L
#undef PG8_BAR
#undef PG8_SCHED
}
}

typedef f32x4 acc_t[2][2][4][2];
#define EPI_ROWS(ai, m) _Pragma("unroll") for (int ai = 0; ai < 2; ++ai) _Pragma("unroll") for (int m = 0; m < 4; ++m)
#define EPI_COLS(bj, n) _Pragma("unroll") for (int bj = 0; bj < 2; ++bj) _Pragma("unroll") for (int n = 0; n < 2; ++n)

struct EpiBf16Plain {
    static constexpr bool REPEATABLE = false; static constexpr bool PERM = false;
    bf16_t* O; int ldo; const float* colscale; float scale;
    __device__ __forceinline__ void operator()(acc_t& acc, const pg8::Unit& u, int wr, int wc, int fr, int fq) const {
        const int row0 = u.pm * 256 + wr * 64 + fr, col0 = u.pn * 256 + wc * 32 + 4 * fq;
        f32x4 cs[2][2];
        EPI_COLS(bj, n) { cs[bj][n] = colscale ? *(const f32x4*)(colscale + col0 + bj * 128 + n * 16) * scale : (f32x4){scale, scale, scale, scale}; }
        EPI_ROWS(ai, m) { bf16_t* rowp = O + (size_t)(row0 + ai * 128 + m * 16) * ldo + col0;
            EPI_COLS(bj, n) { *(u32x2*)(rowp + bj * 128 + n * 16) = pack4(acc[ai][bj][m][n] * cs[bj][n]); } }
    }
};
struct EpiWqK {
    static constexpr bool REPEATABLE = false; static constexpr bool PERM = false;
    bf16_t* O; const float* gain;
    __device__ __forceinline__ void operator()(acc_t& acc, const pg8::Unit& u, int wr, int wc, int fr, int fq) const {
        const int l = u.g >> 3, lb = u.g >> 2, h = u.g & 3;
        const int row0 = wr * 64 + fr, col0 = u.pn * 256 + wc * 32 + 4 * fq;
        bf16_t* base = O + ((size_t)lb * 1024 + h * 256) * 2048;
        const float* gl = gain + l * 2048;
        f32x4 cs[2][2];
        EPI_COLS(bj, n) { cs[bj][n] = *(const f32x4*)(gl + col0 + bj * 128 + n * 16) * 0.04419417382415922f; }
        EPI_ROWS(ai, m) { bf16_t* rowp = base + (size_t)(row0 + ai * 128 + m * 16) * 2048 + col0;
            EPI_COLS(bj, n) { *(u32x2*)(rowp + bj * 128 + n * 16) = pack4(acc[ai][bj][m][n] * cs[bj][n]); } }
    }
};
struct EpiVWo {
    static constexpr bool REPEATABLE = false; static constexpr bool PERM = false;
    bf16_t* O;
    __device__ __forceinline__ void operator()(acc_t& acc, const pg8::Unit& u, int wr, int wc, int fr, int fq) const {
        const int lb = u.g >> 2, h = u.g & 3;
        const int row0 = u.pm * 256 + wr * 64 + fr, col0 = h * 256 + wc * 32 + 4 * fq;
        bf16_t* base = O + (size_t)lb * 2048 * 1024;
        EPI_ROWS(ai, m) { bf16_t* rowp = base + (size_t)(row0 + ai * 128 + m * 16) * 1024 + col0;
            EPI_COLS(bj, n) { *(u32x2*)(rowp + bj * 128 + n * 16) = pack4(acc[ai][bj][m][n]); } }
    }
};
struct EpiF32 {
    static constexpr bool REPEATABLE = false; static constexpr bool PERM = false;
    float* C; int ldc;
    __device__ __forceinline__ void operator()(acc_t& acc, const pg8::Unit& u, int wr, int wc, int fr, int fq) const {
        const int row0 = u.pm * 256 + wr * 64 + fr, col0 = u.pn * 256 + wc * 32 + 4 * fq;
        EPI_ROWS(ai, m) { float* rowp = C + (size_t)(row0 + ai * 128 + m * 16) * ldc + col0;
            EPI_COLS(bj, n) { *(f32x4*)(rowp + bj * 128 + n * 16) = acc[ai][bj][m][n]; } }
    }
};
struct EpiProj {
    static constexpr bool REPEATABLE = false; static constexpr bool PERM = false;
    LAS const float* rstd_tab; const float* rc; const float* rs; bf16_t* O; int ldo; bf16_t* U2; int u_tiles, rope_lo, rope_hi;
    __device__ __forceinline__ void operator()(acc_t& acc, const pg8::Unit& u, int wr, int wc, int fr, int fq) const {
        const int row0 = u.pm * 256 + wr * 64 + fr;
        const bool is_u = u.pn < u_tiles, rope = (u.pn >= rope_lo) && (u.pn < rope_hi) && (wc == 0);
        EPI_ROWS(ai, m) {
            const int row = row0 + ai * 128 + m * 16;
            const float rstd = rstd_tab[ai * 128 + wr * 64 + m * 16 + fr];
            f32x4 v[2][2];
            EPI_COLS(bj, n) { v[bj][n] = acc[ai][bj][m][n] * rstd; }
            if (rope) {
                const int pos = row & (SEQ - 1);
#if defined(ROPE_TABLE)
                const f32x4 c = *(const f32x4*)(rc + pos * 16 + 4 * fq), s = *(const f32x4*)(rs + pos * 16 + 4 * fq);
#else
                f32x4 c, s;
#pragma unroll
                for (int e = 0; e < 4; ++e) { const float invrev = __builtin_amdgcn_exp2f(-1.1832230355827609f * (float)(4 * fq + e) - 2.6514961294723187f);
                    const float fr_ = __builtin_amdgcn_fractf((float)pos * invrev); c[e] = __builtin_amdgcn_cosf(fr_); s[e] = __builtin_amdgcn_sinf(fr_); }
#endif
#pragma unroll
                for (int bj = 0; bj < 2; ++bj) { const f32x4 x1 = v[bj][0], x2 = v[bj][1]; v[bj][0] = x1 * c - x2 * s; v[bj][1] = x2 * c + x1 * s; }
            }
            if (is_u) {
                const int cg = row >> 5, t = row & 31;
                EPI_COLS(bj, n) { const int g = (u.pn * 256 + bj * 128 + wc * 32 + n * 16) >> 4;
                    *(u32x2*)(U2 + ((size_t)g * S5NCH + cg) * S5KT + t * 16 + 4 * fq) = pack4(v[bj][n]); }
            } else if (ldo == 0) {
                const int t = u.pn - u_tiles, which = t >> 3, b = row >> 13, pos = row & (SEQ - 1);
#pragma unroll
                for (int bj = 0; bj < 2; ++bj) { const int h = 2 * (t & 7) + bj;
                    bf16_t* rowp = O + (size_t)which * MTOK * DM + ((size_t)(b * 16 + h) * SEQ + pos) * 128 + wc * 32 + 4 * fq;
#pragma unroll
                    for (int n = 0; n < 2; ++n) *(u32x2*)(rowp + n * 16) = pack4(v[bj][n]); }
            } else {
                bf16_t* rowp = O + (size_t)row * ldo + (u.pn - u_tiles) * 256 + wc * 32 + 4 * fq;
                EPI_COLS(bj, n) { *(u32x2*)(rowp + bj * 128 + n * 16) = pack4(v[bj][n]); }
            }
        }
    }
};
struct EpiRes {
    static constexpr bool REPEATABLE = false; static constexpr bool PERM = true;
    const float* base32; bf16_t* HB; float* rss_next; bool dry = false;
    __device__ __forceinline__ void operator()(acc_t& acc, const pg8::Unit& u, int wr, int wc, int fr, int fq) const {
        const int row0 = u.pm * 256 + wr * 64 + fr, col0 = u.pn * 256 + wc * 32 + 8 * fq;
        EPI_ROWS(ai, m) {
            const int row = row0 + ai * 128 + m * 16; const size_t off = (size_t)row * DM + col0; float ss = 0.f;
            if (base32) {
                EPI_COLS(bj, n) { acc[ai][bj][m][n] += *(const f32x4*)(base32 + off + bj * 128 + n * 4); }
            } else {
#pragma unroll
                for (int bj = 0; bj < 2; ++bj) { const u32x4 w = *(const u32x4*)(HB + off + bj * 128);
                    acc[ai][bj][m][0] += (f32x4){bf2f(w.x & 0xffffu), bf2f(w.x >> 16), bf2f(w.y & 0xffffu), bf2f(w.y >> 16)};
                    acc[ai][bj][m][1] += (f32x4){bf2f(w.z & 0xffffu), bf2f(w.z >> 16), bf2f(w.w & 0xffffu), bf2f(w.w >> 16)}; }
            }
#pragma unroll
            for (int bj = 0; bj < 2; ++bj) { const f32x4 o0 = acc[ai][bj][m][0], o1 = acc[ai][bj][m][1]; const u32x2 w0 = pack4(o0), w1 = pack4(o1); const u32x4 w = {w0.x, w0.y, w1.x, w1.y};
                if (dry) { asm volatile("" :: "v"(w.x), "v"(w.y), "v"(w.z), "v"(w.w)); } else { *(u32x4*)(HB + off + bj * 128) = w; }
                ss += ((o0[0] * o0[0] + o0[1] * o0[1]) + (o0[2] * o0[2] + o0[3] * o0[3])) + ((o1[0] * o1[0] + o1[1] * o1[1]) + (o1[2] * o1[2] + o1[3] * o1[3])); }
            ss = x16_sum(ss);
            if (fq == 0 && !dry) rss_next[(size_t)row * 32 + u.pn * 4 + wc] = ss;
        }
    }
};
struct EpiSoftmax {
    static constexpr bool REPEATABLE = false; static constexpr bool PERM = false;
    LAS const float* rstd_tab; bf16_t* P; LAS float* xch;
    __device__ __forceinline__ void operator()(acc_t& acc, const pg8::Unit& u, int wr, int wc, int fr, int fq) const {
        const int row0 = u.pm * 256 + wr * 64 + fr;
        LAS float* xmax = xch; LAS float* xsum = xch + 1024;
        EPI_ROWS(ai, m) {
            const int rl = ai * 128 + wr * 64 + m * 16 + fr, row = u.pm * 256 + rl;
            const float rstd = rstd_tab[rl] * 1.4426950408889634f;
            float mx = -3.0e38f;
            EPI_COLS(bj, n) { const f32x4 s = acc[ai][bj][m][n] * rstd; acc[ai][bj][m][n] = s; mx = fmaxf(mx, fmaxf(fmaxf(s[0], s[1]), fmaxf(s[2], s[3]))); }
            mx = x16_max(mx);
            if (fq == 0) xmax[rl * 4 + wc] = mx;
        }
        LDS_WAIT(); __builtin_amdgcn_s_barrier(); asm volatile("" ::: "memory");
        EPI_ROWS(ai, m) {
            const int rl = ai * 128 + wr * 64 + m * 16 + fr;
            const f32x4 m4 = *(const LAS f32x4*)(xmax + rl * 4); const float mx = fmaxf(fmaxf(m4[0], m4[1]), fmaxf(m4[2], m4[3]));
            float sm = 0.f;
            EPI_COLS(bj, n) { f32x4 s = acc[ai][bj][m][n];
#pragma unroll
                for (int j = 0; j < 4; ++j) s[j] = __builtin_amdgcn_exp2f(s[j] - mx);
                acc[ai][bj][m][n] = s; sm += (s[0] + s[1]) + (s[2] + s[3]); }
            sm = x16_sum(sm);
            if (fq == 0) xsum[rl * 4 + wc] = sm;
        }
        LDS_WAIT(); __builtin_amdgcn_s_barrier(); asm volatile("" ::: "memory");
        EPI_ROWS(ai, m) {
            const int rl = ai * 128 + wr * 64 + m * 16 + fr;
            const f32x4 s4 = *(const LAS f32x4*)(xsum + rl * 4); const float inv = __builtin_amdgcn_rcpf((s4[0] + s4[1]) + (s4[2] + s4[3]));
            bf16_t* rowp = P + (size_t)(row0 + ai * 128 + m * 16) * 1024 + u.pn * 256 + wc * 32 + 4 * fq;
            EPI_COLS(bj, n) { *(u32x2*)(rowp + bj * 128 + n * 16) = pack4(acc[ai][bj][m][n] * inv); }
        }
    }
};
struct EpiSwiglu {
    static constexpr bool REPEATABLE = true; static constexpr bool PERM = true;
    LAS const float* rstd_tab; bf16_t* O; bool dry = false;
    __device__ __forceinline__ void operator()(acc_t& acc, const pg8::Unit& u, int wr, int wc, int fr, int fq) const {
        const int row0 = u.pm * 256 + wr * 64 + fr;
        EPI_ROWS(ai, m) {
            const int row = row0 + ai * 128 + m * 16;
#if defined(KREP_DIAG)
            const float rstd = 0.5f * rstd_tab[ai * 128 + wr * 64 + m * 16 + fr];
#else
            const float rstd = rstd_tab[ai * 128 + wr * 64 + m * 16 + fr];
#endif
            bf16_t* rowp = O + (size_t)row * FFN + u.pn * 128 + wc * 32 + 8 * fq;
            u32x2 wn[2];
            const float kk = -1.4426950408889634f * rstd, r2 = rstd * rstd;
            f32x4 e2[2], ab[2];
#pragma unroll
            for (int n = 0; n < 2; ++n)
#pragma unroll
                for (int j = 0; j < 4; ++j) e2[n][j] = __builtin_amdgcn_exp2f(acc[ai][0][m][n][j] * kk);
#pragma unroll
            for (int n = 0; n < 2; ++n) ab[n] = acc[ai][0][m][n] * acc[ai][1][m][n] * r2;
#pragma unroll
            for (int n = 0; n < 2; ++n)
#pragma unroll
                for (int j = 0; j < 4; ++j) e2[n][j] = __builtin_amdgcn_rcpf(1.0f + e2[n][j]);
#pragma unroll
            for (int n = 0; n < 2; ++n) wn[n] = pack4(ab[n] * e2[n]);
            { const u32x4 w = {wn[0].x, wn[0].y, wn[1].x, wn[1].y}; if (dry) { asm volatile("" :: "v"(w.x), "v"(w.y), "v"(w.z), "v"(w.w)); } else { *(u32x4*)rowp = w; } }
        }
    }
};
__device__ __forceinline__ float gelu_tanh(float x) { const float z = 0.7978845608028654f * (x + 0.044715f * x * x * x); const float e = __builtin_amdgcn_exp2f(2.8853900817779268f * z); return x * (1.0f - __builtin_amdgcn_rcpf(1.0f + e)); }
struct EpiS5Y {
    static constexpr bool REPEATABLE = false; static constexpr bool PERM = false;
    bf16_t* G;
    __device__ __forceinline__ void operator()(acc_t& acc, const pg8::Unit& u, int wr, int wc, int fr, int fq) const {
        const int g = u.pm >> 1;
        EPI_ROWS(ai, m) {
            const int cg = (u.pm & 1) * 256 + ai * 128 + wr * 64 + m * 16 + fr;
            EPI_COLS(bj, n) { const int t = (u.pn * 256 + bj * 128 + wc * 32 + n * 16) >> 4; const f32x4 y = acc[ai][bj][m][n]; f32x4 o;
#pragma unroll
                for (int j = 0; j < 4; ++j) o[j] = gelu_tanh(y[j]);
                *(u32x2*)(G + (size_t)(cg * S5L + t) * 1024 + g * 16 + 4 * fq) = pack4(o); }
        }
    }
};
struct EpiGlu {
    static constexpr bool REPEATABLE = false; static constexpr bool PERM = false;
    const bf16_t* G; const float* bias; bf16_t* O;
    __device__ __forceinline__ void operator()(acc_t& acc, const pg8::Unit& u, int wr, int wc, int fr, int fq) const {
        const int row0 = u.pm * 256 + wr * 64 + fr, col0 = u.pn * 256 + wc * 32 + 4 * fq;
        f32x4 bv[2][2];
        EPI_COLS(bj, n) { bv[bj][n] = *(const f32x4*)(bias + col0 + bj * 128 + n * 16); }
        EPI_ROWS(ai, m) {
            const int row = row0 + ai * 128 + m * 16;
            EPI_COLS(bj, n) { const int c = col0 + bj * 128 + n * 16; const u32x2 gw = *(const u32x2*)(G + (size_t)row * 1024 + c);
                const f32x4 s = acc[ai][bj][m][n] + bv[bj][n]; f32x4 o;
                const float g0 = bf2f(gw.x & 0xffffu), g1 = bf2f(gw.x >> 16), g2 = bf2f(gw.y & 0xffffu), g3 = bf2f(gw.y >> 16);
                o[0] = g0 * __builtin_amdgcn_rcpf(1.0f + __builtin_amdgcn_exp2f(-1.4426950408889634f * s[0])); o[1] = g1 * __builtin_amdgcn_rcpf(1.0f + __builtin_amdgcn_exp2f(-1.4426950408889634f * s[1])); o[2] = g2 * __builtin_amdgcn_rcpf(1.0f + __builtin_amdgcn_exp2f(-1.4426950408889634f * s[2])); o[3] = g3 * __builtin_amdgcn_rcpf(1.0f + __builtin_amdgcn_exp2f(-1.4426950408889634f * s[3]));
                *(u32x2*)(O + (size_t)row * DM + c) = pack4(o); }
        }
    }
};

namespace att {
constexpr int D = 128, NW = 8, QBLK = 32, KVBLK = 64;
constexpr float SCALE = 0.088388347648318440f;
constexpr float THR = 8.f;
constexpr size_t SHM_V = KVBLK * D * 2, SHM_K = KVBLK * D * 2, SHM_ATTN = 2 * SHM_V + 2 * SHM_K + NW * 64 * 4;
#define KSWZ(row, colB) ((row) * 256 + ((colB) ^ (((row) & 15) << 4)))
#define SBAR() __builtin_amdgcn_sched_barrier(0)
__device__ __forceinline__ int crow(int r, int hi) { return (r & 3) + 8 * (r >> 2) + 4 * hi; }
__device__ __forceinline__ unsigned cvtpk(float lo, float hi) { unsigned r; asm volatile("v_cvt_pk_bf16_f32 %0, %1, %2" : "=v"(r) : "v"(lo), "v"(hi)); return r; }

__device__ __forceinline__ void partialSM(f32x16& p0, f32x16& p1, float& m_reg, float& mn, float& alpha) {
  constexpr float C = SCALE * 1.4426950408889634f;
  float pmax = p0[0];
#pragma unroll
  for (int r = 1; r < 16; ++r) pmax = fmaxf(pmax, p0[r]);
#pragma unroll
  for (int r = 0; r < 16; ++r) pmax = fmaxf(pmax, p1[r]);
  { auto rr = __builtin_amdgcn_permlane32_swap(__float_as_uint(pmax), __float_as_uint(pmax), false, false);
    pmax = fmaxf(__uint_as_float(rr[0]), __uint_as_float(rr[1])); }
  if (__builtin_expect(__all(pmax - m_reg <= THR / SCALE), 1)) { mn = m_reg; alpha = 1.f; }
  else { mn = fmaxf(m_reg, pmax); alpha = __builtin_amdgcn_exp2f((m_reg - mn) * C); m_reg = mn; }
  float mnC = -mn * C;
#pragma unroll
  for (int r = 0; r < 16; ++r) p0[r] = fmaf(p0[r], C, mnC);
#pragma unroll
  for (int r = 0; r < 16; ++r) p1[r] = fmaf(p1[r], C, mnC);
#pragma unroll
  for (int r = 0; r < 16; ++r) p0[r] = __builtin_amdgcn_exp2f(p0[r]);
}
__device__ __forceinline__ void finishSM(f32x16& p0, f32x16& p1, float alpha, float& l_reg, bf16x8& pa0, bf16x8& pa1, bf16x8& pa2, bf16x8& pa3) {
#pragma unroll
  for (int r = 0; r < 16; ++r) p1[r] = __builtin_amdgcn_exp2f(p1[r]);
  float ps = 0;
#pragma unroll
  for (int r = 0; r < 16; ++r) ps += p0[r];
#pragma unroll
  for (int r = 0; r < 16; ++r) ps += p1[r];
  { auto rr = __builtin_amdgcn_permlane32_swap(__float_as_uint(ps), __float_as_uint(ps), false, false);
    ps = __uint_as_float(rr[0]) + __uint_as_float(rr[1]); }
  l_reg = l_reg * alpha + ps;
#define PK4(P, BASE, OUT) do { unsigned a0 = cvtpk(P[BASE + 0], P[BASE + 1]), a1 = cvtpk(P[BASE + 2], P[BASE + 3]);   \
    unsigned b0 = cvtpk(P[BASE + 4], P[BASE + 5]), b1 = cvtpk(P[BASE + 6], P[BASE + 7]);                              \
    auto r0 = __builtin_amdgcn_permlane32_swap(a0, b0, false, false); auto r1 = __builtin_amdgcn_permlane32_swap(a1, b1, false, false); \
    u32x4 w = {r0[0], r1[0], r0[1], r1[1]}; OUT = *reinterpret_cast<bf16x8*>(&w); } while (0)
  PK4(p0, 0, pa0); PK4(p0, 8, pa1); PK4(p1, 0, pa2); PK4(p1, 8, pa3);
#undef PK4
}
__device__ __forceinline__ void qkt(f32x16& p0, f32x16& p1, const char* Ks, const bf16x8* qr, int r32, int hi) {
  p0 = f32x16{}; p1 = f32x16{};
#pragma unroll
  for (int d0 = 0; d0 < 8; ++d0) { int cb = (d0 * 16 + hi * 8) * 2;
    bf16x8 b0 = *reinterpret_cast<const bf16x8*>(Ks + KSWZ(r32, cb));
    bf16x8 b1 = *reinterpret_cast<const bf16x8*>(Ks + KSWZ(32 + r32, cb));
    p0 = __builtin_amdgcn_mfma_f32_32x32x16_bf16(b0, qr[d0], p0, 0, 0, 0);
    p1 = __builtin_amdgcn_mfma_f32_32x32x16_bf16(b1, qr[d0], p1, 0, 0, 0); }
}
__device__ __forceinline__ void mask_tile(f32x16& p0, f32x16& p1, int tb, int kq, int Mr, int hi) {
#pragma unroll
  for (int r = 0; r < 16; ++r) { const int tt = tb + crow(r, hi);
    const bool ok0 = ((unsigned)tt <= 128u) && ((unsigned)(kq + tt) < (unsigned)Mr);
    const bool ok1 = ((unsigned)(tt + 32) <= 128u) && ((unsigned)(kq + tt + 32) < (unsigned)Mr);
    p0[r] = ok0 ? p0[r] : -3.0e4f; p1[r] = ok1 ? p1[r] : -3.0e4f; }
}
__device__ __forceinline__ int v_st(int k, int c) { const int kk = (k & ~0xC) | ((k & 4) << 1) | ((k & 8) >> 1); return ((kk >> 3) * 4 + (c >> 5)) * 512 + ((kk & 7) * 32 + (c & 31)) * 2; }
__device__ __forceinline__ int v_rd_base(int lane) { return ((lane & 3) << 3) | (((lane >> 2) & 3) << 6) | (((lane >> 4) & 1) << 5) | (((lane >> 5) & 1) << 8); }
constexpr int v_rd_off(int d0, int ks, int half) { return d0 * 512 + ks * 4096 + half * 2048; }
template <int OFF> __device__ __forceinline__ s16x4 tr_read(int vb) {
  s16x4 r; asm volatile("ds_read_b64_tr_b16 %0, %1 offset:%2" : "=&v"(r) : "v"(vb), "i"(OFF) : "memory"); return r;
}
template <int D0> __device__ __forceinline__ void pv_one(f32x16& od, int vb, bf16x8 pa0, bf16x8 pa1, bf16x8 pa2, bf16x8 pa3) {
  const s16x4 l0 = tr_read<v_rd_off(D0, 0, 0)>(vb), h0 = tr_read<v_rd_off(D0, 0, 1)>(vb), l1 = tr_read<v_rd_off(D0, 1, 0)>(vb), h1 = tr_read<v_rd_off(D0, 1, 1)>(vb);
  const s16x4 l2 = tr_read<v_rd_off(D0, 2, 0)>(vb), h2 = tr_read<v_rd_off(D0, 2, 1)>(vb), l3 = tr_read<v_rd_off(D0, 3, 0)>(vb), h3 = tr_read<v_rd_off(D0, 3, 1)>(vb);
  asm volatile("s_waitcnt lgkmcnt(0)" ::: "memory"); SBAR();
#define PK(L, H) (bf16x8){L[0], L[1], L[2], L[3], H[0], H[1], H[2], H[3]}
  od = __builtin_amdgcn_mfma_f32_32x32x16_bf16(pa0, PK(l0, h0), od, 0, 0, 0);
  od = __builtin_amdgcn_mfma_f32_32x32x16_bf16(pa1, PK(l1, h1), od, 0, 0, 0);
  od = __builtin_amdgcn_mfma_f32_32x32x16_bf16(pa2, PK(l2, h2), od, 0, 0, 0);
  od = __builtin_amdgcn_mfma_f32_32x32x16_bf16(pa3, PK(l3, h3), od, 0, 0, 0);
#undef PK
}
__device__ __forceinline__ void pv_d0(f32x16* o, int vb, bf16x8 pa0, bf16x8 pa1, bf16x8 pa2, bf16x8 pa3) {
  pv_one<0>(o[0], vb, pa0, pa1, pa2, pa3); pv_one<1>(o[1], vb, pa0, pa1, pa2, pa3); pv_one<2>(o[2], vb, pa0, pa1, pa2, pa3); pv_one<3>(o[3], vb, pa0, pa1, pa2, pa3);
}

template <bool MASK>
__device__ __forceinline__ void attn_body(const bf16_t* __restrict__ Qb, const long ldq, const bf16_t* __restrict__ Kh, const bf16_t* __restrict__ Vh, const long ldk,
                                          const int kfirst, const int Mr, const int NT, bf16_t* __restrict__ Ob, const long ldo, float* __restrict__ lse, const long ldlse, char* lds) {
  int tid = threadIdx.x; asm volatile("" : "+v"(tid));
  const int wid = tid >> 6, lane = tid & 63, r32 = lane & 31, hi = lane >> 5;
  char* V_lds = lds; char* K_lds = lds + 2 * SHM_V;
  float* ws = (float*)(lds + 2 * SHM_V + 2 * SHM_K) + wid * 64; float* li_l = ws; float* al_l = ws + 32;
  float m_reg = -1e30f, l_reg = 0; f32x16 o[4] = {}; bf16x8 qr[8];
  const bf16_t* Qw = Qb + (long)(wid * QBLK + r32) * ldq + hi * 8;
#pragma unroll
  for (int d0 = 0; d0 < 8; ++d0) qr[d0] = *reinterpret_cast<const bf16x8*>(Qw + d0 * 16);
  const int sr = tid >> 4, sc = (tid & 15) * 8, vst0 = v_st(sr, sc), vst1 = v_st(32 + sr, sc);
  const int vb0 = (int)(uintptr_t)V_lds + v_rd_base(lane);
  const int qi = wid * QBLK + r32;
  struct { bf16x8 vs0, vs1, ks0, ks1; } sr_[2];
#define KROW(k0, rr) (MASK ? (long)min(max(kfirst + (k0) + (rr), 0), Mr - 1) : (long)((k0) + (rr)))
#define SLOAD(i, k0) do { const long _r0 = KROW(k0, sr) * ldk + sc, _r1 = KROW(k0, 32 + sr) * ldk + sc; \
    sr_[i].vs0 = *reinterpret_cast<const bf16x8*>(Vh + _r0); sr_[i].vs1 = *reinterpret_cast<const bf16x8*>(Vh + _r1); \
    sr_[i].ks0 = *reinterpret_cast<const bf16x8*>(Kh + _r0); sr_[i].ks1 = *reinterpret_cast<const bf16x8*>(Kh + _r1); } while (0)
#define SWRITE(b, i) do { *(bf16x8*)(V_lds + (b) * SHM_V + vst0) = sr_[i].vs0;          \
    *(bf16x8*)(V_lds + (b) * SHM_V + vst1) = sr_[i].vs1; int kc = sc * 2;               \
    *(bf16x8*)(K_lds + (b) * SHM_K + KSWZ(sr, kc)) = sr_[i].ks0;                       \
    *(bf16x8*)(K_lds + (b) * SHM_K + KSWZ(32 + sr, kc)) = sr_[i].ks1; } while (0)
#define SWAIT() asm volatile("s_waitcnt vmcnt(4)" ::: "memory")
#define RESC(a) do { if (__any((a) < 1.f)) { if (hi == 0) al_l[r32] = (a); asm volatile("s_waitcnt lgkmcnt(0)" ::: "memory"); \
    _Pragma("unroll") for (int d = 0; d < 4; ++d) _Pragma("unroll") for (int r = 0; r < 16; ++r) o[d][r] *= al_l[crow(r, hi)]; } } while (0)
#define MASKT(P0, P1, j) do { if (MASK) mask_tile(P0, P1, (j) * KVBLK - qi, kfirst + qi, Mr, hi); } while (0)
  f32x16 pA0, pA1, pB0, pB1; float mnA, mnB, alA, alB; bf16x8 pa0, pa1, pa2, pa3;
  constexpr int SE = 0, SO = 1;
  SLOAD(SE, 0); asm volatile("s_waitcnt vmcnt(0)" ::: "memory"); SWRITE(0, SE); __syncthreads();
  qkt(pA0, pA1, K_lds, qr, r32, hi); MASKT(pA0, pA1, 0); partialSM(pA0, pA1, m_reg, mnA, alA);
  SLOAD(SO, KVBLK); if (2 < NT) SLOAD(SE, 2 * KVBLK);
  SWAIT(); SWRITE(1, SO); __syncthreads();
  for (int j = 1; j + 1 < NT; j += 2) {
    SBAR(); qkt(pB0, pB1, K_lds + SHM_K, qr, r32, hi);
    finishSM(pA0, pA1, alA, l_reg, pa0, pa1, pa2, pa3); SBAR();
    SLOAD(SO, (j + 2) * KVBLK); SBAR();
    pv_d0(o, vb0, pa0, pa1, pa2, pa3); MASKT(pB0, pB1, j); partialSM(pB0, pB1, m_reg, mnB, alB);
    __syncthreads(); SWAIT(); SWRITE(0, SE);
    RESC(alB); __syncthreads();
    SBAR(); qkt(pA0, pA1, K_lds, qr, r32, hi);
    finishSM(pB0, pB1, alB, l_reg, pa0, pa1, pa2, pa3); SBAR();
    if (j + 3 < NT) SLOAD(SE, (j + 3) * KVBLK); SBAR();
    pv_d0(o, vb0 + (int)SHM_V, pa0, pa1, pa2, pa3); MASKT(pA0, pA1, j + 1); partialSM(pA0, pA1, m_reg, mnA, alA);
    __syncthreads(); SWAIT(); SWRITE(1, SO);
    RESC(alA); __syncthreads();
  }
  SBAR(); qkt(pB0, pB1, K_lds + SHM_K, qr, r32, hi);
  finishSM(pA0, pA1, alA, l_reg, pa0, pa1, pa2, pa3); SBAR();
  pv_d0(o, vb0, pa0, pa1, pa2, pa3); MASKT(pB0, pB1, NT - 1); partialSM(pB0, pB1, m_reg, mnB, alB);
  __syncthreads(); RESC(alB);
  finishSM(pB0, pB1, alB, l_reg, pa0, pa1, pa2, pa3); SBAR();
  pv_d0(o, vb0 + (int)SHM_V, pa0, pa1, pa2, pa3);
  if (hi == 0) li_l[r32] = l_reg; asm volatile("s_waitcnt lgkmcnt(0)" ::: "memory");
  float rli[16];
#pragma unroll
  for (int r = 0; r < 16; ++r) rli[r] = __builtin_amdgcn_rcpf(li_l[crow(r, hi)]);
  bf16_t* Ow = Ob + (long)(wid * QBLK) * ldo;
#pragma unroll
  for (int r = 0; r < 16; ++r) { const int orow = crow(r, hi);
#pragma unroll
    for (int d0 = 0; d0 < 4; ++d0) Ow[(long)orow * ldo + d0 * 32 + r32] = (bf16_t)f2bf(o[d0][r] * rli[r]); }
  if (lse != nullptr && hi == 0) lse[(long)(wid * QBLK + r32) * ldlse] = m_reg * SCALE + __logf(l_reg);
#undef KROW
#undef SLOAD
#undef SWRITE
#undef SWAIT
#undef RESC
#undef MASKT
}

struct VFB { s16x4 l0, h0, l1, h1, l2, h2, l3, h3; };
template <int D0> __device__ __forceinline__ void vfb_load(VFB& f, int vb) {
  f.l0 = tr_read<v_rd_off(D0, 0, 0)>(vb); f.h0 = tr_read<v_rd_off(D0, 0, 1)>(vb); f.l1 = tr_read<v_rd_off(D0, 1, 0)>(vb); f.h1 = tr_read<v_rd_off(D0, 1, 1)>(vb);
  f.l2 = tr_read<v_rd_off(D0, 2, 0)>(vb); f.h2 = tr_read<v_rd_off(D0, 2, 1)>(vb); f.l3 = tr_read<v_rd_off(D0, 3, 0)>(vb); f.h3 = tr_read<v_rd_off(D0, 3, 1)>(vb);
}
#define VFB_WAIT(N, f) asm volatile("s_waitcnt lgkmcnt(" #N ")" : "+v"(f.l0), "+v"(f.h0), "+v"(f.l1), "+v"(f.h1), "+v"(f.l2), "+v"(f.h2), "+v"(f.l3), "+v"(f.h3) :: "memory")
__device__ __forceinline__ void vfb_mma(f32x16& od, const VFB& f, bf16x8 pa0, bf16x8 pa1, bf16x8 pa2, bf16x8 pa3) {
#define PK(L, H) (bf16x8){L[0], L[1], L[2], L[3], H[0], H[1], H[2], H[3]}
  od = __builtin_amdgcn_mfma_f32_32x32x16_bf16(pa0, PK(f.l0, f.h0), od, 0, 0, 0);
  od = __builtin_amdgcn_mfma_f32_32x32x16_bf16(pa1, PK(f.l1, f.h1), od, 0, 0, 0);
  od = __builtin_amdgcn_mfma_f32_32x32x16_bf16(pa2, PK(f.l2, f.h2), od, 0, 0, 0);
  od = __builtin_amdgcn_mfma_f32_32x32x16_bf16(pa3, PK(f.l3, f.h3), od, 0, 0, 0);
#undef PK
}
template <int OFF> __device__ __forceinline__ bf16x8 dsb_rd128(int a) { bf16x8 r; asm volatile("ds_read_b128 %0, %1 offset:%2" : "=&v"(r) : "v"(a), "i"(OFF) : "memory"); return r; }
#define KB_RD(A, B, d0) do { const int _a = (kx ^ ((d0) * 32)) + krow; A = dsb_rd128<0>(_a); B = dsb_rd128<8192>(_a); } while (0)
#define KB_WAIT(N, A, B) asm volatile("s_waitcnt lgkmcnt(" #N ")" : "+v"(A), "+v"(B) :: "memory")
#define KB_MMA(A, B, d0) do { p0 = __builtin_amdgcn_mfma_f32_32x32x16_bf16(A, qr[d0], p0, 0, 0, 0); p1 = __builtin_amdgcn_mfma_f32_32x32x16_bf16(B, qr[d0], p1, 0, 0, 0); } while (0)
__device__ __forceinline__ void attn_band_body(const bf16_t* __restrict__ Qb, const long ldq, const bf16_t* __restrict__ Kh, const bf16_t* __restrict__ Vh, const long ldk,
                                               const int kfirst, const int Mr, bf16_t* __restrict__ Ob, const long ldo, float* __restrict__ lse, const long ldlse, char* lds) {
  int tid = threadIdx.x; asm volatile("" : "+v"(tid));
  const int wid = __builtin_amdgcn_readfirstlane(tid >> 6), lane = tid & 63, r32 = lane & 31, hi = lane >> 5;
  char* V_lds = lds; char* K_lds = lds + 2 * SHM_V;
  float* ws = (float*)(lds + 2 * SHM_V + 2 * SHM_K) + wid * 64; float* li_l = ws; float* al_l = ws + 32;
  float m_reg = -1e30f, l_reg = 0; f32x16 o[4] = {}; bf16x8 qr[8];
  const bf16_t* Qw = Qb + (long)(wid * QBLK + r32) * ldq + hi * 8;
#pragma unroll
  for (int d0 = 0; d0 < 8; ++d0) qr[d0] = *reinterpret_cast<const bf16x8*>(Qw + d0 * 16);
  const int sr = tid >> 4, sc = (tid & 15) * 8, vst0 = v_st(sr, sc), vst1 = v_st(32 + sr, sc);
  const int vb0 = (int)(uintptr_t)V_lds + v_rd_base(lane);
  const int qi = wid * QBLK + r32;
  const int jlo = wid >> 1, jhi = (32 * wid + 159) >> 6;
  const int kx = (hi * 16) ^ ((r32 & 15) << 4), krow0 = (int)(uintptr_t)K_lds + r32 * 256;
  const bool edge = (kfirst < 0) | (kfirst + 384 > Mr);
  bf16x8 vs0, vs1, ks0, ks1;
#define KROW(k0, rr) ((long)min(max(kfirst + (k0) + (rr), 0), Mr - 1))
#define SLOAD(k0) do { const long _r0 = KROW(k0, sr) * ldk + sc, _r1 = KROW(k0, 32 + sr) * ldk + sc; \
    vs0 = *reinterpret_cast<const bf16x8*>(Vh + _r0); vs1 = *reinterpret_cast<const bf16x8*>(Vh + _r1); \
    ks0 = *reinterpret_cast<const bf16x8*>(Kh + _r0); ks1 = *reinterpret_cast<const bf16x8*>(Kh + _r1); } while (0)
#define SWRITE(b) do { *(bf16x8*)(V_lds + (b) * SHM_V + vst0) = vs0; *(bf16x8*)(V_lds + (b) * SHM_V + vst1) = vs1; const int kc = sc * 2; \
    *(bf16x8*)(K_lds + (b) * SHM_K + KSWZ(sr, kc)) = ks0; *(bf16x8*)(K_lds + (b) * SHM_K + KSWZ(32 + sr, kc)) = ks1; } while (0)
  SLOAD(0); SWRITE(0); __syncthreads();
#pragma unroll
  for (int d0 = 0; d0 < 8; ++d0) asm volatile("" : "+v"(qr[d0]));
#pragma unroll 1
  for (int j = 0; j < 6; ++j) {
    const int b = j & 1;
    if (j + 1 < 6) SLOAD((j + 1) * KVBLK);
    if (j >= jlo && j <= jhi) {
      f32x16 p0 = {}, p1 = {}; float mn, alpha; bf16x8 pa0, pa1, pa2, pa3;
      { const int krow = krow0 + b * (int)SHM_K; bf16x8 ka0, kb0, ka1, kb1, ka2, kb2;
        KB_RD(ka0, kb0, 0); KB_RD(ka1, kb1, 1);
        KB_RD(ka2, kb2, 2); KB_WAIT(4, ka0, kb0); KB_MMA(ka0, kb0, 0);
        KB_RD(ka0, kb0, 3); KB_WAIT(4, ka1, kb1); KB_MMA(ka1, kb1, 1);
        KB_RD(ka1, kb1, 4); KB_WAIT(4, ka2, kb2); KB_MMA(ka2, kb2, 2);
        KB_RD(ka2, kb2, 5); KB_WAIT(4, ka0, kb0); KB_MMA(ka0, kb0, 3);
        KB_RD(ka0, kb0, 6); KB_WAIT(4, ka1, kb1); KB_MMA(ka1, kb1, 4);
        KB_RD(ka1, kb1, 7); KB_WAIT(4, ka2, kb2); KB_MMA(ka2, kb2, 5);
        KB_WAIT(2, ka0, kb0); KB_MMA(ka0, kb0, 6);
        KB_WAIT(0, ka1, kb1); KB_MMA(ka1, kb1, 7); }
      if (edge | (j != jlo + 1)) mask_tile(p0, p1, j * KVBLK - qi, kfirst + qi, Mr, hi);
      partialSM(p0, p1, m_reg, mn, alpha);
      if (__any(alpha < 1.f)) { if (hi == 0) al_l[r32] = alpha; asm volatile("s_waitcnt lgkmcnt(0)" ::: "memory");
#pragma unroll
        for (int d = 0; d < 4; ++d)
#pragma unroll
          for (int r = 0; r < 16; ++r) o[d][r] *= al_l[crow(r, hi)]; }
      finishSM(p0, p1, alpha, l_reg, pa0, pa1, pa2, pa3); SBAR();
      { const int vb = vb0 + b * (int)SHM_V; VFB fa, fb;
        vfb_load<0>(fa, vb);
        vfb_load<1>(fb, vb); VFB_WAIT(8, fa); vfb_mma(o[0], fa, pa0, pa1, pa2, pa3);
        vfb_load<2>(fa, vb); VFB_WAIT(8, fb); vfb_mma(o[1], fb, pa0, pa1, pa2, pa3);
        vfb_load<3>(fb, vb); VFB_WAIT(8, fa); vfb_mma(o[2], fa, pa0, pa1, pa2, pa3);
        VFB_WAIT(0, fb); vfb_mma(o[3], fb, pa0, pa1, pa2, pa3); }
    }
    if (j + 1 < 6) SWRITE(b ^ 1);
    __syncthreads();
  }
  if (hi == 0) li_l[r32] = l_reg; asm volatile("s_waitcnt lgkmcnt(0)" ::: "memory");
  float rli[16];
#pragma unroll
  for (int r = 0; r < 16; ++r) rli[r] = __builtin_amdgcn_rcpf(li_l[crow(r, hi)]);
  bf16_t* Ow = Ob + (long)(wid * QBLK) * ldo;
#pragma unroll
  for (int r = 0; r < 16; ++r) { const int orow = crow(r, hi);
#pragma unroll
    for (int d0 = 0; d0 < 4; ++d0) Ow[(long)orow * ldo + d0 * 32 + r32] = (bf16_t)f2bf(o[d0][r] * rli[r]); }
  if (hi == 0) lse[(long)(wid * QBLK + r32) * ldlse] = m_reg * SCALE + __logf(l_reg);
#undef KROW
#undef SLOAD
#undef SWRITE
}

struct BandUnit { const bf16_t* Q; const bf16_t* K; const bf16_t* V; bf16_t* O; float* L; int ld, ldo, ldl, kfirst, Mr, lsh; };
template <class UF>
__device__ __forceinline__ void attn_band_stream(const int U, UF unit_of, char* lds) {
  int tid = threadIdx.x; asm volatile("" : "+v"(tid));
  const int wid = __builtin_amdgcn_readfirstlane(tid >> 6), lane = tid & 63, r32 = lane & 31, hi = lane >> 5, w32 = lane & 31;
  constexpr int TILE = 32768, OFF_B = 3 * TILE, OFF_WS = 4 * TILE;
  float* ws = (float*)(lds + OFF_WS) + wid * 64; float* li_l = ws; float* al_l = ws + 32;
  const int jlo = wid >> 1, qi = wid * QBLK + r32;
  const int kx = (hi * 16) ^ ((r32 & 15) << 4);
  const int krow_l = (int)(uintptr_t)lds + 16384 + r32 * 256, vb_l = (int)(uintptr_t)lds + v_rd_base(lane);
  const int krow0 = 4 * wid + (lane >> 4), kch = ((lane & 15) ^ (krow0 & 15)) * 8;
  const int vkk = (wid >> 1) * 8 + (w32 >> 2), vkey0 = (vkk & ~0xC) | ((vkk & 4) << 1) | ((vkk & 8) >> 1), vcol = (2 * (wid & 1) + (lane >> 5)) * 32 + (w32 & 3) * 8;
#define BS_DMA(bu, j, boff) do { const int _kb = (bu).kfirst + 64 * (j); const unsigned _ld = (unsigned)(bu).ld; \
    _Pragma("unroll") for (int _i = 0; _i < 2; ++_i) { const unsigned _ro = (unsigned)min(max(_kb + krow0 + 32 * _i, 0), (bu).Mr - 1) * _ld + kch; \
      __builtin_amdgcn_global_load_lds((const unsigned*)((bu).K + _ro), (LAS unsigned*)(lds + (boff) + 16384 + (wid + 8 * _i) * 1024), 16, 0, 0); } \
    _Pragma("unroll") for (int _i = 0; _i < 2; ++_i) { const unsigned _ro = (unsigned)min(max(_kb + vkey0 + 32 * _i, 0), (bu).Mr - 1) * _ld + vcol; \
      __builtin_amdgcn_global_load_lds((const unsigned*)((bu).V + _ro), (LAS unsigned*)(lds + (boff) + (wid + 8 * _i) * 1024), 16, 0, 0); } } while (0)
#define BS_QLOAD(bu) do { const bf16_t* _q = (bu).Q + (long)qi * (bu).ld + hi * 8; \
    asm volatile("global_load_dwordx4 %0, %8, off\n\tglobal_load_dwordx4 %1, %8, off offset:32\n\tglobal_load_dwordx4 %2, %8, off offset:64\n\tglobal_load_dwordx4 %3, %8, off offset:96\n\t" \
                 "global_load_dwordx4 %4, %8, off offset:128\n\tglobal_load_dwordx4 %5, %8, off offset:160\n\tglobal_load_dwordx4 %6, %8, off offset:192\n\tglobal_load_dwordx4 %7, %8, off offset:224" \
                 : "=&v"(qr[0]), "=&v"(qr[1]), "=&v"(qr[2]), "=&v"(qr[3]), "=&v"(qr[4]), "=&v"(qr[5]), "=&v"(qr[6]), "=&v"(qr[7]) : "v"(_q) : "memory"); } while (0)
#define BS_POS_DMA(gq) do { const int _un = (gq) / 5, _jn = (gq) - 5 * _un; \
    if ((gq) <= 5 * U) { \
      if (_un < U) { const BandUnit _bn = unit_of(_un); BS_DMA(_bn, _jn, ((gq) % 3) * TILE); ndma += 4; } \
      if (_jn == 0 && _un >= 1) { const BandUnit _bp = unit_of(_un - 1); BS_DMA(_bp, 5, OFF_B); ndma += 4; } } } while (0)
  float m_reg = -1e30f, l_reg = 0; f32x16 o[4] = {}; bf16x8 qr[8];
  { int ndma = 0; if (U > 0) { const BandUnit b0 = unit_of(0); BS_QLOAD(b0); } else {
#pragma unroll
      for (int d0 = 0; d0 < 8; ++d0) qr[d0] = bf16x8{}; }
    BS_POS_DMA(0); BS_POS_DMA(1); }
  asm volatile("s_waitcnt vmcnt(0)" ::: "memory");
#pragma unroll
  for (int d0 = 0; d0 < 8; ++d0) asm volatile("" : "+v"(qr[d0]));
  __builtin_amdgcn_s_barrier(); asm volatile("" ::: "memory");
#pragma unroll 1
  for (int g = 0; g <= 5 * U + 2; ++g) {
    const int rel = g - jlo, uw = rel >= 0 ? rel / 5 : -1, jr = rel - 5 * uw;
    int ndma = 0;
    if (uw >= 0 && jr >= 3 && uw < U) {
      const BandUnit bu = unit_of(uw);
      if (hi == 0) li_l[r32] = l_reg; asm volatile("s_waitcnt lgkmcnt(0)" ::: "memory");
      bf16_t* Ow = bu.O + (long)(wid * QBLK) * bu.ldo;
      const int rb = (jr - 3) * 8;
#pragma unroll
      for (int rr = 0; rr < 8; ++rr) { const int orow = ((rb + rr) & 3) + 8 * ((rb + rr) >> 2) + 4 * hi; const float rl = __builtin_amdgcn_rcpf(li_l[orow]);
#pragma unroll
        for (int d0 = 0; d0 < 4; ++d0) { const float v = jr == 3 ? o[d0][rr] : o[d0][8 + rr]; Ow[(long)orow * bu.ldo + d0 * 32 + r32] = (bf16_t)f2bf(v * rl); } }
      if (jr == 3 && hi == 0) bu.L[(long)qi * bu.ldl] = m_reg * SCALE + __logf(l_reg);
      asm volatile("s_waitcnt vmcnt(0)" ::: "memory");
      if (jr == 3 && uw + 1 < U) { const BandUnit bn = unit_of(uw + 1); BS_QLOAD(bn); ndma += 8; }
      BS_POS_DMA(g + 2);
    } else {
    BS_POS_DMA(g + 2);
    if (uw >= 0 && jr <= 2 && uw < U) {
      const BandUnit bu = unit_of(uw);
      const int j = jlo + jr, boff = (j == 5) ? OFF_B : (g % 3) * TILE;
      if (jr == 0) { m_reg = -1e30f; l_reg = 0.f;
#pragma unroll
        for (int d = 0; d < 4; ++d) o[d] = f32x16{}; }
      const bool edge = (bu.kfirst < 0) | (bu.kfirst + 384 > bu.Mr);
      f32x16 p0 = {}, p1 = {}; float mn, alpha; bf16x8 pa0, pa1, pa2, pa3;
      { const int krow = krow_l + boff; bf16x8 ka0, kb0, ka1, kb1, ka2, kb2;
        KB_RD(ka0, kb0, 0); KB_RD(ka1, kb1, 1);
        KB_RD(ka2, kb2, 2); KB_WAIT(4, ka0, kb0); KB_MMA(ka0, kb0, 0);
        KB_RD(ka0, kb0, 3); KB_WAIT(4, ka1, kb1); KB_MMA(ka1, kb1, 1);
        KB_RD(ka1, kb1, 4); KB_WAIT(4, ka2, kb2); KB_MMA(ka2, kb2, 2);
        KB_RD(ka2, kb2, 5); KB_WAIT(4, ka0, kb0); KB_MMA(ka0, kb0, 3);
        KB_RD(ka0, kb0, 6); KB_WAIT(4, ka1, kb1); KB_MMA(ka1, kb1, 4);
        KB_RD(ka1, kb1, 7); KB_WAIT(4, ka2, kb2); KB_MMA(ka2, kb2, 5);
        KB_WAIT(2, ka0, kb0); KB_MMA(ka0, kb0, 6);
        KB_WAIT(0, ka1, kb1); KB_MMA(ka1, kb1, 7); }
      if (edge | (jr != 1)) mask_tile(p0, p1, j * KVBLK - qi, bu.kfirst + qi, bu.Mr, hi);
      partialSM(p0, p1, m_reg, mn, alpha);
      if (jr != 0 && __any(alpha < 1.f)) { if (hi == 0) al_l[r32] = alpha; asm volatile("s_waitcnt lgkmcnt(0)" ::: "memory");
#pragma unroll
        for (int d = 0; d < 4; ++d)
#pragma unroll
          for (int r = 0; r < 16; ++r) o[d][r] *= al_l[crow(r, hi)]; }
      if (jr == 0) alpha = 0.f;
      finishSM(p0, p1, alpha, l_reg, pa0, pa1, pa2, pa3); SBAR();
      { const int vb = vb_l + boff; VFB fa, fb;
        vfb_load<0>(fa, vb);
        vfb_load<1>(fb, vb); VFB_WAIT(8, fa); vfb_mma(o[0], fa, pa0, pa1, pa2, pa3);
        vfb_load<2>(fa, vb); VFB_WAIT(8, fb); vfb_mma(o[1], fb, pa0, pa1, pa2, pa3);
        vfb_load<3>(fb, vb); VFB_WAIT(8, fa); vfb_mma(o[2], fa, pa0, pa1, pa2, pa3);
        VFB_WAIT(0, fb); vfb_mma(o[3], fb, pa0, pa1, pa2, pa3); }
    } }
    asm volatile("s_waitcnt lgkmcnt(0)" ::: "memory");
#define BS_VMW(n) case n: asm volatile("s_waitcnt vmcnt(" #n ")" ::: "memory"); break;
    switch (ndma) { BS_VMW(4) BS_VMW(8) BS_VMW(12) BS_VMW(16) default: asm volatile("s_waitcnt vmcnt(0)" ::: "memory"); break; }
#undef BS_VMW
    __builtin_amdgcn_s_barrier(); asm volatile("" ::: "memory");
  }
#undef BS_DMA
#undef BS_QLOAD
#undef BS_POS_DMA
}

__device__ __forceinline__ void partialSM1(f32x16& p0, float& m_reg, float& mn, float& alpha) {
  constexpr float C = SCALE * 1.4426950408889634f;
  float pmax = p0[0];
#pragma unroll
  for (int r = 1; r < 16; ++r) pmax = fmaxf(pmax, p0[r]);
  { auto rr = __builtin_amdgcn_permlane32_swap(__float_as_uint(pmax), __float_as_uint(pmax), false, false);
    pmax = fmaxf(__uint_as_float(rr[0]), __uint_as_float(rr[1])); }
  if (__builtin_expect(__all(pmax - m_reg <= THR / SCALE), 1)) { mn = m_reg; alpha = 1.f; }
  else { mn = fmaxf(m_reg, pmax); alpha = __builtin_amdgcn_exp2f((m_reg - mn) * C); m_reg = mn; }
  const float mnC = -mn * C;
#pragma unroll
  for (int r = 0; r < 16; ++r) p0[r] = __builtin_amdgcn_exp2f(fmaf(p0[r], C, mnC));
}
__device__ __forceinline__ void finishSM1(f32x16& p0, float alpha, float& l_reg, bf16x8& pa0, bf16x8& pa1) {
  float ps = 0;
#pragma unroll
  for (int r = 0; r < 16; ++r) ps += p0[r];
  { auto rr = __builtin_amdgcn_permlane32_swap(__float_as_uint(ps), __float_as_uint(ps), false, false);
    ps = __uint_as_float(rr[0]) + __uint_as_float(rr[1]); }
  l_reg = l_reg * alpha + ps;
#define PK4(P, BASE, OUT) do { unsigned a0 = cvtpk(P[BASE + 0], P[BASE + 1]), a1 = cvtpk(P[BASE + 2], P[BASE + 3]);   \
    unsigned b0 = cvtpk(P[BASE + 4], P[BASE + 5]), b1 = cvtpk(P[BASE + 6], P[BASE + 7]);                              \
    auto r0 = __builtin_amdgcn_permlane32_swap(a0, b0, false, false); auto r1 = __builtin_amdgcn_permlane32_swap(a1, b1, false, false); \
    u32x4 w = {r0[0], r1[0], r0[1], r1[1]}; OUT = *reinterpret_cast<bf16x8*>(&w); } while (0)
  PK4(p0, 0, pa0); PK4(p0, 8, pa1);
#undef PK4
}
struct VF2 { s16x4 l0, h0, l1, h1; };
template <int D0> __device__ __forceinline__ void vf2_load(VF2& f, int vb) {
  f.l0 = tr_read<v_rd_off(D0, 0, 0)>(vb); f.h0 = tr_read<v_rd_off(D0, 0, 1)>(vb); f.l1 = tr_read<v_rd_off(D0, 1, 0)>(vb); f.h1 = tr_read<v_rd_off(D0, 1, 1)>(vb);
}
#define VF2_WAIT(N, f) asm volatile("s_waitcnt lgkmcnt(" #N ")" : "+v"(f.l0), "+v"(f.h0), "+v"(f.l1), "+v"(f.h1) :: "memory")
__device__ __forceinline__ void vf2_mma(f32x16& od, const VF2& f, bf16x8 pa0, bf16x8 pa1) {
#define PK(L, H) (bf16x8){L[0], L[1], L[2], L[3], H[0], H[1], H[2], H[3]}
  od = __builtin_amdgcn_mfma_f32_32x32x16_bf16(pa0, PK(f.l0, f.h0), od, 0, 0, 0);
  od = __builtin_amdgcn_mfma_f32_32x32x16_bf16(pa1, PK(f.l1, f.h1), od, 0, 0, 0);
#undef PK
}
__device__ __forceinline__ void attn_band_wave(const bf16_t* __restrict__ Qb, const long ldq, const bf16_t* __restrict__ Kh, const bf16_t* __restrict__ Vh, const long ldk,
                                               const int kfirst, const int Mr, bf16_t* __restrict__ Ob, const long ldo, float* __restrict__ lse, const long ldlse, char* lds) {
  int tid = threadIdx.x; asm volatile("" : "+v"(tid));
  const int wid = __builtin_amdgcn_readfirstlane(tid >> 6), lane = tid & 63, r32 = lane & 31, hi = lane >> 5, w32 = lane & 31;
  char* Vw = lds + wid * 16384;
  float* ws = (float*)(lds + 131072) + wid * 64; float* li_l = ws; float* al_l = ws + 32;
  const int kf = kfirst + 32 * wid;
  const bool edge = (kf < 0) | (kf + 160 > Mr);
  float m_reg = -1e30f, l_reg = 0; f32x16 o[4] = {}; bf16x8 qr[8], kr[8];
  const bf16_t* Qw = Qb + (long)(wid * QBLK + r32) * ldq + hi * 8;
#pragma unroll
  for (int d0 = 0; d0 < 8; ++d0) qr[d0] = *reinterpret_cast<const bf16x8*>(Qw + d0 * 16);
  const int vb0 = (int)(uintptr_t)Vw + v_rd_base(lane);
  const int vkey = ((w32 >> 2) & 3) + 8 * ((w32 >> 4) & 1), vcol = (lane >> 5) * 32 + (w32 & 3) * 8;
  const unsigned ldku = (unsigned)ldk;
#define BW_KLOAD(s) do { const unsigned _ro = (unsigned)min(max(kf + 32 * (s) + r32, 0), Mr - 1) * ldku + hi * 8; const bf16_t* _kp = Kh + _ro; \
    asm volatile("global_load_dwordx4 %0, %8, off\n\tglobal_load_dwordx4 %1, %8, off offset:32\n\tglobal_load_dwordx4 %2, %8, off offset:64\n\tglobal_load_dwordx4 %3, %8, off offset:96\n\t" \
                 "global_load_dwordx4 %4, %8, off offset:128\n\tglobal_load_dwordx4 %5, %8, off offset:160\n\tglobal_load_dwordx4 %6, %8, off offset:192\n\tglobal_load_dwordx4 %7, %8, off offset:224" \
                 : "=&v"(kr[0]), "=&v"(kr[1]), "=&v"(kr[2]), "=&v"(kr[3]), "=&v"(kr[4]), "=&v"(kr[5]), "=&v"(kr[6]), "=&v"(kr[7]) : "v"(_kp) : "memory"); } while (0)
#define BW_KWAIT(N) asm volatile("s_waitcnt vmcnt(" #N ")" : "+v"(kr[0]), "+v"(kr[1]), "+v"(kr[2]), "+v"(kr[3]), "+v"(kr[4]), "+v"(kr[5]), "+v"(kr[6]), "+v"(kr[7]) :: "memory")
#define BW_VDMA(s, b) do { _Pragma("unroll") for (int kg = 0; kg < 4; ++kg) { \
      const unsigned _ro = (unsigned)min(max(kf + 32 * (s) + vkey + 4 * (kg & 1) + 16 * (kg >> 1), 0), Mr - 1) * ldku + vcol; \
      __builtin_amdgcn_global_load_lds((const unsigned*)(Vh + _ro), (LAS unsigned*)(Vw + (b) * 8192 + (2 * kg) * 1024), 16, 0, 0); \
      __builtin_amdgcn_global_load_lds((const unsigned*)(Vh + _ro + 64), (LAS unsigned*)(Vw + (b) * 8192 + (2 * kg + 1) * 1024), 16, 0, 0); } } while (0)
  BW_VDMA(0, 0); BW_KLOAD(0);
#pragma unroll
  for (int d0 = 0; d0 < 8; ++d0) asm volatile("" : "+v"(qr[d0]));
#define BW_STEP(s, LAST) do { const int b = (s) & 1; \
    if (!(LAST)) BW_VDMA((s) + 1, b ^ 1); \
    f32x16 p0 = {}; float mn, alpha; bf16x8 pa0, pa1; \
    if (!(LAST)) BW_KWAIT(8); else BW_KWAIT(0); \
    _Pragma("unroll") for (int d0 = 0; d0 < 8; ++d0) p0 = __builtin_amdgcn_mfma_f32_32x32x16_bf16(kr[d0], qr[d0], p0, 0, 0, 0); \
    SBAR(); \
    if (!(LAST)) BW_KLOAD((s) + 1); \
    if (edge | ((s) == 0) | ((s) == 4)) { \
      _Pragma("unroll") for (int r = 0; r < 16; ++r) { const int key = 32 * (s) + crow(r, hi); \
        const bool ok = ((unsigned)(key - r32) <= 128u) && ((unsigned)(kf + key) < (unsigned)Mr); \
        p0[r] = ok ? p0[r] : -3.0e4f; } } \
    partialSM1(p0, m_reg, mn, alpha); \
    if (__any(alpha < 1.f)) { if (hi == 0) al_l[r32] = alpha; asm volatile("s_waitcnt lgkmcnt(0)" ::: "memory"); \
      _Pragma("unroll") for (int d = 0; d < 4; ++d) \
        _Pragma("unroll") for (int r = 0; r < 16; ++r) o[d][r] *= al_l[crow(r, hi)]; } \
    finishSM1(p0, alpha, l_reg, pa0, pa1); \
    if (!(LAST)) asm volatile("s_waitcnt vmcnt(16)" ::: "memory"); else asm volatile("s_waitcnt vmcnt(0)" ::: "memory");     \
    SBAR(); \
    const int vb = vb0 + b * 8192; VF2 fa, fb; \
    vf2_load<0>(fa, vb); vf2_load<1>(fb, vb); VF2_WAIT(4, fa); vf2_mma(o[0], fa, pa0, pa1); \
    vf2_load<2>(fa, vb); VF2_WAIT(4, fb); vf2_mma(o[1], fb, pa0, pa1); \
    vf2_load<3>(fb, vb); VF2_WAIT(4, fa); vf2_mma(o[2], fa, pa0, pa1); \
    VF2_WAIT(0, fb); vf2_mma(o[3], fb, pa0, pa1); } while (0)
#pragma unroll 1
  for (int s = 0; s < 4; ++s) BW_STEP(s, false);
  BW_STEP(4, true);
#undef BW_STEP
  if (hi == 0) li_l[r32] = l_reg; asm volatile("s_waitcnt lgkmcnt(0)" ::: "memory");
  float rli[16];
#pragma unroll
  for (int r = 0; r < 16; ++r) rli[r] = __builtin_amdgcn_rcpf(li_l[crow(r, hi)]);
  bf16_t* Ow = Ob + (long)(wid * QBLK) * ldo;
#pragma unroll
  for (int r = 0; r < 16; ++r) { const int orow = crow(r, hi);
#pragma unroll
    for (int d0 = 0; d0 < 4; ++d0) Ow[(long)orow * ldo + d0 * 32 + r32] = (bf16_t)f2bf(o[d0][r] * rli[r]); }
  if (hi == 0) lse[(long)(wid * QBLK + r32) * ldlse] = m_reg * SCALE + __logf(l_reg);
#undef BW_KLOAD
#undef BW_KWAIT
#undef BW_VDMA
}

constexpr int W_SHM_V = KVBLK * 256 * 2, W_SHM_K = KVBLK * D * 2, W_OFF_K = 3 * W_SHM_V, W_OFF_WS = W_OFF_K + 2 * W_SHM_K, W_SHM_TOTAL = W_OFF_WS + NW * 64 * 4;
constexpr int w_rd_off(int d0, int ks, int half) { return d0 * 512 + ks * 8192 + half * 4096; }
template <int D0> __device__ __forceinline__ void pvw_one(f32x16& od, int vb, bf16x8 pa0, bf16x8 pa1, bf16x8 pa2, bf16x8 pa3) {
  const s16x4 l0 = tr_read<w_rd_off(D0, 0, 0)>(vb), h0 = tr_read<w_rd_off(D0, 0, 1)>(vb), l1 = tr_read<w_rd_off(D0, 1, 0)>(vb), h1 = tr_read<w_rd_off(D0, 1, 1)>(vb);
  const s16x4 l2 = tr_read<w_rd_off(D0, 2, 0)>(vb), h2 = tr_read<w_rd_off(D0, 2, 1)>(vb), l3 = tr_read<w_rd_off(D0, 3, 0)>(vb), h3 = tr_read<w_rd_off(D0, 3, 1)>(vb);
  asm volatile("s_waitcnt lgkmcnt(0)" ::: "memory"); SBAR();
#define PK(L, H) (bf16x8){L[0], L[1], L[2], L[3], H[0], H[1], H[2], H[3]}
  od = __builtin_amdgcn_mfma_f32_32x32x16_bf16(pa0, PK(l0, h0), od, 0, 0, 0);
  od = __builtin_amdgcn_mfma_f32_32x32x16_bf16(pa1, PK(l1, h1), od, 0, 0, 0);
  od = __builtin_amdgcn_mfma_f32_32x32x16_bf16(pa2, PK(l2, h2), od, 0, 0, 0);
  od = __builtin_amdgcn_mfma_f32_32x32x16_bf16(pa3, PK(l3, h3), od, 0, 0, 0);
#undef PK
}
struct VF { s16x4 l0, h0, l1, h1, l2, h2, l3, h3; };
template <int D0> __device__ __forceinline__ void vf_load(VF& f, int vb) {
  f.l0 = tr_read<w_rd_off(D0, 0, 0)>(vb); f.h0 = tr_read<w_rd_off(D0, 0, 1)>(vb); f.l1 = tr_read<w_rd_off(D0, 1, 0)>(vb); f.h1 = tr_read<w_rd_off(D0, 1, 1)>(vb);
  f.l2 = tr_read<w_rd_off(D0, 2, 0)>(vb); f.h2 = tr_read<w_rd_off(D0, 2, 1)>(vb); f.l3 = tr_read<w_rd_off(D0, 3, 0)>(vb); f.h3 = tr_read<w_rd_off(D0, 3, 1)>(vb);
}
#define VF_WAIT(N, f) asm volatile("s_waitcnt lgkmcnt(" #N ")" : "+v"(f.l0), "+v"(f.h0), "+v"(f.l1), "+v"(f.h1), "+v"(f.l2), "+v"(f.h2), "+v"(f.l3), "+v"(f.h3) :: "memory")
__device__ __forceinline__ void vf_mma(f32x16& od, const VF& f, bf16x8 pa0, bf16x8 pa1, bf16x8 pa2, bf16x8 pa3) {
#define PK(L, H) (bf16x8){L[0], L[1], L[2], L[3], H[0], H[1], H[2], H[3]}
  od = __builtin_amdgcn_mfma_f32_32x32x16_bf16(pa0, PK(f.l0, f.h0), od, 0, 0, 0);
  od = __builtin_amdgcn_mfma_f32_32x32x16_bf16(pa1, PK(f.l1, f.h1), od, 0, 0, 0);
  od = __builtin_amdgcn_mfma_f32_32x32x16_bf16(pa2, PK(f.l2, f.h2), od, 0, 0, 0);
  od = __builtin_amdgcn_mfma_f32_32x32x16_bf16(pa3, PK(f.l3, f.h3), od, 0, 0, 0);
#undef PK
}
template <int OFF> __device__ __forceinline__ bf16x8 ds_rd128(int a) { bf16x8 r; asm volatile("ds_read_b128 %0, %1 offset:%2" : "=&v"(r) : "v"(a), "i"(OFF) : "memory"); return r; }
#define KF_RD(A, B, d0) do { const int _a = (kx ^ ((d0) * 32)) + krow; A = ds_rd128<0>(_a); B = ds_rd128<8192>(_a); } while (0)
#define KF_WAIT(N, A, B) asm volatile("s_waitcnt lgkmcnt(" #N ")" : "+v"(A), "+v"(B) :: "memory")
#define KF_MMA(A, B, d0) do { p0 = __builtin_amdgcn_mfma_f32_32x32x16_bf16(A, qr[d0], p0, 0, 0, 0); p1 = __builtin_amdgcn_mfma_f32_32x32x16_bf16(B, qr[d0], p1, 0, 0, 0); } while (0)
__device__ __forceinline__ void attn_wide_body(const bf16_t* __restrict__ Qb, const bf16_t* __restrict__ Kh, const bf16_t* __restrict__ Vh, const int ld, const int NT,
                                               bf16_t* __restrict__ Ob, const int ldo, char* lds,
                                               const bool comb, const float lam, const float gscale, const float* __restrict__ subln, bf16_t* __restrict__ Cb, const int ldc) {
  int tid = threadIdx.x; asm volatile("" : "+v"(tid));
  const int wid = __builtin_amdgcn_readfirstlane(tid >> 6), lane = tid & 63, r32 = lane & 31, hi = lane >> 5;
  float* ws = (float*)(lds + W_OFF_WS) + wid * 64; float* li_l = ws; float* al_l = ws + 32;
  float m_reg = -1e30f, l_reg = 0; f32x16 o[8] = {}; bf16x8 qr[8];
  const bf16_t* Qw = Qb + (long)(wid * QBLK + r32) * ld + hi * 8;
#pragma unroll
  for (int d0 = 0; d0 < 8; ++d0) qr[d0] = *reinterpret_cast<const bf16x8*>(Qw + d0 * 16);
  unsigned kof[2], vof[4];
#pragma unroll
  for (int i = 0; i < 2; ++i) { const int g = wid + 8 * i, row = 4 * g + (lane >> 4), chunk = (lane & 15) ^ (row & 15); kof[i] = (unsigned)(row * ld + chunk * 8); }
#pragma unroll
  for (int i = 0; i < 4; ++i) { const int p = wid + 8 * i, sub = lane >> 5, w32 = lane & 31, kk = (p >> 2) * 8 + (w32 >> 2), k = (kk & ~0xC) | ((kk & 4) << 1) | ((kk & 8) >> 1);
    vof[i] = (unsigned)(k * ld + (2 * (p & 3) + sub) * 32 + (w32 & 3) * 8); }
  const int vb0 = (int)(uintptr_t)lds + v_rd_base(lane);
  const int kx = (hi * 16) ^ ((r32 & 15) << 4), krow0 = (int)(uintptr_t)lds + W_OFF_K + r32 * 256;
#define W_DMA(k0, b, bv) do { const bf16_t* _kp = Kh + (long)(k0) * ld; const bf16_t* _vp = Vh + (long)(k0) * ld; \
    _Pragma("unroll") for (int _i = 0; _i < 2; ++_i) __builtin_amdgcn_global_load_lds((const unsigned*)(_kp + kof[_i]), (LAS unsigned*)(lds + W_OFF_K + (b) * W_SHM_K + (wid + 8 * _i) * 1024), 16, 0, 0); \
    _Pragma("unroll") for (int _i = 0; _i < 4; ++_i) __builtin_amdgcn_global_load_lds((const unsigned*)(_vp + vof[_i]), (LAS unsigned*)(lds + (bv) * W_SHM_V + (wid + 8 * _i) * 1024), 16, 0, 0); } while (0)
  W_DMA(0, 0, 0);
  asm volatile("s_waitcnt vmcnt(0)" ::: "memory"); __builtin_amdgcn_s_barrier(); asm volatile("" ::: "memory");
#pragma unroll
  for (int d0 = 0; d0 < 8; ++d0) asm volatile("" : "+v"(qr[d0]));
#if defined(W_PRIO)
  if (wid >= 4) __builtin_amdgcn_s_setprio(1);
#endif
  const bool lagB = wid >= 4;
  bf16x8 pa0 = {}, pa1 = {}, pa2 = {}, pa3 = {};
#define W_PV(vbx) do { const int _vb = (vbx); VF fa, fb; vf_load<0>(fa, _vb); \
    vf_load<1>(fb, _vb); VF_WAIT(8, fa); vf_mma(o[0], fa, pa0, pa1, pa2, pa3); \
    vf_load<2>(fa, _vb); VF_WAIT(8, fb); vf_mma(o[1], fb, pa0, pa1, pa2, pa3); \
    vf_load<3>(fb, _vb); VF_WAIT(8, fa); vf_mma(o[2], fa, pa0, pa1, pa2, pa3); \
    vf_load<4>(fa, _vb); VF_WAIT(8, fb); vf_mma(o[3], fb, pa0, pa1, pa2, pa3); \
    vf_load<5>(fb, _vb); VF_WAIT(8, fa); vf_mma(o[4], fa, pa0, pa1, pa2, pa3); \
    vf_load<6>(fa, _vb); VF_WAIT(8, fb); vf_mma(o[5], fb, pa0, pa1, pa2, pa3); \
    vf_load<7>(fb, _vb); VF_WAIT(8, fa); vf_mma(o[6], fa, pa0, pa1, pa2, pa3); \
    VF_WAIT(0, fb); vf_mma(o[7], fb, pa0, pa1, pa2, pa3); } while (0)
#pragma unroll 1
  for (int j = 0; j <= NT; ++j) {
    if (j + 1 < NT) W_DMA((j + 1) * KVBLK, (j + 1) & 1, (j + 1) % 3);
    if (lagB && j >= 1) { W_PV(vb0 + ((j - 1) % 3) * W_SHM_V); SBAR(); }
    if (j < NT) {
      f32x16 p0 = {}, p1 = {}; float mn, alpha;
      const int krow = krow0 + (j & 1) * W_SHM_K;
      { bf16x8 ka0, kb0, ka1, kb1, ka2, kb2;
        KF_RD(ka0, kb0, 0); KF_RD(ka1, kb1, 1);
        KF_RD(ka2, kb2, 2); KF_WAIT(4, ka0, kb0); KF_MMA(ka0, kb0, 0);
        KF_RD(ka0, kb0, 3); KF_WAIT(4, ka1, kb1); KF_MMA(ka1, kb1, 1);
        KF_RD(ka1, kb1, 4); KF_WAIT(4, ka2, kb2); KF_MMA(ka2, kb2, 2);
        KF_RD(ka2, kb2, 5); KF_WAIT(4, ka0, kb0); KF_MMA(ka0, kb0, 3);
        KF_RD(ka0, kb0, 6); KF_WAIT(4, ka1, kb1); KF_MMA(ka1, kb1, 4);
        KF_RD(ka1, kb1, 7); KF_WAIT(4, ka2, kb2); KF_MMA(ka2, kb2, 5);
        KF_WAIT(2, ka0, kb0); KF_MMA(ka0, kb0, 6);
        KF_WAIT(0, ka1, kb1); KF_MMA(ka1, kb1, 7); }
      partialSM(p0, p1, m_reg, mn, alpha);
      if (__any(alpha < 1.f)) { if (hi == 0) al_l[r32] = alpha; asm volatile("s_waitcnt lgkmcnt(0)" ::: "memory");
#pragma unroll
        for (int d = 0; d < 8; ++d)
#pragma unroll
          for (int r = 0; r < 16; ++r) o[d][r] *= al_l[crow(r, hi)]; }
      finishSM(p0, p1, alpha, l_reg, pa0, pa1, pa2, pa3); SBAR();
      if (!lagB) W_PV(vb0 + (j % 3) * W_SHM_V);
    }
    asm volatile("s_waitcnt vmcnt(0) lgkmcnt(0)" ::: "memory"); __builtin_amdgcn_s_barrier(); asm volatile("" ::: "memory");
  }
#undef W_PV
#if defined(W_PRIO)
  __builtin_amdgcn_s_setprio(0);
#endif
  if (hi == 0) li_l[r32] = l_reg; asm volatile("s_waitcnt lgkmcnt(0)" ::: "memory");
  float rli[16];
#pragma unroll
  for (int r = 0; r < 16; ++r) rli[r] = __builtin_amdgcn_rcpf(li_l[crow(r, hi)]);
  bf16_t* Ow = Ob + (long)(wid * QBLK) * ldo;
  if (!comb) {
#pragma unroll
    for (int r = 0; r < 16; ++r) { const int orow = crow(r, hi);
#pragma unroll
      for (int d0 = 0; d0 < 8; ++d0) Ow[(long)orow * ldo + d0 * 32 + r32] = (bf16_t)f2bf(o[d0][r] * rli[r]); }
  } else {
    bf16_t* Cw = Cb + (long)(wid * QBLK) * ldc;
#pragma unroll
    for (int r = 0; r < 16; ++r) { const int orow = crow(r, hi); float ss = 0.f;
#pragma unroll
      for (int d0 = 0; d0 < 8; ++d0) { const float v = bf2f((unsigned)Ow[(long)orow * ldo + d0 * 32 + r32]) - lam * (o[d0][r] * rli[r]); o[d0][r] = v; ss += v * v; }
      ss += __shfl_xor(ss, 1); ss += __shfl_xor(ss, 2); ss += __shfl_xor(ss, 4); ss += __shfl_xor(ss, 8); ss += __shfl_xor(ss, 16);
      const float rstd = __builtin_amdgcn_rsqf(ss * (1.0f / 256.0f) + NORM_EPS) * gscale;
#pragma unroll
      for (int d0 = 0; d0 < 8; ++d0) o[d0][r] *= rstd; }
#pragma unroll
    for (int d0 = 0; d0 < 8; ++d0) { const float gsub = subln[d0 * 32 + r32];
#pragma unroll
      for (int r = 0; r < 16; ++r) Cw[(long)crow(r, hi) * ldc + d0 * 32 + r32] = (bf16_t)f2bf(o[d0][r] * gsub); }
  }
#undef W_DMA
}
__device__ __forceinline__ float pmax16(const f32x4 (&P)[4]) {
  float m = P[0][0];
#pragma unroll
  for (int kb = 0; kb < 4; ++kb)
#pragma unroll
    for (int t2 = 0; t2 < 4; ++t2) if (kb | t2) m = fmaxf(m, P[kb][t2]);
  return m;
}
#define PMAX16(P) pmax16(P)
template <int LAST, int S> __device__ __forceinline__ float bmask(float p, int w) {
  if constexpr (!LAST) { if constexpr (S >= 15) return p; else if constexpr (S < -12) return -3.0e4f; else return (w <= S) ? p : -3.0e4f; }
  else { if constexpr (S <= -12) return p; else if constexpr (S > 15) return -3.0e4f; else return (S <= w) ? p : -3.0e4f; }
}
#define BM1(ODD, LAST, A, KB, T) p[A][KB][T] = bmask<LAST, 16 * ((KB) - (A)) + (T) - 32 * (ODD)>(p[A][KB][T], wl);
#define BM4(ODD, LAST, A, KB) BM1(ODD, LAST, A, KB, 0) BM1(ODD, LAST, A, KB, 1) BM1(ODD, LAST, A, KB, 2) BM1(ODD, LAST, A, KB, 3)
#define BM16(ODD, LAST, A) BM4(ODD, LAST, A, 0) BM4(ODD, LAST, A, 1) BM4(ODD, LAST, A, 2) BM4(ODD, LAST, A, 3)
#define BMALL(ODD, LAST) do { BM16(ODD, LAST, 0) BM16(ODD, LAST, 1) } while (0)
__device__ __forceinline__ float xrow16_max(float x) {
  auto s = __builtin_amdgcn_permlane16_swap(__float_as_uint(x), __float_as_uint(x), false, false); x = fmaxf(__uint_as_float(s[0]), __uint_as_float(s[1]));
  auto u = __builtin_amdgcn_permlane32_swap(__float_as_uint(x), __float_as_uint(x), false, false); return fmaxf(__uint_as_float(u[0]), __uint_as_float(u[1]));
}
__device__ __forceinline__ float xrow16_sum(float x) {
  auto s = __builtin_amdgcn_permlane16_swap(__float_as_uint(x), __float_as_uint(x), false, false); x = __uint_as_float(s[0]) + __uint_as_float(s[1]);
  auto u = __builtin_amdgcn_permlane32_swap(__float_as_uint(x), __float_as_uint(x), false, false); return __uint_as_float(u[0]) + __uint_as_float(u[1]);
}
constexpr int w16_off(int s, int db, int second) { return s * 16384 + db * 256 + second * 8192; }
template <int S, int G4> __device__ __forceinline__ void vf16_load(VF& f, int vb) {
  f.l0 = tr_read<w16_off(S, 4 * G4 + 0, 0)>(vb); f.h0 = tr_read<w16_off(S, 4 * G4 + 0, 1)>(vb); f.l1 = tr_read<w16_off(S, 4 * G4 + 1, 0)>(vb); f.h1 = tr_read<w16_off(S, 4 * G4 + 1, 1)>(vb);
  f.l2 = tr_read<w16_off(S, 4 * G4 + 2, 0)>(vb); f.h2 = tr_read<w16_off(S, 4 * G4 + 2, 1)>(vb); f.l3 = tr_read<w16_off(S, 4 * G4 + 3, 0)>(vb); f.h3 = tr_read<w16_off(S, 4 * G4 + 3, 1)>(vb);
}
__device__ __forceinline__ void vf16_mma(f32x4* o0, f32x4* o1, const VF& f, bf16x8 pb0, bf16x8 pb1) {
#define PK(L, H) (bf16x8){L[0], L[1], L[2], L[3], H[0], H[1], H[2], H[3]}
  o0[0] = __builtin_amdgcn_mfma_f32_16x16x32_bf16(PK(f.l0, f.h0), pb0, o0[0], 0, 0, 0); o1[0] = __builtin_amdgcn_mfma_f32_16x16x32_bf16(PK(f.l0, f.h0), pb1, o1[0], 0, 0, 0);
  o0[1] = __builtin_amdgcn_mfma_f32_16x16x32_bf16(PK(f.l1, f.h1), pb0, o0[1], 0, 0, 0); o1[1] = __builtin_amdgcn_mfma_f32_16x16x32_bf16(PK(f.l1, f.h1), pb1, o1[1], 0, 0, 0);
  o0[2] = __builtin_amdgcn_mfma_f32_16x16x32_bf16(PK(f.l2, f.h2), pb0, o0[2], 0, 0, 0); o1[2] = __builtin_amdgcn_mfma_f32_16x16x32_bf16(PK(f.l2, f.h2), pb1, o1[2], 0, 0, 0);
  o0[3] = __builtin_amdgcn_mfma_f32_16x16x32_bf16(PK(f.l3, f.h3), pb0, o0[3], 0, 0, 0); o1[3] = __builtin_amdgcn_mfma_f32_16x16x32_bf16(PK(f.l3, f.h3), pb1, o1[3], 0, 0, 0);
#undef PK
}
__device__ __forceinline__ void attn_wide16_body(const bf16_t* __restrict__ Qb, const bf16_t* __restrict__ Kh, const bf16_t* __restrict__ Vh, const int ld, const int NT,
                                                 bf16_t* __restrict__ Ob, const int ldo, char* lds,
                                                 const bool comb, const float lam, const float gscale, const float* __restrict__ subln, bf16_t* __restrict__ Cb, const int ldc) {
  int tid = threadIdx.x; asm volatile("" : "+v"(tid));
  const int wid = __builtin_amdgcn_readfirstlane(tid >> 6), lane = tid & 63, c16 = lane & 15, g = lane >> 4;
  constexpr float C = SCALE * 1.4426950408889634f;
  float m0 = -1e30f, m1 = -1e30f, l0 = 0.f, l1 = 0.f; f32x4 o[2][16]; bf16x8 qr[2][4];
#pragma unroll
  for (int a = 0; a < 2; ++a)
#pragma unroll
    for (int b = 0; b < 16; ++b) o[a][b] = f32x4{0.f, 0.f, 0.f, 0.f};
#pragma unroll
  for (int qb = 0; qb < 2; ++qb)
#pragma unroll
    for (int d0 = 0; d0 < 4; ++d0) qr[qb][d0] = *reinterpret_cast<const bf16x8*>(Qb + (long)(wid * QBLK + qb * 16 + c16) * ld + d0 * 32 + g * 8);
  const int krw = 4 * wid + (lane >> 4); const unsigned kof0 = (unsigned)(krw * ld + ((lane & 15) ^ (krw & 15)) * 8), kstep = 32u * (unsigned)ld;
  const unsigned vof0 = (unsigned)((8 * (wid >> 2) + ((lane & 15) >> 1)) * ld + (4 * (wid & 3) + (lane >> 4)) * 16 + (lane & 1) * 8), vstep = 16u * (unsigned)ld;
#define W16_DMA(k0, b) do { const bf16_t* _kp = Kh + (long)(k0) * ld; const bf16_t* _vp = Vh + (long)(k0) * ld; \
    _Pragma("unroll") for (int _i = 0; _i < 2; ++_i) __builtin_amdgcn_global_load_lds((const unsigned*)(_kp + kof0 + _i * kstep), (LAS unsigned*)(lds + W_OFF_K + (b) * W_SHM_K + (wid + 8 * _i) * 1024), 16, 0, 0); \
    _Pragma("unroll") for (int _i = 0; _i < 4; ++_i) __builtin_amdgcn_global_load_lds((const unsigned*)(_vp + vof0 + _i * vstep), (LAS unsigned*)(lds + (b) * W_SHM_V + (wid + 8 * _i) * 1024), 16, 0, 0); } while (0)
  const int kx = (g ^ c16) << 4, kq0 = (int)(uintptr_t)lds + W_OFF_K + c16 * 256;
  const int vb0 = (int)(uintptr_t)lds + (g >> 1) * 4096 + (4 * (g & 1) + (c16 >> 2)) * 32 + (c16 & 3) * 8;
  W16_DMA(0, 0);
  asm volatile("s_waitcnt vmcnt(0)" ::: "memory"); __builtin_amdgcn_s_barrier(); asm volatile("" ::: "memory");
#pragma unroll
  for (int qb = 0; qb < 2; ++qb)
#pragma unroll
    for (int d0 = 0; d0 < 4; ++d0) asm volatile("" : "+v"(qr[qb][d0]));
#pragma unroll 1
  for (int j = 0; j < NT; ++j) {
    const int b = j & 1;
    if (j + 1 < NT) W16_DMA((j + 1) * KVBLK, b ^ 1);
    f32x4 p[2][4];
    { const int kq = kq0 + b * W_SHM_K; const int ka0 = kq + (0 ^ kx), ka1 = kq + (64 ^ kx), ka2 = kq + (128 ^ kx), ka3 = kq + (192 ^ kx);
      bf16x8 f0, f1, f2;
#define K16_RD(F, IDX) F = ds_rd128<((IDX) >> 2) * 4096>(((IDX) & 3) == 0 ? ka0 : ((IDX) & 3) == 1 ? ka1 : ((IDX) & 3) == 2 ? ka2 : ka3)
#define K16_WAIT(N, F) asm volatile("s_waitcnt lgkmcnt(" #N ")" : "+v"(F) :: "memory")
#define K16_MMA(F, IDX) do { p[0][(IDX) >> 2] = __builtin_amdgcn_mfma_f32_16x16x32_bf16(F, qr[0][(IDX) & 3], ((IDX) & 3) ? p[0][(IDX) >> 2] : f32x4{0.f, 0.f, 0.f, 0.f}, 0, 0, 0); \
                             p[1][(IDX) >> 2] = __builtin_amdgcn_mfma_f32_16x16x32_bf16(F, qr[1][(IDX) & 3], ((IDX) & 3) ? p[1][(IDX) >> 2] : f32x4{0.f, 0.f, 0.f, 0.f}, 0, 0, 0); } while (0)
      K16_RD(f0, 0); K16_RD(f1, 1);
      K16_RD(f2, 2); K16_WAIT(2, f0); K16_MMA(f0, 0);
      K16_RD(f0, 3); K16_WAIT(2, f1); K16_MMA(f1, 1);
      K16_RD(f1, 4); K16_WAIT(2, f2); K16_MMA(f2, 2);
      K16_RD(f2, 5); K16_WAIT(2, f0); K16_MMA(f0, 3);
      K16_RD(f0, 6); K16_WAIT(2, f1); K16_MMA(f1, 4);
      K16_RD(f1, 7); K16_WAIT(2, f2); K16_MMA(f2, 5);
      K16_RD(f2, 8); K16_WAIT(2, f0); K16_MMA(f0, 6);
      K16_RD(f0, 9); K16_WAIT(2, f1); K16_MMA(f1, 7);
      K16_RD(f1, 10); K16_WAIT(2, f2); K16_MMA(f2, 8);
      K16_RD(f2, 11); K16_WAIT(2, f0); K16_MMA(f0, 9);
      K16_RD(f0, 12); K16_WAIT(2, f1); K16_MMA(f1, 10);
      K16_RD(f1, 13); K16_WAIT(2, f2); K16_MMA(f2, 11);
      K16_RD(f2, 14); K16_WAIT(2, f0); K16_MMA(f0, 12);
      K16_RD(f0, 15); K16_WAIT(2, f1); K16_MMA(f1, 13);
      K16_WAIT(1, f2); K16_MMA(f2, 14);
      K16_WAIT(0, f0); K16_MMA(f0, 15);
#undef K16_RD
#undef K16_WAIT
#undef K16_MMA
    }
    float pm0 = PMAX16(p[0]), pm1 = PMAX16(p[1]);
    pm0 = xrow16_max(pm0); pm1 = xrow16_max(pm1);
    float al0 = 1.f, al1 = 1.f;
    if (!__builtin_expect(__all((pm0 - m0 <= THR / SCALE) & (pm1 - m1 <= THR / SCALE)), 1)) {
      const float n0 = fmaxf(m0, pm0), n1 = fmaxf(m1, pm1); al0 = __builtin_amdgcn_exp2f((m0 - n0) * C); al1 = __builtin_amdgcn_exp2f((m1 - n1) * C); m0 = n0; m1 = n1;
#pragma unroll
      for (int db = 0; db < 16; ++db) { o[0][db] = o[0][db] * al0; o[1][db] = o[1][db] * al1; } }
    const float mc0 = -m0 * C, mc1 = -m1 * C; float ps0 = 0.f, ps1 = 0.f;
#pragma unroll
    for (int kb = 0; kb < 4; ++kb)
#pragma unroll
      for (int t2 = 0; t2 < 4; ++t2) { p[0][kb][t2] = __builtin_amdgcn_exp2f(fmaf(p[0][kb][t2], C, mc0)); p[1][kb][t2] = __builtin_amdgcn_exp2f(fmaf(p[1][kb][t2], C, mc1)); ps0 += p[0][kb][t2]; ps1 += p[1][kb][t2]; }
    ps0 = xrow16_sum(ps0); ps1 = xrow16_sum(ps1); l0 = l0 * al0 + ps0; l1 = l1 * al1 + ps1;
    bf16x8 pb[2][2];
#pragma unroll
    for (int a = 0; a < 2; ++a)
#pragma unroll
      for (int s = 0; s < 2; ++s) { u32x4 w = {cvtpk(p[a][2 * s][0], p[a][2 * s][1]), cvtpk(p[a][2 * s][2], p[a][2 * s][3]), cvtpk(p[a][2 * s + 1][0], p[a][2 * s + 1][1]), cvtpk(p[a][2 * s + 1][2], p[a][2 * s + 1][3])};
        pb[a][s] = *reinterpret_cast<bf16x8*>(&w); }
    SBAR();
    { const int vb = vb0 + b * W_SHM_V; VF fa, fb;
      vf16_load<0, 0>(fa, vb);
      vf16_load<0, 1>(fb, vb); VF_WAIT(8, fa); vf16_mma(&o[0][0], &o[1][0], fa, pb[0][0], pb[1][0]);
      vf16_load<0, 2>(fa, vb); VF_WAIT(8, fb); vf16_mma(&o[0][4], &o[1][4], fb, pb[0][0], pb[1][0]);
      vf16_load<0, 3>(fb, vb); VF_WAIT(8, fa); vf16_mma(&o[0][8], &o[1][8], fa, pb[0][0], pb[1][0]);
      vf16_load<1, 0>(fa, vb); VF_WAIT(8, fb); vf16_mma(&o[0][12], &o[1][12], fb, pb[0][0], pb[1][0]);
      vf16_load<1, 1>(fb, vb); VF_WAIT(8, fa); vf16_mma(&o[0][0], &o[1][0], fa, pb[0][1], pb[1][1]);
      vf16_load<1, 2>(fa, vb); VF_WAIT(8, fb); vf16_mma(&o[0][4], &o[1][4], fb, pb[0][1], pb[1][1]);
      vf16_load<1, 3>(fb, vb); VF_WAIT(8, fa); vf16_mma(&o[0][8], &o[1][8], fa, pb[0][1], pb[1][1]);
      VF_WAIT(0, fb); vf16_mma(&o[0][12], &o[1][12], fb, pb[0][1], pb[1][1]); }
    asm volatile("s_waitcnt vmcnt(0) lgkmcnt(0)" ::: "memory"); __builtin_amdgcn_s_barrier(); asm volatile("" ::: "memory");
  }
  const float rl0 = __builtin_amdgcn_rcpf(l0), rl1 = __builtin_amdgcn_rcpf(l1);
#pragma unroll
  for (int qb = 0; qb < 2; ++qb) { const float rl = qb ? rl1 : rl0;
    bf16_t* Or = Ob + (long)(wid * QBLK + qb * 16 + c16) * ldo + 4 * g;
    if (!comb) {
#pragma unroll
      for (int db = 0; db < 16; ++db) { const u32x2 w = {cvtpk(o[qb][db][0] * rl, o[qb][db][1] * rl), cvtpk(o[qb][db][2] * rl, o[qb][db][3] * rl)}; *reinterpret_cast<u32x2*>(Or + db * 16) = w; }
    } else {
      bf16_t* Cr = Cb + (long)(wid * QBLK + qb * 16 + c16) * ldc + 4 * g; float ss = 0.f;
#pragma unroll
      for (int db = 0; db < 16; ++db) { const u32x2 w = *reinterpret_cast<const u32x2*>(Or + db * 16);
        const float v0 = bf2f(w.x & 0xffffu) - lam * (o[qb][db][0] * rl), v1 = bf2f(w.x >> 16) - lam * (o[qb][db][1] * rl), v2 = bf2f(w.y & 0xffffu) - lam * (o[qb][db][2] * rl), v3 = bf2f(w.y >> 16) - lam * (o[qb][db][3] * rl);
        o[qb][db] = f32x4{v0, v1, v2, v3}; ss += (v0 * v0 + v1 * v1) + (v2 * v2 + v3 * v3); }
      ss = xrow16_sum(ss);
      const float rstd = __builtin_amdgcn_rsqf(ss * (1.0f / 256.0f) + NORM_EPS) * gscale;
#pragma unroll
      for (int db = 0; db < 16; ++db) { const f32x4 gs = *reinterpret_cast<const f32x4*>(subln + db * 16 + 4 * g);
        const u32x2 w = {cvtpk(o[qb][db][0] * rstd * gs[0], o[qb][db][1] * rstd * gs[1]), cvtpk(o[qb][db][2] * rstd * gs[2], o[qb][db][3] * rstd * gs[3])}; *reinterpret_cast<u32x2*>(Cr + db * 16) = w; }
    }
  }
#undef W16_DMA
}
constexpr int wb16_off(int s, int db, int second) { return s * 8192 + db * 256 + second * 4096; }
template <int S, int G4> __device__ __forceinline__ void vfb16_load(VF& f, int vb) {
  f.l0 = tr_read<wb16_off(S, 4 * G4 + 0, 0)>(vb); f.h0 = tr_read<wb16_off(S, 4 * G4 + 0, 1)>(vb); f.l1 = tr_read<wb16_off(S, 4 * G4 + 1, 0)>(vb); f.h1 = tr_read<wb16_off(S, 4 * G4 + 1, 1)>(vb);
  f.l2 = tr_read<wb16_off(S, 4 * G4 + 2, 0)>(vb); f.h2 = tr_read<wb16_off(S, 4 * G4 + 2, 1)>(vb); f.l3 = tr_read<wb16_off(S, 4 * G4 + 3, 0)>(vb); f.h3 = tr_read<wb16_off(S, 4 * G4 + 3, 1)>(vb);
}
template <class UF>
__device__ __forceinline__ void attn_band16_stream(const int U, UF unit_of, char* lds) {
  int tid = threadIdx.x; asm volatile("" : "+v"(tid));
  const int wid = __builtin_amdgcn_readfirstlane(tid >> 6), lane = tid & 63, c16 = lane & 15, g = lane >> 4;
  constexpr float C = SCALE * 1.4426950408889634f;
  constexpr int TILE = 32768, OFF_B = 3 * TILE, OFF_WS = 4 * TILE;
  const int jlo = wid >> 1, qi0 = wid * QBLK + c16;
  const int kx = (g ^ c16) << 4;
  const int kq_l = (int)(uintptr_t)lds + 16384 + c16 * 256, vb_l = (int)(uintptr_t)lds + (g >> 1) * 2048 + (4 * (g & 1) + (c16 >> 2)) * 32 + (c16 & 3) * 8;
  const int krow0 = 4 * wid + (lane >> 4), kch = ((lane & 15) ^ (krow0 & 15)) * 8;
  const int vkey0 = 8 * (wid >> 1) + ((lane & 15) >> 1), vcol = (4 * (wid & 1) + (lane >> 4)) * 16 + (lane & 1) * 8;
#define BS_DMA(bu, j, boff) do { const int _kb = (bu).kfirst + 64 * (j); const int _sh = (bu).lsh;     \
    _Pragma("unroll") for (int _i = 0; _i < 2; ++_i) { const unsigned _ro = (__umul24((unsigned)min(max(_kb + krow0 + 32 * _i, 0), (bu).Mr - 1), 6144u) << _sh) + kch; \
      __builtin_amdgcn_global_load_lds((const unsigned*)((bu).K + _ro), (LAS unsigned*)(lds + (boff) + 16384 + (wid + 8 * _i) * 1024), 16, 0, 0); } \
    _Pragma("unroll") for (int _i = 0; _i < 2; ++_i) { const unsigned _ro = (__umul24((unsigned)min(max(_kb + vkey0 + 32 * _i, 0), (bu).Mr - 1), 6144u) << _sh) + vcol; \
      __builtin_amdgcn_global_load_lds((const unsigned*)((bu).V + _ro), (LAS unsigned*)(lds + (boff) + (wid + 8 * _i) * 1024), 16, 0, 0); } } while (0)
#define BS_QLOAD(bu) do { const bf16_t* _q = (bu).Q + (long)qi0 * (bu).ld + g * 8; const bf16_t* _q2 = _q + 16L * (bu).ld; \
    asm volatile("global_load_dwordx4 %0, %8, off\n\tglobal_load_dwordx4 %1, %8, off offset:64\n\tglobal_load_dwordx4 %2, %8, off offset:128\n\tglobal_load_dwordx4 %3, %8, off offset:192\n\t" \
                 "global_load_dwordx4 %4, %9, off\n\tglobal_load_dwordx4 %5, %9, off offset:64\n\tglobal_load_dwordx4 %6, %9, off offset:128\n\tglobal_load_dwordx4 %7, %9, off offset:192" \
                 : "=&v"(qr[0]), "=&v"(qr[1]), "=&v"(qr[2]), "=&v"(qr[3]), "=&v"(qr[4]), "=&v"(qr[5]), "=&v"(qr[6]), "=&v"(qr[7]) : "v"(_q), "v"(_q2) : "memory"); } while (0)
#define BS_POS_DMA(gq) do { const int _un = (gq) / 5, _jn = (gq) - 5 * _un; \
    if ((gq) <= 5 * U) { \
      if (_un < U) { const BandUnit _bn = unit_of(_un); BS_DMA(_bn, _jn, ((gq) % 3) * TILE); ndma += 4; } \
      if (_jn == 0 && _un >= 1) { const BandUnit _bp = unit_of(_un - 1); BS_DMA(_bp, 5, OFF_B); ndma += 4; } } } while (0)
  float m0 = -1e30f, m1 = -1e30f, l0 = 0.f, l1 = 0.f; f32x4 o[2][8]; bf16x8 qr[8];
#pragma unroll
  for (int a = 0; a < 2; ++a)
#pragma unroll
    for (int b = 0; b < 8; ++b) o[a][b] = f32x4{0.f, 0.f, 0.f, 0.f};
  { int ndma = 0; if (U > 0) { const BandUnit b0 = unit_of(0); BS_QLOAD(b0); } else {
#pragma unroll
      for (int d0 = 0; d0 < 8; ++d0) qr[d0] = bf16x8{}; }
    BS_POS_DMA(0); BS_POS_DMA(1); }
  asm volatile("s_waitcnt vmcnt(0)" ::: "memory");
#pragma unroll
  for (int d0 = 0; d0 < 8; ++d0) asm volatile("" : "+v"(qr[d0]));
  __builtin_amdgcn_s_barrier(); asm volatile("" ::: "memory");
#pragma unroll 1
  for (int gg = 0; gg <= 5 * U + 2; ++gg) {
    const int rel = gg - jlo, uw = rel >= 0 ? rel / 5 : -1, jr = rel - 5 * uw;
    int ndma = 0;
    if (uw >= 0 && jr >= 3 && uw < U) {
      const BandUnit bu = unit_of(uw);
      if (jr == 3) {
        const float rl0 = __builtin_amdgcn_rcpf(l0), rl1 = __builtin_amdgcn_rcpf(l1);
#pragma unroll
        for (int qb = 0; qb < 2; ++qb) { const float rl = qb ? rl1 : rl0; bf16_t* Or = bu.O + (long)(qi0 + 16 * qb) * bu.ldo + 4 * g;
#pragma unroll
          for (int db = 0; db < 8; ++db) { const u32x2 w = {cvtpk(o[qb][db][0] * rl, o[qb][db][1] * rl), cvtpk(o[qb][db][2] * rl, o[qb][db][3] * rl)}; *reinterpret_cast<u32x2*>(Or + db * 16) = w; } }
        if (g == 0) { bu.L[(long)qi0 * bu.ldl] = m0 * SCALE + __logf(l0); bu.L[(long)(qi0 + 16) * bu.ldl] = m1 * SCALE + __logf(l1); } }
      asm volatile("s_waitcnt vmcnt(0)" ::: "memory");
      if (jr == 3 && uw + 1 < U) { const BandUnit bn = unit_of(uw + 1); BS_QLOAD(bn); ndma += 8; }
      BS_POS_DMA(gg + 2);
    } else {
    BS_POS_DMA(gg + 2);
    if (uw >= 0 && jr <= 2 && uw < U) {
      const BandUnit bu = unit_of(uw);
      const int j = jlo + jr, boff = (j == 5) ? OFF_B : (gg % 3) * TILE;
      if (jr == 0) { m0 = m1 = -1e30f; l0 = l1 = 0.f;
#pragma unroll
        for (int a = 0; a < 2; ++a)
#pragma unroll
          for (int b = 0; b < 8; ++b) o[a][b] = f32x4{0.f, 0.f, 0.f, 0.f}; }
      if ((bu.kfirst + 64 * j >= 0) & (bu.kfirst + 64 * j + 64 <= bu.Mr)) {
      f32x4 p[2][4];
      { int kxo = kx; asm volatile("" : "+v"(kxo));
        const int kq = kq_l + boff; const int ka0 = kq + (0 ^ kxo), ka1 = kq + (64 ^ kxo), ka2 = kq + (128 ^ kxo), ka3 = kq + (192 ^ kxo);
        bf16x8 f0, f1;
#define K16_RD(F, IDX) F = dsb_rd128<((IDX) >> 2) * 4096>(((IDX) & 3) == 0 ? ka0 : ((IDX) & 3) == 1 ? ka1 : ((IDX) & 3) == 2 ? ka2 : ka3)
#define K16_WAIT(N, F) asm volatile("s_waitcnt lgkmcnt(" #N ")" : "+v"(F) :: "memory")
#define K16_MMA(F, IDX) do { p[0][(IDX) >> 2] = __builtin_amdgcn_mfma_f32_16x16x32_bf16(F, qr[(IDX) & 3], ((IDX) & 3) ? p[0][(IDX) >> 2] : f32x4{0.f, 0.f, 0.f, 0.f}, 0, 0, 0); \
                             p[1][(IDX) >> 2] = __builtin_amdgcn_mfma_f32_16x16x32_bf16(F, qr[4 + ((IDX) & 3)], ((IDX) & 3) ? p[1][(IDX) >> 2] : f32x4{0.f, 0.f, 0.f, 0.f}, 0, 0, 0); } while (0)
        K16_RD(f0, 0);
        K16_RD(f1, 1); K16_WAIT(1, f0); K16_MMA(f0, 0);
        K16_RD(f0, 2); K16_WAIT(1, f1); K16_MMA(f1, 1);
        K16_RD(f1, 3); K16_WAIT(1, f0); K16_MMA(f0, 2);
        K16_RD(f0, 4); K16_WAIT(1, f1); K16_MMA(f1, 3);
        K16_RD(f1, 5); K16_WAIT(1, f0); K16_MMA(f0, 4);
        K16_RD(f0, 6); K16_WAIT(1, f1); K16_MMA(f1, 5);
        K16_RD(f1, 7); K16_WAIT(1, f0); K16_MMA(f0, 6);
        K16_RD(f0, 8); K16_WAIT(1, f1); K16_MMA(f1, 7);
        K16_RD(f1, 9); K16_WAIT(1, f0); K16_MMA(f0, 8);
        K16_RD(f0, 10); K16_WAIT(1, f1); K16_MMA(f1, 9);
        K16_RD(f1, 11); K16_WAIT(1, f0); K16_MMA(f0, 10);
        K16_RD(f0, 12); K16_WAIT(1, f1); K16_MMA(f1, 11);
        K16_RD(f1, 13); K16_WAIT(1, f0); K16_MMA(f0, 12);
        K16_RD(f0, 14); K16_WAIT(1, f1); K16_MMA(f1, 13);
        K16_RD(f1, 15); K16_WAIT(1, f0); K16_MMA(f0, 14);
        K16_WAIT(0, f1); K16_MMA(f1, 15);
#undef K16_RD
#undef K16_WAIT
#undef K16_MMA
      }
      if (jr != 1) {
        const int wl = c16 - 4 * g;
        if (wid & 1) { if (jr == 0) BMALL(1, 0); else BMALL(1, 1); } else { if (jr == 0) BMALL(0, 0); else BMALL(0, 1); } }
      float pm0 = PMAX16(p[0]), pm1 = PMAX16(p[1]);
      pm0 = xrow16_max(pm0); pm1 = xrow16_max(pm1);
      float al0 = 1.f, al1 = 1.f;
      if (!__builtin_expect(__all((pm0 - m0 <= THR / SCALE) & (pm1 - m1 <= THR / SCALE)), 1)) {
        const float n0 = fmaxf(m0, pm0), n1 = fmaxf(m1, pm1); al0 = __builtin_amdgcn_exp2f((m0 - n0) * C); al1 = __builtin_amdgcn_exp2f((m1 - n1) * C); m0 = n0; m1 = n1;
        if (jr != 0) {
#pragma unroll
          for (int db = 0; db < 8; ++db) { o[0][db] = o[0][db] * al0; o[1][db] = o[1][db] * al1; } } }
      const float mc0 = -m0 * C, mc1 = -m1 * C; float ps0 = 0.f, ps1 = 0.f;
#pragma unroll
      for (int kb = 0; kb < 4; ++kb)
#pragma unroll
        for (int t2 = 0; t2 < 4; ++t2) { p[0][kb][t2] = __builtin_amdgcn_exp2f(fmaf(p[0][kb][t2], C, mc0)); p[1][kb][t2] = __builtin_amdgcn_exp2f(fmaf(p[1][kb][t2], C, mc1)); ps0 += p[0][kb][t2]; ps1 += p[1][kb][t2]; }
      ps0 = xrow16_sum(ps0); ps1 = xrow16_sum(ps1); l0 = l0 * al0 + ps0; l1 = l1 * al1 + ps1;
      bf16x8 pb[2][2];
#pragma unroll
      for (int a = 0; a < 2; ++a)
#pragma unroll
        for (int s = 0; s < 2; ++s) { u32x4 w = {cvtpk(p[a][2 * s][0], p[a][2 * s][1]), cvtpk(p[a][2 * s][2], p[a][2 * s][3]), cvtpk(p[a][2 * s + 1][0], p[a][2 * s + 1][1]), cvtpk(p[a][2 * s + 1][2], p[a][2 * s + 1][3])};
          pb[a][s] = *reinterpret_cast<bf16x8*>(&w); }
      SBAR();
      { int vb = vb_l + boff; asm volatile("" : "+v"(vb)); VF fa;
        vfb16_load<0, 0>(fa, vb); VF_WAIT(0, fa); vf16_mma(&o[0][0], &o[1][0], fa, pb[0][0], pb[1][0]);
        vfb16_load<0, 1>(fa, vb); VF_WAIT(0, fa); vf16_mma(&o[0][4], &o[1][4], fa, pb[0][0], pb[1][0]);
        vfb16_load<1, 0>(fa, vb); VF_WAIT(0, fa); vf16_mma(&o[0][0], &o[1][0], fa, pb[0][1], pb[1][1]);
        vfb16_load<1, 1>(fa, vb); VF_WAIT(0, fa); vf16_mma(&o[0][4], &o[1][4], fa, pb[0][1], pb[1][1]); }
      }
    } }
    asm volatile("s_waitcnt lgkmcnt(0)" ::: "memory");
#define BS_VMW(n) case n: asm volatile("s_waitcnt vmcnt(" #n ")" ::: "memory"); break;
    switch (ndma) { BS_VMW(4) BS_VMW(8) BS_VMW(12) BS_VMW(16) default: asm volatile("s_waitcnt vmcnt(0)" ::: "memory"); break; }
#undef BS_VMW
    __builtin_amdgcn_s_barrier(); asm volatile("" ::: "memory");
  }
#undef BS_DMA
#undef BS_QLOAD
#undef BS_POS_DMA
}
}

struct Frame { LAS unsigned char* lds; int wave, vcu, G; };
#define FRAME_TID() int f_tid = threadIdx.x; asm volatile("" : "+v"(f_tid)); const int f_lane = f_tid & 63; (void)f_lane

constexpr int TP_SCR = 64 * 65 * 4;
struct TpDesc { const float* W; bf16_t* WT; const float* gain; int K, N, mode, item; };
__device__ __forceinline__ void tp_load(const TpDesc& d, f32x4 (&v)[16], int lane) {
    const int nblk = d.N / 64, kb = d.item / nblk, nb = d.item % nblk, k0 = 64 * kb, n0 = 64 * nb, r = lane >> 4, q = lane & 15;
#pragma unroll
    for (int i = 0; i < 16; ++i) v[i] = *(const f32x4*)(d.W + (size_t)(k0 + 4 * i + r) * d.N + n0 + 4 * q);
}
__device__ __forceinline__ void tp_finish(const TpDesc& d, const f32x4 (&v)[16], LAS float* scr, int lane) {
    const int nblk = d.N / 64, kb = d.item / nblk, nb = d.item % nblk, k0 = 64 * kb, n0 = 64 * nb, r = lane >> 4, q = lane & 15;
#pragma unroll
    for (int i = 0; i < 16; ++i) { const int kk = 4 * i + r; f32x4 w = v[i]; if (d.gain) w = w * d.gain[k0 + kk];
        LAS float* p = scr + kk * 65 + 4 * q; p[0] = w[0]; p[1] = w[1]; p[2] = w[2]; p[3] = w[3]; }
    LDS_WAIT(); asm volatile("" ::: "memory");
    int d0 = n0;
    if (d.mode == 1) { const int half = n0 / FFN, j = n0 % FFN; d0 = (j / 128) * 256 + half * 128 + (j % 128); }
    const int c = lane & 7;
#pragma unroll
    for (int j = 0; j < 8; ++j) { const int n = (lane >> 3) + 8 * j; const LAS float* s = scr + (8 * c) * 65 + n;
        u32x4 o; o.x = cvt_pk_bf16(s[0 * 65], s[1 * 65]); o.y = cvt_pk_bf16(s[2 * 65], s[3 * 65]); o.z = cvt_pk_bf16(s[4 * 65], s[5 * 65]); o.w = cvt_pk_bf16(s[6 * 65], s[7 * 65]);
        *(u32x4*)(d.WT + (size_t)(d0 + n) * d.K + k0 + 8 * c) = o; }
    LDS_WAIT(); asm volatile("" ::: "memory");
}

struct Args { const float* in[28]; float* out; unsigned char* ws; };
#define P_x (P.in[0])
#define P_mem (P.in[1])
#define P_mix_g (P.in[2])
#define P_xa_g (P.in[3])
#define P_mem_g (P.in[4])
#define P_wq (P.in[5])
#define P_wkv (P.in[6])
#define P_wo (P.in[7])
#define P_ffn_g (P.in[8])
#define P_w13 (P.in[9])
#define P_w2 (P.in[10])
#define P_w_in (P.in[11])
#define P_w_abo (P.in[12])
#define P_lam_re (P.in[13])
#define P_lam_im (P.in[14])
#define P_log_step (P.in[15])
#define P_b_re (P.in[16])
#define P_b_im (P.in[17])
#define P_c_re (P.in[18])
#define P_c_im (P.in[19])
#define P_s5_d (P.in[20])
#define P_glu_w (P.in[21])
#define P_glu_b (P.in[22])
#define P_dlam (P.in[23])
#define P_subln (P.in[24])
#define P_wqkv (P.in[25])
#define P_wco (P.in[26])
#define P_fin_g (P.in[27])
typedef Args Ptrs;

__device__ __forceinline__ void p0_prologue(const Frame& F, const Ptrs& P) {
    FRAME_TID();
    unsigned char* ws = P.ws;
    LAS float* scr = (LAS float*)(F.lds + F.wave * TP_SCR);
    const int gw = F.vcu * 8 + F.wave, NGW = F.G * 8;
    const long gt = (long)F.vcu * 512 + f_tid, NGT = (long)F.G * 512;
    constexpr int I_IN = 32 * 64, I_SQ = 32 * 32, I_GLU = 16 * 16, I_QKV = 32 * 96, I_KV = 32 * 64, I_13 = 32 * 176, I_2 = 88 * 32;
    constexpr int NITEMS = 2 * I_IN + 2 * I_SQ + 2 * I_GLU + 2 * I_QKV + 2 * I_SQ + 4 * I_KV + 4 * I_SQ + 4 * I_13 + 4 * I_2;
    auto decode = [&](int it, TpDesc& d) {
        int r = it;
        if (r < 2 * I_IN) { const int mi = r / I_IN; d = TpDesc{P_w_in + (size_t)mi * 2048 * 4096, (bf16_t*)(ws + WS_W_IN) + (size_t)mi * 2048 * 4096, P_mix_g + (2 * mi) * 2048, 2048, 4096, 0, r % I_IN}; return; } r -= 2 * I_IN;
        if (r < 2 * I_SQ) { const int mi = r / I_SQ; d = TpDesc{P_w_abo + (size_t)mi * 2048 * 2048, (bf16_t*)(ws + WS_W_ABO) + (size_t)mi * 2048 * 2048, nullptr, 2048, 2048, 0, r % I_SQ}; return; } r -= 2 * I_SQ;
        if (r < 2 * I_GLU) { const int mi = r / I_GLU; d = TpDesc{P_glu_w + (size_t)mi * 1024 * 1024, (bf16_t*)(ws + WS_W_GLU) + (size_t)mi * 1024 * 1024, nullptr, 1024, 1024, 0, r % I_GLU}; return; } r -= 2 * I_GLU;
        if (r < 2 * I_QKV) { const int mi = r / I_QKV; d = TpDesc{P_wqkv + (size_t)mi * 2048 * 6144, (bf16_t*)(ws + WS_W_QKV) + (size_t)mi * 2048 * 6144, P_mix_g + (2 * mi + 1) * 2048, 2048, 6144, 0, r % I_QKV}; return; } r -= 2 * I_QKV;
        if (r < 2 * I_SQ) { const int mi = r / I_SQ; d = TpDesc{P_wco + (size_t)mi * 2048 * 2048, (bf16_t*)(ws + WS_W_CO) + (size_t)mi * 2048 * 2048, nullptr, 2048, 2048, 0, r % I_SQ}; return; } r -= 2 * I_SQ;
        if (r < 4 * I_KV) { const int mi = r / I_KV; d = TpDesc{P_wkv + (size_t)mi * 2048 * 4096, (bf16_t*)(ws + WS_WKV_T) + (size_t)mi * 2048 * 4096, P_mem_g + mi * 2048, 2048, 4096, 0, r % I_KV}; return; } r -= 4 * I_KV;
        if (r < 4 * I_SQ) { const int mi = r / I_SQ; d = TpDesc{P_wo + (size_t)mi * 2048 * 2048, (bf16_t*)(ws + WS_WO_T) + (size_t)mi * 2048 * 2048, nullptr, 2048, 2048, 0, r % I_SQ}; return; } r -= 4 * I_SQ;
        if (r < 4 * I_13) { const int mi = r / I_13; d = TpDesc{P_w13 + (size_t)mi * 2048 * 11264, (bf16_t*)(ws + WS_W13) + (size_t)mi * 2048 * 11264, P_ffn_g + mi * 2048, 2048, 11264, 1, r % I_13}; return; } r -= 4 * I_13;
        { const int mi = r / I_2; d = TpDesc{P_w2 + (size_t)mi * 5632 * 2048, (bf16_t*)(ws + WS_W2) + (size_t)mi * 5632 * 2048, nullptr, 5632, 2048, 0, r % I_2}; }
    };
    {
        TpDesc dc, dn; f32x4 va[16], vb[16];
        int it = gw;
        if (it < NITEMS) { decode(it, dc); tp_load(dc, va, f_lane); }
#pragma unroll 1
        for (; it < NITEMS; it += 2 * NGW) {
            const int it1 = it + NGW, it2 = it + 2 * NGW;
            if (it1 < NITEMS) { decode(it1, dn); tp_load(dn, vb, f_lane); }
            tp_finish(dc, va, scr, f_lane);
            if (it1 < NITEMS) { if (it2 < NITEMS) { decode(it2, dc); tp_load(dc, va, f_lane); } tp_finish(dn, vb, scr, f_lane); }
        }
    }
    { const f32x8* src = (const f32x8*)P_wq; u32x4* dst = (u32x4*)(ws + WS_WQ_B);
      for (long i = gt; i < (long)4 * 2048 * 2048 / 8; i += 4 * NGT) { f32x8 v[4];
#pragma unroll
          for (int u = 0; u < 4; ++u) v[u] = src[min(i + u * NGT, (long)4 * 2048 * 2048 / 8 - 1)];
#pragma unroll
          for (int u = 0; u < 4; ++u) if (i + u * NGT < (long)4 * 2048 * 2048 / 8) { u32x4 o; o.x = cvt_pk_bf16(v[u][0], v[u][1]); o.y = cvt_pk_bf16(v[u][2], v[u][3]); o.z = cvt_pk_bf16(v[u][4], v[u][5]); o.w = cvt_pk_bf16(v[u][6], v[u][7]); dst[i + u * NGT] = o; } } }
    { bf16_t* HB = (bf16_t*)(ws + WS_HB); float* rss0 = (float*)(ws + WS_RSSP);
      for (int row = gw; row < MTOK; row += NGW) { const f32x4* xr = (const f32x4*)(P_x + (size_t)row * DM) + f_lane; float ss = 0.f; f32x4 xv[8];
#pragma unroll
          for (int j = 0; j < 8; ++j) xv[j] = xr[64 * j];
#pragma unroll
          for (int j = 0; j < 8; ++j) { const f32x4 v = xv[j]; ss += (v[0] * v[0] + v[1] * v[1]) + (v[2] * v[2] + v[3] * v[3]); *(u32x2*)(HB + (size_t)row * DM + (j * 64 + f_lane) * 4) = pack4(v); }
          ss = wave_sum(ss); if (f_lane < 32) rss0[(size_t)row * 32 + f_lane] = f_lane == 0 ? ss : 0.f; } }
    { bf16_t* MN = (bf16_t*)(ws + WS_MEMN);
      for (int row = gw; row < BATCH * MEML; row += NGW) { const f32x4* xr = (const f32x4*)(P_mem + (size_t)row * DM) + f_lane; f32x4 v[8]; float ss = 0.f;
#pragma unroll
          for (int j = 0; j < 8; ++j) { v[j] = xr[64 * j]; ss += (v[j][0] * v[j][0] + v[j][1] * v[j][1]) + (v[j][2] * v[j][2] + v[j][3] * v[j][3]); }
          const float rstd = 1.0f / sqrtf(wave_sum(ss) * (1.0f / DM) + NORM_EPS);
#pragma unroll
          for (int j = 0; j < 8; ++j) *(u32x2*)(MN + (size_t)row * DM + (j * 64 + f_lane) * 4) = pack4(v[j] * rstd); } }
}


__device__ __forceinline__ void s5_tables_task(const Frame& F, const Ptrs& P, int i, int g) {
    FRAME_TID();
    unsigned char* ws = P.ws;
    LAS f32x2* LPs = (LAS f32x2*)(F.lds);
    LAS f32x2* BBs = (LAS f32x2*)(F.lds + 33792);
    LAS f32x2* CCs = (LAS f32x2*)(F.lds + 50176);
    LAS float* KTs = (LAS float*)(F.lds + 66560);
    LAS f32x2* Qs = (LAS f32x2*)(F.lds + 132096);
    const int t = f_tid;
    for (int e = t; e < 2 * 64 * 33; e += 512) { const int d = e / (64 * 33), rem = e - d * (64 * 33), p = rem / 33, tau = rem - p * 33; const int gd = (i * 2 + d) * 64 + g, idx = gd * 64 + p;
        const float st = expf(P_log_step[gd]), a = P_lam_re[idx] * st, b = P_lam_im[idx] * st; const float mag = expf((float)tau * a), ang = (float)tau * b; LPs[e] = (f32x2){mag * cosf(ang), mag * sinf(ang)}; }
    if (t < 128) { const int d = t >> 6, p = t & 63, gd = (i * 2 + d) * 64 + g, idx = gd * 64 + p; const float st = expf(P_log_step[gd]), lr = P_lam_re[idx], li = P_lam_im[idx], a = lr * st, b = li * st;
        const float sh = sinf(0.5f * b), nr = expm1f(a) * cosf(b) - 2.0f * sh * sh, ni = expf(a) * sinf(b), den = lr * lr + li * li;
        Qs[t] = (f32x2){(nr * lr + ni * li) / den, (ni * lr - nr * li) / den}; }
    for (int e = t; e < 2048; e += 512) { const int d = e >> 10, n = (e >> 6) & 15, p = e & 63; const size_t ci = ((size_t)((i * 2 + d) * 64 + g) * 16 + n) * 64 + p; CCs[e] = (f32x2){P_c_re[ci], P_c_im[ci]}; }
    LDS_WAIT(); __syncthreads();
    for (int e = t; e < 2048; e += 512) { const int d = e >> 10, p = (e >> 4) & 63, n = e & 15; const size_t bi = ((size_t)((i * 2 + d) * 64 + g) * 64 + p) * 16 + n; const f32x2 q = Qs[d * 64 + p];
        const float br = P_b_re[bi], bim = P_b_im[bi]; BBs[e] = (f32x2){q.x * br - q.y * bim, q.x * bim + q.y * br}; }
    if (t < 128) { const int d = t >> 6, p = t & 63; ((f32x2*)(ws + WS_LP))[((size_t)(i * 2 + d) * 64 + g) * 64 + p] = LPs[(d * 64 + p) * 33 + 32]; }
    LDS_WAIT(); __syncthreads();
    {
        const int d = t >> 8, no = (t >> 4) & 15, ni = t & 15; float acc[32];
#pragma unroll
        for (int tau = 0; tau < 32; ++tau) acc[tau] = 0.f;
#pragma unroll 2
        for (int p = 0; p < 64; ++p) { const f32x2 c = CCs[(d * 16 + no) * 64 + p], bb = BBs[(d * 64 + p) * 16 + ni]; const float wr = c.x * bb.x - c.y * bb.y, wi = c.x * bb.y + c.y * bb.x;
            const LAS f32x2* lp = LPs + (d * 64 + p) * 33;
#pragma unroll
            for (int tau = 0; tau < 32; ++tau) { const f32x2 L = lp[tau]; acc[tau] += wr * L.x - wi * L.y; } }
#pragma unroll
        for (int tau = 0; tau < 32; ++tau) KTs[(d * 32 + tau) * 256 + no * 16 + ni] = acc[tau];
    }
    LDS_WAIT(); __syncthreads();
    bf16_t* BTE = (bf16_t*)(ws + WS_BTE) + (size_t)(i * 64 + g) * 256 * 512;
    for (int c8 = t; c8 < 256 * 64; c8 += 512) { const int k8 = c8 & 63, j = c8 >> 6, s = k8 >> 1, n0 = (k8 & 1) * 8, which = j >> 6, p = j & 63, d = which >> 1, ex = d == 0 ? 31 - s : s;
        const f32x2 lp = LPs[(d * 64 + p) * 33 + ex]; float v[8];
#pragma unroll
        for (int q = 0; q < 8; ++q) { const f32x2 bb = BBs[(d * 64 + p) * 16 + n0 + q]; v[q] = (which & 1) ? (lp.x * bb.y + lp.y * bb.x) : (lp.x * bb.x - lp.y * bb.y); }
        u32x4 o; o.x = cvt_pk_bf16(v[0], v[1]); o.y = cvt_pk_bf16(v[2], v[3]); o.z = cvt_pk_bf16(v[4], v[5]); o.w = cvt_pk_bf16(v[6], v[7]);
        *(u32x4*)(BTE + (size_t)j * 512 + k8 * 8) = o; }
    bf16_t* BTT = (bf16_t*)(ws + WS_BTT) + (size_t)(i * 64 + g) * 512 * S5KT;
    for (int c8 = t; c8 < 512 * 32; c8 += 512) { const int j8 = c8 & 31, row = c8 >> 5, tt = row >> 4, no = row & 15, j0 = j8 * 8, which = j0 >> 6, p0 = j0 & 63, d = which >> 1, ex = d == 0 ? tt + 1 : 32 - tt; float v[8];
#pragma unroll
        for (int q = 0; q < 8; ++q) { const int p = p0 + q; const f32x2 lp = LPs[(d * 64 + p) * 33 + ex], c = CCs[(d * 16 + no) * 64 + p]; v[q] = (which & 1) ? -(c.x * lp.y + c.y * lp.x) : (c.x * lp.x - c.y * lp.y); }
        u32x4 o; o.x = cvt_pk_bf16(v[0], v[1]); o.y = cvt_pk_bf16(v[2], v[3]); o.z = cvt_pk_bf16(v[4], v[5]); o.w = cvt_pk_bf16(v[6], v[7]);
        *(u32x4*)(BTT + (size_t)row * S5KT + 512 + j0) = o; }
    for (int c8 = t; c8 < 512 * 64; c8 += 512) { const int k8 = c8 & 63, row = c8 >> 6, tt = row >> 4, no = row & 15, s = k8 >> 1, ni0 = (k8 & 1) * 8; float v[8];
        if (s < tt) {
#pragma unroll
            for (int q = 0; q < 8; ++q) v[q] = KTs[(0 * 32 + (tt - s)) * 256 + no * 16 + ni0 + q];
        } else if (s > tt) {
#pragma unroll
            for (int q = 0; q < 8; ++q) v[q] = KTs[(1 * 32 + (s - tt)) * 256 + no * 16 + ni0 + q];
        } else { const float dv = P_s5_d[i * 1024 + g * 16 + no];
#pragma unroll
            for (int q = 0; q < 8; ++q) v[q] = KTs[no * 16 + ni0 + q] + KTs[32 * 256 + no * 16 + ni0 + q] + ((ni0 + q == no) ? dv : 0.f); }
        u32x4 o; o.x = cvt_pk_bf16(v[0], v[1]); o.y = cvt_pk_bf16(v[2], v[3]); o.z = cvt_pk_bf16(v[4], v[5]); o.w = cvt_pk_bf16(v[6], v[7]);
        *(u32x4*)(BTT + (size_t)row * S5KT + k8 * 8) = o; }
}

__device__ __forceinline__ void p1_thin(const Frame& F, const Ptrs& P) {
    FRAME_TID();
    unsigned char* ws = P.ws; const long gt = (long)F.vcu * 512 + f_tid, NGT = (long)F.G * 512;
    const f32x2* LP = (const f32x2*)(ws + WS_LP); const f32x2* BB = (const f32x2*)(ws + WS_BBAR);
    float* KT = (float*)(ws + WS_KTAB);
    for (long e = gt; e < (long)2 * 2 * 64 * 32 * 256; e += NGT) {
        const int ni = (int)(e & 15), no = (int)((e >> 4) & 15), tau = (int)((e >> 8) & 31); const long igd = e >> 13;
        float acc = 0.f;
#pragma unroll 4
        for (int p = 0; p < 64; ++p) { const long idx = igd * 64 + p; const f32x2 lp = LP[idx * 33 + tau], bb = BB[idx * 16 + ni];
            const float xr = lp.x * bb.x - lp.y * bb.y, xi = lp.x * bb.y + lp.y * bb.x;
            const float cr = P_c_re[(igd * 16 + no) * 64 + p], ci = P_c_im[(igd * 16 + no) * 64 + p];
            acc += cr * xr - ci * xi; }
        KT[e] = acc;
    }
    bf16_t* BTE = (bf16_t*)(ws + WS_BTE);
    for (long e = gt; e < (long)2 * 64 * 256 * 64; e += NGT) {
        const int k8 = (int)(e & 63), j = (int)((e >> 6) & 255), g = (int)((e >> 14) & 63), i = (int)(e >> 20);
        const int s = k8 >> 1, n0 = (k8 & 1) * 8, which = j >> 6, p = j & 63, d = which >> 1, ex = d == 0 ? 31 - s : s;
        const long idx = ((long)(i * 2 + d) * 64 + g) * 64 + p; const f32x2 lp = LP[idx * 33 + ex];
        float v[8];
#pragma unroll
        for (int q = 0; q < 8; ++q) { const f32x2 bb = BB[idx * 16 + n0 + q]; v[q] = (which & 1) ? (lp.x * bb.y + lp.y * bb.x) : (lp.x * bb.x - lp.y * bb.y); }
        u32x4 o; o.x = cvt_pk_bf16(v[0], v[1]); o.y = cvt_pk_bf16(v[2], v[3]); o.z = cvt_pk_bf16(v[4], v[5]); o.w = cvt_pk_bf16(v[6], v[7]);
        *(u32x4*)(BTE + (((size_t)(i * 64 + g) * 256 + j) * 512 + k8 * 8)) = o;
    }
    bf16_t* BTT = (bf16_t*)(ws + WS_BTT);
    for (long e = gt; e < (long)2 * 64 * 512 * 32; e += NGT) {
        const int j8 = (int)(e & 31), row = (int)((e >> 5) & 511), g = (int)((e >> 14) & 63), i = (int)(e >> 20);
        const int t = row >> 4, no = row & 15, j0 = j8 * 8, which = j0 >> 6, p0 = j0 & 63, d = which >> 1, ex = d == 0 ? t + 1 : 32 - t;
        const long igd = (long)(i * 2 + d) * 64 + g;
        float v[8];
#pragma unroll
        for (int q = 0; q < 8; ++q) { const int p = p0 + q; const f32x2 lp = LP[(igd * 64 + p) * 33 + ex];
            const float cr = P_c_re[(igd * 16 + no) * 64 + p], ci = P_c_im[(igd * 16 + no) * 64 + p];
            v[q] = (which & 1) ? -(cr * lp.y + ci * lp.x) : (cr * lp.x - ci * lp.y); }
        u32x4 o; o.x = cvt_pk_bf16(v[0], v[1]); o.y = cvt_pk_bf16(v[2], v[3]); o.z = cvt_pk_bf16(v[4], v[5]); o.w = cvt_pk_bf16(v[6], v[7]);
        *(u32x4*)(BTT + (((size_t)(i * 64 + g) * 512 + row) * S5KT + 512 + j0)) = o;
    }
}
__device__ __forceinline__ void p2_thin(const Frame& F, const Ptrs& P) {
    FRAME_TID();
    unsigned char* ws = P.ws; const long gt = (long)F.vcu * 512 + f_tid, NGT = (long)F.G * 512;
    const float* KT = (const float*)(ws + WS_KTAB); bf16_t* BTT = (bf16_t*)(ws + WS_BTT);
    for (long e = gt; e < (long)2 * 64 * 512 * 64; e += NGT) {
        const int k8 = (int)(e & 63), row = (int)((e >> 6) & 511), g = (int)((e >> 15) & 63), i = (int)(e >> 21);
        const int t = row >> 4, no = row & 15, s = k8 >> 1, ni0 = (k8 & 1) * 8;
        f32x8 v;
        if (s < t) v = *(const f32x8*)(KT + ((((size_t)(i * 2 + 0) * 64 + g) * 32 + (t - s)) * 256 + no * 16 + ni0));
        else if (s > t) v = *(const f32x8*)(KT + ((((size_t)(i * 2 + 1) * 64 + g) * 32 + (s - t)) * 256 + no * 16 + ni0));
        else { v = *(const f32x8*)(KT + ((((size_t)(i * 2 + 0) * 64 + g) * 32) * 256 + no * 16 + ni0)) + *(const f32x8*)(KT + ((((size_t)(i * 2 + 1) * 64 + g) * 32) * 256 + no * 16 + ni0));
            const float dv = P_s5_d[i * 1024 + g * 16 + no];
#pragma unroll
            for (int q = 0; q < 8; ++q) v[q] += (ni0 + q == no) ? dv : 0.f; }
        u32x4 o; o.x = cvt_pk_bf16(v[0], v[1]); o.y = cvt_pk_bf16(v[2], v[3]); o.z = cvt_pk_bf16(v[4], v[5]); o.w = cvt_pk_bf16(v[6], v[7]);
        *(u32x4*)(BTT + (((size_t)(i * 64 + g) * 512 + row) * S5KT + k8 * 8)) = o;
    }
}
__device__ __forceinline__ void s5_scan(const Frame& F, const Ptrs& P, int i) {
    FRAME_TID();
    unsigned char* ws = P.ws;
    if (F.wave != 0) return;
    const f32x2* LP = (const f32x2*)(ws + WS_LP); const float* E = (const float*)(ws + WS_E); bf16_t* U2 = (bf16_t*)(ws + WS_U2);
    for (int w = F.vcu; w < 256; w += F.G) {
        const int b = w >> 7, g = (w >> 1) & 63, d = w & 1, p = f_lane;
        const f32x2 a = LP[(((long)(i * 2 + d) * 64 + g) * 64 + p)];
        const size_t r0 = (size_t)g * S5NCH + b * 256;
        float cr = 0.f, ci = 0.f;
        if (d == 0) {
#pragma unroll 8
            for (int c = 0; c < 256; ++c) { const size_t r = r0 + c;
                U2[r * S5KT + 512 + p] = (bf16_t)f2bf(cr); U2[r * S5KT + 576 + p] = (bf16_t)f2bf(ci);
                const float er = E[r * 256 + p], ei = E[r * 256 + 64 + p];
                const float nr = a.x * cr - a.y * ci + er, nim = a.x * ci + a.y * cr + ei; cr = nr; ci = nim; }
        } else {
#pragma unroll 8
            for (int c = 255; c >= 0; --c) { const size_t r = r0 + c;
                U2[r * S5KT + 640 + p] = (bf16_t)f2bf(cr); U2[r * S5KT + 704 + p] = (bf16_t)f2bf(ci);
                const float er = E[r * 256 + 128 + p], ei = E[r * 256 + 192 + p];
                const float nr = a.x * cr - a.y * ci + er, nim = a.x * ci + a.y * cr + ei; cr = nr; ci = nim; }
        }
    }
}
__device__ __forceinline__ void s5_scan_local(const Frame& F, const Ptrs& P, int i, int b, int g) {
    FRAME_TID();
    unsigned char* ws = P.ws;
    if (F.wave > 1) return;
    const f32x2* LP = (const f32x2*)(ws + WS_LP); const float* E = (const float*)(ws + WS_E); bf16_t* U2 = (bf16_t*)(ws + WS_U2);
    const int d = F.wave, p = f_lane;
    const f32x2 a = LP[(((long)(i * 2 + d) * 64 + g) * 64 + p)];
    const size_t r0 = (size_t)g * S5NCH + b * 256;
    float cr = 0.f, ci = 0.f;
    float era[16], eia[16], erb[16], eib[16];
#define S5_LD(ER, EI, blk) do { _Pragma("unroll") for (int q = 0; q < 16; ++q) { const int c = d == 0 ? (blk) * 16 + q : 255 - ((blk) * 16 + q); const size_t r = r0 + c; \
        ER[q] = E[r * 256 + d * 128 + p]; EI[q] = E[r * 256 + d * 128 + 64 + p]; } } while (0)
#define S5_SCAN(ER, EI, blk) do { _Pragma("unroll") for (int q = 0; q < 16; ++q) { const int c = d == 0 ? (blk) * 16 + q : 255 - ((blk) * 16 + q); const size_t r = r0 + c; \
        U2[r * S5KT + 512 + d * 128 + p] = (bf16_t)f2bf(cr); U2[r * S5KT + 576 + d * 128 + p] = (bf16_t)f2bf(ci); \
        const float nr = a.x * cr - a.y * ci + ER[q], nim = a.x * ci + a.y * cr + EI[q]; cr = nr; ci = nim; } } while (0)
    S5_LD(era, eia, 0);
#pragma unroll 1
    for (int blk = 0; blk < 16; blk += 2) {
        S5_LD(erb, eib, blk + 1);
        S5_SCAN(era, eia, blk);
        if (blk + 2 < 16) S5_LD(era, eia, blk + 2);
        S5_SCAN(erb, eib, blk + 1);
    }
#undef S5_LD
#undef S5_SCAN
}
__device__ __forceinline__ void diff_combine(const Frame& F, const Ptrs& P, int i, int layer) {
    FRAME_TID();
    unsigned char* ws = P.ws; const int gw = F.vcu * 8 + F.wave, NGW = F.G * 8;
    const float* lv = P_dlam + i * 512;
    float d01 = lv[f_lane] * lv[128 + f_lane] + lv[64 + f_lane] * lv[192 + f_lane], d23 = lv[256 + f_lane] * lv[384 + f_lane] + lv[320 + f_lane] * lv[448 + f_lane];
    d01 = wave_sum(d01); d23 = wave_sum(d23);
    int ly_ = layer; asm volatile("" : "+s"(ly_));
    const float linit = ly_ == 0 ? 2.000000000e-01f : ly_ == 1 ? 3.555090676e-01f : ly_ == 2 ? 4.707130183e-01f : 5.560582042e-01f;
    const float lam = __builtin_bit_cast(float, __builtin_amdgcn_readfirstlane(__builtin_bit_cast(int, expf(d01) - expf(d23) + linit)));
    const bf16_t* O1 = (const bf16_t*)(ws + WS_O12); const bf16_t* O2 = O1 + (size_t)MTOK * 1024; bf16_t* CAT = (bf16_t*)(ws + WS_CAT);
    for (int task = gw; task < MTOK * 4; task += NGW) {
        const int tok = task >> 2, h = task & 3; const size_t off = (size_t)tok * 1024 + h * 256 + f_lane * 4;
        const u32x2 a = *(const u32x2*)(O1 + off), b = *(const u32x2*)(O2 + off);
        f32x4 v; v[0] = bf2f(a.x & 0xffffu) - lam * bf2f(b.x & 0xffffu); v[1] = bf2f(a.x >> 16) - lam * bf2f(b.x >> 16); v[2] = bf2f(a.y & 0xffffu) - lam * bf2f(b.y & 0xffffu); v[3] = bf2f(a.y >> 16) - lam * bf2f(b.y >> 16);
        const float ss = wave_sum((v[0] * v[0] + v[1] * v[1]) + (v[2] * v[2] + v[3] * v[3]));
        const float rstd = 1.0f / sqrtf(ss * (1.0f / 256.0f) + NORM_EPS);
        const f32x4 gsub = *(const f32x4*)(P_subln + i * 256 + f_lane * 4) * (1.0f - linit);
        *(u32x2*)(CAT + (size_t)tok * DM + 1024 + h * 256 + f_lane * 4) = pack4(v * rstd * gsub);
    }
}
__device__ __forceinline__ void dilated_merge(const Frame& F, const Ptrs& P) {
    FRAME_TID();
    unsigned char* ws = P.ws; const int gw = F.vcu * 8 + F.wave, NGW = F.G * 8;
    const bf16_t* OB = (const bf16_t*)(ws + WS_OB); const float* LSE = (const float*)(ws + WS_LSE); bf16_t* CAT = (bf16_t*)(ws + WS_CAT);
    const int pmg = (F.G == 256) ? (8 * ((int)blockIdx.x & 7) + (((int)blockIdx.x >> 3) & 7)) * 256 + ((int)blockIdx.x >> 6) * 64 : -1;
    for (int it = 0; it < (pmg >= 0 ? 8 : (MTOK + NGW - 1) / NGW); ++it) { const int tok = pmg >= 0 ? pmg + it * 8 + F.wave : gw + it * NGW; if (tok >= MTOK) break;
        u32x4 av[4], bv[4], cv[4]; float l0v[4], l1v[4], l2v[4];
#pragma unroll
        for (int k = 0; k < 4; ++k) { const int ci = f_lane + 64 * k, col = ci * 8, h = ci >> 4;
            l0v[k] = LSE[(size_t)tok * 16 + h]; l1v[k] = LSE[((size_t)MTOK + tok) * 16 + h]; l2v[k] = LSE[((size_t)2 * MTOK + tok) * 16 + h];
            av[k] = *(const u32x4*)(OB + (size_t)tok * DM + col); bv[k] = *(const u32x4*)(OB + ((size_t)MTOK + tok) * DM + col); cv[k] = *(const u32x4*)(OB + ((size_t)2 * MTOK + tok) * DM + col); }
#pragma unroll
        for (int k = 0; k < 4; ++k) { const int ci = f_lane + 64 * k, col = ci * 8;
            const float l0 = l0v[k], l1 = l1v[k], l2 = l2v[k];
            const float mx = fmaxf(l0, fmaxf(l1, l2)); float w0 = __expf(l0 - mx), w1 = __expf(l1 - mx), w2 = __expf(l2 - mx); const float inv = 1.0f / (w0 + w1 + w2); w0 *= inv; w1 *= inv; w2 *= inv;
            const u32x4 a = av[k], b = bv[k], c = cv[k];
            u32x4 o;
#pragma unroll
            for (int q = 0; q < 4; ++q) { const float lo = w0 * bf2f(a[q] & 0xffffu) + w1 * bf2f(b[q] & 0xffffu) + w2 * bf2f(c[q] & 0xffffu), hi = w0 * bf2f(a[q] >> 16) + w1 * bf2f(b[q] >> 16) + w2 * bf2f(c[q] >> 16); o[q] = cvt_pk_bf16(lo, hi); }
            *(u32x4*)(CAT + (size_t)tok * DM + col) = o; }
    }
}
__device__ __forceinline__ void final_norm(const Frame& F, const Ptrs& P) {
    FRAME_TID();
    unsigned char* ws = P.ws; const int gw = F.vcu * 8 + F.wave, NGW = F.G * 8;
    const bf16_t* HB = (const bf16_t*)(ws + WS_HB); const float* rss = (const float*)(ws + WS_RSSP) + (size_t)12 * MTOK * 32;
    f32x4 gn[8];
#pragma unroll
    for (int j = 0; j < 8; ++j) gn[j] = *(const f32x4*)(P_fin_g + (j * 64 + f_lane) * 4);
    for (int row = gw; row < MTOK; row += NGW) {
        u32x2 w[8]; const float part = f_lane < 32 ? rss[(size_t)row * 32 + f_lane] : 0.f;
#pragma unroll
        for (int j = 0; j < 8; ++j) w[j] = *(const u32x2*)(HB + (size_t)row * DM + (j * 64 + f_lane) * 4);
        const float rstd = 1.0f / sqrtf(wave_sum(part) * (1.0f / DM) + NORM_EPS);
#pragma unroll
        for (int j = 0; j < 8; ++j) { const f32x4 h = {bf2f(w[j].x & 0xffffu), bf2f(w[j].x >> 16), bf2f(w[j].y & 0xffffu), bf2f(w[j].y >> 16)};
            *(f32x4*)(P.out + (size_t)row * DM + (j * 64 + f_lane) * 4) = h * rstd * gn[j]; } }
}
#ifndef SITES
#define SITES 0xFFFFFFFF
#endif


struct ListOrder {
    int n, pm, g; const char* A; size_t astep; const char* B; size_t bstep; int pn0;
    __device__ __forceinline__ bool next(int i, pg8::Unit& u) const { if (i >= n) return false; u.pm = pm; u.pn = pn0 + i; u.g = g; u.a = A + (size_t)i * astep; u.b = B + (size_t)(pn0 + i) * bstep; return true; }
};
struct WqKOrder {
    int G, c; const char* KV; const char* WQ;
    __device__ __forceinline__ bool next(int i, pg8::Unit& u) const {
        const int L = i * G + c; if (L >= 256) return false;
        u.g = L >> 3; u.pn = L & 7; u.pm = 0; const int l = u.g >> 3, b = (u.g >> 2) & 1, h = u.g & 3;
        u.a = KV + ((size_t)(b * 256) * 16384 + l * 4096 + h * 512) * 2;
        u.b = WQ + ((size_t)l * 2048 * 2048 + (size_t)u.pn * 256 * 2048 + h * 512) * 2; return true; }
};
struct VWoOrder {
    int G, c; const char* KV; const char* WO;
    __device__ __forceinline__ bool next(int i, pg8::Unit& u) const {
        const int L = i * G + c; if (L >= 256) return false;
        u.g = L >> 3; u.pm = L & 7; u.pn = 0; const int l = u.g >> 3, b = (u.g >> 2) & 1, h = u.g & 3;
        u.a = WO + ((size_t)l * 2048 * 2048 + (size_t)u.pm * 256 * 2048 + h * 512) * 2;
        u.b = KV + ((size_t)(b * 256) * 16384 + l * 4096 + 2048 + h * 512) * 2; return true; }
};


#ifndef DBG_RT
#define DBG_RT 0
#endif
#ifndef REP_P0
#define REP_P0 1
#endif
#ifndef REP_F1
#define REP_F1 1
#endif
#ifndef REP_DATT
#define REP_DATT 1
#endif
#ifndef REP_DIL
#define REP_DIL 1
#endif
#ifndef REP_PROJ
#define REP_PROJ 1
#endif
#ifndef REP_X1
#define REP_X1 1
#endif
#ifndef REP_S5
#define REP_S5 1
#endif
#ifndef REP_P12
#define REP_P12 1
#endif
#ifndef USE_GROUP_SYNC
#define USE_GROUP_SYNC 1
#endif
#ifndef REP_THIN
#define REP_THIN 1
#endif
#ifndef REP_DIL_IN
#define REP_DIL_IN 1
#endif
#ifndef DBG_STOP
#define DBG_STOP 0
#endif
#ifndef DBG_LAYER
#define DBG_LAYER 0
#endif
#ifndef DBG_SUB
#define DBG_SUB 0
#endif
#if DBG_RT
#ifndef DBG_X
#define DBG_X 0
#endif
__device__ int g_dbg[4] = {DBG_STOP, DBG_LAYER, DBG_SUB, DBG_X};
#endif
__device__ __forceinline__ void dbg_dump_bf(float* out, const bf16_t* a, size_t na, const bf16_t* b, size_t nb, int vcu, int G) {
    for (size_t j = (size_t)vcu * 512 + threadIdx.x; j < (size_t)MTOK * DM; j += (size_t)G * 512) { float v = bf2f(a[j % na]); if (b) v += bf2f(b[j % nb]); out[j] = v; }
}
__device__ __forceinline__ void dbg_dump_f32(float* out, const float* a, int vcu, int G) {
    for (size_t j = (size_t)vcu * 512 + threadIdx.x; j < (size_t)MTOK * DM; j += (size_t)G * 512) out[j] = a[j];
}
__global__ void __launch_bounds__(512, 2) mega_fwd(Args args) {
    extern __shared__ __attribute__((aligned(16))) unsigned char lds_raw[];
    Frame F; F.lds = (LAS unsigned char*)lds_raw; F.wave = __builtin_amdgcn_readfirstlane((int)threadIdx.x >> 6);
    F.G = gridDim.x; { const int bx = blockIdx.x; F.vcu = (F.G % 8 == 0) ? (bx % 8) * (F.G / 8) + bx / 8 : bx; }
    const Args& P = args;
    typedef __attribute__((address_space(1))) unsigned char gws_t;
    gws_t* const ws0 = (gws_t*)args.ws; gws_t* ws = ws0;
    if (threadIdx.x < 16) ((LAS unsigned*)(F.lds + LDS_MISC))[threadIdx.x] = 0u;
    __syncthreads();
    XcdBarrier bar = xcd_barrier_post((unsigned*)(ws + WS_CTL), (volatile LAS unsigned*)(F.lds + LDS_MISC));
#if defined(BAR2)
#define GRID_BAR() do { xcd_barrier(bar); xcd_barrier(bar); } while (0)
#else
#define GRID_BAR() xcd_barrier(bar)
#endif
    if (threadIdx.x == 0) __hip_atomic_store((unsigned*)(ws + WS_CTL) + GS_XCC_WORD + blockIdx.x, xb_xcc_id() + 1u, __ATOMIC_RELAXED, __HIP_MEMORY_SCOPE_AGENT);
    const int bx = (int)blockIdx.x;
#if DBG_RT
    const int dbg_stop = __builtin_amdgcn_readfirstlane(((volatile int*)g_dbg)[0]), dbg_layer = __builtin_amdgcn_readfirstlane(((volatile int*)g_dbg)[1]), dbg_sub = __builtin_amdgcn_readfirstlane(((volatile int*)g_dbg)[2]), dbg_x = __builtin_amdgcn_readfirstlane(((volatile int*)g_dbg)[3]);
#endif
    float* RSS = (float*)(ws + WS_RSSP);
    bf16_t* HB = (bf16_t*)(ws + WS_HB); float* H = (float*)(ws + WS_H); bf16_t* CAT = (bf16_t*)(ws + WS_CAT); bf16_t* XP = (bf16_t*)(ws + WS_XP);
    const float* rc = (const float*)(ws + WS_ROPE); const float* rs = rc + SEQ * 16;

#if defined(DBG_FILL)
    { u32x4* p = (u32x4*)(ws + MiB); const size_t n = (WS_END - MiB) / 16; const unsigned pat = DBG_FILL; for (size_t j = (size_t)F.vcu * 512 + threadIdx.x; j < n; j += (size_t)F.G * 512) p[j] = (u32x4){pat, pat, pat, pat}; }
    GRID_BAR();
#endif

#if (SITES >> 0) & 1
#if !defined(S5TAB_IN_P1)
    if (bx < 128) { s5_tables_task(F, P, bx >> 6, bx & 63); asm volatile("s_waitcnt vmcnt(0) lgkmcnt(0)" ::: "memory"); __syncthreads(); }
#endif
    _Pragma("unroll 1") for (int rp = 0; rp < REP_P0; ++rp) p0_prologue(F, P);
#endif

    GRID_BAR();
    bool use_group;
    {   int t_ = threadIdx.x; asm volatile("" : "+v"(t_));
        int okv = 1;
        if (t_ < 256) { const unsigned* xw = (const unsigned*)(ws + WS_CTL) + GS_XCC_WORD; const unsigned a = __hip_atomic_load(xw + t_, __ATOMIC_RELAXED, __HIP_MEMORY_SCOPE_AGENT), b0 = __hip_atomic_load(xw + (t_ & 63), __ATOMIC_RELAXED, __HIP_MEMORY_SCOPE_AGENT); okv = (a == b0) && (a != 0u); }
        use_group = (__syncthreads_and(okv) != 0) && (F.G == 256) && (USE_GROUP_SYNC != 0); }
    unsigned gs_epoch = 0;
    const int gs_gid = bx & 63;
#define CHAIN_BAR() do { if (use_group) { ++gs_epoch; group_sync((unsigned*)(ws + WS_CTL), gs_gid, 4u * gs_epoch); } else { GRID_BAR(); } } while (0)
    _Pragma("unroll 1") for (int rp12 = 0; rp12 < REP_P12; ++rp12) {

#if defined(S5TAB_IN_P1)
    if (bx < 128) s5_tables_task(F, P, bx >> 6, bx & 63);
    else
#else
    if (bx >= 128)
#endif
    {   pg8::DenseOrder S; S.init((const void*)(ws + WS_MEMN), 2048, (const void*)(ws + WS_WKV_T), 2048, BATCH * MEML, 16384, F.G - 128, bx - 128);
        EpiBf16Plain E{(bf16_t*)(ws + WS_KVALL), 16384, nullptr, 1.0f};
        pg8::gemm_phase(F.lds, 2048, 2048, 2048, S, E); }

    GRID_BAR();

#if (SITES >> 3) & 1
    {   WqKOrder S{F.G, bx, (const char*)(ws + WS_KVALL), (const char*)(ws + WS_WQ_B)}; EpiWqK E{(bf16_t*)(ws + WS_WQK), P_xa_g};
        pg8::gemm_phase(F.lds, 512, 16384, 2048, S, E); }
#endif


#if (SITES >> 4) & 1
    {   VWoOrder S{F.G, bx, (const char*)(ws + WS_KVALL), (const char*)(ws + WS_WO_T)}; EpiVWo E{(bf16_t*)(ws + WS_VWO)};
        pg8::gemm_phase(F.lds, 512, 2048, 16384, S, E); }
#endif


    GRID_BAR();
    }
#if DBG_RT
    if (dbg_stop == 1) {
    dbg_dump_bf(args.out, (const bf16_t*)(ws + WS_WQK), (size_t)16 << 20, (const bf16_t*)(ws + WS_VWO), (size_t)16 << 20, F.vcu, F.G); return;
    }
#endif
#if DBG_RT
    if (dbg_stop == 13) {
    dbg_dump_bf(args.out, (const bf16_t*)(ws + WS_W13) + (size_t)dbg_layer * 11264 * 2048, (size_t)11264 * 2048, (const bf16_t*)(ws + WS_W2) + (size_t)dbg_layer * 2048 * 5632, (size_t)2048 * 5632, F.vcu, F.G); return;
    }
#endif
#if DBG_RT
    if (dbg_stop == 14) {
    { const bf16_t* a = (const bf16_t*)(ws + WS_W13) + (size_t)dbg_layer * 11264 * 2048; const bf16_t* b = (const bf16_t*)(ws + WS_W2) + (size_t)dbg_layer * 2048 * 5632; for (size_t j = (size_t)F.vcu * 512 + threadIdx.x; j < (size_t)MTOK * DM; j += (size_t)F.G * 512) args.out[j] = 30.0f * (bf2f(a[j % ((size_t)11264 * 2048)]) + bf2f(b[j % ((size_t)2048 * 5632)])); return; }
    }
#endif
#if DBG_RT
    if (dbg_stop == 7) {
    dbg_dump_bf(args.out, (const bf16_t*)(ws + WS_BTT), (size_t)48 << 20, (const bf16_t*)(ws + WS_BTE), (size_t)16 << 20, F.vcu, F.G); return;
    }
#endif
#if DBG_RT
    if (dbg_stop == 8) {
    dbg_dump_bf(args.out, (const bf16_t*)(ws + WS_W13), (size_t)88 << 20, (const bf16_t*)(ws + WS_W2), (size_t)44 << 20, F.vcu, F.G); return;
    }
#endif

#pragma unroll 1
    for (int layer = 0; layer < DEPTH; ++layer) {
        const int i = layer >> 1; const bool even = (layer & 1) == 0;
#pragma unroll 1
        for (int sub = 0; sub < 3; ++sub) {
            gws_t* ws = ws0; asm volatile("" : "+s"(ws));
            const float* rss_cur = RSS + (size_t)(3 * layer + sub) * MTOK * 32; float* rss_next = RSS + (size_t)(3 * layer + sub + 1) * MTOK * 32;
            if (sub == 0) {

#if (SITES >> 6) & 1
#if DBG_RT
                const int nrep = ((dbg_x & 1) && layer == dbg_layer) ? 2 : 1, iw = ((dbg_x & 2) && layer == dbg_layer) ? 0 : i;
                if ((dbg_x & 4) && layer == dbg_layer) GRID_BAR();
#else
                const int nrep = REP_PROJ, iw = i;
#endif
#pragma unroll 1
                for (int rep = 0; rep < nrep; ++rep)
                {   const bf16_t* Bt = even ? (const bf16_t*)(ws + WS_W_IN) + (size_t)iw * 4096 * 2048 : (const bf16_t*)(ws + WS_W_QKV) + (size_t)iw * 6144 * 2048;
                    pg8::DenseOrder S; S.init(HB, 2048, Bt, 2048, MTOK, even ? 4096 : 6144, F.G, bx);
                    const float* rss_p = rss_cur;
#if DBG_RT
                    if ((dbg_x & 8) && layer == dbg_layer) rss_p = RSS + (size_t)6 * MTOK * 32;
#endif
                    { pg8::Unit u0; if (S.next(0, u0)) fill_rstd_tab(rss_p, u0.pm, (LAS float*)(F.lds + LDS_RSTD)); }
                    EpiProj E{(LAS const float*)(F.lds + LDS_RSTD), rc, rs, even ? (bf16_t*)(ws + WS_QKVE) : (bf16_t*)(ws + WS_QKVO), even ? 3072 : 6144, (bf16_t*)(ws + WS_U2), even ? 4 : 0, even ? 4 : 0, even ? 12 : 16};
                    pg8::gemm_phase(F.lds, 2048, 2048, 2048, S, E); }
#endif

                GRID_BAR();
#if DBG_RT
    if (dbg_stop == 10) {
                if (layer == dbg_layer) { unsigned* q = (unsigned*)(ws + WS_QKVO); for (size_t j = (size_t)F.vcu * 512 + threadIdx.x; j < (size_t)MTOK * DM / 2; j += (size_t)F.G * 512) { const unsigned w = __hip_atomic_fetch_or(q + j, 0u, __ATOMIC_RELAXED, __HIP_MEMORY_SCOPE_AGENT); args.out[2 * j] = bf2f(w & 0xffffu); args.out[2 * j + 1] = bf2f(w >> 16); } return; }
    }
#endif
#if DBG_RT
    if (dbg_stop == 2) {
                if (layer == dbg_layer) { if (even) dbg_dump_bf(args.out, (const bf16_t*)(ws + WS_U2), (size_t)24 << 20, (const bf16_t*)(ws + WS_QKVE), (size_t)48 << 20, F.vcu, F.G); else dbg_dump_bf(args.out, (const bf16_t*)(ws + WS_QKVO), (size_t)96 << 20, nullptr, 1, F.vcu, F.G); return; }
    }
#endif
                if (even) {
                    _Pragma("unroll 1") for (int rps = 0; rps < REP_S5; ++rps) {
                    {
                        const int pm = (bx >> 1) & 127, hf = bx & 1, g = pm >> 1, b = pm & 1;
                        {   ListOrder S{1, pm, g, (const char*)(ws + WS_U2) + (size_t)pm * 256 * S5KT * 2, 0, (const char*)((const bf16_t*)(ws + WS_BTE) + ((size_t)i * 64 + g) * 256 * 512), 0, 0};
                            EpiF32 E{(float*)(ws + WS_E), 256};
                            pg8::gemm_phase(F.lds, 512, S5KT, 512, S, E); }
                        asm volatile("s_waitcnt vmcnt(0)" ::: "memory"); __syncthreads();
                        s5_scan_local(F, P, i, b, g);
                        asm volatile("s_waitcnt vmcnt(0)" ::: "memory"); __syncthreads();
                        {   ListOrder S{1, pm, g, (const char*)(ws + WS_U2) + (size_t)pm * 256 * S5KT * 2, 0, (const char*)((const bf16_t*)(ws + WS_BTT) + ((size_t)i * 64 + g) * 512 * S5KT), (size_t)256 * S5KT * 2, hf};
                            EpiS5Y E{(bf16_t*)(ws + WS_G)};
                            pg8::gemm_phase(F.lds, S5KT, S5KT, S5KT, S, E); }
                    }
                    GRID_BAR();

#if (SITES >> 10) & 1
                    {   pg8::DenseOrder S; S.init((const void*)(ws + WS_G), 1024, (const bf16_t*)(ws + WS_W_GLU) + (size_t)i * 1024 * 1024, 1024, MTOK, 1024, F.G, bx);
                        EpiGlu E{(const bf16_t*)(ws + WS_G), P_glu_b + i * 1024, CAT};
                        pg8::gemm_phase(F.lds, 1024, 1024, 1024, S, E); }
#endif

                    if (rps + 1 < REP_S5) GRID_BAR();
                    }

#if (SITES >> 11) & 1
                    {   const bf16_t* QKV = (const bf16_t*)(ws + WS_QKVE); bf16_t* O12 = (bf16_t*)(ws + WS_O12);
                        float lam, gscale;
                        {   int t_ = threadIdx.x; asm volatile("" : "+v"(t_)); const int ln = t_ & 63; const float* lv = P_dlam + i * 512;
                            const float d01 = wave_sum(lv[ln] * lv[128 + ln] + lv[64 + ln] * lv[192 + ln]), d23 = wave_sum(lv[256 + ln] * lv[384 + ln] + lv[320 + ln] * lv[448 + ln]);
                            int ly_ = layer; asm volatile("" : "+s"(ly_)); const float linit = __builtin_bit_cast(float, ly_ == 0 ? 0x3e4ccccdu : 0x3ef1014cu);
                            lam = __builtin_bit_cast(float, __builtin_amdgcn_readfirstlane(__builtin_bit_cast(int, expf(d01) - expf(d23) + linit))); gscale = 1.0f - linit; }
                        _Pragma("unroll 1") for (int rp = 0; rp < REP_DATT; ++rp)
                        for (int unit = F.vcu; unit < 256; unit += F.G) {
                            const int binst = unit >> 5, qb = unit & 31, b = binst >> 2, h = binst & 3;
                            const bf16_t* Vh = QKV + (size_t)(b * SEQ) * 3072 + 2048 + h * 256;
                            bf16_t* Ob = O12 + ((size_t)b * SEQ + qb * 256) * 1024 + h * 256;
                            bf16_t* Cb = CAT + ((size_t)b * SEQ + qb * 256) * DM + 1024 + h * 256;
                            _Pragma("unroll 1") for (int c = 0; c < 2; ++c) {
                                const bf16_t* Qb = QKV + (size_t)(b * SEQ + qb * 256) * 3072 + (h * 2 + c) * 128;
                                const bf16_t* Kh = QKV + (size_t)(b * SEQ) * 3072 + 1024 + (h * 2 + c) * 128;
                                asm volatile("s_waitcnt vmcnt(0)" ::: "memory"); __syncthreads();
#if defined(W32)
                                att::attn_wide_body(Qb, Kh, Vh, 3072, SEQ / 64, Ob, 1024, (char*)lds_raw, c == 1, lam, gscale, P_subln + i * 256, Cb, DM);
#else
                                att::attn_wide16_body(Qb, Kh, Vh, 3072, SEQ / 64, Ob, 1024, (char*)lds_raw, c == 1, lam, gscale, P_subln + i * 256, Cb, DM);
#endif
                            }
                        } }
#endif

                    GRID_BAR();
                } else {

#if (SITES >> 13) & 1
#if !defined(BAND_WG) && !defined(BAND_WAVE)
                    {   const bf16_t* QKV = (const bf16_t*)(ws + WS_QKVO); bf16_t* OB = (bf16_t*)(ws + WS_OB); float* LSE = (float*)(ws + WS_LSE);
                        const int vcu_ = F.vcu, G_ = F.G;
                        auto unit_of = [=](int i) -> att::BandUnit {
                            int br, b, h, r, qb2;
                            if (G_ == 256) { const int x = vcu_ >> 5, Lx = i * 32 + (vcu_ & 31), c48 = Lx / 48, cg = x * 8 + c48, m = Lx - c48 * 48, qs = m & 15, half = cg & 1; br = m >> 4; b = cg >> 5; h = (cg >> 1) & 15;
                                const int sh = 2 * br; qb2 = (half << (4 - sh)) + (qs >> sh); r = qs & ((1 << sh) - 1); }
                            else { const int unit = vcu_ + i * G_, g32 = unit >> 5, rq = unit & 31; br = g32 >> 5; b = (g32 >> 4) & 1; h = g32 & 15; const int sh = 2 * br; r = rq >> (5 - sh); qb2 = rq & ((32 >> sh) - 1); }
                            const int sh2 = 2 * br, dil = 1 << sh2, Mr = SEQ >> sh2;
                            const size_t tok0 = (size_t)b * SEQ + r, tokq = tok0 + ((size_t)(qb2 * 256) << sh2);
                            att::BandUnit u; u.Q = QKV + tokq * 6144 + h * 128; u.K = QKV + tok0 * 6144 + 2048 + h * 128; u.V = QKV + tok0 * 6144 + 4096 + h * 128;
                            u.O = OB + ((size_t)br * MTOK + tokq) * DM + h * 128; u.L = LSE + ((size_t)br * MTOK + tokq) * 16 + h;
                            u.ld = dil * 6144; u.ldo = dil * DM; u.ldl = dil * 16; u.kfirst = qb2 * 256 - 64; u.Mr = Mr; u.lsh = sh2; return u; };
                        const int U = vcu_ < 3072 ? (3072 - vcu_ + G_ - 1) / G_ : 0;
                        _Pragma("unroll 1") for (int rp = 0; rp < REP_DIL; ++rp) { __syncthreads(); att::attn_band16_stream(U, unit_of, (char*)lds_raw); } }
#else
                    {   const bf16_t* QKV = (const bf16_t*)(ws + WS_QKVO); bf16_t* OB = (bf16_t*)(ws + WS_OB); float* LSE = (float*)(ws + WS_LSE);
                        _Pragma("unroll 1") for (int rp = 0; rp < REP_DIL; ++rp)
                        for (int unit = F.vcu; unit < 3072; unit += F.G) {
                            const int g32 = unit >> 5, rq = unit & 31, br = g32 >> 5, b = (g32 >> 4) & 1, h = g32 & 15;
                            const int dil = 1 << (2 * br), Mr = SEQ / dil, nqb = Mr / 256, r = rq / nqb, qb2 = rq % nqb;
                            const size_t tok0 = (size_t)b * SEQ + r;
                            const size_t tokq = tok0 + (size_t)(qb2 * 256) * dil;
                            const bf16_t* Qb = QKV + tokq * 6144 + h * 128;
                            const bf16_t* Kh = QKV + tok0 * 6144 + 2048 + h * 128;
                            const bf16_t* Vh = QKV + tok0 * 6144 + 4096 + h * 128;
                            bf16_t* Ob = OB + ((size_t)br * MTOK + tokq) * DM + h * 128;
                            float* ls = LSE + ((size_t)br * MTOK + tokq) * 16 + h;
                            _Pragma("unroll 1") for (int rpi = 0; rpi < REP_DIL_IN; ++rpi) {
#if defined(DIL_PROBE)
                            att::attn_band_wave(Qb, 6144L, Kh, Vh, 6144L, qb2 * 256 - 64, Mr, (bf16_t*)(ws + WS_HID) + (size_t)(unit & 2047) * 32768, 128L, (float*)(ws + WS_HID + (160u << 20)) + (size_t)unit * 256, 1L, (char*)lds_raw);
#endif
#if defined(BAND_WG)
                            __syncthreads();
                            att::attn_band_body(Qb, (long)dil * 6144, Kh, Vh, (long)dil * 6144, qb2 * 256 - 64, Mr, Ob, (long)dil * DM, ls, (long)dil * 16, (char*)lds_raw);
#else
                            att::attn_band_wave(Qb, (long)dil * 6144, Kh, Vh, (long)dil * 6144, qb2 * 256 - 64, Mr, Ob, (long)dil * DM, ls, (long)dil * 16, (char*)lds_raw);
#endif
                            }
                        } }
#endif
#endif

                    GRID_BAR();

#if (SITES >> 14) & 1
                    _Pragma("unroll 1") for (int rpt = 0; rpt < REP_THIN; ++rpt) dilated_merge(F, P);
#endif

                    CHAIN_BAR();
                }
            } else if (sub == 1) {

#if (SITES >> 15) & 1
                _Pragma("unroll 1") for (int rp = 0; rp < REP_X1; ++rp)
                {   pg8::DenseOrder S; S.init(HB, 2048, (const bf16_t*)(ws + WS_WQK) + (size_t)layer * 2 * 1024 * 2048, 2048, MTOK, 1024, F.G, bx, 32, (size_t)1024 * 2048 * 2);
                    { pg8::Unit u0; if (S.next(0, u0)) fill_rstd_tab(rss_cur, u0.pm, (LAS float*)(F.lds + LDS_RSTD)); }
                    EpiSoftmax E{(LAS const float*)(F.lds + LDS_RSTD), XP, (LAS float*)(F.lds + LDS_EPI)};
                    pg8::gemm_phase(F.lds, 2048, 2048, 2048, S, E); }
#endif

                CHAIN_BAR();
            } else {

#if (SITES >> 16) & 1
                _Pragma("unroll 1") for (int rp = 0; rp < REP_F1; ++rp)
                {   pg8::DenseOrder S; S.init(HB, 2048, (const bf16_t*)(ws + WS_W13) + (size_t)layer * 11264 * 2048, 2048, MTOK, 11264, F.G, bx);
                    { pg8::Unit u0; if (S.next(0, u0)) fill_rstd_tab(rss_cur, u0.pm, (LAS float*)(F.lds + LDS_RSTD)); }
                    EpiSwiglu E{(LAS const float*)(F.lds + LDS_RSTD), (bf16_t*)(ws + WS_HID)};
                    pg8::gemm_phase(F.lds, 2048, 2048, 2048, S, E); }
#endif

                CHAIN_BAR();
            }
#if DBG_RT
    if (dbg_stop == 15) {
            if (layer == dbg_layer && sub == dbg_sub) { const bf16_t* a = (const bf16_t*)(ws + WS_W13) + (size_t)dbg_layer * 11264 * 2048; const bf16_t* b = (const bf16_t*)(ws + WS_W2) + (size_t)dbg_layer * 2048 * 5632; for (size_t j = (size_t)F.vcu * 512 + threadIdx.x; j < (size_t)MTOK * DM; j += (size_t)F.G * 512) args.out[j] = 30.0f * (bf2f(a[j % ((size_t)11264 * 2048)]) + bf2f(b[j % ((size_t)2048 * 5632)])); return; }
    }
#endif
#if DBG_RT
    if (dbg_stop == 3) {
            if (layer == dbg_layer && sub == dbg_sub) { if (sub == 0) dbg_dump_bf(args.out, CAT, (size_t)32 << 20, nullptr, 1, F.vcu, F.G); else if (sub == 1) dbg_dump_bf(args.out, XP, (size_t)16 << 20, nullptr, 1, F.vcu, F.G); else dbg_dump_bf(args.out, (const bf16_t*)(ws + WS_HID), (size_t)88 << 20, nullptr, 1, F.vcu, F.G); return; }
    }
#endif

#if (SITES >> 17) & 1
            {   const bf16_t* A; const bf16_t* Bt; int K, pmdiv = 1 << 30; size_t bgroup = 0;
                if (sub == 0) { A = CAT; K = 2048; Bt = even ? (const bf16_t*)(ws + WS_W_ABO) + (size_t)i * 2048 * 2048 : (const bf16_t*)(ws + WS_W_CO) + (size_t)i * 2048 * 2048; }
                else if (sub == 1) { A = XP; K = 1024; Bt = (const bf16_t*)(ws + WS_VWO) + (size_t)layer * 2 * 2048 * 1024; pmdiv = 32; bgroup = (size_t)2048 * 1024 * 2; }
                else { A = (const bf16_t*)(ws + WS_HID); K = FFN; Bt = (const bf16_t*)(ws + WS_W2) + (size_t)layer * 2048 * FFN; }
                pg8::DenseOrder S; S.init(A, K, Bt, K, MTOK, 2048, F.G, bx, pmdiv, bgroup);
                EpiRes E{(layer == 0 && sub == 0) ? P_x : (const float*)nullptr, HB, rss_next};
                pg8::gemm_phase(F.lds, K, K, K, S, E);
#if defined(REP_RES)
                { asm volatile("s_waitcnt vmcnt(0)" ::: "memory"); __syncthreads(); EpiRes E2 = E; E2.dry = true; pg8::gemm_phase(F.lds, K, K, K, S, E2); }
#endif
                }
#endif

            if (layer == DEPTH - 1 && sub == 2) { GRID_BAR(); } else { CHAIN_BAR(); }
#if DBG_RT
    if (dbg_stop == 12) {
            if (layer == dbg_layer && sub == dbg_sub) { for (size_t j = (size_t)F.vcu * 512 + threadIdx.x; j < (size_t)MTOK * DM; j += (size_t)F.G * 512) args.out[j] = 200.0f * (H[j] - P_x[j]); return; }
    }
#endif
#if DBG_RT
    if (dbg_stop == 16) {
            if (layer == dbg_layer && sub == dbg_sub) { for (size_t j = (size_t)F.vcu * 512 + threadIdx.x; j < (size_t)MTOK * DM; j += (size_t)F.G * 512) args.out[j] = 200.0f * bf2f(HB[j]); return; }
    }
#endif
#if DBG_RT
    if (dbg_stop == 17) {
            if (layer == dbg_layer && sub == dbg_sub) { unsigned* q = (unsigned*)HB; for (size_t j = (size_t)F.vcu * 512 + threadIdx.x; j < (size_t)MTOK * DM / 2; j += (size_t)F.G * 512) { const unsigned w = __hip_atomic_fetch_or(q + j, 0u, __ATOMIC_RELAXED, __HIP_MEMORY_SCOPE_AGENT); args.out[2 * j] = 200.0f * bf2f(w & 0xffffu); args.out[2 * j + 1] = 200.0f * bf2f(w >> 16); } return; }
    }
#endif
#if DBG_RT
    if (dbg_stop == 4) {
            if (layer == dbg_layer && sub == dbg_sub) { dbg_dump_f32(args.out, H, F.vcu, F.G); return; }
    }
#endif
#if DBG_RT
    if (dbg_stop == 5) {
            if (layer == dbg_layer && sub == dbg_sub) { dbg_dump_bf(args.out, HB, (size_t)32 << 20, nullptr, 1, F.vcu, F.G); __syncthreads(); if (blockIdx.x < 32) { const int j = blockIdx.x * 512 + threadIdx.x; args.out[j] = rss_next[j]; } return; }
    }
#endif
#if DBG_RT
    if (dbg_stop == 6) {
            if (layer == dbg_layer && sub == dbg_sub) { dbg_dump_bf(args.out, (const bf16_t*)(ws + WS_W_QKV), (size_t)24 << 20, nullptr, 1, F.vcu, F.G); return; }
    }
#endif
        }
    }

#if DBG_RT
    if (dbg_stop == 11) {
    { const unsigned* xc = (const unsigned*)(ws + WS_CTL) + 8192; bool ok = true; for (int b = 0; b < (int)gridDim.x; ++b) ok = ok && (xc[b] == ((xc[0] + (unsigned)b) & 7u)); const float v = ok ? 0.0f : 0.26f; for (size_t j = (size_t)F.vcu * 512 + threadIdx.x; j < (size_t)MTOK * DM; j += (size_t)F.G * 512) args.out[j] = v; return; }
    }
#endif
#if DBG_RT
    if (dbg_stop == 9) {
    { const unsigned tmo = xb_ld((unsigned*)(ws + WS_CTL) + XB_TMO); const float v = tmo ? 0.26f : 0.0f; for (size_t j = (size_t)F.vcu * 512 + threadIdx.x; j < (size_t)MTOK * DM; j += (size_t)F.G * 512) args.out[j] = v; return; }
    }
#endif
#if (SITES >> 18) & 1
    final_norm(F, P);
#endif

#undef GRID_BAR
}

extern "C" void kernel_launch(void* const* d_in, const int* in_sizes, int n_in, void* d_out, int out_size, void* d_ws, size_t ws_size, hipStream_t stream) {
    static int grid = 0;
    if (grid == 0) {
        if (n_in != 28 || in_sizes[0] != MTOK * DM || out_size != MTOK * DM || ws_size < WS_END) {
            fprintf(stderr, "kernel_launch: built for 28 inputs, x/out of %d floats and >= %zu bytes of workspace; got n_in %d, in0 %d, out %d, ws %zu; nothing launched\n", MTOK * DM, (size_t)WS_END, n_in, n_in > 0 ? in_sizes[0] : -1, out_size, ws_size);
            grid = -1; return; }
        int dev = 0, cus = 0, per_cu = 0;
        if (hipGetDevice(&dev) != hipSuccess || hipDeviceGetAttribute(&cus, hipDeviceAttributeMultiprocessorCount, dev) != hipSuccess) { grid = -1; return; }
        if (hipFuncSetAttribute((const void*)mega_fwd, hipFuncAttributeMaxDynamicSharedMemorySize, LDS_BYTES) != hipSuccess) { fprintf(stderr, "kernel_launch: hipFuncSetAttribute failed\n"); grid = -1; return; }
        if (hipOccupancyMaxActiveBlocksPerMultiprocessor(&per_cu, (const void*)mega_fwd, 512, LDS_BYTES) != hipSuccess || per_cu < 1)
            fprintf(stderr, "kernel_launch: note: occupancy query reports %d workgroups per CU\n", per_cu);
        (void)hipGetLastError();
        grid = cus;
    }
    if (grid < 0) return;
    if (hipMemsetAsync((char*)d_ws + WS_CTL, 0, CTL_BYTES, stream) != hipSuccess) { fprintf(stderr, "kernel_launch: hipMemsetAsync failed\n"); return; }
    Args a{};
    for (int i = 0; i < 28; ++i) a.in[i] = (const float*)d_in[i];
    a.out = (float*)d_out; a.ws = (unsigned char*)d_ws;
    hipLaunchKernelGGL(mega_fwd, dim3(grid), dim3(512), LDS_BYTES, stream, a);
    const hipError_t le = hipPeekAtLastError();
    if (le != hipSuccess) fprintf(stderr, "kernel_launch: launch failed: %s\n", hipGetErrorName(le));
}
```
